# Optimizing an MI355X kernel written in HIP

```python
import math
import jax, jax.numpy as jnp
from jax import lax
import numpy as np

D_MODEL = 1024
BATCH = 16
SEQ = 2048
DEPTH = 2

N_A_LAYERS = DEPTH // 2
N_B_LAYERS = DEPTH - N_A_LAYERS

RET_HEADS = 4
RET_QK_DIM = D_MODEL // RET_HEADS
RET_V_DIM = 2 * RET_QK_DIM
RET_CHUNK = 128
ROPE_BASE = 10000.0

SB_HEADS = 16
SB_HEAD_DIM = D_MODEL // SB_HEADS
SB_BLOCK = 128

D_FF = ((8 * D_MODEL // 3 + 127) // 128) * 128
CONV_WIDTH = 3
EPS = 1e-6

kernel_name = 'yoco_retention_stickbreaking_convffn_adaln'


def rms_norm(x, gain):
    x32 = x.astype(jnp.float32)
    y = x32 * lax.rsqrt(jnp.mean(x32 * x32, axis=-1, keepdims=True) + EPS)
    return (y * gain.astype(jnp.float32)).astype(x.dtype)


def modulate(xn, shift, scale):
    return (xn * (1.0 + scale[:, None, :]) + shift[:, None, :]).astype(xn.dtype)


def rotary(x, positions):
    half = x.shape[-1] // 2
    inv = ROPE_BASE ** (-jnp.arange(half, dtype=jnp.float32) / half)
    ang = positions.astype(jnp.float32)[..., None] * inv
    cos = jnp.cos(ang)[:, :, None, :]
    sin = jnp.sin(ang)[:, :, None, :]
    x32 = x.astype(jnp.float32)
    x1, x2 = x32[..., :half], x32[..., half:]
    return jnp.concatenate([x1 * cos - x2 * sin, x1 * sin + x2 * cos], axis=-1)


def retention(h, positions, w_in, w_out):
    B, S, _ = h.shape
    H, dk, dv, C = RET_HEADS, RET_QK_DIM, RET_V_DIM, RET_CHUNK
    proj = h @ w_in
    q, k, v, g = jnp.split(proj, [H * dk, 2 * H * dk, 2 * H * dk + H * dv], axis=-1)
    q = rotary(q.reshape(B, S, H, dk), positions)
    k = rotary(k.reshape(B, S, H, dk), positions) * (dk ** -0.5)
    v = v.reshape(B, S, H, dv).astype(jnp.float32)
    log_gamma = jnp.log(1.0 - 2.0 ** (-5.0 - jnp.arange(H, dtype=jnp.float32)))
    N = S // C

    def to_chunks(t):
        d = t.shape[-1]
        return t.reshape(B, N, C, H, d).transpose(1, 0, 3, 2, 4)

    idx = jnp.arange(C, dtype=jnp.float32)
    rel = idx[:, None] - idx[None, :]
    intra = jnp.where(rel[None] >= 0, jnp.exp(jnp.maximum(rel, 0.0)[None] * log_gamma[:, None, None]), 0.0)
    q_decay = jnp.exp((idx + 1.0)[None, :] * log_gamma[:, None])
    k_decay = jnp.exp((C - 1.0 - idx)[None, :] * log_gamma[:, None])
    chunk_decay = jnp.exp(C * log_gamma)

    def step(state, xs):
        qc, kc, vc = xs
        scores = jnp.einsum('bhnd,bhmd->bhnm', qc, kc) * intra[None]
        inner = jnp.einsum('bhnm,bhmv->bhnv', scores, vc)
        cross = jnp.einsum('bhnd,bhdv->bhnv', qc * q_decay[None, :, :, None], state)
        state = state * chunk_decay[None, :, None, None] + jnp.einsum(
            'bhmd,bhmv->bhdv', kc * k_decay[None, :, :, None], vc)
        return state, inner + cross

    state0 = jnp.zeros((B, H, dk, dv), jnp.float32)
    _, o = lax.scan(step, state0, (to_chunks(q), to_chunks(k), to_chunks(v)))
    o = o.transpose(1, 0, 3, 2, 4).reshape(B, S, H, dv)
    o = o * lax.rsqrt(jnp.mean(o * o, axis=-1, keepdims=True) + EPS)
    o = o.reshape(B, S, H * dv).astype(h.dtype)
    return (jax.nn.silu(g) * o) @ w_out


def shared_kv(h, c_act, kv_ada_w, kv_ada_b, kv_norm_g, w_kv, k_norm_g):
    B, S, _ = h.shape
    shift, scale = jnp.split(c_act @ kv_ada_w + kv_ada_b, 2, axis=-1)
    hn = modulate(rms_norm(h, kv_norm_g), shift, scale)
    k, v = jnp.split(hn @ w_kv, 2, axis=-1)
    k = rms_norm(k.reshape(B, S, SB_HEADS, SB_HEAD_DIM), k_norm_g)
    v = v.reshape(B, S, SB_HEADS, SB_HEAD_DIM)
    return k.transpose(0, 2, 1, 3), v.transpose(0, 2, 1, 3)


def stick_breaking(h, k, v, w_q, q_gain, w_out):
    B, S, _ = h.shape
    H, dh, BLK = SB_HEADS, SB_HEAD_DIM, SB_BLOCK
    NB = S // BLK
    q = rms_norm((h @ w_q).reshape(B, S, H, dh), q_gain).transpose(0, 2, 1, 3)
    qb = q.reshape(B, H, NB, BLK, dh).transpose(2, 0, 1, 3, 4)
    k32 = k.astype(jnp.float32)
    v32 = v.astype(jnp.float32)
    kpos = jnp.arange(S)
    scale = dh ** -0.5

    def block(args):
        qblk, i = args
        qpos = i * BLK + jnp.arange(BLK)
        mask = kpos[None, :] < qpos[:, None]
        z = jnp.einsum('bhqd,bhkd->bhqk', qblk.astype(jnp.float32), k32) * scale
        log_beta = jax.nn.log_sigmoid(z)
        log_1mb = jnp.where(mask, log_beta - z, 0.0)
        between = lax.cumsum(log_1mb, axis=3, reverse=True) - log_1mb
        A = jnp.where(mask, jnp.exp(log_beta + between), 0.0)
        return jnp.einsum('bhqk,bhkd->bhqd', A, v32)

    o = lax.map(block, (qb, jnp.arange(NB)))
    o = o.transpose(1, 0, 3, 2, 4).reshape(B, S, H * dh).astype(h.dtype)
    return o @ w_out


def conv_ffn(h, w_in, conv_w, conv_b, w_out):
    S = h.shape[1]
    u = h @ w_in
    up = jnp.pad(u, ((0, 0), (CONV_WIDTH - 1, 0), (0, 0)))
    y = conv_b[None, None, :] + up[:, 0:S] * conv_w[0]
    for tap in range(1, CONV_WIDTH):
        y = y + up[:, tap:tap + S] * conv_w[tap]
    val, gate = jnp.split(y, 2, axis=-1)
    return (val * jax.nn.silu(gate)) @ w_out


def setup_inputs(seed: int = 0) -> dict:
    key = jax.random.key(seed)
    ks = jax.random.split(key, 24)
    D, F = D_MODEL, D_FF
    f32 = jnp.float32

    def nrm(k, shape, fan_in, mult=1.0):
        return jax.random.normal(k, shape, f32) * (mult * fan_in ** -0.5)

    def gain(k, shape):
        return 1.0 + 0.02 * jax.random.normal(k, shape, f32)

    ret_in_cols = 2 * RET_HEADS * RET_QK_DIM + 2 * RET_HEADS * RET_V_DIM
    offsets = jax.random.randint(ks[2], (BATCH, 1), 0, 1024, dtype=jnp.int32)
    positions = (offsets + jnp.arange(SEQ, dtype=jnp.int32)[None, :]).astype(jnp.int32)
    return {
        'x': jax.random.normal(ks[0], (BATCH, SEQ, D), f32),
        'c': jax.random.normal(ks[1], (BATCH, D), f32),
        'positions': positions,
        'ada_w': nrm(ks[3], (DEPTH, D, 6 * D), D, 0.5),
        'ada_b': 0.02 * jax.random.normal(ks[4], (DEPTH, 6 * D), f32),
        'norm_mix_g': gain(ks[5], (DEPTH, D)),
        'norm_ffn_g': gain(ks[6], (DEPTH, D)),
        'ret_w_in': nrm(ks[7], (N_A_LAYERS, D, ret_in_cols), D),
        'ret_w_out': nrm(ks[8], (N_A_LAYERS, RET_HEADS * RET_V_DIM, D), RET_HEADS * RET_V_DIM),
        'kv_ada_w': nrm(ks[9], (D, 2 * D), D, 0.5),
        'kv_ada_b': 0.02 * jax.random.normal(ks[10], (2 * D,), f32),
        'kv_norm_g': gain(ks[11], (D,)),
        'w_kv': nrm(ks[12], (D, 2 * D), D),
        'k_norm_g': gain(ks[13], (SB_HEAD_DIM,)),
        'sb_w_q': nrm(ks[14], (N_B_LAYERS, D, D), D),
        'q_norm_g': gain(ks[15], (N_B_LAYERS, SB_HEAD_DIM)),
        'sb_w_out': nrm(ks[16], (N_B_LAYERS, D, D), D),
        'ffn_w_in': nrm(ks[17], (DEPTH, D, 2 * F), D),
        'ffn_conv_w': nrm(ks[18], (DEPTH, CONV_WIDTH, 2 * F), CONV_WIDTH),
        'ffn_conv_b': 0.02 * jax.random.normal(ks[19], (DEPTH, 2 * F), f32),
        'ffn_w_out': nrm(ks[20], (DEPTH, F, D), F),
    }


def reference(x, c, positions, ada_w, ada_b, norm_mix_g, norm_ffn_g, ret_w_in, ret_w_out,
              kv_ada_w, kv_ada_b, kv_norm_g, w_kv, k_norm_g, sb_w_q, q_norm_g, sb_w_out,
              ffn_w_in, ffn_conv_w, ffn_conv_b, ffn_w_out):
    c_act = jax.nn.silu(c)
    mods = jnp.einsum('bd,lde->lbe', c_act, ada_w) + ada_b[:, None, :]
    h = x
    k_sh = None
    v_sh = None
    for layer in range(DEPTH):
        shift_m, scale_m, gate_m, shift_f, scale_f, gate_f = jnp.split(mods[layer], 6, axis=-1)
        hn = modulate(rms_norm(h, norm_mix_g[layer]), shift_m, scale_m)
        if layer < N_A_LAYERS:
            mix = retention(hn, positions, ret_w_in[layer], ret_w_out[layer])
        else:
            j = layer - N_A_LAYERS
            if j == 0:
                k_sh, v_sh = shared_kv(h, c_act, kv_ada_w, kv_ada_b, kv_norm_g, w_kv, k_norm_g)
            mix = stick_breaking(hn, k_sh, v_sh, sb_w_q[j], q_norm_g[j], sb_w_out[j])
        h = h + (gate_m[:, None, :] * mix).astype(h.dtype)
        hf = modulate(rms_norm(h, norm_ffn_g[layer]), shift_f, scale_f)
        ff = conv_ffn(hf, ffn_w_in[layer], ffn_conv_w[layer], ffn_conv_b[layer], ffn_w_out[layer])
        h = h + (gate_f[:, None, :] * ff).astype(h.dtype)
    return h
```

```cpp
#include <hip/hip_runtime.h>
#include <hip/hip_cooperative_groups.h>
#include <cstdio>
#include <cstdint>
namespace cg = cooperative_groups;
namespace pg8 {
#define PG8_LAS __attribute__((address_space(3)))
typedef unsigned short bf16_t;
typedef short bf16x8 __attribute__((ext_vector_type(8)));
typedef float f32x4 __attribute__((ext_vector_type(4)));
typedef unsigned u32x4 __attribute__((ext_vector_type(4)));
constexpr int BM = 256, BK = 64, HALF = 128, HTB = HALF * BK * 2  , STAGE_BYTES = 8 * HTB, NXCD = 8, WGM = 8;

__host__ __device__ __forceinline__ int lds_byte(int r, int c) { const int st = (r >> 4) * 2 + (c >> 5), rr = r & 15, cc = c & 31, ob = rr * 64 + cc * 2; return st * 1024 + (ob ^ (((ob >> 9) & 1) << 5)); }
__host__ __device__ __forceinline__ void stage_rc(int b, int& R, int& C) { const int st = b / 1024, sb = b % 1024, swz = sb ^ (((sb >> 9) & 1) << 5); R = (st >> 1) * 16 + swz / 64; C = (st & 1) * 32 + (swz % 64) / 2; }
__host__ __device__ __forceinline__ int perm32(int rho) { const int n = rho >> 4, i = rho & 15; return 8 * (i >> 2) + 4 * n + (i & 3); }

struct Unit { int pm, pn, kk; };
struct Gemm { const bf16_t* A; const bf16_t* Bt; int M, N, K, ld; };

struct StaticOrder {
    int nM, nN, nwg, G, c;
    __host__ __device__ void init(int M, int N, int G_, int c_) { nM = M / BM; nN = N / BM; nwg = nM * nN; G = G_; c = c_; }
    __host__ __device__ bool next(int i, Unit& u) const {
        const long L = (long)i * G + c; if (L >= nwg) return false;
        int wgid = (int)L; { const int q = nwg / NXCD, r = nwg % NXCD, xcd = wgid % NXCD, off = wgid / NXCD; wgid = (xcd < r ? xcd * (q + 1) : r * (q + 1) + (xcd - r) * q) + off; }
        const int nig = WGM * nN, gid = wgid / nig, fm = gid * WGM, gsz = (nM - fm) < WGM ? (nM - fm) : WGM;
        u.pm = fm + ((wgid % nig) % gsz); u.pn = (wgid % nig) / gsz; u.kk = 0; return true;
    }
    __device__ __forceinline__ void a_ready(const Unit&) const {}
    __device__ __forceinline__ void done(const Unit&) const {}
};

struct SegOrder : StaticOrder {
    __host__ __device__ bool next(int i, Unit& u) const { if (!StaticOrder::next(i >> 2, u)) return false; u.kk = i & 3; return true; }
};
typedef float f32x2 __attribute__((ext_vector_type(2)));
typedef __bf16 bf16x2_t __attribute__((ext_vector_type(2)));
constexpr float EPS = 1e-6f;
__device__ __forceinline__ unsigned pk_bf16(float lo, float hi) { f32x2 v = {lo, hi}; bf16x2_t b = __builtin_convertvector(v, bf16x2_t); return __builtin_bit_cast(unsigned, b); }
__device__ __forceinline__ u32x4 pk8(const f32x4 a, const f32x4 b) { u32x4 w; w.x = pk_bf16(a[0], a[1]); w.y = pk_bf16(a[2], a[3]); w.z = pk_bf16(b[0], b[1]); w.w = pk_bf16(b[2], b[3]); return w; }
__device__ __forceinline__ float silu_f(float x) { return x * __builtin_amdgcn_rcpf(1.f + __builtin_amdgcn_exp2f(-1.44269504089f * x)); }
__device__ __forceinline__ f32x4 silu4(f32x4 v) { f32x4 o; o[0] = silu_f(v[0]); o[1] = silu_f(v[1]); o[2] = silu_f(v[2]); o[3] = silu_f(v[3]); return o; }
__device__ __forceinline__ float dot4(const f32x4 a) { return (a[0] * a[0] + a[1] * a[1]) + (a[2] * a[2] + a[3] * a[3]); }
template <int CTRL> __device__ __forceinline__ float dppf(float old, float src) { return __builtin_bit_cast(float, __builtin_amdgcn_update_dpp(__builtin_bit_cast(int, old), __builtin_bit_cast(int, src), CTRL, 0xf, 0xf, false)); }


typedef const PG8_LAS unsigned long long* ptab_t;
enum { T_OUT = 21, T_WS = 22 };
__device__ __forceinline__ unsigned char* ldp(ptab_t tab, int k) { const unsigned long long v = tab[k]; const unsigned lo = __builtin_amdgcn_readfirstlane((unsigned)v), hi = __builtin_amdgcn_readfirstlane((unsigned)(v >> 32)); return (unsigned char*)(((unsigned long long)hi << 32) | lo); }
constexpr size_t MiB_ = 1u << 20;
constexpr int M_ = 32768;
constexpr size_t O_MODS = 65536, O_KVM = O_MODS + (size_t)2 * 16 * 6144 * 4, O_SW1 = O_KVM + (size_t)16 * 2048 * 4, O_SW3 = O_SW1 + (size_t)16 * 6144 * 4, O_SW5 = O_SW3 + (size_t)2 * 16 * 5632 * 4,
                 O_SW6 = O_SW5 + (size_t)16 * 2048 * 4, O_SS = O_SW6 + (size_t)16 * 1024 * 4, O_SSO = O_SS + (size_t)4 * M_ * 4, O_SMALL_END = O_SSO + (size_t)M_ * 4 * 4;
constexpr size_t O_A = 64 * MiB_, O_BIG = 128 * MiB_, O_Q = O_BIG, O_KD = O_BIG + 64 * MiB_, O_V = O_BIG + 128 * MiB_, O_SG = O_BIG + 256 * MiB_;
constexpr size_t O_ACT = O_BIG, O_HF = O_BIG + 176 * MiB_, O_HL = O_HF + 22 * MiB_, O_AM1 = O_BIG + 220 * MiB_, O_KN = O_BIG, O_VT = O_BIG + 64 * MiB_, O_QN = O_BIG + 128 * MiB_, O_OSB = O_BIG + 284 * MiB_;

struct EpiRetIn {
    static constexpr bool PERM = true, AFTER_DRAIN = false, SEG = false;
    ptab_t tab;
    __device__ __forceinline__ void operator()(f32x4 (&acc)[2][2][4][2], const Unit& u, int wr, int wc, int, int) const {
        int lane_ = threadIdx.x & 63; asm volatile("" : "+v"(lane_)); const int fr = lane_ & 15, fq = lane_ >> 4;
        unsigned char* ws = ldp(tab, T_WS); const int* pos = (const int*)ldp(tab, 2);
        const float* ss = (const float*)(ws + O_SS); const float* sW = (const float*)(ws + O_SW1);
        bf16_t* Q = (bf16_t*)(ws + O_Q); bf16_t* KD = (bf16_t*)(ws + O_KD); bf16_t* V = (bf16_t*)(ws + O_V); bf16_t* SG = (bf16_t*)(ws + O_SG);
        const int b = u.pm >> 3, cl = wc * 32 + 8 * fq, row0 = u.pm * BM + wr * 64 + fr;
        f32x4 sw[2][2];
#pragma unroll
        for (int bj = 0; bj < 2; ++bj)
#pragma unroll
            for (int n = 0; n < 2; ++n) sw[bj][n] = *(const f32x4*)(sW + b * 6144 + u.pn * 256 + bj * 128 + cl + 4 * n);
        if (u.pn < 8) {
            const bool isk = u.pn >= 4; const int h = u.pn & 3;
            bf16_t* dst = (isk ? KD : Q) + h * 256 + cl;
            float inv[8];
#pragma unroll
            for (int i = 0; i < 8; ++i) inv[i] = __builtin_amdgcn_exp2f(-(float)(cl + i) * 0.10381025296523f) * 0.15915494309189535f;
            const float lg = __builtin_amdgcn_logf(1.f - __builtin_amdgcn_exp2f(-5.f - (float)h));
#pragma unroll
            for (int ai = 0; ai < 2; ++ai)
#pragma unroll
                for (int m = 0; m < 4; ++m) {
                    const int row = row0 + ai * HALF + m * 16;
                    const float p = (float)pos[row], rs = __builtin_amdgcn_rsqf(ss[row] * (1.f / 1024.f) + EPS);
                    const float ksc = isk ? 0.0625f * __builtin_amdgcn_exp2f(lg * (float)(63 - (row & 63))) : 1.f;
                    f32x4 o1[2], o2[2];
#pragma unroll
                    for (int n = 0; n < 2; ++n)
#pragma unroll
                        for (int e = 0; e < 4; ++e) {
                            const float x1 = acc[ai][0][m][n][e] * rs + sw[0][n][e], x2 = acc[ai][1][m][n][e] * rs + sw[1][n][e];
                            const float r = __builtin_amdgcn_fractf(p * inv[4 * n + e]);
                            const float s = __builtin_amdgcn_sinf(r), c = __builtin_amdgcn_cosf(r);
                            o1[n][e] = (x1 * c - x2 * s) * ksc; o2[n][e] = (x1 * s + x2 * c) * ksc;
                        }
                    *(u32x4*)(dst + (size_t)row * 1024) = pk8(o1[0], o1[1]);
                    *(u32x4*)(dst + (size_t)row * 1024 + 128) = pk8(o2[0], o2[1]);
                }
        } else {
            const bool isg = u.pn >= 16;
            bf16_t* dst = (isg ? SG : V) + ((u.pn - 8) & 7) * 256 + cl;
#pragma unroll
            for (int ai = 0; ai < 2; ++ai)
#pragma unroll
                for (int m = 0; m < 4; ++m) {
                    const int row = row0 + ai * HALF + m * 16;
                    const float rs = __builtin_amdgcn_rsqf(ss[row] * (1.f / 1024.f) + EPS);
#pragma unroll
                    for (int bj = 0; bj < 2; ++bj) {
                        f32x4 v0 = acc[ai][bj][m][0] * rs + sw[bj][0], v1 = acc[ai][bj][m][1] * rs + sw[bj][1];
                        if (isg) { v0 = silu4(v0); v1 = silu4(v1); }
                        *(u32x4*)(dst + (size_t)row * 2048 + bj * HALF) = pk8(v0, v1);
                    }
                }
        }
    }
};

template <int WHICH> struct EpiRes {
    static constexpr int NOUT = (WHICH == 1) ? 2 : (WHICH == 3 ? 0 : 1);
    static constexpr bool HOOK = (WHICH == 0), SSACC = (WHICH != 3);
    static constexpr bool PERM = true, AFTER_DRAIN = false, SEG = HOOK;
    ptab_t tab;
    __device__ __forceinline__ void seg(f32x4 (&acc)[2][2][4][2], int kk, int tile, int wr) const {
        int lane_ = threadIdx.x & 63; asm volatile("" : "+v"(lane_)); const int fr = lane_ & 15;
        const PG8_LAS float* tb = (const PG8_LAS float*)((const PG8_LAS unsigned char*)tab - 64 - (147456 - 512) + 131072) + (tile * 256 + wr * 64 + fr) * 4 + kk;
#pragma unroll
        for (int ai = 0; ai < 2; ++ai)
#pragma unroll
            for (int m = 0; m < 4; ++m) {
                const float ratio = tb[(ai * HALF + m * 16) * 4];
#pragma unroll
                for (int bj = 0; bj < 2; ++bj)
#pragma unroll
                    for (int n = 0; n < 2; ++n) acc[ai][bj][m][n] *= ratio;
            }
    }
    __device__ __forceinline__ void operator()(f32x4 (&acc)[2][2][4][2], const Unit& u, int wr, int wc, int, int) const {
        int lane_ = threadIdx.x & 63; asm volatile("" : "+v"(lane_)); const int fr = lane_ & 15, fq = lane_ >> 4;
        unsigned char* ws = ldp(tab, T_WS); float* hout = (float*)ldp(tab, T_OUT);
        const float* mods = (const float*)(ws + O_MODS);
        const float* hin = (WHICH == 0) ? (const float*)ldp(tab, 0) : hout;
        const float* gate = mods + (WHICH >= 2 ? 16 * 6144 : 0) + ((WHICH == 0 || WHICH == 2) ? 2048 : 5120);
        const float* g0 = nullptr; const float* sc0 = nullptr; int st0 = 6144; bf16_t* o0 = (bf16_t*)(ws + O_A);
        const float* g1 = nullptr; const float* sc1 = nullptr; const int st1 = 6144; bf16_t* o1 = (bf16_t*)(ws + O_AM1);
        if (WHICH == 0) { g0 = (const float*)ldp(tab, 6); sc0 = mods + 4096; }
        if (WHICH == 1) { g0 = (const float*)ldp(tab, 11); sc0 = (const float*)(ws + O_KVM) + 1024; st0 = 2048; g1 = (const float*)ldp(tab, 5) + 1024; sc1 = mods + 16 * 6144 + 1024; }
        if (WHICH == 2) { g0 = (const float*)ldp(tab, 6) + 1024; sc0 = mods + 16 * 6144 + 4096; }
        float* ss = (float*)(ws + O_SS) + (WHICH + 1) * M_;
        const int b = u.pm >> 3, cl = wc * 32 + 8 * fq, row0 = u.pm * BM + wr * 64 + fr;
        f32x4 gt[2][2], gs0[2][2], gs1[2][2];
#pragma unroll
        for (int bj = 0; bj < 2; ++bj)
#pragma unroll
            for (int n = 0; n < 2; ++n) {
                const int col = u.pn * BM + bj * HALF + cl + 4 * n;
                gt[bj][n] = *(const f32x4*)(gate + b * 6144 + col);
                if (NOUT >= 1) gs0[bj][n] = *(const f32x4*)(g0 + col) * (*(const f32x4*)(sc0 + b * st0 + col) + 1.f);
                if (NOUT >= 2) gs1[bj][n] = *(const f32x4*)(g1 + col) * (*(const f32x4*)(sc1 + b * st1 + col) + 1.f);
            }
#pragma unroll
        for (int ai = 0; ai < 2; ++ai)
#pragma unroll
            for (int m = 0; m < 4; ++m) {
                const int row = row0 + ai * HALF + m * 16;
                const float rs = 1.f;
                float sq = 0.f;
#pragma unroll
                for (int bj = 0; bj < 2; ++bj) {
                    const size_t off = (size_t)row * 1024 + u.pn * BM + bj * HALF + cl;
                    f32x4 h0 = *(const f32x4*)(hin + off), h1 = *(const f32x4*)(hin + off + 4);
                    h0 += gt[bj][0] * (acc[ai][bj][m][0] * rs); h1 += gt[bj][1] * (acc[ai][bj][m][1] * rs);
                    *(f32x4*)(hout + off) = h0; *(f32x4*)(hout + off + 4) = h1;
                    if (SSACC) sq += dot4(h0) + dot4(h1);
                    if (NOUT >= 1) *(u32x4*)(o0 + off) = pk8(h0 * gs0[bj][0], h1 * gs0[bj][1]);
                    if (NOUT >= 2) *(u32x4*)(o1 + off) = pk8(h0 * gs1[bj][0], h1 * gs1[bj][1]);
                }
                if (SSACC) { sq += __shfl_xor(sq, 16); sq += __shfl_xor(sq, 32); if (fq == 0) atomicAdd(ss + row, sq); }
            }
    }
};

struct EpiFfnIn {
    static constexpr bool PERM = true, AFTER_DRAIN = false, SEG = false;
    ptab_t tab; int l;
    __device__ __forceinline__ void operator()(f32x4 (&acc)[2][2][4][2], const Unit& u, int wr, int wc, int, int) const {
        int lane_ = threadIdx.x & 63; asm volatile("" : "+v"(lane_)); const int fr = lane_ & 15, fq = lane_ >> 4;
        unsigned char* ws = ldp(tab, T_WS);
        const float* ss = (const float*)(ws + O_SS) + (l == 0 ? 1 : 3) * M_; const float* sW = (const float*)(ws + O_SW3) + l * 16 * 5632;
        const float* cw = (const float*)ldp(tab, 18) + l * 3 * 5632; const float* cb = (const float*)ldp(tab, 19) + l * 5632;
        bf16_t* ACT = (bf16_t*)(ws + O_ACT); float* HF = (float*)(ws + O_HF); float* HL = (float*)(ws + O_HL);
        const int b = u.pm >> 3, cl = wc * 32 + 8 * fq, row0 = u.pm * BM + wr * 64 + fr, ch = u.pn * HALF + cl;
        {
            f32x4 sw[2][2];
#pragma unroll
            for (int bj = 0; bj < 2; ++bj)
#pragma unroll
                for (int n = 0; n < 2; ++n) sw[bj][n] = *(const f32x4*)(sW + b * 5632 + u.pn * BM + bj * HALF + cl + 4 * n);
#pragma unroll
            for (int ai = 0; ai < 2; ++ai)
#pragma unroll
                for (int m = 0; m < 4; ++m) {
                    const float rs = __builtin_amdgcn_rsqf(ss[row0 + ai * HALF + m * 16] * (1.f / 1024.f) + EPS);
#pragma unroll
                    for (int bj = 0; bj < 2; ++bj)
#pragma unroll
                        for (int n = 0; n < 2; ++n) acc[ai][bj][m][n] = acc[ai][bj][m][n] * rs + sw[bj][n];
                }
        }
#pragma unroll
        for (int ai = 0; ai < 2; ++ai) {
            const int blk = u.pm * 4 + ai * 2 + wr;
            if (fr < 2) {
                float* d = HF + (size_t)(blk * 2 + fr) * 5632 + u.pn * BM + cl;
#pragma unroll
                for (int bj = 0; bj < 2; ++bj)
#pragma unroll
                    for (int n = 0; n < 2; ++n) *(f32x4*)(d + bj * HALF + 4 * n) = acc[ai][bj][0][n];
            }
            if (fr >= 14) {
                float* d = HL + (size_t)(blk * 2 + fr - 14) * 5632 + u.pn * BM + cl;
#pragma unroll
                for (int bj = 0; bj < 2; ++bj)
#pragma unroll
                    for (int n = 0; n < 2; ++n) *(f32x4*)(d + bj * HALF + 4 * n) = acc[ai][bj][3][n];
            }
        }
#pragma unroll
        for (int bj = 0; bj < 2; ++bj)
#pragma unroll
            for (int n = 0; n < 2; ++n) {
                const int colo = bj * 2816 + ch + 4 * n;
                f32x4 w0 = *(const f32x4*)(cw + colo), w1 = *(const f32x4*)(cw + 5632 + colo), w2 = *(const f32x4*)(cw + 2 * 5632 + colo), bb = *(const f32x4*)(cb + colo);
                asm volatile("" : "+v"(w0), "+v"(w1), "+v"(w2), "+v"(bb));
#pragma unroll
                for (int ai = 0; ai < 2; ++ai)
#pragma unroll
                    for (int m = 3; m >= 0; --m) {
                        f32x4 x = acc[ai][bj][m][n]; asm volatile("" : "+v"(x));
                        f32x4 q1 = (f32x4){0.f, 0.f, 0.f, 0.f}, q2 = q1;
                        if (m > 0) { f32x4 xp = acc[ai][bj][m - 1][n]; asm volatile("" : "+v"(xp));
#pragma unroll
                            for (int e = 0; e < 4; ++e) { q1[e] = dppf<0x121>(0.f, xp[e]); q2[e] = dppf<0x122>(0.f, xp[e]); } }
                        f32x4 y;
#pragma unroll
                        for (int e = 0; e < 4; ++e) { const float p1 = dppf<0x111>(q1[e], x[e]), p2 = dppf<0x112>(q2[e], x[e]);
                            y[e] = bb[e] + w2[e] * x[e] + w1[e] * p1 + w0[e] * p2; }
                        asm volatile("" : "+v"(y));
                        acc[ai][bj][m][n] = y;
                    }
            }
#pragma unroll
        for (int ai = 0; ai < 2; ++ai)
#pragma unroll
            for (int m = 0; m < 4; ++m) {
                const int row = row0 + ai * HALF + m * 16;
                const f32x4 v0 = acc[ai][0][m][0] * silu4(acc[ai][1][m][0]), v1 = acc[ai][0][m][1] * silu4(acc[ai][1][m][1]);
                if (m > 0 || fr >= 2) *(u32x4*)(ACT + (size_t)row * 2816 + ch) = pk8(v0, v1);
            }
    }
};

template <int MODE> struct EpiKVQ {
    static constexpr bool PERM = true, AFTER_DRAIN = false, SEG = false;
    ptab_t tab;
    __device__ __forceinline__ void operator()(f32x4 (&acc)[2][2][4][2], const Unit& u, int wr, int wc, int, int) const {
        int lane_ = threadIdx.x & 63; asm volatile("" : "+v"(lane_)); const int fr = lane_ & 15, fq = lane_ >> 4;
        unsigned char* ws = ldp(tab, T_WS);
        const float* ss = (const float*)(ws + O_SS) + 2 * M_; const float* sW = (const float*)(ws + (MODE == 0 ? O_SW5 : O_SW6)); constexpr int nW = (MODE == 0) ? 2048 : 1024;
        const float* gain = (const float*)ldp(tab, MODE == 0 ? 13 : 15); bf16_t* DN = (bf16_t*)(ws + (MODE == 0 ? O_KN : O_QN)); bf16_t* VT = (bf16_t*)(ws + O_VT);
        const int b = u.pm >> 3, row0 = u.pm * BM + wr * 64 + fr, head = 4 * (u.pn & 3) + wc, dl = 8 * fq;
        f32x4 sw[2][2];
#pragma unroll
        for (int bj = 0; bj < 2; ++bj)
#pragma unroll
            for (int n = 0; n < 2; ++n) sw[bj][n] = *(const f32x4*)(sW + b * nW + u.pn * BM + bj * HALF + wc * 32 + dl + 4 * n);
        const bool isv = (MODE == 0) && (u.pn >= 4);
        if (!isv) {
            f32x4 gn[2][2];
#pragma unroll
            for (int bj = 0; bj < 2; ++bj)
#pragma unroll
                for (int n = 0; n < 2; ++n) gn[bj][n] = *(const f32x4*)(gain + 32 * bj + dl + 4 * n) * (MODE == 1 ? 0.125f : 1.f);
#pragma unroll
            for (int ai = 0; ai < 2; ++ai)
#pragma unroll
                for (int m = 0; m < 4; ++m) {
                    const int row = row0 + ai * HALF + m * 16;
                    const float rs = __builtin_amdgcn_rsqf(ss[row] * (1.f / 1024.f) + EPS);
                    f32x4 v[2][2]; float sq = 0.f;
#pragma unroll
                    for (int bj = 0; bj < 2; ++bj)
#pragma unroll
                        for (int n = 0; n < 2; ++n) { v[bj][n] = acc[ai][bj][m][n] * rs + sw[bj][n]; sq += dot4(v[bj][n]); }
                    sq += __shfl_xor(sq, 16); sq += __shfl_xor(sq, 32);
                    const float rh = __builtin_amdgcn_rsqf(sq * (1.f / 64.f) + EPS);
#pragma unroll
                    for (int bj = 0; bj < 2; ++bj) *(u32x4*)(DN + (size_t)row * 1024 + head * 64 + 32 * bj + dl) = pk8(v[bj][0] * gn[bj][0] * rh, v[bj][1] * gn[bj][1] * rh);
                }
        } else {
            bf16_t* vt = VT + (size_t)(b * 16 + head) * 64 * 2048;
#pragma unroll
            for (int ai = 0; ai < 2; ++ai)
#pragma unroll
                for (int m = 0; m < 4; ++m) {
                    const int row = row0 + ai * HALF + m * 16, s = row & 2047;
                    const float rs = __builtin_amdgcn_rsqf(ss[row] * (1.f / 1024.f) + EPS);
#pragma unroll
                    for (int bj = 0; bj < 2; ++bj)
#pragma unroll
                        for (int n = 0; n < 2; ++n) {
                            const f32x4 v = acc[ai][bj][m][n] * rs + sw[bj][n];
#pragma unroll
                            for (int e = 0; e < 4; e += 2) { const unsigned w = pk_bf16(v[e], v[e + 1]); const int d = 32 * bj + dl + 4 * n + e;
                                vt[(size_t)d * 2048 + s] = (bf16_t)(w & 0xffffu); vt[(size_t)(d + 1) * 2048 + s] = (bf16_t)(w >> 16); }
                        }
                }
        }
    }
};
template <class Epi, class Sched, bool ALIGN_EPI = false, bool SP2 = false>
__device__ __forceinline__ void gemm_phase(PG8_LAS unsigned char* lds, const Gemm g, const Sched& S, const Epi& E) {
    const int tid = threadIdx.x, wid = __builtin_amdgcn_readfirstlane(tid >> 6), lane = tid & 63, wr = wid >> 2, wc = wid & 3, fr = lane & 15, fq = lane >> 4;
    const int K = g.ld, nt = g.K / BK;
    unsigned voffA[2], voffB[2];
#pragma unroll
    for (int i = 0; i < 2; ++i) { int R, C; stage_rc(tid * 16 + i * 8192, R, C); const int Rb = Epi::PERM ? ((R & ~31) + perm32(R & 31)) : R;
        voffA[i] = (unsigned)(R * K + C) * 2u; voffB[i] = (unsigned)(Rb * K + C) * 2u; }
    const size_t kstep = (size_t)(BK * 2);
    const size_t hstep = (size_t)HALF * K * 2;
    const size_t tstep = 2 * hstep;
    const unsigned ldsw = (unsigned)wid * 1024u;
    const int aoff = lds_byte(wr * 64 + fr, fq * 8), boff = lds_byte(wc * 32 + fr, fq * 8);
#define PG8_SA(b, h) (((b) * 2 + (h)) * HTB)
#define PG8_SB(b, h) ((4 + (b) * 2 + (h)) * HTB)
#define PG8_STAGE(bufoff, gbase, voff) do { _Pragma("unroll") for (int _i = 0; _i < 2; ++_i) \
        __builtin_amdgcn_global_load_lds((const unsigned*)((const char*)(gbase) + (voff)[_i]), (PG8_LAS unsigned*)(lds + (bufoff) + ldsw + _i * 8192), 16, 0, 0); } while (0)
#define PG8_LDA(dst, b, h) do { _Pragma("unroll") for (int m = 0; m < 4; ++m) _Pragma("unroll") for (int k = 0; k < 2; ++k) dst[m][k] = *(const PG8_LAS bf16x8*)(lds + PG8_SA(b, h) + aoff + m * 2048 + k * 1024); } while (0)
#define PG8_LDB(dst, b, h) do { _Pragma("unroll") for (int n = 0; n < 2; ++n) _Pragma("unroll") for (int k = 0; k < 2; ++k) dst[n][k] = *(const PG8_LAS bf16x8*)(lds + PG8_SB(b, h) + boff + n * 2048 + k * 1024); } while (0)
#define PG8_MMA(ai, bj, At, Bt) do { __builtin_amdgcn_s_setprio(1); _Pragma("unroll") for (int m = 0; m < 4; ++m) _Pragma("unroll") for (int n = 0; n < 2; ++n) _Pragma("unroll") for (int k = 0; k < 2; ++k) \
        acc[ai][bj][m][n] = __builtin_amdgcn_mfma_f32_16x16x32_bf16(Bt[n][k], At[m][k], acc[ai][bj][m][n], 0, 0, 0); __builtin_amdgcn_s_setprio(0); } while (0)
#define PG8_WAIT_V(n) asm volatile("s_waitcnt vmcnt(" #n ")" ::: "memory")
#define PG8_WAIT_L(n) asm volatile("s_waitcnt lgkmcnt(" #n ")" ::: "memory")
#define PG8_BAR __builtin_amdgcn_s_barrier()
#define PG8_SCHED __builtin_amdgcn_sched_barrier(0)
    Unit cur, nxt; int ui = 0;
    if (!S.next(0, cur)) return;
    f32x4 acc[2][2][4][2];
#pragma unroll
    for (int a = 0; a < 2; ++a)
#pragma unroll
        for (int b = 0; b < 2; ++b)
#pragma unroll
            for (int m = 0; m < 4; ++m)
#pragma unroll
                for (int n = 0; n < 2; ++n) acc[a][b][m][n] = (f32x4){0.f, 0.f, 0.f, 0.f};
    bf16x8 At[4][2], B0[2][2], B1[2][2];
    const size_t sstep = (size_t)g.K * 2;
    const char* cA = (const char*)g.A + (size_t)cur.pm * tstep + cur.kk * sstep; const char* cB = (const char*)g.Bt + (size_t)cur.pn * tstep + cur.kk * sstep;
    S.a_ready(cur);
    if constexpr (SP2) {
        PG8_STAGE(PG8_SB(0, 0), cB, voffB); PG8_STAGE(PG8_SB(0, 1), cB + hstep, voffB); PG8_STAGE(PG8_SA(0, 0), cA, voffA); PG8_STAGE(PG8_SA(0, 1), cA + hstep, voffA);
        if (wr == 1) PG8_BAR;
        PG8_WAIT_V(2); PG8_BAR;
        PG8_STAGE(PG8_SB(1, 0), cB + kstep, voffB); PG8_STAGE(PG8_SA(1, 0), cA + kstep, voffA); PG8_STAGE(PG8_SB(1, 1), cB + hstep + kstep, voffB);
        PG8_WAIT_V(6); PG8_BAR;
    } else {
        PG8_STAGE(PG8_SB(0, 0), cB, voffB); PG8_STAGE(PG8_SA(0, 0), cA, voffA); PG8_STAGE(PG8_SB(0, 1), cB + hstep, voffB); PG8_STAGE(PG8_SA(0, 1), cA + hstep, voffA);
        if (wr == 1) PG8_BAR;
        PG8_WAIT_V(4); PG8_BAR;
        PG8_STAGE(PG8_SB(1, 0), cB + kstep, voffB); PG8_STAGE(PG8_SA(1, 0), cA + kstep, voffA); PG8_STAGE(PG8_SB(1, 1), cB + hstep + kstep, voffB);
        PG8_WAIT_V(6); PG8_BAR;
    }
    for (;;) {
        const bool has_next = S.next(ui + 1, nxt);
        const char* nA = has_next ? (const char*)g.A + (size_t)nxt.pm * tstep + nxt.kk * sstep : cA; const char* nB = has_next ? (const char*)g.Bt + (size_t)nxt.pn * tstep + nxt.kk * sstep : cB;
        for (int t = 0; t < nt; t += 2) {
            const bool last = (t == nt - 2);
            const char* a1 = cA + (size_t)(t + 1) * kstep;
            const char* a2 = last ? nA : cA + (size_t)(t + 2) * kstep; const char* b2 = last ? nB : cB + (size_t)(t + 2) * kstep;
            const char* a3 = a2 + kstep; const char* b3 = b2 + kstep;
            if (last && has_next) S.a_ready(nxt);
            if constexpr (SP2) {
            PG8_LDB(B0, 0, 0); PG8_LDB(B1, 0, 1); PG8_SCHED; PG8_LDA(At, 0, 0); PG8_STAGE(PG8_SA(1, 1), a1 + hstep, voffA);
            PG8_WAIT_V(8); PG8_WAIT_L(0); PG8_BAR; PG8_MMA(0, 0, At, B0); PG8_MMA(0, 1, At, B1); PG8_BAR; PG8_SCHED;
            PG8_LDA(At, 0, 1); PG8_STAGE(PG8_SB(0, 0), b2, voffB); PG8_STAGE(PG8_SB(0, 1), b2 + hstep, voffB); PG8_STAGE(PG8_SA(0, 0), a2, voffA);
            PG8_WAIT_V(8); PG8_WAIT_L(0); PG8_BAR; PG8_MMA(1, 0, At, B0); PG8_MMA(1, 1, At, B1); PG8_BAR; PG8_SCHED;
            PG8_LDB(B0, 1, 0); PG8_LDB(B1, 1, 1); PG8_SCHED; PG8_LDA(At, 1, 0); PG8_STAGE(PG8_SA(0, 1), a2 + hstep, voffA);
            PG8_WAIT_V(8); PG8_WAIT_L(0); PG8_BAR; PG8_MMA(0, 0, At, B0); PG8_MMA(0, 1, At, B1); PG8_BAR; PG8_SCHED;
            PG8_LDA(At, 1, 1); PG8_STAGE(PG8_SB(1, 0), b3, voffB); PG8_STAGE(PG8_SB(1, 1), b3 + hstep, voffB); PG8_STAGE(PG8_SA(1, 0), a3, voffA);
            PG8_WAIT_V(8); PG8_WAIT_L(0); PG8_BAR; PG8_MMA(1, 0, At, B0); PG8_MMA(1, 1, At, B1); PG8_BAR; PG8_SCHED;
            } else {
            PG8_LDB(B0, 0, 0); PG8_SCHED; PG8_LDA(At, 0, 0); PG8_STAGE(PG8_SA(1, 1), a1 + hstep, voffA);
            PG8_WAIT_L(8); PG8_BAR; PG8_WAIT_L(0); PG8_MMA(0, 0, At, B0); PG8_BAR; PG8_SCHED;
            PG8_LDB(B1, 0, 1); PG8_STAGE(PG8_SB(0, 0), b2, voffB);
            PG8_BAR; PG8_WAIT_L(0); PG8_MMA(0, 1, At, B1); PG8_BAR;
            PG8_LDA(At, 0, 1); PG8_STAGE(PG8_SA(0, 0), a2, voffA);
            PG8_BAR; PG8_WAIT_L(0); PG8_MMA(1, 0, At, B0); PG8_BAR; PG8_SCHED;
            PG8_STAGE(PG8_SB(0, 1), b2 + hstep, voffB);
            PG8_WAIT_V(6); PG8_BAR; PG8_MMA(1, 1, At, B1); PG8_BAR;
            PG8_LDB(B0, 1, 0); PG8_SCHED; PG8_LDA(At, 1, 0); PG8_STAGE(PG8_SA(0, 1), a2 + hstep, voffA);
            PG8_WAIT_L(8); PG8_BAR; PG8_WAIT_L(0); PG8_MMA(0, 0, At, B0); PG8_BAR; PG8_SCHED;
            PG8_LDB(B1, 1, 1); PG8_STAGE(PG8_SB(1, 0), b3, voffB);
            PG8_BAR; PG8_WAIT_L(0); PG8_MMA(0, 1, At, B1); PG8_BAR;
            PG8_LDA(At, 1, 1); PG8_STAGE(PG8_SA(1, 0), a3, voffA);
            PG8_BAR; PG8_WAIT_L(0); PG8_MMA(1, 0, At, B0); PG8_BAR; PG8_SCHED;
            PG8_STAGE(PG8_SB(1, 1), b3 + hstep, voffB);
            PG8_WAIT_V(6); PG8_BAR; PG8_MMA(1, 1, At, B1); PG8_BAR;
            }
        }
        if constexpr (ALIGN_EPI) { if (wr == 0) PG8_BAR; }
        if constexpr (Epi::SEG) E.seg(acc, cur.kk, ui >> 2, wr);
        if (!Epi::SEG || cur.kk == 3) {
            if constexpr (!Epi::AFTER_DRAIN) { E(acc, cur, wr, wc, fr, fq); S.done(cur); }
            if (!has_next) break;
#pragma unroll
            for (int a = 0; a < 2; ++a)
#pragma unroll
                for (int b = 0; b < 2; ++b)
#pragma unroll
                    for (int m = 0; m < 4; ++m)
#pragma unroll
                        for (int n = 0; n < 2; ++n) acc[a][b][m][n] = (f32x4){0.f, 0.f, 0.f, 0.f};
        }
        cur = nxt; cA = nA; cB = nB; ++ui;
        if constexpr (ALIGN_EPI) { if (wr == 1) PG8_BAR; }
    }
    PG8_WAIT_V(0);
    if constexpr (!ALIGN_EPI) { if (wr == 0) PG8_BAR; }
    PG8_BAR;
    if constexpr (Epi::AFTER_DRAIN) { E.fused(acc, cur, wr, wc, fr, fq, lds, wid, lane); S.done(cur); }
#undef PG8_SA
#undef PG8_SB
#undef PG8_STAGE
#undef PG8_LDA
#undef PG8_LDB
#undef PG8_MMA
#undef PG8_WAIT_V
#undef PG8_WAIT_L
#undef PG8_BAR
#undef PG8_SCHED
}
}

#define LAS __attribute__((address_space(3)))
typedef unsigned short bf16;
typedef float f32x4 __attribute__((ext_vector_type(4)));
typedef float f32x16 __attribute__((ext_vector_type(16)));
typedef short bf16x8 __attribute__((ext_vector_type(8)));
typedef short s16x4 __attribute__((ext_vector_type(4)));
typedef unsigned u32x4 __attribute__((ext_vector_type(4)));
typedef unsigned u32x2 __attribute__((ext_vector_type(2)));
using pg8::pk_bf16; using pg8::EPS;

#ifndef MK_ONE_LAUNCH
#define MK_ONE_LAUNCH 0
#endif
constexpr int NWAVES = 8, NTHREADS = 512;
constexpr int NB = 16, SEQ = 2048, D = 1024, M = NB * SEQ, FF = 2816, FF2 = 5632, RN = 6144;
constexpr int NPHASE = 14;

constexpr size_t MiB = 1u << 20;
constexpr size_t WS_CTL = 0;
constexpr size_t WS_MODS = pg8::O_MODS, WS_KVM = pg8::O_KVM, WS_SW1 = pg8::O_SW1, WS_SW3 = pg8::O_SW3, WS_SW5 = pg8::O_SW5, WS_SW6 = pg8::O_SW6, WS_SS = pg8::O_SS, WS_SSO = pg8::O_SSO;
static_assert(pg8::O_SMALL_END <= 6 * MiB && pg8::M_ == M, "small region");
constexpr size_t WS_WT1 = 6 * MiB;
constexpr size_t WS_WT2 = WS_WT1 + (size_t)6144 * 1024 * 2;
constexpr size_t WS_WT3 = WS_WT2 + (size_t)1024 * 2048 * 2;
constexpr size_t WS_WT4 = WS_WT3 + (size_t)2 * 5632 * 1024 * 2;
constexpr size_t WS_WT5 = WS_WT4 + (size_t)2 * 1024 * 2816 * 2;
constexpr size_t WS_WT6 = WS_WT5 + (size_t)2048 * 1024 * 2;
constexpr size_t WS_WT7 = WS_WT6 + (size_t)1024 * 1024 * 2;
static_assert(WS_WT7 + (size_t)1024 * 1024 * 2 <= 64 * MiB, "weights region");
constexpr size_t WS_A = pg8::O_A, WS_Q = pg8::O_Q, WS_KD = pg8::O_KD, WS_V = pg8::O_V, WS_SG = pg8::O_SG, WS_ACT = pg8::O_ACT, WS_HF = pg8::O_HF, WS_HL = pg8::O_HL, WS_AM1 = pg8::O_AM1,
                 WS_KN = pg8::O_KN, WS_VT = pg8::O_VT, WS_QN = pg8::O_QN, WS_OSB = pg8::O_OSB;
constexpr size_t WS_END = 512 * MiB;
static_assert((size_t)512 * 2 * 5632 * 4 <= 22 * MiB && WS_HL + 22 * MiB <= WS_AM1 && WS_AM1 + 64 * MiB <= WS_OSB && WS_OSB + 64 * MiB <= WS_END && WS_ACT + (size_t)M * FF * 2 <= WS_HF, "big region");

constexpr int LDS_BYTES = 147456;
constexpr int MISC_OFF = LDS_BYTES - 512;
using pg8::ptab_t; using pg8::ldp; using pg8::T_OUT; using pg8::T_WS;

#define LBAR() do { asm volatile("s_waitcnt lgkmcnt(0)" ::: "memory"); __builtin_amdgcn_s_barrier(); asm volatile("" ::: "memory"); } while (0)

#define XB_TMO      128
#define XB_XCNT(j)  (256  + 64 * (j))
#define XB_XSUB(j)  (1280 + 64 * (j))
#define XB_XGEN(j)  (2304 + 64 * (j))
#define XB_TOP      3328
#define XB_TOPGEN   3392
#define XCD_BAR_WORDS 3456
#define XB_SPIN_CAP (1u << 20)
__device__ __forceinline__ unsigned xb_ld(unsigned* p)              { return __hip_atomic_load(p, __ATOMIC_RELAXED, __HIP_MEMORY_SCOPE_AGENT); }
__device__ __forceinline__ unsigned xb_add(unsigned* p, unsigned v) { return __hip_atomic_fetch_add(p, v, __ATOMIC_RELAXED, __HIP_MEMORY_SCOPE_AGENT); }
__device__ __forceinline__ unsigned xb_xcc_id() { return (unsigned)__builtin_amdgcn_s_getreg((3 << 11) | 20) & 0xFu; }
#define XB_SPIN(cond, bar) do { unsigned _sp = 0; while (cond) { __builtin_amdgcn_s_sleep(1); \
    if ((++_sp & 255u) == 0u) { if (xb_ld(&(bar)[XB_TMO])) break; if (_sp > XB_SPIN_CAP) { atomicAdd(&(bar)[XB_TMO], 1u); break; } } } } while (0)
struct XcdBarrier { unsigned* bar; unsigned x; volatile LAS unsigned* st; };
__device__ __forceinline__ XcdBarrier xcd_barrier_post(unsigned* bar, volatile LAS unsigned* st) {
    XcdBarrier b; b.bar = bar; b.x = xb_xcc_id(); b.st = st;
    if (threadIdx.x == 0) (void)xb_add(&bar[XB_XCNT(b.x)], 1u);
    return b;
}
__device__ __forceinline__ void xcd_barrier_complete(unsigned* bar, unsigned x, unsigned& nloc, unsigned& nx) {
    const unsigned G = gridDim.x * gridDim.y * gridDim.z;
    unsigned sum, cnt, mine, sp = 0u;
    for (;;) {
        sum = 0u; cnt = 0u; mine = 0u;
#pragma unroll
        for (unsigned j = 0; j < 16; ++j) { const unsigned c = xb_ld(&bar[XB_XCNT(j)]); sum += c; cnt += (c > 0u) ? 1u : 0u; mine = (j == x) ? c : mine; }
        if (sum == G) break;
        __builtin_amdgcn_s_sleep(1);
        if ((++sp & 255u) == 0u) { if (xb_ld(&bar[XB_TMO])) break; if (sp > XB_SPIN_CAP) { atomicAdd(&bar[XB_TMO], 1u); break; } }
    }
    nloc = mine > 0u ? mine : 1u; nx = cnt > 0u ? cnt : 1u;
}
__device__ __forceinline__ void xcd_barrier(const XcdBarrier& b) {
    asm volatile("s_waitcnt vmcnt(0)" ::: "memory");
    __syncthreads();
    if (threadIdx.x == 0) {
        unsigned* bar = b.bar;
        __builtin_amdgcn_s_waitcnt(0);
        unsigned nloc = b.st[0], nx = b.st[1];
        if (nloc == 0u) { xcd_barrier_complete(bar, b.x, nloc, nx); b.st[0] = nloc; b.st[1] = nx; }
        const unsigned old = xb_add(&bar[XB_XSUB(b.x)], 1u);
        const unsigned gen = old / nloc;
        if (old + 1u == (gen + 1u) * nloc) {
            __builtin_amdgcn_fence(__ATOMIC_RELEASE, "agent");
            asm volatile("s_waitcnt vmcnt(0)" ::: "memory");
            const unsigned og = xb_add(&bar[XB_TOP], 1u);
            const unsigned tg = og / nx;
            if (og + 1u == (tg + 1u) * nx) xb_add(&bar[XB_TOPGEN], 1u);
            else XB_SPIN(xb_ld(&bar[XB_TOPGEN]) == tg, bar);
            __builtin_amdgcn_fence(__ATOMIC_ACQUIRE, "agent");
            xb_add(&bar[XB_XGEN(b.x)], 1u);
            asm volatile("s_waitcnt vmcnt(0)" ::: "memory");
        } else {
            XB_SPIN(xb_ld(&bar[XB_XGEN(b.x)]) == gen, bar);
            __builtin_amdgcn_fence(__ATOMIC_ACQUIRE, "agent");
            asm volatile("s_waitcnt vmcnt(0)" ::: "memory");
        }
    }
    __syncthreads();
}

__device__ __forceinline__ float wave_sum(float v) {
#pragma unroll
    for (int o = 1; o < 64; o <<= 1) v += __shfl_xor(v, o);
    return v;
}
__device__ __forceinline__ float bf2f(unsigned short u) { return __builtin_bit_cast(float, (unsigned)u << 16); }

struct Args { const void* in[21]; float* out; unsigned char* ws; int ph_lo, ph_hi; };

__device__ __forceinline__ void p0_transpose_item(const float* W, int K, int N, bf16* WT, int k0, int sc, int nd0, LAS float* scr, int lane) {
#pragma unroll 8
    for (int i = 0; i < 32; ++i) { const int kk = 2 * i + (lane >> 5); scr[kk * 33 + (lane & 31)] = W[(size_t)(k0 + kk) * N + sc + (lane & 31)]; }
    asm volatile("s_waitcnt lgkmcnt(0)" ::: "memory");
    const int c = lane & 7;
#pragma unroll
    for (int j = 0; j < 4; ++j) { const int n = (lane >> 3) + 8 * j; const LAS float* s = scr + (8 * c) * 33 + n;
        u32x4 o; o.x = pk_bf16(s[0 * 33], s[1 * 33]); o.y = pk_bf16(s[2 * 33], s[3 * 33]); o.z = pk_bf16(s[4 * 33], s[5 * 33]); o.w = pk_bf16(s[6 * 33], s[7 * 33]);
        *(u32x4*)(WT + (size_t)(nd0 + n) * K + k0 + 8 * c) = o; }
    asm volatile("s_waitcnt lgkmcnt(0)" ::: "memory");
}
__device__ __forceinline__ int src_col(int type, int nd0) {
    if (type == 0) return nd0;
    const int pn = nd0 >> 8, r = nd0 & 255, bj = r >> 7;
    if (type == 1) return bj * FF + 128 * pn + (r & 127);
    const int wc = (r & 127) >> 5, head = 4 * (pn & 3) + wc;
    return (pn >= 4 ? 1024 : 0) + head * 64 + 32 * bj;
}
__device__ __forceinline__ void p0_phase(ptab_t tab, LAS unsigned char* lds, int vcu, int G) {
    const int tid = threadIdx.x, lane = tid & 63, w = __builtin_amdgcn_readfirstlane(tid >> 6);
    unsigned char* ws = ldp(tab, T_WS);
    { float* z = (float*)(ws + WS_SS) + M; const int n = 3 * M + 4 * M;
      for (int i = vcu * NTHREADS + tid; i < n / 4; i += G * NTHREADS) ((f32x4*)z)[i] = (f32x4){0.f, 0.f, 0.f, 0.f}; }
    if (vcu < 224) {
        LAS float* cact = (LAS float*)lds;
        LAS float* part = (LAS float*)(lds + 65536);
        const float* c = (const float*)ldp(tab, 1);
        for (int i = tid; i < 16 * 1024; i += NTHREADS) { const float x = c[i]; cact[i] = pg8::silu_f(x); }
        LBAR();
        const int col = vcu * 64;
        const float* W; int N, cw; const float* bias; float* dst; int dstride;
        if (col < 12288) { const int l = col / 6144; cw = col - l * 6144; W = (const float*)ldp(tab, 3) + (size_t)l * 1024 * 6144; N = 6144; bias = (const float*)ldp(tab, 4) + l * 6144; dst = (float*)(ws + WS_MODS) + (size_t)l * 16 * 6144; dstride = 6144; }
        else { cw = col - 12288; W = (const float*)ldp(tab, 9); N = 2048; bias = (const float*)ldp(tab, 10); dst = (float*)(ws + WS_KVM); dstride = 2048; }
        float acc[16];
#pragma unroll
        for (int b = 0; b < 16; ++b) acc[b] = 0.f;
        const float* wp = W + (size_t)(128 * w) * N + cw + lane;
#pragma unroll 2
        for (int kk = 0; kk < 128; kk += 4) {
            const float w0 = wp[(size_t)(kk + 0) * N], w1 = wp[(size_t)(kk + 1) * N], w2 = wp[(size_t)(kk + 2) * N], w3 = wp[(size_t)(kk + 3) * N];
#pragma unroll
            for (int b = 0; b < 16; ++b) { const f32x4 cv = *(const LAS f32x4*)(cact + b * 1024 + 128 * w + kk); acc[b] += (cv[0] * w0 + cv[1] * w1) + (cv[2] * w2 + cv[3] * w3); }
        }
#pragma unroll
        for (int b = 0; b < 16; ++b) part[(w * 16 + b) * 64 + lane] = acc[b];
        LBAR();
        for (int o = tid; o < 1024; o += NTHREADS) { const int b = o >> 6, l = o & 63; float s = bias[cw + l];
#pragma unroll
            for (int ww = 0; ww < 8; ++ww) s += part[(ww * 16 + b) * 64 + l];
            dst[(size_t)b * dstride + cw + l] = s; }
        LBAR();
    }
    {
        LAS float* scr = (LAS float*)(lds + w * 8448);
        const int gw = vcu * NWAVES + w, NGW = G * NWAVES;
        constexpr int I0 = 16 * 192, I1 = 32 * 32, I2 = 16 * 176, I4 = 44 * 32, I6 = 16 * 64, I7 = 16 * 32;
        constexpr int NIT = I0 + I1 + 2 * I2 + 2 * I4 + I6 + 2 * I7;
        for (int it = gw; it < NIT; it += NGW) {
            int r = it; const float* W; int K, N, type; bf16* WT;
            if (r < I0) { W = (const float*)ldp(tab, 7); K = 1024; N = 6144; type = 0; WT = (bf16*)(ws + WS_WT1); }
            else if ((r -= I0) < I1) { W = (const float*)ldp(tab, 8); K = 2048; N = 1024; type = 0; WT = (bf16*)(ws + WS_WT2); }
            else if ((r -= I1) < 2 * I2) { const int l = r / I2; r -= l * I2; W = (const float*)ldp(tab, 17) + (size_t)l * 1024 * FF2; K = 1024; N = FF2; type = 1; WT = (bf16*)(ws + WS_WT3) + (size_t)l * FF2 * 1024; }
            else if ((r -= 2 * I2) < 2 * I4) { const int l = r / I4; r -= l * I4; W = (const float*)ldp(tab, 20) + (size_t)l * FF * 1024; K = FF; N = 1024; type = 0; WT = (bf16*)(ws + WS_WT4) + (size_t)l * 1024 * FF; }
            else if ((r -= 2 * I4) < I6) { W = (const float*)ldp(tab, 12); K = 1024; N = 2048; type = 2; WT = (bf16*)(ws + WS_WT5); }
            else if ((r -= I6) < I7) { W = (const float*)ldp(tab, 14); K = 1024; N = 1024; type = 2; WT = (bf16*)(ws + WS_WT6); }
            else { r -= I7; W = (const float*)ldp(tab, 16); K = 1024; N = 1024; type = 0; WT = (bf16*)(ws + WS_WT7); }
            const int nblk = N / 32, kb = r / nblk, nb = r - kb * nblk;
            p0_transpose_item(W, K, N, WT, 64 * kb, src_col(type, 32 * nb), 32 * nb, scr, lane);
        }
    }
}

__device__ __forceinline__ void p1_phase(ptab_t tab, LAS unsigned char* lds, int vcu, int G) {
    const int tid = threadIdx.x, lane = tid & 63, w = __builtin_amdgcn_readfirstlane(tid >> 6);
    unsigned char* ws = ldp(tab, T_WS);
    const float* mods = (const float*)(ws + WS_MODS);
    const int gw = vcu * NWAVES + w, NGW = G * NWAVES;
    {
        const float* x = (const float*)ldp(tab, 0); const float* g = (const float*)ldp(tab, 5);
        bf16* A0 = (bf16*)(ws + WS_A); float* ss0 = (float*)(ws + WS_SS);
        const int rpw = M / NGW;
        for (int r0 = gw * rpw; r0 < M; r0 += NGW * rpw) {
            const int b = r0 / SEQ;
            f32x4 gs[4];
#pragma unroll
            for (int j = 0; j < 4; ++j) { const int col = 4 * lane + 256 * j; gs[j] = *(const f32x4*)(g + col) * (*(const f32x4*)(mods + (size_t)b * 6144 + 1024 + col) + 1.f); }
            for (int r = r0; r < r0 + rpw; ++r) {
                f32x4 v[4]; float s = 0.f;
#pragma unroll
                for (int j = 0; j < 4; ++j) { v[j] = *(const f32x4*)(x + (size_t)r * D + 4 * lane + 256 * j); s += pg8::dot4(v[j]); }
                s = wave_sum(s);
                if (lane == 0) ss0[r] = s;
#pragma unroll
                for (int j = 0; j < 4; ++j) { const f32x4 o = v[j] * gs[j]; u32x2 p; p.x = pk_bf16(o[0], o[1]); p.y = pk_bf16(o[2], o[3]); *(u32x2*)(A0 + (size_t)r * D + 4 * lane + 256 * j) = p; }
            }
        }
    }
    {
        LAS float* sh = (LAS float*)lds;
        for (int ty = 0; ty < 5; ++ty) {
            const float* sp; int sst, N; const bf16* WT; float* dst;
            if (ty == 0)      { sp = mods;                         sst = 6144; N = RN;   WT = (const bf16*)(ws + WS_WT1); dst = (float*)(ws + WS_SW1); }
            else if (ty == 1) { sp = mods + 3072;                  sst = 6144; N = FF2;  WT = (const bf16*)(ws + WS_WT3); dst = (float*)(ws + WS_SW3); }
            else if (ty == 2) { sp = mods + 16 * 6144 + 3072;      sst = 6144; N = FF2;  WT = (const bf16*)(ws + WS_WT3) + (size_t)FF2 * 1024; dst = (float*)(ws + WS_SW3) + 16 * FF2; }
            else if (ty == 3) { sp = (const float*)(ws + WS_KVM);  sst = 2048; N = 2048; WT = (const bf16*)(ws + WS_WT5); dst = (float*)(ws + WS_SW5); }
            else              { sp = mods + 16 * 6144;             sst = 6144; N = 1024; WT = (const bf16*)(ws + WS_WT6); dst = (float*)(ws + WS_SW6); }
            LBAR();
            for (int i = tid; i < 16 * 1024; i += NTHREADS) sh[i] = sp[(size_t)(i >> 10) * sst + (i & 1023)];
            LBAR();
            for (int n = gw; n < N; n += NGW) {
                const u32x4 w0 = *(const u32x4*)(WT + (size_t)n * 1024 + 8 * lane), w1 = *(const u32x4*)(WT + (size_t)n * 1024 + 512 + 8 * lane);
                float wf[16];
#pragma unroll
                for (int i = 0; i < 4; ++i) { wf[2 * i] = __builtin_bit_cast(float, w0[i] << 16); wf[2 * i + 1] = __builtin_bit_cast(float, w0[i] & 0xffff0000u);
                                              wf[8 + 2 * i] = __builtin_bit_cast(float, w1[i] << 16); wf[8 + 2 * i + 1] = __builtin_bit_cast(float, w1[i] & 0xffff0000u); }
                float mine = 0.f;
#pragma unroll
                for (int b = 0; b < 16; ++b) {
                    const LAS float* s0 = sh + b * 1024 + 8 * lane;
                    const f32x4 a0 = *(const LAS f32x4*)s0, a1 = *(const LAS f32x4*)(s0 + 4), a2 = *(const LAS f32x4*)(s0 + 512), a3 = *(const LAS f32x4*)(s0 + 516);
                    float p = (a0[0] * wf[0] + a0[1] * wf[1]) + (a0[2] * wf[2] + a0[3] * wf[3]) + (a1[0] * wf[4] + a1[1] * wf[5]) + (a1[2] * wf[6] + a1[3] * wf[7])
                            + (a2[0] * wf[8] + a2[1] * wf[9]) + (a2[2] * wf[10] + a2[3] * wf[11]) + (a3[0] * wf[12] + a3[1] * wf[13]) + (a3[2] * wf[14] + a3[3] * wf[15]);
                    p = wave_sum(p);
                    if (lane == b) mine = p;
                }
                if (lane < 16) dst[(size_t)lane * N + n] = mine;
            }
        }
    }
}

constexpr int RT_QROWB = 528, RT_VROWB = 272, RT_PROWB = 144;
constexpr int RT_QS = 0, RT_KS = 64 * RT_QROWB, RT_VS = 2 * 64 * RT_QROWB, RT_PS = RT_VS + 64 * RT_VROWB, RT_BYTES = RT_PS + 64 * RT_PROWB;
static_assert(RT_BYTES <= MISC_OFF, "retention LDS");
__device__ __forceinline__ s16x4 tr16(const LAS unsigned char* p) { typedef short v4i16_t __attribute__((ext_vector_type(4))); return __builtin_bit_cast(s16x4, __builtin_amdgcn_ds_read_tr16_b64_v4i16((LAS v4i16_t*)p)); }
#define MFMA16(a, b, c) __builtin_amdgcn_mfma_f32_16x16x32_bf16((a), (b), (c), 0, 0, 0)
#define MFMA32(a, b, c) __builtin_amdgcn_mfma_f32_32x32x16_bf16((a), (b), (c), 0, 0, 0)
__device__ __forceinline__ bf16x8 cat8(s16x4 lo, s16x4 hi) { return (bf16x8){lo[0], lo[1], lo[2], lo[3], hi[0], hi[1], hi[2], hi[3]}; }
__device__ __forceinline__ bf16x8 pack8(const f32x4 a, const f32x4 b) { return __builtin_bit_cast(bf16x8, pg8::pk8(a, b)); }

__device__ __forceinline__ void ret_unit(LAS unsigned char* lds, const bf16* Q, const bf16* KD, const bf16* V, bf16* SG, float* SSO, int unit) {
    const int tid = threadIdx.x, lane = tid & 63, w = __builtin_amdgcn_readfirstlane(tid >> 6);
    const int b = unit >> 4, h = (unit >> 2) & 3, vs = unit & 3;
    const int c16 = lane & 15, g4 = lane >> 4;
    const float lg2 = __builtin_amdgcn_logf(1.f - __builtin_amdgcn_exp2f(-5.f - (float)h));
    const float gC = __builtin_amdgcn_exp2f(lg2 * 64.f);
    const char* gQ = (const char*)(Q + (size_t)b * SEQ * 1024 + h * 256);
    const char* gK = (const char*)(KD + (size_t)b * SEQ * 1024 + h * 256);
    const char* gV = (const char*)(V + (size_t)b * SEQ * 2048 + h * 512 + vs * 128);
    u32x4 pq[4], pk[4], pv[2];
#define RT_LOAD(c) do { _Pragma("unroll") for (int j = 0; j < 4; ++j) { const int cc = tid + 512 * j, row = cc >> 5, ck = cc & 31; const size_t go = (size_t)((c) * 64 + row) * 2048 + ck * 16; \
        pq[j] = *(const u32x4*)(gQ + go); pk[j] = *(const u32x4*)(gK + go); } \
        _Pragma("unroll") for (int j = 0; j < 2; ++j) { const int cc = tid + 512 * j, row = cc >> 4, ck = cc & 15; pv[j] = *(const u32x4*)(gV + (size_t)((c) * 64 + row) * 4096 + ck * 16); } } while (0)
#define RT_STORE() do { _Pragma("unroll") for (int j = 0; j < 4; ++j) { const int cc = tid + 512 * j, row = cc >> 5, ck = cc & 31; *(LAS u32x4*)(lds + RT_QS + row * RT_QROWB + ck * 16) = pq[j]; *(LAS u32x4*)(lds + RT_KS + row * RT_QROWB + ck * 16) = pk[j]; } \
        _Pragma("unroll") for (int j = 0; j < 2; ++j) { const int cc = tid + 512 * j, row = cc >> 4, ck = cc & 15; *(LAS u32x4*)(lds + RT_VS + row * RT_VROWB + ck * 16) = pv[j]; } } while (0)
    f32x4 st[16], oc[4], sT[2]; bf16x8 vf[2];
#pragma unroll
    for (int i = 0; i < 16; ++i) st[i] = (f32x4){0.f, 0.f, 0.f, 0.f};
#pragma unroll
    for (int i = 0; i < 4; ++i) oc[i] = (f32x4){0.f, 0.f, 0.f, 0.f};
    const int ntS = w & 3, mtb = 2 * (w >> 2);
    const LAS unsigned char* qrowS = lds + RT_QS + (16 * ntS + c16) * RT_QROWB + g4 * 16;
    const LAS unsigned char* krowS = lds + RT_KS + (16 * mtb + c16) * RT_QROWB + g4 * 16;
    const LAS unsigned char* qrowC = lds + RT_QS + c16 * RT_QROWB + g4 * 8;
    const LAS unsigned char* ktr = lds + RT_KS + (8 * g4 + (c16 >> 2)) * RT_QROWB + (c16 & 3) * 8;
    const LAS unsigned char* vtr = lds + RT_VS + (8 * g4 + (c16 >> 2)) * RT_VROWB + w * 32 + (c16 & 3) * 8;
    const LAS unsigned char* prow = lds + RT_PS + c16 * RT_PROWB + g4 * 16;
    LAS unsigned char* pst = lds + RT_PS + (16 * ntS + c16) * RT_PROWB + g4 * 8;
    RT_LOAD(0);
    for (int c = 0; c < 32; ++c) {
        LBAR();
        RT_STORE();
        if (c + 1 < 32) RT_LOAD(c + 1);
        LBAR();
#pragma unroll
        for (int ks = 0; ks < 2; ++ks) vf[ks] = cat8(tr16(vtr + (32 * ks) * RT_VROWB), tr16(vtr + (32 * ks + 4) * RT_VROWB));
        sT[0] = (f32x4){0.f, 0.f, 0.f, 0.f}; sT[1] = (f32x4){0.f, 0.f, 0.f, 0.f};
#pragma unroll
        for (int ks = 0; ks < 8; ++ks) {
            const bf16x8 bq = *(const LAS bf16x8*)(qrowS + ks * 64);
#pragma unroll
            for (int i = 0; i < 2; ++i) { const bf16x8 ak = *(const LAS bf16x8*)(krowS + i * 16 * RT_QROWB + ks * 64); sT[i] = MFMA16(ak, bq, sT[i]); }
        }
        {
            const int n = 16 * ntS + c16; const float fac = __builtin_amdgcn_exp2f(lg2 * (float)(n - 63));
#pragma unroll
            for (int i = 0; i < 2; ++i) {
                const int m0 = 16 * (mtb + i) + 4 * g4; float v[4];
#pragma unroll
                for (int e = 0; e < 4; ++e) v[e] = (n >= m0 + e) ? sT[i][e] * fac : 0.f;
                u32x2 p; p.x = pk_bf16(v[0], v[1]); p.y = pk_bf16(v[2], v[3]);
                *(LAS u32x2*)(pst + (mtb + i) * 32) = p;
            }
        }
        __builtin_amdgcn_sched_barrier(0);
#pragma unroll
        for (int ks = 0; ks < 8; ++ks) {
            const bf16x8 as = pack8(st[2 * ks], st[2 * ks + 1]);
#pragma unroll
            for (int nt = 0; nt < 4; ++nt) {
                const s16x4 lo = *(const LAS s16x4*)(qrowC + nt * 16 * RT_QROWB + ks * 64), hi = *(const LAS s16x4*)(qrowC + nt * 16 * RT_QROWB + ks * 64 + 32);
                oc[nt] = MFMA16(as, cat8(lo, hi), oc[nt]);
            }
            __builtin_amdgcn_sched_barrier(0);
        }
#pragma unroll
        for (int i = 0; i < 16; ++i) {
            f32x4 sacc = st[i] * gC;
#pragma unroll
            for (int ks = 0; ks < 2; ++ks) { const bf16x8 kt = cat8(tr16(ktr + (32 * ks) * RT_QROWB + i * 32), tr16(ktr + (32 * ks + 4) * RT_QROWB + i * 32)); sacc = MFMA16(kt, vf[ks], sacc); }
            st[i] = sacc;
            if ((i & 3) == 3) __builtin_amdgcn_sched_barrier(0);
        }
        LBAR();
#pragma unroll
        for (int nt = 0; nt < 4; ++nt) { const float gq = __builtin_amdgcn_exp2f(lg2 * (float)(16 * nt + c16 + 1)); oc[nt] *= gq; }
#pragma unroll
        for (int ks = 0; ks < 2; ++ks)
#pragma unroll
            for (int nt = 0; nt < 4; ++nt) if (32 * ks <= 16 * nt + 15) { const bf16x8 bp = *(const LAS bf16x8*)(prow + nt * 16 * RT_PROWB + ks * 64); oc[nt] = MFMA16(vf[ks], bp, oc[nt]); }
#pragma unroll
        for (int nt = 0; nt < 4; ++nt) {
            const int row = b * SEQ + c * 64 + 16 * nt + c16;
            float sq = pg8::dot4(oc[nt]); sq += __shfl_xor(sq, 16); sq += __shfl_xor(sq, 32);
            if (g4 == 0) atomicAdd(SSO + (size_t)row * 4 + h, sq);
            bf16* gp = SG + (size_t)row * 2048 + h * 512 + vs * 128 + 16 * w + 4 * g4;
            const u32x2 sg = *(const u32x2*)gp;
            const float o0 = oc[nt][0] * __builtin_bit_cast(float, sg.x << 16), o1 = oc[nt][1] * __builtin_bit_cast(float, sg.x & 0xffff0000u);
            const float o2 = oc[nt][2] * __builtin_bit_cast(float, sg.y << 16), o3 = oc[nt][3] * __builtin_bit_cast(float, sg.y & 0xffff0000u);
            u32x2 p; p.x = pk_bf16(o0, o1); p.y = pk_bf16(o2, o3); *(u32x2*)gp = p;
            oc[nt] = (f32x4){0.f, 0.f, 0.f, 0.f};
        }
    }
    LBAR();
#undef RT_LOAD
#undef RT_STORE
}

__device__ __forceinline__ int crow(int r, int hi) { return (r & 3) + 8 * (r >> 2) + 4 * hi; }
__device__ __forceinline__ void sb_unit(const bf16* QN, const bf16* KN, const bf16* VT, bf16* O, int bh, int qblk, int lane) {
    const int r32 = lane & 31, hh = lane >> 5, b = bh >> 4, h = bh & 15;
    const size_t row0 = (size_t)b * SEQ + 32 * qblk;
    bf16x8 qf[4];
#pragma unroll
    for (int s = 0; s < 4; ++s) qf[s] = *(const bf16x8*)(QN + (row0 + r32) * 1024 + h * 64 + 16 * s + 8 * hh);
    f32x16 oT[2];
#pragma unroll
    for (int i = 0; i < 16; ++i) { oT[0][i] = 0.f; oT[1][i] = 0.f; }
    float R = 0.f;
    const bf16* kbase = KN + ((size_t)b * SEQ + r32) * 1024 + h * 64 + 8 * hh;
    const bf16* vbase = VT + ((size_t)bh * 64 + r32) * 2048 + 4 * hh;
    for (int kt = qblk; kt >= 0; --kt) {
        bf16x8 kf[4];
#pragma unroll
        for (int s = 0; s < 4; ++s) kf[s] = *(const bf16x8*)(kbase + (size_t)(32 * kt) * 1024 + 16 * s);
        s16x4 vlo[2][2], vhi[2][2];
#pragma unroll
        for (int dt = 0; dt < 2; ++dt)
#pragma unroll
            for (int sp = 0; sp < 2; ++sp) { const bf16* p = vbase + (size_t)(32 * dt) * 2048 + 32 * kt + 16 * sp; vlo[dt][sp] = *(const s16x4*)p; vhi[dt][sp] = *(const s16x4*)(p + 8); }
        f32x16 z;
#pragma unroll
        for (int i = 0; i < 16; ++i) z[i] = 0.f;
#pragma unroll
        for (int s = 0; s < 4; ++s) z = MFMA32(kf[s], qf[s], z);
        float sp_[16], lb[16];
        const bool diag = (kt == qblk);
#pragma unroll
        for (int i = 0; i < 16; ++i) {
            const float zz = z[i];
            const float t = __builtin_amdgcn_exp2f(-1.44269504089f * __builtin_fabsf(zz));
            float s = __builtin_fmaxf(zz, 0.f) + 0.69314718056f * __builtin_amdgcn_logf(1.f + t);
            const bool valid = !diag || (crow(i, hh) < r32);
            sp_[i] = valid ? s : 0.f;
            lb[i] = valid ? (zz - s) : -INFINITY;
        }
        float gsum[4], pgs[4];
#pragma unroll
        for (int q = 0; q < 4; ++q) { gsum[q] = (sp_[4 * q] + sp_[4 * q + 1]) + (sp_[4 * q + 2] + sp_[4 * q + 3]); pgs[q] = __shfl_xor(gsum[q], 32); }
        float later = 0.f;
        f32x16 pa;
#pragma unroll
        for (int q = 3; q >= 0; --q) {
            const float L = later + (hh == 0 ? pgs[q] : 0.f);
            const float s3 = L, s2 = s3 + sp_[4 * q + 3], s1 = s2 + sp_[4 * q + 2], s0 = s1 + sp_[4 * q + 1];
            pa[4 * q + 0] = __builtin_amdgcn_exp2f(1.44269504089f * (lb[4 * q + 0] - R - s0));
            pa[4 * q + 1] = __builtin_amdgcn_exp2f(1.44269504089f * (lb[4 * q + 1] - R - s1));
            pa[4 * q + 2] = __builtin_amdgcn_exp2f(1.44269504089f * (lb[4 * q + 2] - R - s2));
            pa[4 * q + 3] = __builtin_amdgcn_exp2f(1.44269504089f * (lb[4 * q + 3] - R - s3));
            later += gsum[q] + pgs[q];
        }
        R += later;
#pragma unroll
        for (int sp = 0; sp < 2; ++sp) {
            const bf16x8 pf = pack8((f32x4){pa[8 * sp], pa[8 * sp + 1], pa[8 * sp + 2], pa[8 * sp + 3]}, (f32x4){pa[8 * sp + 4], pa[8 * sp + 5], pa[8 * sp + 6], pa[8 * sp + 7]});
#pragma unroll
            for (int dt = 0; dt < 2; ++dt) oT[dt] = MFMA32(cat8(vlo[dt][sp], vhi[dt][sp]), pf, oT[dt]);
        }
        if (__all(R > 64.f)) break;
    }
#pragma unroll
    for (int dt = 0; dt < 2; ++dt)
#pragma unroll
        for (int q = 0; q < 4; ++q) {
            u32x2 p; p.x = pk_bf16(oT[dt][4 * q], oT[dt][4 * q + 1]); p.y = pk_bf16(oT[dt][4 * q + 2], oT[dt][4 * q + 3]);
            *(u32x2*)(O + (row0 + r32) * 1024 + h * 64 + 32 * dt + 8 * q + 4 * hh) = p;
        }
}

__device__ __forceinline__ void fix_phase(const float* HF, const float* HL, const float* cw, const float* cb, bf16* ACT, int vcu, int G) {
    const int NIT = 512 * 2 * (FF / 4);
    for (int it = vcu * NTHREADS + threadIdx.x; it < NIT; it += G * NTHREADS) {
        const int cg4 = it % (FF / 4), bi = it / (FF / 4), i = bi & 1, blk = bi >> 1;
        const int c0 = 4 * cg4, pn = c0 >> 7, j = c0 & 127, nv = 256 * pn + j;
        const bool first = (blk & 31) == 0;
        f32x4 val, gat;
#pragma unroll
        for (int half = 0; half < 2; ++half) {
            const int nn = nv + 128 * half, co = half * FF + c0;
            const f32x4 u0 = *(const f32x4*)(HF + (size_t)(blk * 2 + i) * FF2 + nn);
            f32x4 u1, u2; const f32x4 zero = (f32x4){0.f, 0.f, 0.f, 0.f};
            if (i == 1) { u1 = *(const f32x4*)(HF + (size_t)(blk * 2) * FF2 + nn); u2 = first ? zero : *(const f32x4*)(HL + (size_t)((blk - 1) * 2 + 1) * FF2 + nn); }
            else { u1 = first ? zero : *(const f32x4*)(HL + (size_t)((blk - 1) * 2 + 1) * FF2 + nn); u2 = first ? zero : *(const f32x4*)(HL + (size_t)((blk - 1) * 2) * FF2 + nn); }
            const f32x4 y = *(const f32x4*)(cb + co) + *(const f32x4*)(cw + 2 * FF2 + co) * u0 + *(const f32x4*)(cw + FF2 + co) * u1 + *(const f32x4*)(cw + co) * u2;
            if (half == 0) val = y; else gat = y;
        }
        const f32x4 o = val * pg8::silu4(gat);
        u32x2 p; p.x = pk_bf16(o[0], o[1]); p.y = pk_bf16(o[2], o[3]);
        *(u32x2*)(ACT + (size_t)(64 * blk + i) * FF + c0) = p;
    }
}

__device__ __forceinline__ XcdBarrier mk_bar(ptab_t tab, LAS unsigned char* lds) { XcdBarrier b; b.bar = (unsigned*)(ldp(tab, T_WS) + WS_CTL) + 1024; b.x = xb_xcc_id(); b.st = (volatile LAS unsigned*)(lds + MISC_OFF) + 8; return b; }
__global__ void __launch_bounds__(NTHREADS, 2) yoco_fwd(Args a) {
    extern __shared__ __attribute__((aligned(16))) unsigned char lds_raw[];
    LAS unsigned char* lds = (LAS unsigned char*)lds_raw;
    volatile LAS unsigned* MISC = (volatile LAS unsigned*)(lds + MISC_OFF);
    LAS unsigned long long* tabw = (LAS unsigned long long*)(lds + MISC_OFF + 64);
    const ptab_t tab = (ptab_t)(lds + MISC_OFF + 64);
    if (threadIdx.x < 16) MISC[threadIdx.x] = 0u;
    if (threadIdx.x == 64) {
#pragma unroll
        for (int i = 0; i < 21; ++i) tabw[i] = (unsigned long long)a.in[i];
        tabw[T_OUT] = (unsigned long long)a.out; tabw[T_WS] = (unsigned long long)a.ws;
        MISC[0] = (unsigned)a.ph_lo; MISC[1] = (unsigned)a.ph_hi;
    }
    __syncthreads();
    if (a.ph_hi - a.ph_lo > 1) (void)xcd_barrier_post((unsigned*)(a.ws + WS_CTL) + 1024, MISC + 8);
#define PH_LO ((int)__builtin_amdgcn_readfirstlane(MISC[0]))
#define PH_HI ((int)__builtin_amdgcn_readfirstlane(MISC[1]))
#define IN(k) (PH_LO <= (k) && (k) < PH_HI)
#define SEAM(k) do { if (IN(k) && IN((k) + 1)) xcd_barrier(mk_bar(tab, lds)); } while (0)
#define GRID ((int)gridDim.x)
#define BX ((int)blockIdx.x)
#define VCU ((GRID % 8 == 0) ? (BX % 8) * (GRID / 8) + BX / 8 : BX)
#define WSP (ldp(tab, T_WS))

#ifndef SKIP_P0
    if (IN(0)) { p0_phase(tab, lds, VCU, GRID); }
#endif
    if (IN(0) && IN(1)) {
        if (MK_ONE_LAUNCH) { cg::this_grid().sync(); }
        xcd_barrier(mk_bar(tab, lds));
    }
#ifndef SKIP_P1
    if (IN(1)) { p1_phase(tab, lds, VCU, GRID); }
#endif
    SEAM(1);
    if (IN(2)) {
        pg8::Gemm g{(const bf16*)(WSP + WS_A), (const bf16*)(WSP + WS_WT1), M, RN, D, D}; pg8::StaticOrder S; S.init(M, RN, GRID, BX);
        pg8::EpiRetIn E{tab};
        pg8::gemm_phase<pg8::EpiRetIn, pg8::StaticOrder, true, true>(lds, g, S, E);
    }
    SEAM(2);
#ifndef SKIP_RET
    if (IN(3)) {
        unsigned char* ws = WSP;
        for (int u = VCU; u < 256; u += GRID) ret_unit(lds, (const bf16*)(ws + WS_Q), (const bf16*)(ws + WS_KD), (const bf16*)(ws + WS_V), (bf16*)(ws + WS_SG), (float*)(ws + WS_SSO), u);
    }
#endif
    SEAM(3);
    if (IN(4)) {
        pg8::Gemm g{(const bf16*)(WSP + WS_SG), (const bf16*)(WSP + WS_WT2), M, D, 512, 2048}; pg8::SegOrder S; S.init(M, D, GRID, BX);
        pg8::EpiRes<0> E{tab};
        {
            const int slot = threadIdx.x >> 8, r = threadIdx.x & 255; pg8::Unit u;
            if (S.next(4 * slot, u)) {
                const f32x4 s4 = *(const f32x4*)((const float*)(WSP + WS_SSO) + (size_t)(u.pm * 256 + r) * 4);
                const float e0 = s4[0] * (1.f / 512.f) + EPS, e1 = s4[1] * (1.f / 512.f) + EPS, e2 = s4[2] * (1.f / 512.f) + EPS, e3 = s4[3] * (1.f / 512.f) + EPS;
                f32x4 o; o[0] = __builtin_sqrtf(e1 / e0); o[1] = __builtin_sqrtf(e2 / e1); o[2] = __builtin_sqrtf(e3 / e2); o[3] = 1.f / __builtin_sqrtf(e3);
                *(LAS f32x4*)(lds + 131072 + (slot * 256 + r) * 16) = o;
            }
            LBAR();
        }
        pg8::gemm_phase<pg8::EpiRes<0>, pg8::SegOrder, true, true>(lds, g, S, E);
    }
    SEAM(4);
#pragma unroll 1
    for (int l = 0; l < 2; ++l) {
        const int pb = (l == 0) ? 5 : 11;
        if (IN(pb)) {
            pg8::Gemm g{(const bf16*)(WSP + WS_A), (const bf16*)(WSP + WS_WT3) + (size_t)l * FF2 * 1024, M, FF2, D, D}; pg8::StaticOrder S; S.init(M, FF2, GRID, BX);
            pg8::EpiFfnIn E{tab, l};
            pg8::gemm_phase<pg8::EpiFfnIn, pg8::StaticOrder, true, true>(lds, g, S, E);
        }
        SEAM(pb);
        if (IN(pb + 1)) { unsigned char* ws = WSP; fix_phase((const float*)(ws + WS_HF), (const float*)(ws + WS_HL), (const float*)ldp(tab, 18) + l * 3 * FF2, (const float*)ldp(tab, 19) + l * FF2, (bf16*)(ws + WS_ACT), VCU, GRID); }
        SEAM(pb + 1);
        if (IN(pb + 2)) {
            pg8::Gemm g{(const bf16*)(WSP + WS_ACT), (const bf16*)(WSP + WS_WT4) + (size_t)l * 1024 * FF, M, D, FF, FF}; pg8::StaticOrder S; S.init(M, D, GRID, BX);
            if (l == 0) { pg8::EpiRes<1> E{tab}; pg8::gemm_phase<pg8::EpiRes<1>, pg8::StaticOrder, true, true>(lds, g, S, E); }
            else        { pg8::EpiRes<3> E{tab}; pg8::gemm_phase<pg8::EpiRes<3>, pg8::StaticOrder, true, true>(lds, g, S, E); }
        }
        if (l == 1) break;
        SEAM(7);
        if (IN(8)) {
            { pg8::Gemm g{(const bf16*)(WSP + WS_A), (const bf16*)(WSP + WS_WT5), M, 2048, D, D}; pg8::StaticOrder S; S.init(M, 2048, GRID, BX);
              pg8::EpiKVQ<0> E{tab};
              pg8::gemm_phase<pg8::EpiKVQ<0>, pg8::StaticOrder, true, true>(lds, g, S, E); }
            { pg8::Gemm g{(const bf16*)(WSP + WS_AM1), (const bf16*)(WSP + WS_WT6), M, D, D, D}; pg8::StaticOrder S; S.init(M, D, GRID, BX);
              pg8::EpiKVQ<1> E{tab};
              pg8::gemm_phase<pg8::EpiKVQ<1>, pg8::StaticOrder, true, true>(lds, g, S, E); }
        }
        SEAM(8);
#ifndef SKIP_SB
        if (IN(9)) {
            unsigned char* ws = WSP; const int vcu = VCU, wave = __builtin_amdgcn_readfirstlane(threadIdx.x >> 6), lane = threadIdx.x & 63;
            for (int i = 0; i < 8; ++i) { const int bh = (vcu >> 3) + 32 * i, qg = ((vcu & 7) + i) & 7;
                if (bh < 256) sb_unit((const bf16*)(ws + WS_QN), (const bf16*)(ws + WS_KN), (const bf16*)(ws + WS_VT), (bf16*)(ws + WS_OSB), bh, qg * 8 + wave, lane); }
        }
#endif
        SEAM(9);
        if (IN(10)) {
            pg8::Gemm g{(const bf16*)(WSP + WS_OSB), (const bf16*)(WSP + WS_WT7), M, D, D, D}; pg8::StaticOrder S; S.init(M, D, GRID, BX);
            pg8::EpiRes<2> E{tab};
            pg8::gemm_phase<pg8::EpiRes<2>, pg8::StaticOrder, true, true>(lds, g, S, E);
        }
        SEAM(10);
    }
#undef IN
#undef SEAM
}

extern "C" void kernel_launch(void* const* d_in, const int* in_sizes, int n_in, void* d_out, int out_size, void* d_ws, size_t ws_size, hipStream_t stream) {
    static int grid = 0;
    if (grid == 0) {
        if (n_in != 21 || in_sizes[0] != M * D || out_size != M * D || ws_size < WS_END) { fprintf(stderr, "kernel_launch: unexpected problem: n_in %d in0 %d out %d ws %zu (need %zu)\n", n_in, n_in > 0 ? in_sizes[0] : -1, out_size, ws_size, (size_t)WS_END); grid = -1; return; }
        int dev = 0, cus = 0, per_cu = 0;
        if (hipGetDevice(&dev) != hipSuccess || hipDeviceGetAttribute(&cus, hipDeviceAttributeMultiprocessorCount, dev) != hipSuccess) { grid = -1; return; }
        if (hipFuncSetAttribute((const void*)yoco_fwd, hipFuncAttributeMaxDynamicSharedMemorySize, LDS_BYTES) != hipSuccess) { fprintf(stderr, "kernel_launch: hipFuncSetAttribute failed\n"); grid = -1; return; }
        if (hipOccupancyMaxActiveBlocksPerMultiprocessor(&per_cu, (const void*)yoco_fwd, NTHREADS, LDS_BYTES) != hipSuccess || per_cu < 1) { fprintf(stderr, "kernel_launch: occupancy query says %d\n", per_cu); (void)hipGetLastError(); per_cu = 1; }
        grid = cus;
        if (grid > 256) grid = 256;
    }
    if (grid < 0) return;
    (void)hipMemsetAsync((char*)d_ws + WS_CTL, 0, 65536, stream);
    Args a{};
    for (int i = 0; i < 21; ++i) a.in[i] = d_in[i];
    a.out = (float*)d_out; a.ws = (unsigned char*)d_ws;
#if MK_ONE_LAUNCH
    a.ph_lo = 0; a.ph_hi = NPHASE;
    void* args[] = {&a};
    hipError_t e = hipLaunchCooperativeKernel((const void*)yoco_fwd, dim3(grid), dim3(NTHREADS), args, LDS_BYTES, stream);
    if (e != hipSuccess) fprintf(stderr, "kernel_launch: cooperative launch failed: %s\n", hipGetErrorString(e));
#else
    for (int p = 0; p < NPHASE; ++p) { a.ph_lo = p; a.ph_hi = p + 1; hipLaunchKernelGGL(yoco_fwd, dim3(grid), dim3(NTHREADS), LDS_BYTES, stream, a); }
#endif
}
```

```cpp
#include <hip/hip_runtime.h>
#include <hip/hip_cooperative_groups.h>
#include <cstdio>
#include <cstdint>
namespace cg = cooperative_groups;
namespace pg8 {
#define PG8_LAS __attribute__((address_space(3)))
typedef unsigned short bf16_t;
typedef short bf16x8 __attribute__((ext_vector_type(8)));
typedef float f32x4 __attribute__((ext_vector_type(4)));
typedef unsigned u32x4 __attribute__((ext_vector_type(4)));
constexpr int BM = 256, BK = 64, HALF = 128, HTB = HALF * BK * 2  , STAGE_BYTES = 8 * HTB, NXCD = 8, WGM = 8;

__host__ __device__ __forceinline__ int lds_byte(int r, int c) { const int st = (r >> 4) * 2 + (c >> 5), rr = r & 15, cc = c & 31, ob = rr * 64 + cc * 2; return st * 1024 + (ob ^ (((ob >> 9) & 1) << 5)); }
__host__ __device__ __forceinline__ void stage_rc(int b, int& R, int& C) { const int st = b / 1024, sb = b % 1024, swz = sb ^ (((sb >> 9) & 1) << 5); R = (st >> 1) * 16 + swz / 64; C = (st & 1) * 32 + (swz % 64) / 2; }
__host__ __device__ __forceinline__ int perm32(int rho) { const int n = rho >> 4, i = rho & 15; return 8 * (i >> 2) + 4 * n + (i & 3); }

struct Unit { int pm, pn, kk; };
struct Gemm { const bf16_t* A; const bf16_t* Bt; int M, N, K, ld; };

struct StaticOrder {
    int nM, nN, nwg, G, c;
    __host__ __device__ void init(int M, int N, int G_, int c_) { nM = M / BM; nN = N / BM; nwg = nM * nN; G = G_; c = c_; }
    __host__ __device__ bool next(int i, Unit& u) const {
        const long L = (long)i * G + c; if (L >= nwg) return false;
        int wgid = (int)L; { const int q = nwg / NXCD, r = nwg % NXCD, xcd = wgid % NXCD, off = wgid / NXCD; wgid = (xcd < r ? xcd * (q + 1) : r * (q + 1) + (xcd - r) * q) + off; }
        const int nig = WGM * nN, gid = wgid / nig, fm = gid * WGM, gsz = (nM - fm) < WGM ? (nM - fm) : WGM;
        u.pm = fm + ((wgid % nig) % gsz); u.pn = (wgid % nig) / gsz; u.kk = 0; return true;
    }
    __device__ __forceinline__ void a_ready(const Unit&) const {}
    __device__ __forceinline__ void done(const Unit&) const {}
};

struct SegOrder : StaticOrder {
    __host__ __device__ bool next(int i, Unit& u) const { if (!StaticOrder::next(i >> 2, u)) return false; u.kk = i & 3; return true; }
};
typedef float f32x2 __attribute__((ext_vector_type(2)));
typedef __bf16 bf16x2_t __attribute__((ext_vector_type(2)));
constexpr float EPS = 1e-6f;
__device__ __forceinline__ unsigned pk_bf16(float lo, float hi) { f32x2 v = {lo, hi}; bf16x2_t b = __builtin_convertvector(v, bf16x2_t); return __builtin_bit_cast(unsigned, b); }
__device__ __forceinline__ u32x4 pk8(const f32x4 a, const f32x4 b) { u32x4 w; w.x = pk_bf16(a[0], a[1]); w.y = pk_bf16(a[2], a[3]); w.z = pk_bf16(b[0], b[1]); w.w = pk_bf16(b[2], b[3]); return w; }
__device__ __forceinline__ float silu_f(float x) { return x * __builtin_amdgcn_rcpf(1.f + __builtin_amdgcn_exp2f(-1.44269504089f * x)); }
__device__ __forceinline__ f32x4 silu4(f32x4 v) { f32x4 o; o[0] = silu_f(v[0]); o[1] = silu_f(v[1]); o[2] = silu_f(v[2]); o[3] = silu_f(v[3]); return o; }
__device__ __forceinline__ float dot4(const f32x4 a) { return (a[0] * a[0] + a[1] * a[1]) + (a[2] * a[2] + a[3] * a[3]); }
template <int CTRL> __device__ __forceinline__ float dppf(float old, float src) { return __builtin_bit_cast(float, __builtin_amdgcn_update_dpp(__builtin_bit_cast(int, old), __builtin_bit_cast(int, src), CTRL, 0xf, 0xf, false)); }


typedef const PG8_LAS unsigned long long* ptab_t;
enum { T_OUT = 21, T_WS = 22 };
__device__ __forceinline__ unsigned char* ldp(ptab_t tab, int k) { const unsigned long long v = tab[k]; const unsigned lo = __builtin_amdgcn_readfirstlane((unsigned)v), hi = __builtin_amdgcn_readfirstlane((unsigned)(v >> 32)); return (unsigned char*)(((unsigned long long)hi << 32) | lo); }
constexpr size_t MiB_ = 1u << 20;
constexpr int M_ = 32768;
constexpr size_t O_MODS = 65536, O_KVM = O_MODS + (size_t)2 * 16 * 6144 * 4, O_SW1 = O_KVM + (size_t)16 * 2048 * 4, O_SW3 = O_SW1 + (size_t)16 * 6144 * 4, O_SW5 = O_SW3 + (size_t)2 * 16 * 5632 * 4,
                 O_SW6 = O_SW5 + (size_t)16 * 2048 * 4, O_SS = O_SW6 + (size_t)16 * 1024 * 4, O_SSO = O_SS + (size_t)4 * M_ * 4, O_SMALL_END = O_SSO + (size_t)M_ * 4 * 4;
constexpr size_t O_A = 64 * MiB_, O_BIG = 128 * MiB_, O_Q = O_BIG, O_KD = O_BIG + 64 * MiB_, O_V = O_BIG + 128 * MiB_, O_SG = O_BIG + 256 * MiB_;
constexpr size_t O_ACT = O_BIG, O_HF = O_BIG + 176 * MiB_, O_HL = O_HF + 22 * MiB_, O_AM1 = O_BIG + 220 * MiB_, O_KN = O_BIG, O_VT = O_BIG + 64 * MiB_, O_QN = O_BIG + 128 * MiB_, O_OSB = O_BIG + 284 * MiB_;

struct EpiRetIn {
    static constexpr bool PERM = true, AFTER_DRAIN = false, SEG = false;
    ptab_t tab;
    __device__ __forceinline__ void operator()(f32x4 (&acc)[2][2][4][2], const Unit& u, int wr, int wc, int, int) const {
        int lane_ = threadIdx.x & 63; asm volatile("" : "+v"(lane_)); const int fr = lane_ & 15, fq = lane_ >> 4;
        unsigned char* ws = ldp(tab, T_WS); const int* pos = (const int*)ldp(tab, 2);
        const float* ss = (const float*)(ws + O_SS); const float* sW = (const float*)(ws + O_SW1);
        bf16_t* Q = (bf16_t*)(ws + O_Q); bf16_t* KD = (bf16_t*)(ws + O_KD); bf16_t* V = (bf16_t*)(ws + O_V); bf16_t* SG = (bf16_t*)(ws + O_SG);
        const int b = u.pm >> 3, cl = wc * 32 + 8 * fq, row0 = u.pm * BM + wr * 64 + fr;
        f32x4 sw[2][2];
#pragma unroll
        for (int bj = 0; bj < 2; ++bj)
#pragma unroll
            for (int n = 0; n < 2; ++n) sw[bj][n] = *(const f32x4*)(sW + b * 6144 + u.pn * 256 + bj * 128 + cl + 4 * n);
        if (u.pn < 8) {
            const bool isk = u.pn >= 4; const int h = u.pn & 3;
            bf16_t* dst = (isk ? KD : Q) + h * 256 + cl;
            float inv[8];
#pragma unroll
            for (int i = 0; i < 8; ++i) inv[i] = __builtin_amdgcn_exp2f(-(float)(cl + i) * 0.10381025296523f) * 0.15915494309189535f;
            const float lg = __builtin_amdgcn_logf(1.f - __builtin_amdgcn_exp2f(-5.f - (float)h));
#pragma unroll
            for (int ai = 0; ai < 2; ++ai)
#pragma unroll
                for (int m = 0; m < 4; ++m) {
                    const int row = row0 + ai * HALF + m * 16;
                    const float p = (float)pos[row], rs = __builtin_amdgcn_rsqf(ss[row] * (1.f / 1024.f) + EPS);
                    const float ksc = isk ? 0.0625f * __builtin_amdgcn_exp2f(lg * (float)(63 - (row & 63))) : 1.f;
                    f32x4 o1[2], o2[2];
#pragma unroll
                    for (int n = 0; n < 2; ++n)
#pragma unroll
                        for (int e = 0; e < 4; ++e) {
                            const float x1 = acc[ai][0][m][n][e] * rs + sw[0][n][e], x2 = acc[ai][1][m][n][e] * rs + sw[1][n][e];
                            const float r = __builtin_amdgcn_fractf(p * inv[4 * n + e]);
                            const float s = __builtin_amdgcn_sinf(r), c = __builtin_amdgcn_cosf(r);
                            o1[n][e] = (x1 * c - x2 * s) * ksc; o2[n][e] = (x1 * s + x2 * c) * ksc;
                        }
                    *(u32x4*)(dst + (size_t)row * 1024) = pk8(o1[0], o1[1]);
                    *(u32x4*)(dst + (size_t)row * 1024 + 128) = pk8(o2[0], o2[1]);
                }
        } else {
            const bool isg = u.pn >= 16;
            bf16_t* dst = (isg ? SG : V) + ((u.pn - 8) & 7) * 256 + cl;
#pragma unroll
            for (int ai = 0; ai < 2; ++ai)
#pragma unroll
                for (int m = 0; m < 4; ++m) {
                    const int row = row0 + ai * HALF + m * 16;
                    const float rs = __builtin_amdgcn_rsqf(ss[row] * (1.f / 1024.f) + EPS);
#pragma unroll
                    for (int bj = 0; bj < 2; ++bj) {
                        f32x4 v0 = acc[ai][bj][m][0] * rs + sw[bj][0], v1 = acc[ai][bj][m][1] * rs + sw[bj][1];
                        if (isg) { v0 = silu4(v0); v1 = silu4(v1); }
                        *(u32x4*)(dst + (size_t)row * 2048 + bj * HALF) = pk8(v0, v1);
                    }
                }
        }
    }
};

template <int WHICH> struct EpiRes {
    static constexpr int NOUT = (WHICH == 1) ? 2 : (WHICH == 3 ? 0 : 1);
    static constexpr bool HOOK = (WHICH == 0), SSACC = (WHICH != 3);
    static constexpr bool PERM = true, AFTER_DRAIN = false, SEG = HOOK;
    ptab_t tab;
    __device__ __forceinline__ void seg(f32x4 (&acc)[2][2][4][2], int kk, int tile, int wr) const {
        int lane_ = threadIdx.x & 63; asm volatile("" : "+v"(lane_)); const int fr = lane_ & 15;
        const PG8_LAS float* tb = (const PG8_LAS float*)((const PG8_LAS unsigned char*)tab - 64 - (147456 - 512) + 131072) + (tile * 256 + wr * 64 + fr) * 4 + kk;
#pragma unroll
        for (int ai = 0; ai < 2; ++ai)
#pragma unroll
            for (int m = 0; m < 4; ++m) {
                const float ratio = tb[(ai * HALF + m * 16) * 4];
#pragma unroll
                for (int bj = 0; bj < 2; ++bj)
#pragma unroll
                    for (int n = 0; n < 2; ++n) acc[ai][bj][m][n] *= ratio;
            }
    }
    __device__ __forceinline__ void operator()(f32x4 (&acc)[2][2][4][2], const Unit& u, int wr, int wc, int, int) const {
        int lane_ = threadIdx.x & 63; asm volatile("" : "+v"(lane_)); const int fr = lane_ & 15, fq = lane_ >> 4;
        unsigned char* ws = ldp(tab, T_WS); float* hout = (float*)ldp(tab, T_OUT);
        const float* mods = (const float*)(ws + O_MODS);
        const float* hin = (WHICH == 0) ? (const float*)ldp(tab, 0) : hout;
        const float* gate = mods + (WHICH >= 2 ? 16 * 6144 : 0) + ((WHICH == 0 || WHICH == 2) ? 2048 : 5120);
        const float* g0 = nullptr; const float* sc0 = nullptr; int st0 = 6144; bf16_t* o0 = (bf16_t*)(ws + O_A);
        const float* g1 = nullptr; const float* sc1 = nullptr; const int st1 = 6144; bf16_t* o1 = (bf16_t*)(ws + O_AM1);
        if (WHICH == 0) { g0 = (const float*)ldp(tab, 6); sc0 = mods + 4096; }
        if (WHICH == 1) { g0 = (const float*)ldp(tab, 11); sc0 = (const float*)(ws + O_KVM) + 1024; st0 = 2048; g1 = (const float*)ldp(tab, 5) + 1024; sc1 = mods + 16 * 6144 + 1024; }
        if (WHICH == 2) { g0 = (const float*)ldp(tab, 6) + 1024; sc0 = mods + 16 * 6144 + 4096; }
        float* ss = (float*)(ws + O_SS) + (WHICH + 1) * M_;
        const int b = u.pm >> 3, cl = wc * 32 + 8 * fq, row0 = u.pm * BM + wr * 64 + fr;
        f32x4 gt[2][2], gs0[2][2], gs1[2][2];
#pragma unroll
        for (int bj = 0; bj < 2; ++bj)
#pragma unroll
            for (int n = 0; n < 2; ++n) {
                const int col = u.pn * BM + bj * HALF + cl + 4 * n;
                gt[bj][n] = *(const f32x4*)(gate + b * 6144 + col);
                if (NOUT >= 1) gs0[bj][n] = *(const f32x4*)(g0 + col) * (*(const f32x4*)(sc0 + b * st0 + col) + 1.f);
                if (NOUT >= 2) gs1[bj][n] = *(const f32x4*)(g1 + col) * (*(const f32x4*)(sc1 + b * st1 + col) + 1.f);
            }
#pragma unroll
        for (int ai = 0; ai < 2; ++ai)
#pragma unroll
            for (int m = 0; m < 4; ++m) {
                const int row = row0 + ai * HALF + m * 16;
                const float rs = 1.f;
                float sq = 0.f;
#pragma unroll
                for (int bj = 0; bj < 2; ++bj) {
                    const size_t off = (size_t)row * 1024 + u.pn * BM + bj * HALF + cl;
                    f32x4 h0 = *(const f32x4*)(hin + off), h1 = *(const f32x4*)(hin + off + 4);
                    h0 += gt[bj][0] * (acc[ai][bj][m][0] * rs); h1 += gt[bj][1] * (acc[ai][bj][m][1] * rs);
                    *(f32x4*)(hout + off) = h0; *(f32x4*)(hout + off + 4) = h1;
                    if (SSACC) sq += dot4(h0) + dot4(h1);
                    if (NOUT >= 1) *(u32x4*)(o0 + off) = pk8(h0 * gs0[bj][0], h1 * gs0[bj][1]);
                    if (NOUT >= 2) *(u32x4*)(o1 + off) = pk8(h0 * gs1[bj][0], h1 * gs1[bj][1]);
                }
                if (SSACC) { sq += __shfl_xor(sq, 16); sq += __shfl_xor(sq, 32); if (fq == 0) atomicAdd(ss + row, sq); }
            }
    }
};

struct EpiFfnIn {
    static constexpr bool PERM = true, AFTER_DRAIN = false, SEG = false;
    ptab_t tab; int l;
    __device__ __forceinline__ void operator()(f32x4 (&acc)[2][2][4][2], const Unit& u, int wr, int wc, int, int) const {
        int lane_ = threadIdx.x & 63; asm volatile("" : "+v"(lane_)); const int fr = lane_ & 15, fq = lane_ >> 4;
        unsigned char* ws = ldp(tab, T_WS);
        const float* ss = (const float*)(ws + O_SS) + (l == 0 ? 1 : 3) * M_; const float* sW = (const float*)(ws + O_SW3) + l * 16 * 5632;
        const float* cw = (const float*)ldp(tab, 18) + l * 3 * 5632; const float* cb = (const float*)ldp(tab, 19) + l * 5632;
        bf16_t* ACT = (bf16_t*)(ws + O_ACT); float* HF = (float*)(ws + O_HF); float* HL = (float*)(ws + O_HL);
        const int b = u.pm >> 3, cl = wc * 32 + 8 * fq, row0 = u.pm * BM + wr * 64 + fr, ch = u.pn * HALF + cl;
        {
            f32x4 sw[2][2];
#pragma unroll
            for (int bj = 0; bj < 2; ++bj)
#pragma unroll
                for (int n = 0; n < 2; ++n) sw[bj][n] = *(const f32x4*)(sW + b * 5632 + u.pn * BM + bj * HALF + cl + 4 * n);
#pragma unroll
            for (int ai = 0; ai < 2; ++ai)
#pragma unroll
                for (int m = 0; m < 4; ++m) {
                    const float rs = __builtin_amdgcn_rsqf(ss[row0 + ai * HALF + m * 16] * (1.f / 1024.f) + EPS);
#pragma unroll
                    for (int bj = 0; bj < 2; ++bj)
#pragma unroll
                        for (int n = 0; n < 2; ++n) acc[ai][bj][m][n] = acc[ai][bj][m][n] * rs + sw[bj][n];
                }
        }
#pragma unroll
        for (int ai = 0; ai < 2; ++ai) {
            const int blk = u.pm * 4 + ai * 2 + wr;
            if (fr < 2) {
                float* d = HF + (size_t)(blk * 2 + fr) * 5632 + u.pn * BM + cl;
#pragma unroll
                for (int bj = 0; bj < 2; ++bj)
#pragma unroll
                    for (int n = 0; n < 2; ++n) *(f32x4*)(d + bj * HALF + 4 * n) = acc[ai][bj][0][n];
            }
            if (fr >= 14) {
                float* d = HL + (size_t)(blk * 2 + fr - 14) * 5632 + u.pn * BM + cl;
#pragma unroll
                for (int bj = 0; bj < 2; ++bj)
#pragma unroll
                    for (int n = 0; n < 2; ++n) *(f32x4*)(d + bj * HALF + 4 * n) = acc[ai][bj][3][n];
            }
        }
#pragma unroll
        for (int bj = 0; bj < 2; ++bj)
#pragma unroll
            for (int n = 0; n < 2; ++n) {
                const int colo = bj * 2816 + ch + 4 * n;
                f32x4 w0 = *(const f32x4*)(cw + colo), w1 = *(const f32x4*)(cw + 5632 + colo), w2 = *(const f32x4*)(cw + 2 * 5632 + colo), bb = *(const f32x4*)(cb + colo);
                asm volatile("" : "+v"(w0), "+v"(w1), "+v"(w2), "+v"(bb));
#pragma unroll
                for (int ai = 0; ai < 2; ++ai)
#pragma unroll
                    for (int m = 3; m >= 0; --m) {
                        f32x4 x = acc[ai][bj][m][n]; asm volatile("" : "+v"(x));
                        f32x4 q1 = (f32x4){0.f, 0.f, 0.f, 0.f}, q2 = q1;
                        if (m > 0) { f32x4 xp = acc[ai][bj][m - 1][n]; asm volatile("" : "+v"(xp));
#pragma unroll
                            for (int e = 0; e < 4; ++e) { q1[e] = dppf<0x121>(0.f, xp[e]); q2[e] = dppf<0x122>(0.f, xp[e]); } }
                        f32x4 y;
#pragma unroll
                        for (int e = 0; e < 4; ++e) { const float p1 = dppf<0x111>(q1[e], x[e]), p2 = dppf<0x112>(q2[e], x[e]);
                            y[e] = bb[e] + w2[e] * x[e] + w1[e] * p1 + w0[e] * p2; }
                        asm volatile("" : "+v"(y));
                        acc[ai][bj][m][n] = y;
                    }
            }
#pragma unroll
        for (int ai = 0; ai < 2; ++ai)
#pragma unroll
            for (int m = 0; m < 4; ++m) {
                const int row = row0 + ai * HALF + m * 16;
                const f32x4 v0 = acc[ai][0][m][0] * silu4(acc[ai][1][m][0]), v1 = acc[ai][0][m][1] * silu4(acc[ai][1][m][1]);
                if (m > 0 || fr >= 2) *(u32x4*)(ACT + (size_t)row * 2816 + ch) = pk8(v0, v1);
            }
    }
};

template <int MODE> struct EpiKVQ {
    static constexpr bool PERM = true, AFTER_DRAIN = false, SEG = false;
    ptab_t tab;
    __device__ __forceinline__ void operator()(f32x4 (&acc)[2][2][4][2], const Unit& u, int wr, int wc, int, int) const {
        int lane_ = threadIdx.x & 63; asm volatile("" : "+v"(lane_)); const int fr = lane_ & 15, fq = lane_ >> 4;
        unsigned char* ws = ldp(tab, T_WS);
        const float* ss = (const float*)(ws + O_SS) + 2 * M_; const float* sW = (const float*)(ws + (MODE == 0 ? O_SW5 : O_SW6)); constexpr int nW = (MODE == 0) ? 2048 : 1024;
        const float* gain = (const float*)ldp(tab, MODE == 0 ? 13 : 15); bf16_t* DN = (bf16_t*)(ws + (MODE == 0 ? O_KN : O_QN)); bf16_t* VT = (bf16_t*)(ws + O_VT);
        const int b = u.pm >> 3, row0 = u.pm * BM + wr * 64 + fr, head = 4 * (u.pn & 3) + wc, dl = 8 * fq;
        f32x4 sw[2][2];
#pragma unroll
        for (int bj = 0; bj < 2; ++bj)
#pragma unroll
            for (int n = 0; n < 2; ++n) sw[bj][n] = *(const f32x4*)(sW + b * nW + u.pn * BM + bj * HALF + wc * 32 + dl + 4 * n);
        const bool isv = (MODE == 0) && (u.pn >= 4);
        if (!isv) {
            f32x4 gn[2][2];
#pragma unroll
            for (int bj = 0; bj < 2; ++bj)
#pragma unroll
                for (int n = 0; n < 2; ++n) gn[bj][n] = *(const f32x4*)(gain + 32 * bj + dl + 4 * n) * (MODE == 1 ? 0.125f : 1.f);
#pragma unroll
            for (int ai = 0; ai < 2; ++ai)
#pragma unroll
                for (int m = 0; m < 4; ++m) {
                    const int row = row0 + ai * HALF + m * 16;
                    const float rs = __builtin_amdgcn_rsqf(ss[row] * (1.f / 1024.f) + EPS);
                    f32x4 v[2][2]; float sq = 0.f;
#pragma unroll
                    for (int bj = 0; bj < 2; ++bj)
#pragma unroll
                        for (int n = 0; n < 2; ++n) { v[bj][n] = acc[ai][bj][m][n] * rs + sw[bj][n]; sq += dot4(v[bj][n]); }
                    sq += __shfl_xor(sq, 16); sq += __shfl_xor(sq, 32);
                    const float rh = __builtin_amdgcn_rsqf(sq * (1.f / 64.f) + EPS);
#pragma unroll
                    for (int bj = 0; bj < 2; ++bj) *(u32x4*)(DN + (size_t)row * 1024 + head * 64 + 32 * bj + dl) = pk8(v[bj][0] * gn[bj][0] * rh, v[bj][1] * gn[bj][1] * rh);
                }
        } else {
            bf16_t* vt = VT + (size_t)(b * 16 + head) * 64 * 2048;
#pragma unroll
            for (int ai = 0; ai < 2; ++ai)
#pragma unroll
                for (int m = 0; m < 4; ++m) {
                    const int row = row0 + ai * HALF + m * 16, s = row & 2047;
                    const float rs = __builtin_amdgcn_rsqf(ss[row] * (1.f / 1024.f) + EPS);
#pragma unroll
                    for (int bj = 0; bj < 2; ++bj)
#pragma unroll
                        for (int n = 0; n < 2; ++n) {
                            const f32x4 v = acc[ai][bj][m][n] * rs + sw[bj][n];
#pragma unroll
                            for (int e = 0; e < 4; e += 2) { const unsigned w = pk_bf16(v[e], v[e + 1]); const int d = 32 * bj + dl + 4 * n + e;
                                vt[(size_t)d * 2048 + s] = (bf16_t)(w & 0xffffu); vt[(size_t)(d + 1) * 2048 + s] = (bf16_t)(w >> 16); }
                        }
                }
        }
    }
};
template <class Epi, class Sched, bool ALIGN_EPI = false, bool SP2 = false>
__device__ __forceinline__ void gemm_phase(PG8_LAS unsigned char* lds, const Gemm g, const Sched& S, const Epi& E) {
    const int tid = threadIdx.x, wid = __builtin_amdgcn_readfirstlane(tid >> 6), lane = tid & 63, wr = wid >> 2, wc = wid & 3, fr = lane & 15, fq = lane >> 4;
    const int K = g.ld, nt = g.K / BK;
    unsigned voffA[2], voffB[2];
#pragma unroll
    for (int i = 0; i < 2; ++i) { int R, C; stage_rc(tid * 16 + i * 8192, R, C); const int Rb = Epi::PERM ? ((R & ~31) + perm32(R & 31)) : R;
        voffA[i] = (unsigned)(R * K + C) * 2u; voffB[i] = (unsigned)(Rb * K + C) * 2u; }
    const size_t kstep = (size_t)(BK * 2);
    const size_t hstep = (size_t)HALF * K * 2;
    const size_t tstep = 2 * hstep;
    const unsigned ldsw = (unsigned)wid * 1024u;
    const int aoff = lds_byte(wr * 64 + fr, fq * 8), boff = lds_byte(wc * 32 + fr, fq * 8);
#define PG8_SA(b, h) (((b) * 2 + (h)) * HTB)
#define PG8_SB(b, h) ((4 + (b) * 2 + (h)) * HTB)
#define PG8_STAGE(bufoff, gbase, voff) do { _Pragma("unroll") for (int _i = 0; _i < 2; ++_i) \
        __builtin_amdgcn_global_load_lds((const unsigned*)((const char*)(gbase) + (voff)[_i]), (PG8_LAS unsigned*)(lds + (bufoff) + ldsw + _i * 8192), 16, 0, 0); } while (0)
#define PG8_LDA(dst, b, h) do { _Pragma("unroll") for (int m = 0; m < 4; ++m) _Pragma("unroll") for (int k = 0; k < 2; ++k) dst[m][k] = *(const PG8_LAS bf16x8*)(lds + PG8_SA(b, h) + aoff + m * 2048 + k * 1024); } while (0)
#define PG8_LDB(dst, b, h) do { _Pragma("unroll") for (int n = 0; n < 2; ++n) _Pragma("unroll") for (int k = 0; k < 2; ++k) dst[n][k] = *(const PG8_LAS bf16x8*)(lds + PG8_SB(b, h) + boff + n * 2048 + k * 1024); } while (0)
#define PG8_MMA(ai, bj, At, Bt) do { __builtin_amdgcn_s_setprio(1); _Pragma("unroll") for (int m = 0; m < 4; ++m) _Pragma("unroll") for (int n = 0; n < 2; ++n) _Pragma("unroll") for (int k = 0; k < 2; ++k) \
        acc[ai][bj][m][n] = __builtin_amdgcn_mfma_f32_16x16x32_bf16(Bt[n][k], At[m][k], acc[ai][bj][m][n], 0, 0, 0); __builtin_amdgcn_s_setprio(0); } while (0)
#define PG8_WAIT_V(n) asm volatile("s_waitcnt vmcnt(" #n ")" ::: "memory")
#define PG8_WAIT_L(n) asm volatile("s_waitcnt lgkmcnt(" #n ")" ::: "memory")
#define PG8_BAR __builtin_amdgcn_s_barrier()
#define PG8_SCHED __builtin_amdgcn_sched_barrier(0)
    Unit cur, nxt; int ui = 0;
    if (!S.next(0, cur)) return;
    f32x4 acc[2][2][4][2];
#pragma unroll
    for (int a = 0; a < 2; ++a)
#pragma unroll
        for (int b = 0; b < 2; ++b)
#pragma unroll
            for (int m = 0; m < 4; ++m)
#pragma unroll
                for (int n = 0; n < 2; ++n) acc[a][b][m][n] = (f32x4){0.f, 0.f, 0.f, 0.f};
    bf16x8 At[4][2], B0[2][2], B1[2][2];
    const size_t sstep = (size_t)g.K * 2;
    const char* cA = (const char*)g.A + (size_t)cur.pm * tstep + cur.kk * sstep; const char* cB = (const char*)g.Bt + (size_t)cur.pn * tstep + cur.kk * sstep;
    S.a_ready(cur);
    if constexpr (SP2) {
        PG8_STAGE(PG8_SB(0, 0), cB, voffB); PG8_STAGE(PG8_SB(0, 1), cB + hstep, voffB); PG8_STAGE(PG8_SA(0, 0), cA, voffA); PG8_STAGE(PG8_SA(0, 1), cA + hstep, voffA);
        if (wr == 1) PG8_BAR;
        PG8_WAIT_V(2); PG8_BAR;
        PG8_STAGE(PG8_SB(1, 0), cB + kstep, voffB); PG8_STAGE(PG8_SA(1, 0), cA + kstep, voffA); PG8_STAGE(PG8_SB(1, 1), cB + hstep + kstep, voffB);
        PG8_WAIT_V(6); PG8_BAR;
    } else {
        PG8_STAGE(PG8_SB(0, 0), cB, voffB); PG8_STAGE(PG8_SA(0, 0), cA, voffA); PG8_STAGE(PG8_SB(0, 1), cB + hstep, voffB); PG8_STAGE(PG8_SA(0, 1), cA + hstep, voffA);
        if (wr == 1) PG8_BAR;
        PG8_WAIT_V(4); PG8_BAR;
        PG8_STAGE(PG8_SB(1, 0), cB + kstep, voffB); PG8_STAGE(PG8_SA(1, 0), cA + kstep, voffA); PG8_STAGE(PG8_SB(1, 1), cB + hstep + kstep, voffB);
        PG8_WAIT_V(6); PG8_BAR;
    }
    for (;;) {
        const bool has_next = S.next(ui + 1, nxt);
        const char* nA = has_next ? (const char*)g.A + (size_t)nxt.pm * tstep + nxt.kk * sstep : cA; const char* nB = has_next ? (const char*)g.Bt + (size_t)nxt.pn * tstep + nxt.kk * sstep : cB;
        for (int t = 0; t < nt; t += 2) {
            const bool last = (t == nt - 2);
            const char* a1 = cA + (size_t)(t + 1) * kstep;
            const char* a2 = last ? nA : cA + (size_t)(t + 2) * kstep; const char* b2 = last ? nB : cB + (size_t)(t + 2) * kstep;
            const char* a3 = a2 + kstep; const char* b3 = b2 + kstep;
            if (last && has_next) S.a_ready(nxt);
            if constexpr (SP2) {
            PG8_LDB(B0, 0, 0); PG8_LDB(B1, 0, 1); PG8_SCHED; PG8_LDA(At, 0, 0); PG8_STAGE(PG8_SA(1, 1), a1 + hstep, voffA);
            PG8_WAIT_V(8); PG8_WAIT_L(0); PG8_BAR; PG8_MMA(0, 0, At, B0); PG8_MMA(0, 1, At, B1); PG8_BAR; PG8_SCHED;
            PG8_LDA(At, 0, 1); PG8_STAGE(PG8_SB(0, 0), b2, voffB); PG8_STAGE(PG8_SB(0, 1), b2 + hstep, voffB); PG8_STAGE(PG8_SA(0, 0), a2, voffA);
            PG8_WAIT_V(8); PG8_WAIT_L(0); PG8_BAR; PG8_MMA(1, 0, At, B0); PG8_MMA(1, 1, At, B1); PG8_BAR; PG8_SCHED;
            PG8_LDB(B0, 1, 0); PG8_LDB(B1, 1, 1); PG8_SCHED; PG8_LDA(At, 1, 0); PG8_STAGE(PG8_SA(0, 1), a2 + hstep, voffA);
            PG8_WAIT_V(8); PG8_WAIT_L(0); PG8_BAR; PG8_MMA(0, 0, At, B0); PG8_MMA(0, 1, At, B1); PG8_BAR; PG8_SCHED;
            PG8_LDA(At, 1, 1); PG8_STAGE(PG8_SB(1, 0), b3, voffB); PG8_STAGE(PG8_SB(1, 1), b3 + hstep, voffB); PG8_STAGE(PG8_SA(1, 0), a3, voffA);
            PG8_WAIT_V(8); PG8_WAIT_L(0); PG8_BAR; PG8_MMA(1, 0, At, B0); PG8_MMA(1, 1, At, B1); PG8_BAR; PG8_SCHED;
            } else {
            PG8_LDB(B0, 0, 0); PG8_SCHED; PG8_LDA(At, 0, 0); PG8_STAGE(PG8_SA(1, 1), a1 + hstep, voffA);
            PG8_WAIT_L(8); PG8_BAR; PG8_WAIT_L(0); PG8_MMA(0, 0, At, B0); PG8_BAR; PG8_SCHED;
            PG8_LDB(B1, 0, 1); PG8_STAGE(PG8_SB(0, 0), b2, voffB);
            PG8_BAR; PG8_WAIT_L(0); PG8_MMA(0, 1, At, B1); PG8_BAR;
            PG8_LDA(At, 0, 1); PG8_STAGE(PG8_SA(0, 0), a2, voffA);
            PG8_BAR; PG8_WAIT_L(0); PG8_MMA(1, 0, At, B0); PG8_BAR; PG8_SCHED;
            PG8_STAGE(PG8_SB(0, 1), b2 + hstep, voffB);
            PG8_WAIT_V(6); PG8_BAR; PG8_MMA(1, 1, At, B1); PG8_BAR;
            PG8_LDB(B0, 1, 0); PG8_SCHED; PG8_LDA(At, 1, 0); PG8_STAGE(PG8_SA(0, 1), a2 + hstep, voffA);
            PG8_WAIT_L(8); PG8_BAR; PG8_WAIT_L(0); PG8_MMA(0, 0, At, B0); PG8_BAR; PG8_SCHED;
            PG8_LDB(B1, 1, 1); PG8_STAGE(PG8_SB(1, 0), b3, voffB);
            PG8_BAR; PG8_WAIT_L(0); PG8_MMA(0, 1, At, B1); PG8_BAR;
            PG8_LDA(At, 1, 1); PG8_STAGE(PG8_SA(1, 0), a3, voffA);
            PG8_BAR; PG8_WAIT_L(0); PG8_MMA(1, 0, At, B0); PG8_BAR; PG8_SCHED;
            PG8_STAGE(PG8_SB(1, 1), b3 + hstep, voffB);
            PG8_WAIT_V(6); PG8_BAR; PG8_MMA(1, 1, At, B1); PG8_BAR;
            }
        }
        if constexpr (ALIGN_EPI) { if (wr == 0) PG8_BAR; }
        if constexpr (Epi::SEG) E.seg(acc, cur.kk, ui >> 2, wr);
        if (!Epi::SEG || cur.kk == 3) {
            if constexpr (!Epi::AFTER_DRAIN) { E(acc, cur, wr, wc, fr, fq); S.done(cur); }
            if (!has_next) break;
#pragma unroll
            for (int a = 0; a < 2; ++a)
#pragma unroll
                for (int b = 0; b < 2; ++b)
#pragma unroll
                    for (int m = 0; m < 4; ++m)
#pragma unroll
                        for (int n = 0; n < 2; ++n) acc[a][b][m][n] = (f32x4){0.f, 0.f, 0.f, 0.f};
        }
        cur = nxt; cA = nA; cB = nB; ++ui;
        if constexpr (ALIGN_EPI) { if (wr == 1) PG8_BAR; }
    }
    PG8_WAIT_V(0);
    if constexpr (!ALIGN_EPI) { if (wr == 0) PG8_BAR; }
    PG8_BAR;
    if constexpr (Epi::AFTER_DRAIN) { E.fused(acc, cur, wr, wc, fr, fq, lds, wid, lane); S.done(cur); }
#undef PG8_SA
#undef PG8_SB
#undef PG8_STAGE
#undef PG8_LDA
#undef PG8_LDB
#undef PG8_MMA
#undef PG8_WAIT_V
#undef PG8_WAIT_L
#undef PG8_BAR
#undef PG8_SCHED
}
}

#define LAS __attribute__((address_space(3)))
typedef unsigned short bf16;
typedef float f32x4 __attribute__((ext_vector_type(4)));
typedef float f32x16 __attribute__((ext_vector_type(16)));
typedef short bf16x8 __attribute__((ext_vector_type(8)));
typedef short s16x4 __attribute__((ext_vector_type(4)));
typedef unsigned u32x4 __attribute__((ext_vector_type(4)));
typedef unsigned u32x2 __attribute__((ext_vector_type(2)));
using pg8::pk_bf16; using pg8::EPS;

#ifndef MK_ONE_LAUNCH
#define MK_ONE_LAUNCH 1
#endif
constexpr int NWAVES = 8, NTHREADS = 512;
constexpr int NB = 16, SEQ = 2048, D = 1024, M = NB * SEQ, FF = 2816, FF2 = 5632, RN = 6144;
constexpr int NPHASE = 14;

constexpr size_t MiB = 1u << 20;
constexpr size_t WS_CTL = 0;
constexpr size_t WS_MODS = pg8::O_MODS, WS_KVM = pg8::O_KVM, WS_SW1 = pg8::O_SW1, WS_SW3 = pg8::O_SW3, WS_SW5 = pg8::O_SW5, WS_SW6 = pg8::O_SW6, WS_SS = pg8::O_SS, WS_SSO = pg8::O_SSO;
static_assert(pg8::O_SMALL_END <= 6 * MiB && pg8::M_ == M, "small region");
constexpr size_t WS_WT1 = 6 * MiB;
constexpr size_t WS_WT2 = WS_WT1 + (size_t)6144 * 1024 * 2;
constexpr size_t WS_WT3 = WS_WT2 + (size_t)1024 * 2048 * 2;
constexpr size_t WS_WT4 = WS_WT3 + (size_t)2 * 5632 * 1024 * 2;
constexpr size_t WS_WT5 = WS_WT4 + (size_t)2 * 1024 * 2816 * 2;
constexpr size_t WS_WT6 = WS_WT5 + (size_t)2048 * 1024 * 2;
constexpr size_t WS_WT7 = WS_WT6 + (size_t)1024 * 1024 * 2;
static_assert(WS_WT7 + (size_t)1024 * 1024 * 2 <= 64 * MiB, "weights region");
constexpr size_t WS_A = pg8::O_A, WS_Q = pg8::O_Q, WS_KD = pg8::O_KD, WS_V = pg8::O_V, WS_SG = pg8::O_SG, WS_ACT = pg8::O_ACT, WS_HF = pg8::O_HF, WS_HL = pg8::O_HL, WS_AM1 = pg8::O_AM1,
                 WS_KN = pg8::O_KN, WS_VT = pg8::O_VT, WS_QN = pg8::O_QN, WS_OSB = pg8::O_OSB;
constexpr size_t WS_END = 512 * MiB;
static_assert((size_t)512 * 2 * 5632 * 4 <= 22 * MiB && WS_HL + 22 * MiB <= WS_AM1 && WS_AM1 + 64 * MiB <= WS_OSB && WS_OSB + 64 * MiB <= WS_END && WS_ACT + (size_t)M * FF * 2 <= WS_HF, "big region");

constexpr int LDS_BYTES = 147456;
constexpr int MISC_OFF = LDS_BYTES - 512;
using pg8::ptab_t; using pg8::ldp; using pg8::T_OUT; using pg8::T_WS;

#define LBAR() do { asm volatile("s_waitcnt lgkmcnt(0)" ::: "memory"); __builtin_amdgcn_s_barrier(); asm volatile("" ::: "memory"); } while (0)

#define XB_TMO      128
#define XB_XCNT(j)  (256  + 64 * (j))
#define XB_XSUB(j)  (1280 + 64 * (j))
#define XB_XGEN(j)  (2304 + 64 * (j))
#define XB_TOP      3328
#define XB_TOPGEN   3392
#define XCD_BAR_WORDS 3456
#define XB_SPIN_CAP (1u << 20)
__device__ __forceinline__ unsigned xb_ld(unsigned* p)              { return __hip_atomic_load(p, __ATOMIC_RELAXED, __HIP_MEMORY_SCOPE_AGENT); }
__device__ __forceinline__ unsigned xb_add(unsigned* p, unsigned v) { return __hip_atomic_fetch_add(p, v, __ATOMIC_RELAXED, __HIP_MEMORY_SCOPE_AGENT); }
__device__ __forceinline__ unsigned xb_xcc_id() { return (unsigned)__builtin_amdgcn_s_getreg((3 << 11) | 20) & 0xFu; }
#define XB_SPIN(cond, bar) do { unsigned _sp = 0; while (cond) { __builtin_amdgcn_s_sleep(1); \
    if ((++_sp & 255u) == 0u) { if (xb_ld(&(bar)[XB_TMO])) break; if (_sp > XB_SPIN_CAP) { atomicAdd(&(bar)[XB_TMO], 1u); break; } } } } while (0)
struct XcdBarrier { unsigned* bar; unsigned x; volatile LAS unsigned* st; };
__device__ __forceinline__ XcdBarrier xcd_barrier_post(unsigned* bar, volatile LAS unsigned* st) {
    XcdBarrier b; b.bar = bar; b.x = xb_xcc_id(); b.st = st;
    if (threadIdx.x == 0) (void)xb_add(&bar[XB_XCNT(b.x)], 1u);
    return b;
}
__device__ __forceinline__ void xcd_barrier_complete(unsigned* bar, unsigned x, unsigned& nloc, unsigned& nx) {
    const unsigned G = gridDim.x * gridDim.y * gridDim.z;
    unsigned sum, cnt, mine, sp = 0u;
    for (;;) {
        sum = 0u; cnt = 0u; mine = 0u;
#pragma unroll
        for (unsigned j = 0; j < 16; ++j) { const unsigned c = xb_ld(&bar[XB_XCNT(j)]); sum += c; cnt += (c > 0u) ? 1u : 0u; mine = (j == x) ? c : mine; }
        if (sum == G) break;
        __builtin_amdgcn_s_sleep(1);
        if ((++sp & 255u) == 0u) { if (xb_ld(&bar[XB_TMO])) break; if (sp > XB_SPIN_CAP) { atomicAdd(&bar[XB_TMO], 1u); break; } }
    }
    nloc = mine > 0u ? mine : 1u; nx = cnt > 0u ? cnt : 1u;
}
__device__ __forceinline__ void xcd_barrier(const XcdBarrier& b) {
    asm volatile("s_waitcnt vmcnt(0)" ::: "memory");
    __syncthreads();
    if (threadIdx.x == 0) {
        unsigned* bar = b.bar;
        __builtin_amdgcn_s_waitcnt(0);
        unsigned nloc = b.st[0], nx = b.st[1];
        if (nloc == 0u) { xcd_barrier_complete(bar, b.x, nloc, nx); b.st[0] = nloc; b.st[1] = nx; }
        const unsigned old = xb_add(&bar[XB_XSUB(b.x)], 1u);
        const unsigned gen = old / nloc;
        if (old + 1u == (gen + 1u) * nloc) {
            __builtin_amdgcn_fence(__ATOMIC_RELEASE, "agent");
            asm volatile("s_waitcnt vmcnt(0)" ::: "memory");
            const unsigned og = xb_add(&bar[XB_TOP], 1u);
            const unsigned tg = og / nx;
            if (og + 1u == (tg + 1u) * nx) xb_add(&bar[XB_TOPGEN], 1u);
            else XB_SPIN(xb_ld(&bar[XB_TOPGEN]) == tg, bar);
            __builtin_amdgcn_fence(__ATOMIC_ACQUIRE, "agent");
            xb_add(&bar[XB_XGEN(b.x)], 1u);
            asm volatile("s_waitcnt vmcnt(0)" ::: "memory");
        } else {
            XB_SPIN(xb_ld(&bar[XB_XGEN(b.x)]) == gen, bar);
            __builtin_amdgcn_fence(__ATOMIC_ACQUIRE, "agent");
            asm volatile("s_waitcnt vmcnt(0)" ::: "memory");
        }
    }
    __syncthreads();
}

__device__ __forceinline__ float wave_sum(float v) {
#pragma unroll
    for (int o = 1; o < 64; o <<= 1) v += __shfl_xor(v, o);
    return v;
}
__device__ __forceinline__ float bf2f(unsigned short u) { return __builtin_bit_cast(float, (unsigned)u << 16); }

struct Args { const void* in[21]; float* out; unsigned char* ws; int ph_lo, ph_hi; };

__device__ __forceinline__ void p0_transpose_item(const float* W, int K, int N, bf16* WT, int k0, int sc, int nd0, LAS float* scr, int lane) {
#pragma unroll 8
    for (int i = 0; i < 32; ++i) { const int kk = 2 * i + (lane >> 5); scr[kk * 33 + (lane & 31)] = W[(size_t)(k0 + kk) * N + sc + (lane & 31)]; }
    asm volatile("s_waitcnt lgkmcnt(0)" ::: "memory");
    const int c = lane & 7;
#pragma unroll
    for (int j = 0; j < 4; ++j) { const int n = (lane >> 3) + 8 * j; const LAS float* s = scr + (8 * c) * 33 + n;
        u32x4 o; o.x = pk_bf16(s[0 * 33], s[1 * 33]); o.y = pk_bf16(s[2 * 33], s[3 * 33]); o.z = pk_bf16(s[4 * 33], s[5 * 33]); o.w = pk_bf16(s[6 * 33], s[7 * 33]);
        *(u32x4*)(WT + (size_t)(nd0 + n) * K + k0 + 8 * c) = o; }
    asm volatile("s_waitcnt lgkmcnt(0)" ::: "memory");
}
__device__ __forceinline__ int src_col(int type, int nd0) {
    if (type == 0) return nd0;
    const int pn = nd0 >> 8, r = nd0 & 255, bj = r >> 7;
    if (type == 1) return bj * FF + 128 * pn + (r & 127);
    const int wc = (r & 127) >> 5, head = 4 * (pn & 3) + wc;
    return (pn >= 4 ? 1024 : 0) + head * 64 + 32 * bj;
}
__device__ __forceinline__ void p0_phase(ptab_t tab, LAS unsigned char* lds, int vcu, int G) {
    const int tid = threadIdx.x, lane = tid & 63, w = __builtin_amdgcn_readfirstlane(tid >> 6);
    unsigned char* ws = ldp(tab, T_WS);
    { float* z = (float*)(ws + WS_SS) + M; const int n = 3 * M + 4 * M;
      for (int i = vcu * NTHREADS + tid; i < n / 4; i += G * NTHREADS) ((f32x4*)z)[i] = (f32x4){0.f, 0.f, 0.f, 0.f}; }
    if (vcu < 224) {
        LAS float* cact = (LAS float*)lds;
        LAS float* part = (LAS float*)(lds + 65536);
        const float* c = (const float*)ldp(tab, 1);
        for (int i = tid; i < 16 * 1024; i += NTHREADS) { const float x = c[i]; cact[i] = pg8::silu_f(x); }
        LBAR();
        const int col = vcu * 64;
        const float* W; int N, cw; const float* bias; float* dst; int dstride;
        if (col < 12288) { const int l = col / 6144; cw = col - l * 6144; W = (const float*)ldp(tab, 3) + (size_t)l * 1024 * 6144; N = 6144; bias = (const float*)ldp(tab, 4) + l * 6144; dst = (float*)(ws + WS_MODS) + (size_t)l * 16 * 6144; dstride = 6144; }
        else { cw = col - 12288; W = (const float*)ldp(tab, 9); N = 2048; bias = (const float*)ldp(tab, 10); dst = (float*)(ws + WS_KVM); dstride = 2048; }
        float acc[16];
#pragma unroll
        for (int b = 0; b < 16; ++b) acc[b] = 0.f;
        const float* wp = W + (size_t)(128 * w) * N + cw + lane;
#pragma unroll 2
        for (int kk = 0; kk < 128; kk += 4) {
            const float w0 = wp[(size_t)(kk + 0) * N], w1 = wp[(size_t)(kk + 1) * N], w2 = wp[(size_t)(kk + 2) * N], w3 = wp[(size_t)(kk + 3) * N];
#pragma unroll
            for (int b = 0; b < 16; ++b) { const f32x4 cv = *(const LAS f32x4*)(cact + b * 1024 + 128 * w + kk); acc[b] += (cv[0] * w0 + cv[1] * w1) + (cv[2] * w2 + cv[3] * w3); }
        }
#pragma unroll
        for (int b = 0; b < 16; ++b) part[(w * 16 + b) * 64 + lane] = acc[b];
        LBAR();
        for (int o = tid; o < 1024; o += NTHREADS) { const int b = o >> 6, l = o & 63; float s = bias[cw + l];
#pragma unroll
            for (int ww = 0; ww < 8; ++ww) s += part[(ww * 16 + b) * 64 + l];
            dst[(size_t)b * dstride + cw + l] = s; }
        LBAR();
    }
    {
        LAS float* scr = (LAS float*)(lds + w * 8448);
        const int gw = vcu * NWAVES + w, NGW = G * NWAVES;
        constexpr int I0 = 16 * 192, I1 = 32 * 32, I2 = 16 * 176, I4 = 44 * 32, I6 = 16 * 64, I7 = 16 * 32;
        constexpr int NIT = I0 + I1 + 2 * I2 + 2 * I4 + I6 + 2 * I7;
        for (int it = gw; it < NIT; it += NGW) {
            int r = it; const float* W; int K, N, type; bf16* WT;
            if (r < I0) { W = (const float*)ldp(tab, 7); K = 1024; N = 6144; type = 0; WT = (bf16*)(ws + WS_WT1); }
            else if ((r -= I0) < I1) { W = (const float*)ldp(tab, 8); K = 2048; N = 1024; type = 0; WT = (bf16*)(ws + WS_WT2); }
            else if ((r -= I1) < 2 * I2) { const int l = r / I2; r -= l * I2; W = (const float*)ldp(tab, 17) + (size_t)l * 1024 * FF2; K = 1024; N = FF2; type = 1; WT = (bf16*)(ws + WS_WT3) + (size_t)l * FF2 * 1024; }
            else if ((r -= 2 * I2) < 2 * I4) { const int l = r / I4; r -= l * I4; W = (const float*)ldp(tab, 20) + (size_t)l * FF * 1024; K = FF; N = 1024; type = 0; WT = (bf16*)(ws + WS_WT4) + (size_t)l * 1024 * FF; }
            else if ((r -= 2 * I4) < I6) { W = (const float*)ldp(tab, 12); K = 1024; N = 2048; type = 2; WT = (bf16*)(ws + WS_WT5); }
            else if ((r -= I6) < I7) { W = (const float*)ldp(tab, 14); K = 1024; N = 1024; type = 2; WT = (bf16*)(ws + WS_WT6); }
            else { r -= I7; W = (const float*)ldp(tab, 16); K = 1024; N = 1024; type = 0; WT = (bf16*)(ws + WS_WT7); }
            const int nblk = N / 32, kb = r / nblk, nb = r - kb * nblk;
            p0_transpose_item(W, K, N, WT, 64 * kb, src_col(type, 32 * nb), 32 * nb, scr, lane);
        }
    }
}

__device__ __forceinline__ void p1_phase(ptab_t tab, LAS unsigned char* lds, int vcu, int G) {
    const int tid = threadIdx.x, lane = tid & 63, w = __builtin_amdgcn_readfirstlane(tid >> 6);
    unsigned char* ws = ldp(tab, T_WS);
    const float* mods = (const float*)(ws + WS_MODS);
    const int gw = vcu * NWAVES + w, NGW = G * NWAVES;
    {
        const float* x = (const float*)ldp(tab, 0); const float* g = (const float*)ldp(tab, 5);
        bf16* A0 = (bf16*)(ws + WS_A); float* ss0 = (float*)(ws + WS_SS);
        const int rpw = M / NGW;
        for (int r0 = gw * rpw; r0 < M; r0 += NGW * rpw) {
            const int b = r0 / SEQ;
            f32x4 gs[4];
#pragma unroll
            for (int j = 0; j < 4; ++j) { const int col = 4 * lane + 256 * j; gs[j] = *(const f32x4*)(g + col) * (*(const f32x4*)(mods + (size_t)b * 6144 + 1024 + col) + 1.f); }
            for (int r = r0; r < r0 + rpw; ++r) {
                f32x4 v[4]; float s = 0.f;
#pragma unroll
                for (int j = 0; j < 4; ++j) { v[j] = *(const f32x4*)(x + (size_t)r * D + 4 * lane + 256 * j); s += pg8::dot4(v[j]); }
                s = wave_sum(s);
                if (lane == 0) ss0[r] = s;
#pragma unroll
                for (int j = 0; j < 4; ++j) { const f32x4 o = v[j] * gs[j]; u32x2 p; p.x = pk_bf16(o[0], o[1]); p.y = pk_bf16(o[2], o[3]); *(u32x2*)(A0 + (size_t)r * D + 4 * lane + 256 * j) = p; }
            }
        }
    }
    {
        LAS float* sh = (LAS float*)lds;
        for (int ty = 0; ty < 5; ++ty) {
            const float* sp; int sst, N; const bf16* WT; float* dst;
            if (ty == 0)      { sp = mods;                         sst = 6144; N = RN;   WT = (const bf16*)(ws + WS_WT1); dst = (float*)(ws + WS_SW1); }
            else if (ty == 1) { sp = mods + 3072;                  sst = 6144; N = FF2;  WT = (const bf16*)(ws + WS_WT3); dst = (float*)(ws + WS_SW3); }
            else if (ty == 2) { sp = mods + 16 * 6144 + 3072;      sst = 6144; N = FF2;  WT = (const bf16*)(ws + WS_WT3) + (size_t)FF2 * 1024; dst = (float*)(ws + WS_SW3) + 16 * FF2; }
            else if (ty == 3) { sp = (const float*)(ws + WS_KVM);  sst = 2048; N = 2048; WT = (const bf16*)(ws + WS_WT5); dst = (float*)(ws + WS_SW5); }
            else              { sp = mods + 16 * 6144;             sst = 6144; N = 1024; WT = (const bf16*)(ws + WS_WT6); dst = (float*)(ws + WS_SW6); }
            LBAR();
            for (int i = tid; i < 16 * 1024; i += NTHREADS) sh[i] = sp[(size_t)(i >> 10) * sst + (i & 1023)];
            LBAR();
            for (int n = gw; n < N; n += NGW) {
                const u32x4 w0 = *(const u32x4*)(WT + (size_t)n * 1024 + 8 * lane), w1 = *(const u32x4*)(WT + (size_t)n * 1024 + 512 + 8 * lane);
                float wf[16];
#pragma unroll
                for (int i = 0; i < 4; ++i) { wf[2 * i] = __builtin_bit_cast(float, w0[i] << 16); wf[2 * i + 1] = __builtin_bit_cast(float, w0[i] & 0xffff0000u);
                                              wf[8 + 2 * i] = __builtin_bit_cast(float, w1[i] << 16); wf[8 + 2 * i + 1] = __builtin_bit_cast(float, w1[i] & 0xffff0000u); }
                float mine = 0.f;
#pragma unroll
                for (int b = 0; b < 16; ++b) {
                    const LAS float* s0 = sh + b * 1024 + 8 * lane;
                    const f32x4 a0 = *(const LAS f32x4*)s0, a1 = *(const LAS f32x4*)(s0 + 4), a2 = *(const LAS f32x4*)(s0 + 512), a3 = *(const LAS f32x4*)(s0 + 516);
                    float p = (a0[0] * wf[0] + a0[1] * wf[1]) + (a0[2] * wf[2] + a0[3] * wf[3]) + (a1[0] * wf[4] + a1[1] * wf[5]) + (a1[2] * wf[6] + a1[3] * wf[7])
                            + (a2[0] * wf[8] + a2[1] * wf[9]) + (a2[2] * wf[10] + a2[3] * wf[11]) + (a3[0] * wf[12] + a3[1] * wf[13]) + (a3[2] * wf[14] + a3[3] * wf[15]);
                    p = wave_sum(p);
                    if (lane == b) mine = p;
                }
                if (lane < 16) dst[(size_t)lane * N + n] = mine;
            }
        }
    }
}

constexpr int RT_QROWB = 528, RT_VROWB = 272, RT_PROWB = 144;
constexpr int RT_QS = 0, RT_KS = 64 * RT_QROWB, RT_VS = 2 * 64 * RT_QROWB, RT_PS = RT_VS + 64 * RT_VROWB, RT_BYTES = RT_PS + 64 * RT_PROWB;
static_assert(RT_BYTES <= MISC_OFF, "retention LDS");
__device__ __forceinline__ s16x4 tr16(const LAS unsigned char* p) { typedef short v4i16_t __attribute__((ext_vector_type(4))); return __builtin_bit_cast(s16x4, __builtin_amdgcn_ds_read_tr16_b64_v4i16((LAS v4i16_t*)p)); }
#define MFMA16(a, b, c) __builtin_amdgcn_mfma_f32_16x16x32_bf16((a), (b), (c), 0, 0, 0)
#define MFMA32(a, b, c) __builtin_amdgcn_mfma_f32_32x32x16_bf16((a), (b), (c), 0, 0, 0)
__device__ __forceinline__ bf16x8 cat8(s16x4 lo, s16x4 hi) { return (bf16x8){lo[0], lo[1], lo[2], lo[3], hi[0], hi[1], hi[2], hi[3]}; }
__device__ __forceinline__ bf16x8 pack8(const f32x4 a, const f32x4 b) { return __builtin_bit_cast(bf16x8, pg8::pk8(a, b)); }

__device__ __forceinline__ void ret_unit(LAS unsigned char* lds, const bf16* Q, const bf16* KD, const bf16* V, bf16* SG, float* SSO, int unit) {
    const int tid = threadIdx.x, lane = tid & 63, w = __builtin_amdgcn_readfirstlane(tid >> 6);
    const int b = unit >> 4, h = (unit >> 2) & 3, vs = unit & 3;
    const int c16 = lane & 15, g4 = lane >> 4;
    const float lg2 = __builtin_amdgcn_logf(1.f - __builtin_amdgcn_exp2f(-5.f - (float)h));
    const float gC = __builtin_amdgcn_exp2f(lg2 * 64.f);
    const char* gQ = (const char*)(Q + (size_t)b * SEQ * 1024 + h * 256);
    const char* gK = (const char*)(KD + (size_t)b * SEQ * 1024 + h * 256);
    const char* gV = (const char*)(V + (size_t)b * SEQ * 2048 + h * 512 + vs * 128);
    u32x4 pq[4], pk[4], pv[2];
#define RT_LOAD(c) do { _Pragma("unroll") for (int j = 0; j < 4; ++j) { const int cc = tid + 512 * j, row = cc >> 5, ck = cc & 31; const size_t go = (size_t)((c) * 64 + row) * 2048 + ck * 16; \
        pq[j] = *(const u32x4*)(gQ + go); pk[j] = *(const u32x4*)(gK + go); } \
        _Pragma("unroll") for (int j = 0; j < 2; ++j) { const int cc = tid + 512 * j, row = cc >> 4, ck = cc & 15; pv[j] = *(const u32x4*)(gV + (size_t)((c) * 64 + row) * 4096 + ck * 16); } } while (0)
#define RT_STORE() do { _Pragma("unroll") for (int j = 0; j < 4; ++j) { const int cc = tid + 512 * j, row = cc >> 5, ck = cc & 31; *(LAS u32x4*)(lds + RT_QS + row * RT_QROWB + ck * 16) = pq[j]; *(LAS u32x4*)(lds + RT_KS + row * RT_QROWB + ck * 16) = pk[j]; } \
        _Pragma("unroll") for (int j = 0; j < 2; ++j) { const int cc = tid + 512 * j, row = cc >> 4, ck = cc & 15; *(LAS u32x4*)(lds + RT_VS + row * RT_VROWB + ck * 16) = pv[j]; } } while (0)
    f32x4 st[16], oc[4], sT[2]; bf16x8 vf[2];
#pragma unroll
    for (int i = 0; i < 16; ++i) st[i] = (f32x4){0.f, 0.f, 0.f, 0.f};
#pragma unroll
    for (int i = 0; i < 4; ++i) oc[i] = (f32x4){0.f, 0.f, 0.f, 0.f};
    const int ntS = w & 3, mtb = 2 * (w >> 2);
    const LAS unsigned char* qrowS = lds + RT_QS + (16 * ntS + c16) * RT_QROWB + g4 * 16;
    const LAS unsigned char* krowS = lds + RT_KS + (16 * mtb + c16) * RT_QROWB + g4 * 16;
    const LAS unsigned char* qrowC = lds + RT_QS + c16 * RT_QROWB + g4 * 8;
    const LAS unsigned char* ktr = lds + RT_KS + (8 * g4 + (c16 >> 2)) * RT_QROWB + (c16 & 3) * 8;
    const LAS unsigned char* vtr = lds + RT_VS + (8 * g4 + (c16 >> 2)) * RT_VROWB + w * 32 + (c16 & 3) * 8;
    const LAS unsigned char* prow = lds + RT_PS + c16 * RT_PROWB + g4 * 16;
    LAS unsigned char* pst = lds + RT_PS + (16 * ntS + c16) * RT_PROWB + g4 * 8;
    RT_LOAD(0);
    for (int c = 0; c < 32; ++c) {
        LBAR();
        RT_STORE();
        if (c + 1 < 32) RT_LOAD(c + 1);
        LBAR();
#pragma unroll
        for (int ks = 0; ks < 2; ++ks) vf[ks] = cat8(tr16(vtr + (32 * ks) * RT_VROWB), tr16(vtr + (32 * ks + 4) * RT_VROWB));
        sT[0] = (f32x4){0.f, 0.f, 0.f, 0.f}; sT[1] = (f32x4){0.f, 0.f, 0.f, 0.f};
#pragma unroll
        for (int ks = 0; ks < 8; ++ks) {
            const bf16x8 bq = *(const LAS bf16x8*)(qrowS + ks * 64);
#pragma unroll
            for (int i = 0; i < 2; ++i) { const bf16x8 ak = *(const LAS bf16x8*)(krowS + i * 16 * RT_QROWB + ks * 64); sT[i] = MFMA16(ak, bq, sT[i]); }
        }
        {
            const int n = 16 * ntS + c16; const float fac = __builtin_amdgcn_exp2f(lg2 * (float)(n - 63));
#pragma unroll
            for (int i = 0; i < 2; ++i) {
                const int m0 = 16 * (mtb + i) + 4 * g4; float v[4];
#pragma unroll
                for (int e = 0; e < 4; ++e) v[e] = (n >= m0 + e) ? sT[i][e] * fac : 0.f;
                u32x2 p; p.x = pk_bf16(v[0], v[1]); p.y = pk_bf16(v[2], v[3]);
                *(LAS u32x2*)(pst + (mtb + i) * 32) = p;
            }
        }
        __builtin_amdgcn_sched_barrier(0);
#pragma unroll
        for (int ks = 0; ks < 8; ++ks) {
            const bf16x8 as = pack8(st[2 * ks], st[2 * ks + 1]);
#pragma unroll
            for (int nt = 0; nt < 4; ++nt) {
                const s16x4 lo = *(const LAS s16x4*)(qrowC + nt * 16 * RT_QROWB + ks * 64), hi = *(const LAS s16x4*)(qrowC + nt * 16 * RT_QROWB + ks * 64 + 32);
                oc[nt] = MFMA16(as, cat8(lo, hi), oc[nt]);
            }
            __builtin_amdgcn_sched_barrier(0);
        }
#pragma unroll
        for (int i = 0; i < 16; ++i) {
            f32x4 sacc = st[i] * gC;
#pragma unroll
            for (int ks = 0; ks < 2; ++ks) { const bf16x8 kt = cat8(tr16(ktr + (32 * ks) * RT_QROWB + i * 32), tr16(ktr + (32 * ks + 4) * RT_QROWB + i * 32)); sacc = MFMA16(kt, vf[ks], sacc); }
            st[i] = sacc;
            if ((i & 3) == 3) __builtin_amdgcn_sched_barrier(0);
        }
        LBAR();
#pragma unroll
        for (int nt = 0; nt < 4; ++nt) { const float gq = __builtin_amdgcn_exp2f(lg2 * (float)(16 * nt + c16 + 1)); oc[nt] *= gq; }
#pragma unroll
        for (int ks = 0; ks < 2; ++ks)
#pragma unroll
            for (int nt = 0; nt < 4; ++nt) if (32 * ks <= 16 * nt + 15) { const bf16x8 bp = *(const LAS bf16x8*)(prow + nt * 16 * RT_PROWB + ks * 64); oc[nt] = MFMA16(vf[ks], bp, oc[nt]); }
#pragma unroll
        for (int nt = 0; nt < 4; ++nt) {
            const int row = b * SEQ + c * 64 + 16 * nt + c16;
            float sq = pg8::dot4(oc[nt]); sq += __shfl_xor(sq, 16); sq += __shfl_xor(sq, 32);
            if (g4 == 0) atomicAdd(SSO + (size_t)row * 4 + h, sq);
            bf16* gp = SG + (size_t)row * 2048 + h * 512 + vs * 128 + 16 * w + 4 * g4;
            const u32x2 sg = *(const u32x2*)gp;
            const float o0 = oc[nt][0] * __builtin_bit_cast(float, sg.x << 16), o1 = oc[nt][1] * __builtin_bit_cast(float, sg.x & 0xffff0000u);
            const float o2 = oc[nt][2] * __builtin_bit_cast(float, sg.y << 16), o3 = oc[nt][3] * __builtin_bit_cast(float, sg.y & 0xffff0000u);
            u32x2 p; p.x = pk_bf16(o0, o1); p.y = pk_bf16(o2, o3); *(u32x2*)gp = p;
            oc[nt] = (f32x4){0.f, 0.f, 0.f, 0.f};
        }
    }
    LBAR();
#undef RT_LOAD
#undef RT_STORE
}

__device__ __forceinline__ int crow(int r, int hi) { return (r & 3) + 8 * (r >> 2) + 4 * hi; }
__device__ __forceinline__ void sb_unit(const bf16* QN, const bf16* KN, const bf16* VT, bf16* O, int bh, int qblk, int lane) {
    const int r32 = lane & 31, hh = lane >> 5, b = bh >> 4, h = bh & 15;
    const size_t row0 = (size_t)b * SEQ + 32 * qblk;
    bf16x8 qf[4];
#pragma unroll
    for (int s = 0; s < 4; ++s) qf[s] = *(const bf16x8*)(QN + (row0 + r32) * 1024 + h * 64 + 16 * s + 8 * hh);
    f32x16 oT[2];
#pragma unroll
    for (int i = 0; i < 16; ++i) { oT[0][i] = 0.f; oT[1][i] = 0.f; }
    float R = 0.f;
    const bf16* kbase = KN + ((size_t)b * SEQ + r32) * 1024 + h * 64 + 8 * hh;
    const bf16* vbase = VT + ((size_t)bh * 64 + r32) * 2048 + 4 * hh;
    for (int kt = qblk; kt >= 0; --kt) {
        bf16x8 kf[4];
#pragma unroll
        for (int s = 0; s < 4; ++s) kf[s] = *(const bf16x8*)(kbase + (size_t)(32 * kt) * 1024 + 16 * s);
        s16x4 vlo[2][2], vhi[2][2];
#pragma unroll
        for (int dt = 0; dt < 2; ++dt)
#pragma unroll
            for (int sp = 0; sp < 2; ++sp) { const bf16* p = vbase + (size_t)(32 * dt) * 2048 + 32 * kt + 16 * sp; vlo[dt][sp] = *(const s16x4*)p; vhi[dt][sp] = *(const s16x4*)(p + 8); }
        f32x16 z;
#pragma unroll
        for (int i = 0; i < 16; ++i) z[i] = 0.f;
#pragma unroll
        for (int s = 0; s < 4; ++s) z = MFMA32(kf[s], qf[s], z);
        float sp_[16], lb[16];
        const bool diag = (kt == qblk);
#pragma unroll
        for (int i = 0; i < 16; ++i) {
            const float zz = z[i];
            const float t = __builtin_amdgcn_exp2f(-1.44269504089f * __builtin_fabsf(zz));
            float s = __builtin_fmaxf(zz, 0.f) + 0.69314718056f * __builtin_amdgcn_logf(1.f + t);
            const bool valid = !diag || (crow(i, hh) < r32);
            sp_[i] = valid ? s : 0.f;
            lb[i] = valid ? (zz - s) : -INFINITY;
        }
        float gsum[4], pgs[4];
#pragma unroll
        for (int q = 0; q < 4; ++q) { gsum[q] = (sp_[4 * q] + sp_[4 * q + 1]) + (sp_[4 * q + 2] + sp_[4 * q + 3]); pgs[q] = __shfl_xor(gsum[q], 32); }
        float later = 0.f;
        f32x16 pa;
#pragma unroll
        for (int q = 3; q >= 0; --q) {
            const float L = later + (hh == 0 ? pgs[q] : 0.f);
            const float s3 = L, s2 = s3 + sp_[4 * q + 3], s1 = s2 + sp_[4 * q + 2], s0 = s1 + sp_[4 * q + 1];
            pa[4 * q + 0] = __builtin_amdgcn_exp2f(1.44269504089f * (lb[4 * q + 0] - R - s0));
            pa[4 * q + 1] = __builtin_amdgcn_exp2f(1.44269504089f * (lb[4 * q + 1] - R - s1));
            pa[4 * q + 2] = __builtin_amdgcn_exp2f(1.44269504089f * (lb[4 * q + 2] - R - s2));
            pa[4 * q + 3] = __builtin_amdgcn_exp2f(1.44269504089f * (lb[4 * q + 3] - R - s3));
            later += gsum[q] + pgs[q];
        }
        R += later;
#pragma unroll
        for (int sp = 0; sp < 2; ++sp) {
            const bf16x8 pf = pack8((f32x4){pa[8 * sp], pa[8 * sp + 1], pa[8 * sp + 2], pa[8 * sp + 3]}, (f32x4){pa[8 * sp + 4], pa[8 * sp + 5], pa[8 * sp + 6], pa[8 * sp + 7]});
#pragma unroll
            for (int dt = 0; dt < 2; ++dt) oT[dt] = MFMA32(cat8(vlo[dt][sp], vhi[dt][sp]), pf, oT[dt]);
        }
        if (__all(R > 64.f)) break;
    }
#pragma unroll
    for (int dt = 0; dt < 2; ++dt)
#pragma unroll
        for (int q = 0; q < 4; ++q) {
            u32x2 p; p.x = pk_bf16(oT[dt][4 * q], oT[dt][4 * q + 1]); p.y = pk_bf16(oT[dt][4 * q + 2], oT[dt][4 * q + 3]);
            *(u32x2*)(O + (row0 + r32) * 1024 + h * 64 + 32 * dt + 8 * q + 4 * hh) = p;
        }
}

__device__ __forceinline__ void fix_phase(const float* HF, const float* HL, const float* cw, const float* cb, bf16* ACT, int vcu, int G) {
    const int NIT = 512 * 2 * (FF / 4);
    for (int it = vcu * NTHREADS + threadIdx.x; it < NIT; it += G * NTHREADS) {
        const int cg4 = it % (FF / 4), bi = it / (FF / 4), i = bi & 1, blk = bi >> 1;
        const int c0 = 4 * cg4, pn = c0 >> 7, j = c0 & 127, nv = 256 * pn + j;
        const bool first = (blk & 31) == 0;
        f32x4 val, gat;
#pragma unroll
        for (int half = 0; half < 2; ++half) {
            const int nn = nv + 128 * half, co = half * FF + c0;
            const f32x4 u0 = *(const f32x4*)(HF + (size_t)(blk * 2 + i) * FF2 + nn);
            f32x4 u1, u2; const f32x4 zero = (f32x4){0.f, 0.f, 0.f, 0.f};
            if (i == 1) { u1 = *(const f32x4*)(HF + (size_t)(blk * 2) * FF2 + nn); u2 = first ? zero : *(const f32x4*)(HL + (size_t)((blk - 1) * 2 + 1) * FF2 + nn); }
            else { u1 = first ? zero : *(const f32x4*)(HL + (size_t)((blk - 1) * 2 + 1) * FF2 + nn); u2 = first ? zero : *(const f32x4*)(HL + (size_t)((blk - 1) * 2) * FF2 + nn); }
            const f32x4 y = *(const f32x4*)(cb + co) + *(const f32x4*)(cw + 2 * FF2 + co) * u0 + *(const f32x4*)(cw + FF2 + co) * u1 + *(const f32x4*)(cw + co) * u2;
            if (half == 0) val = y; else gat = y;
        }
        const f32x4 o = val * pg8::silu4(gat);
        u32x2 p; p.x = pk_bf16(o[0], o[1]); p.y = pk_bf16(o[2], o[3]);
        *(u32x2*)(ACT + (size_t)(64 * blk + i) * FF + c0) = p;
    }
}

__device__ __forceinline__ XcdBarrier mk_bar(ptab_t tab, LAS unsigned char* lds) { XcdBarrier b; b.bar = (unsigned*)(ldp(tab, T_WS) + WS_CTL) + 1024; b.x = xb_xcc_id(); b.st = (volatile LAS unsigned*)(lds + MISC_OFF) + 8; return b; }
__global__ void __launch_bounds__(NTHREADS, 2) yoco_fwd(Args a) {
    extern __shared__ __attribute__((aligned(16))) unsigned char lds_raw[];
    LAS unsigned char* lds = (LAS unsigned char*)lds_raw;
    volatile LAS unsigned* MISC = (volatile LAS unsigned*)(lds + MISC_OFF);
    LAS unsigned long long* tabw = (LAS unsigned long long*)(lds + MISC_OFF + 64);
    const ptab_t tab = (ptab_t)(lds + MISC_OFF + 64);
    if (threadIdx.x < 16) MISC[threadIdx.x] = 0u;
    if (threadIdx.x == 64) {
#pragma unroll
        for (int i = 0; i < 21; ++i) tabw[i] = (unsigned long long)a.in[i];
        tabw[T_OUT] = (unsigned long long)a.out; tabw[T_WS] = (unsigned long long)a.ws;
        MISC[0] = (unsigned)a.ph_lo; MISC[1] = (unsigned)a.ph_hi;
    }
    __syncthreads();
    if (a.ph_hi - a.ph_lo > 1) (void)xcd_barrier_post((unsigned*)(a.ws + WS_CTL) + 1024, MISC + 8);
#define PH_LO ((int)__builtin_amdgcn_readfirstlane(MISC[0]))
#define PH_HI ((int)__builtin_amdgcn_readfirstlane(MISC[1]))
#define IN(k) (PH_LO <= (k) && (k) < PH_HI)
#define SEAM(k) do { if (IN(k) && IN((k) + 1)) xcd_barrier(mk_bar(tab, lds)); } while (0)
#define GRID ((int)gridDim.x)
#define BX ((int)blockIdx.x)
#define VCU ((GRID % 8 == 0) ? (BX % 8) * (GRID / 8) + BX / 8 : BX)
#define WSP (ldp(tab, T_WS))

#ifndef SKIP_P0
    if (IN(0)) { p0_phase(tab, lds, VCU, GRID); }
#endif
    if (IN(0) && IN(1)) {
        if (MK_ONE_LAUNCH) { cg::this_grid().sync(); }
        xcd_barrier(mk_bar(tab, lds));
    }
#ifndef SKIP_P1
    if (IN(1)) { p1_phase(tab, lds, VCU, GRID); }
#endif
    SEAM(1);
    if (IN(2)) {
        pg8::Gemm g{(const bf16*)(WSP + WS_A), (const bf16*)(WSP + WS_WT1), M, RN, D, D}; pg8::StaticOrder S; S.init(M, RN, GRID, BX);
        pg8::EpiRetIn E{tab};
        pg8::gemm_phase<pg8::EpiRetIn, pg8::StaticOrder, true, true>(lds, g, S, E);
    }
    SEAM(2);
#ifndef SKIP_RET
    if (IN(3)) {
        unsigned char* ws = WSP;
        for (int u = VCU; u < 256; u += GRID) ret_unit(lds, (const bf16*)(ws + WS_Q), (const bf16*)(ws + WS_KD), (const bf16*)(ws + WS_V), (bf16*)(ws + WS_SG), (float*)(ws + WS_SSO), u);
    }
#endif
    SEAM(3);
    if (IN(4)) {
        pg8::Gemm g{(const bf16*)(WSP + WS_SG), (const bf16*)(WSP + WS_WT2), M, D, 512, 2048}; pg8::SegOrder S; S.init(M, D, GRID, BX);
        pg8::EpiRes<0> E{tab};
        {
            const int slot = threadIdx.x >> 8, r = threadIdx.x & 255; pg8::Unit u;
            if (S.next(4 * slot, u)) {
                const f32x4 s4 = *(const f32x4*)((const float*)(WSP + WS_SSO) + (size_t)(u.pm * 256 + r) * 4);
                const float e0 = s4[0] * (1.f / 512.f) + EPS, e1 = s4[1] * (1.f / 512.f) + EPS, e2 = s4[2] * (1.f / 512.f) + EPS, e3 = s4[3] * (1.f / 512.f) + EPS;
                f32x4 o; o[0] = __builtin_sqrtf(e1 / e0); o[1] = __builtin_sqrtf(e2 / e1); o[2] = __builtin_sqrtf(e3 / e2); o[3] = 1.f / __builtin_sqrtf(e3);
                *(LAS f32x4*)(lds + 131072 + (slot * 256 + r) * 16) = o;
            }
            LBAR();
        }
        pg8::gemm_phase<pg8::EpiRes<0>, pg8::SegOrder, true, true>(lds, g, S, E);
    }
    SEAM(4);
#pragma unroll 1
    for (int l = 0; l < 2; ++l) {
        const int pb = (l == 0) ? 5 : 11;
        if (IN(pb)) {
            pg8::Gemm g{(const bf16*)(WSP + WS_A), (const bf16*)(WSP + WS_WT3) + (size_t)l * FF2 * 1024, M, FF2, D, D}; pg8::StaticOrder S; S.init(M, FF2, GRID, BX);
            pg8::EpiFfnIn E{tab, l};
            pg8::gemm_phase<pg8::EpiFfnIn, pg8::StaticOrder, true, true>(lds, g, S, E);
        }
        SEAM(pb);
        if (IN(pb + 1)) { unsigned char* ws = WSP; fix_phase((const float*)(ws + WS_HF), (const float*)(ws + WS_HL), (const float*)ldp(tab, 18) + l * 3 * FF2, (const float*)ldp(tab, 19) + l * FF2, (bf16*)(ws + WS_ACT), VCU, GRID); }
        SEAM(pb + 1);
        if (IN(pb + 2)) {
            pg8::Gemm g{(const bf16*)(WSP + WS_ACT), (const bf16*)(WSP + WS_WT4) + (size_t)l * 1024 * FF, M, D, FF, FF}; pg8::StaticOrder S; S.init(M, D, GRID, BX);
            if (l == 0) { pg8::EpiRes<1> E{tab}; pg8::gemm_phase<pg8::EpiRes<1>, pg8::StaticOrder, true, true>(lds, g, S, E); }
            else        { pg8::EpiRes<3> E{tab}; pg8::gemm_phase<pg8::EpiRes<3>, pg8::StaticOrder, true, true>(lds, g, S, E); }
        }
        if (l == 1) break;
        SEAM(7);
        if (IN(8)) {
            { pg8::Gemm g{(const bf16*)(WSP + WS_A), (const bf16*)(WSP + WS_WT5), M, 2048, D, D}; pg8::StaticOrder S; S.init(M, 2048, GRID, BX);
              pg8::EpiKVQ<0> E{tab};
              pg8::gemm_phase<pg8::EpiKVQ<0>, pg8::StaticOrder, true, true>(lds, g, S, E); }
            { pg8::Gemm g{(const bf16*)(WSP + WS_AM1), (const bf16*)(WSP + WS_WT6), M, D, D, D}; pg8::StaticOrder S; S.init(M, D, GRID, BX);
              pg8::EpiKVQ<1> E{tab};
              pg8::gemm_phase<pg8::EpiKVQ<1>, pg8::StaticOrder, true, true>(lds, g, S, E); }
        }
        SEAM(8);
#ifndef SKIP_SB
        if (IN(9)) {
            unsigned char* ws = WSP; const int vcu = VCU, wave = __builtin_amdgcn_readfirstlane(threadIdx.x >> 6), lane = threadIdx.x & 63;
            for (int i = 0; i < 8; ++i) { const int bh = (vcu >> 3) + 32 * i, qg = ((vcu & 7) + i) & 7;
                if (bh < 256) sb_unit((const bf16*)(ws + WS_QN), (const bf16*)(ws + WS_KN), (const bf16*)(ws + WS_VT), (bf16*)(ws + WS_OSB), bh, qg * 8 + wave, lane); }
        }
#endif
        SEAM(9);
        if (IN(10)) {
            pg8::Gemm g{(const bf16*)(WSP + WS_OSB), (const bf16*)(WSP + WS_WT7), M, D, D, D}; pg8::StaticOrder S; S.init(M, D, GRID, BX);
            pg8::EpiRes<2> E{tab};
            pg8::gemm_phase<pg8::EpiRes<2>, pg8::StaticOrder, true, true>(lds, g, S, E);
        }
        SEAM(10);
    }
#undef IN
#undef SEAM
}

extern "C" void kernel_launch(void* const* d_in, const int* in_sizes, int n_in, void* d_out, int out_size, void* d_ws, size_t ws_size, hipStream_t stream) {
    static int grid = 0;
    if (grid == 0) {
        if (n_in != 21 || in_sizes[0] != M * D || out_size != M * D || ws_size < WS_END) { fprintf(stderr, "kernel_launch: unexpected problem: n_in %d in0 %d out %d ws %zu (need %zu)\n", n_in, n_in > 0 ? in_sizes[0] : -1, out_size, ws_size, (size_t)WS_END); grid = -1; return; }
        int dev = 0, cus = 0, per_cu = 0;
        if (hipGetDevice(&dev) != hipSuccess || hipDeviceGetAttribute(&cus, hipDeviceAttributeMultiprocessorCount, dev) != hipSuccess) { grid = -1; return; }
        if (hipFuncSetAttribute((const void*)yoco_fwd, hipFuncAttributeMaxDynamicSharedMemorySize, LDS_BYTES) != hipSuccess) { fprintf(stderr, "kernel_launch: hipFuncSetAttribute failed\n"); grid = -1; return; }
        if (hipOccupancyMaxActiveBlocksPerMultiprocessor(&per_cu, (const void*)yoco_fwd, NTHREADS, LDS_BYTES) != hipSuccess || per_cu < 1) { fprintf(stderr, "kernel_launch: occupancy query says %d\n", per_cu); (void)hipGetLastError(); per_cu = 1; }
        grid = cus;
        if (grid > 256) grid = 256;
    }
    if (grid < 0) return;
    (void)hipMemsetAsync((char*)d_ws + WS_CTL, 0, 65536, stream);
    Args a{};
    for (int i = 0; i < 21; ++i) a.in[i] = d_in[i];
    a.out = (float*)d_out; a.ws = (unsigned char*)d_ws;
#if MK_ONE_LAUNCH
    a.ph_lo = 0; a.ph_hi = NPHASE;
    void* args[] = {&a};
    hipError_t e = hipLaunchCooperativeKernel((const void*)yoco_fwd, dim3(grid), dim3(NTHREADS), args, LDS_BYTES, stream);
    if (e != hipSuccess) fprintf(stderr, "kernel_launch: cooperative launch failed: %s\n", hipGetErrorString(e));
#else
    for (int p = 0; p < NPHASE; ++p) { a.ph_lo = p; a.ph_hi = p + 1; hipLaunchKernelGGL(yoco_fwd, dim3(grid), dim3(NTHREADS), LDS_BYTES, stream, a); }
#endif
}
```

```cpp
#include <hip/hip_runtime.h>
#include <hip/hip_cooperative_groups.h>
#include <cstdio>
#include <cstdint>
namespace cg = cooperative_groups;
namespace pg8 {
#define PG8_LAS __attribute__((address_space(3)))
typedef unsigned short bf16_t;
typedef short bf16x8 __attribute__((ext_vector_type(8)));
typedef float f32x4 __attribute__((ext_vector_type(4)));
typedef unsigned u32x4 __attribute__((ext_vector_type(4)));
constexpr int BM = 256, BK = 64, HALF = 128, HTB = HALF * BK * 2  , STAGE_BYTES = 8 * HTB, NXCD = 8, WGM = 8;

__host__ __device__ __forceinline__ int lds_byte(int r, int c) { const int st = (r >> 4) * 2 + (c >> 5), rr = r & 15, cc = c & 31, ob = rr * 64 + cc * 2; return st * 1024 + (ob ^ (((ob >> 9) & 1) << 5)); }
__host__ __device__ __forceinline__ void stage_rc(int b, int& R, int& C) { const int st = b / 1024, sb = b % 1024, swz = sb ^ (((sb >> 9) & 1) << 5); R = (st >> 1) * 16 + swz / 64; C = (st & 1) * 32 + (swz % 64) / 2; }
__host__ __device__ __forceinline__ int perm32(int rho) { const int n = rho >> 4, i = rho & 15; return 8 * (i >> 2) + 4 * n + (i & 3); }

struct Unit { int pm, pn, kk; };
struct Gemm { const bf16_t* A; const bf16_t* Bt; int M, N, K, ld; };

struct StaticOrder {
    int nM, nN, nwg, G, c;
    __host__ __device__ void init(int M, int N, int G_, int c_) { nM = M / BM; nN = N / BM; nwg = nM * nN; G = G_; c = c_; }
    __host__ __device__ bool next(int i, Unit& u) const {
        const long L = (long)i * G + c; if (L >= nwg) return false;
        int wgid = (int)L; { const int q = nwg / NXCD, r = nwg % NXCD, xcd = wgid % NXCD, off = wgid / NXCD; wgid = (xcd < r ? xcd * (q + 1) : r * (q + 1) + (xcd - r) * q) + off; }
        const int nig = WGM * nN, gid = wgid / nig, fm = gid * WGM, gsz = (nM - fm) < WGM ? (nM - fm) : WGM;
        u.pm = fm + ((wgid % nig) % gsz); u.pn = (wgid % nig) / gsz; u.kk = 0; return true;
    }
    __device__ __forceinline__ void a_ready(const Unit&) const {}
    __device__ __forceinline__ void done(const Unit&) const {}
};

struct SegOrder : StaticOrder {
    __host__ __device__ bool next(int i, Unit& u) const { if (!StaticOrder::next(i >> 2, u)) return false; u.kk = i & 3; return true; }
};
typedef float f32x2 __attribute__((ext_vector_type(2)));
typedef __bf16 bf16x2_t __attribute__((ext_vector_type(2)));
constexpr float EPS = 1e-6f;
__device__ __forceinline__ unsigned pk_bf16(float lo, float hi) { f32x2 v = {lo, hi}; bf16x2_t b = __builtin_convertvector(v, bf16x2_t); return __builtin_bit_cast(unsigned, b); }
__device__ __forceinline__ u32x4 pk8(const f32x4 a, const f32x4 b) { u32x4 w; w.x = pk_bf16(a[0], a[1]); w.y = pk_bf16(a[2], a[3]); w.z = pk_bf16(b[0], b[1]); w.w = pk_bf16(b[2], b[3]); return w; }
__device__ __forceinline__ float silu_f(float x) { return x * __builtin_amdgcn_rcpf(1.f + __builtin_amdgcn_exp2f(-1.44269504089f * x)); }
__device__ __forceinline__ f32x4 silu4(f32x4 v) { f32x4 o; o[0] = silu_f(v[0]); o[1] = silu_f(v[1]); o[2] = silu_f(v[2]); o[3] = silu_f(v[3]); return o; }
__device__ __forceinline__ float dot4(const f32x4 a) { return (a[0] * a[0] + a[1] * a[1]) + (a[2] * a[2] + a[3] * a[3]); }
template <int CTRL> __device__ __forceinline__ float dppf(float old, float src) { return __builtin_bit_cast(float, __builtin_amdgcn_update_dpp(__builtin_bit_cast(int, old), __builtin_bit_cast(int, src), CTRL, 0xf, 0xf, false)); }


typedef const PG8_LAS unsigned long long* ptab_t;
enum { T_OUT = 21, T_WS = 22 };
__device__ __forceinline__ unsigned char* ldp(ptab_t tab, int k) { const unsigned long long v = tab[k]; const unsigned lo = __builtin_amdgcn_readfirstlane((unsigned)v), hi = __builtin_amdgcn_readfirstlane((unsigned)(v >> 32)); return (unsigned char*)(((unsigned long long)hi << 32) | lo); }
constexpr size_t MiB_ = 1u << 20;
constexpr int M_ = 32768;
constexpr size_t O_MODS = 65536, O_KVM = O_MODS + (size_t)2 * 16 * 6144 * 4, O_SW1 = O_KVM + (size_t)16 * 2048 * 4, O_SW3 = O_SW1 + (size_t)16 * 6144 * 4, O_SW5 = O_SW3 + (size_t)2 * 16 * 5632 * 4,
                 O_SW6 = O_SW5 + (size_t)16 * 2048 * 4, O_SS = O_SW6 + (size_t)16 * 1024 * 4, O_SSO = O_SS + (size_t)4 * M_ * 4, O_SMALL_END = O_SSO + (size_t)M_ * 4 * 4;
constexpr size_t O_A = 64 * MiB_, O_BIG = 128 * MiB_, O_Q = O_BIG, O_KD = O_BIG + 64 * MiB_, O_V = O_BIG + 128 * MiB_, O_SG = O_BIG + 256 * MiB_;
constexpr size_t O_ACT = O_BIG, O_HF = O_BIG + 176 * MiB_, O_HL = O_HF + 22 * MiB_, O_AM1 = O_BIG + 220 * MiB_, O_KN = O_BIG, O_VT = O_BIG + 64 * MiB_, O_QN = O_BIG + 128 * MiB_, O_OSB = O_BIG + 284 * MiB_;

struct EpiRetIn {
    static constexpr bool PERM = true, AFTER_DRAIN = false, SEG = false;
    ptab_t tab;
    __device__ __forceinline__ void operator()(f32x4 (&acc)[2][2][4][2], const Unit& u, int wr, int wc, int, int) const {
        int lane_ = threadIdx.x & 63; asm volatile("" : "+v"(lane_)); const int fr = lane_ & 15, fq = lane_ >> 4;
        unsigned char* ws = ldp(tab, T_WS); const int* pos = (const int*)ldp(tab, 2);
        const float* ss = (const float*)(ws + O_SS); const float* sW = (const float*)(ws + O_SW1);
        bf16_t* Q = (bf16_t*)(ws + O_Q); bf16_t* KD = (bf16_t*)(ws + O_KD); bf16_t* V = (bf16_t*)(ws + O_V); bf16_t* SG = (bf16_t*)(ws + O_SG);
        const int b = u.pm >> 3, cl = wc * 32 + 8 * fq, row0 = u.pm * BM + wr * 64 + fr;
        f32x4 sw[2][2];
#pragma unroll
        for (int bj = 0; bj < 2; ++bj)
#pragma unroll
            for (int n = 0; n < 2; ++n) sw[bj][n] = *(const f32x4*)(sW + b * 6144 + u.pn * 256 + bj * 128 + cl + 4 * n);
        if (u.pn < 8) {
            const bool isk = u.pn >= 4; const int h = u.pn & 3;
            bf16_t* dst = (isk ? KD : Q) + h * 256 + cl;
            float inv[8];
#pragma unroll
            for (int i = 0; i < 8; ++i) inv[i] = __builtin_amdgcn_exp2f(-(float)(cl + i) * 0.10381025296523f) * 0.15915494309189535f;
            const float lg = __builtin_amdgcn_logf(1.f - __builtin_amdgcn_exp2f(-5.f - (float)h));
#pragma unroll
            for (int ai = 0; ai < 2; ++ai)
#pragma unroll
                for (int m = 0; m < 4; ++m) {
                    const int row = row0 + ai * HALF + m * 16;
                    const float p = (float)pos[row], rs = __builtin_amdgcn_rsqf(ss[row] * (1.f / 1024.f) + EPS);
                    const float ksc = isk ? 0.0625f * __builtin_amdgcn_exp2f(lg * (float)(63 - (row & 63))) : 1.f;
                    f32x4 o1[2], o2[2];
#pragma unroll
                    for (int n = 0; n < 2; ++n)
#pragma unroll
                        for (int e = 0; e < 4; ++e) {
                            const float x1 = acc[ai][0][m][n][e] * rs + sw[0][n][e], x2 = acc[ai][1][m][n][e] * rs + sw[1][n][e];
                            const float r = __builtin_amdgcn_fractf(p * inv[4 * n + e]);
                            const float s = __builtin_amdgcn_sinf(r), c = __builtin_amdgcn_cosf(r);
                            o1[n][e] = (x1 * c - x2 * s) * ksc; o2[n][e] = (x1 * s + x2 * c) * ksc;
                        }
                    *(u32x4*)(dst + (size_t)row * 1024) = pk8(o1[0], o1[1]);
                    *(u32x4*)(dst + (size_t)row * 1024 + 128) = pk8(o2[0], o2[1]);
                }
        } else {
            const bool isg = u.pn >= 16;
            bf16_t* dst = (isg ? SG : V) + ((u.pn - 8) & 7) * 256 + cl;
#pragma unroll
            for (int ai = 0; ai < 2; ++ai)
#pragma unroll
                for (int m = 0; m < 4; ++m) {
                    const int row = row0 + ai * HALF + m * 16;
                    const float rs = __builtin_amdgcn_rsqf(ss[row] * (1.f / 1024.f) + EPS);
#pragma unroll
                    for (int bj = 0; bj < 2; ++bj) {
                        f32x4 v0 = acc[ai][bj][m][0] * rs + sw[bj][0], v1 = acc[ai][bj][m][1] * rs + sw[bj][1];
                        if (isg) { v0 = silu4(v0); v1 = silu4(v1); }
                        *(u32x4*)(dst + (size_t)row * 2048 + bj * HALF) = pk8(v0, v1);
                    }
                }
        }
    }
};

template <int WHICH> struct EpiRes {
    static constexpr int NOUT = (WHICH == 1) ? 2 : (WHICH == 3 ? 0 : 1);
    static constexpr bool HOOK = (WHICH == 0), SSACC = (WHICH != 3);
    static constexpr bool PERM = true, AFTER_DRAIN = false, SEG = HOOK;
    ptab_t tab;
    __device__ __forceinline__ void seg(f32x4 (&acc)[2][2][4][2], int kk, int tile, int wr) const {
        int lane_ = threadIdx.x & 63; asm volatile("" : "+v"(lane_)); const int fr = lane_ & 15;
        const PG8_LAS float* tb = (const PG8_LAS float*)((const PG8_LAS unsigned char*)tab - 64 - (147456 - 512) + 131072) + (tile * 256 + wr * 64 + fr) * 4 + kk;
#pragma unroll
        for (int ai = 0; ai < 2; ++ai)
#pragma unroll
            for (int m = 0; m < 4; ++m) {
                const float ratio = tb[(ai * HALF + m * 16) * 4];
#pragma unroll
                for (int bj = 0; bj < 2; ++bj)
#pragma unroll
                    for (int n = 0; n < 2; ++n) acc[ai][bj][m][n] *= ratio;
            }
    }
    __device__ __forceinline__ void operator()(f32x4 (&acc)[2][2][4][2], const Unit& u, int wr, int wc, int, int) const {
        int lane_ = threadIdx.x & 63; asm volatile("" : "+v"(lane_)); const int fr = lane_ & 15, fq = lane_ >> 4;
        unsigned char* ws = ldp(tab, T_WS); float* hout = (float*)ldp(tab, T_OUT);
        const float* mods = (const float*)(ws + O_MODS);
        const float* hin = (WHICH == 0) ? (const float*)ldp(tab, 0) : hout;
        const float* gate = mods + (WHICH >= 2 ? 16 * 6144 : 0) + ((WHICH == 0 || WHICH == 2) ? 2048 : 5120);
        const float* g0 = nullptr; const float* sc0 = nullptr; int st0 = 6144; bf16_t* o0 = (bf16_t*)(ws + O_A);
        const float* g1 = nullptr; const float* sc1 = nullptr; const int st1 = 6144; bf16_t* o1 = (bf16_t*)(ws + O_AM1);
        if (WHICH == 0) { g0 = (const float*)ldp(tab, 6); sc0 = mods + 4096; }
        if (WHICH == 1) { g0 = (const float*)ldp(tab, 11); sc0 = (const float*)(ws + O_KVM) + 1024; st0 = 2048; g1 = (const float*)ldp(tab, 5) + 1024; sc1 = mods + 16 * 6144 + 1024; }
        if (WHICH == 2) { g0 = (const float*)ldp(tab, 6) + 1024; sc0 = mods + 16 * 6144 + 4096; }
        float* ss = (float*)(ws + O_SS) + (WHICH + 1) * M_;
        const int b = u.pm >> 3, cl = wc * 32 + 8 * fq, row0 = u.pm * BM + wr * 64 + fr;
        f32x4 gt[2][2], gs0[2][2], gs1[2][2];
#pragma unroll
        for (int bj = 0; bj < 2; ++bj)
#pragma unroll
            for (int n = 0; n < 2; ++n) {
                const int col = u.pn * BM + bj * HALF + cl + 4 * n;
                gt[bj][n] = *(const f32x4*)(gate + b * 6144 + col);
                if (NOUT >= 1) gs0[bj][n] = *(const f32x4*)(g0 + col) * (*(const f32x4*)(sc0 + b * st0 + col) + 1.f);
                if (NOUT >= 2) gs1[bj][n] = *(const f32x4*)(g1 + col) * (*(const f32x4*)(sc1 + b * st1 + col) + 1.f);
            }
#pragma unroll
        for (int ai = 0; ai < 2; ++ai)
#pragma unroll
            for (int m = 0; m < 4; ++m) {
                const int row = row0 + ai * HALF + m * 16;
                const float rs = 1.f;
                float sq = 0.f;
#pragma unroll
                for (int bj = 0; bj < 2; ++bj) {
                    const size_t off = (size_t)row * 1024 + u.pn * BM + bj * HALF + cl;
                    f32x4 h0 = *(const f32x4*)(hin + off), h1 = *(const f32x4*)(hin + off + 4);
                    h0 += gt[bj][0] * (acc[ai][bj][m][0] * rs); h1 += gt[bj][1] * (acc[ai][bj][m][1] * rs);
                    *(f32x4*)(hout + off) = h0; *(f32x4*)(hout + off + 4) = h1;
                    if (SSACC) sq += dot4(h0) + dot4(h1);
                    if (NOUT >= 1) *(u32x4*)(o0 + off) = pk8(h0 * gs0[bj][0], h1 * gs0[bj][1]);
                    if (NOUT >= 2) *(u32x4*)(o1 + off) = pk8(h0 * gs1[bj][0], h1 * gs1[bj][1]);
                }
                if (SSACC) { sq += __shfl_xor(sq, 16); sq += __shfl_xor(sq, 32); if (fq == 0) atomicAdd(ss + row, sq); }
            }
    }
};

struct EpiFfnIn {
    static constexpr bool PERM = true, AFTER_DRAIN = false, SEG = false;
    ptab_t tab; int l;
    __device__ __forceinline__ void operator()(f32x4 (&acc)[2][2][4][2], const Unit& u, int wr, int wc, int, int) const {
        int lane_ = threadIdx.x & 63; asm volatile("" : "+v"(lane_)); const int fr = lane_ & 15, fq = lane_ >> 4;
        unsigned char* ws = ldp(tab, T_WS);
        const float* ss = (const float*)(ws + O_SS) + (l == 0 ? 1 : 3) * M_; const float* sW = (const float*)(ws + O_SW3) + l * 16 * 5632;
        const float* cw = (const float*)ldp(tab, 18) + l * 3 * 5632; const float* cb = (const float*)ldp(tab, 19) + l * 5632;
        bf16_t* ACT = (bf16_t*)(ws + O_ACT); float* HF = (float*)(ws + O_HF); float* HL = (float*)(ws + O_HL);
        const int b = u.pm >> 3, cl = wc * 32 + 8 * fq, row0 = u.pm * BM + wr * 64 + fr, ch = u.pn * HALF + cl;
        {
            f32x4 sw[2][2];
#pragma unroll
            for (int bj = 0; bj < 2; ++bj)
#pragma unroll
                for (int n = 0; n < 2; ++n) sw[bj][n] = *(const f32x4*)(sW + b * 5632 + u.pn * BM + bj * HALF + cl + 4 * n);
#pragma unroll
            for (int ai = 0; ai < 2; ++ai)
#pragma unroll
                for (int m = 0; m < 4; ++m) {
                    const float rs = __builtin_amdgcn_rsqf(ss[row0 + ai * HALF + m * 16] * (1.f / 1024.f) + EPS);
#pragma unroll
                    for (int bj = 0; bj < 2; ++bj)
#pragma unroll
                        for (int n = 0; n < 2; ++n) acc[ai][bj][m][n] = acc[ai][bj][m][n] * rs + sw[bj][n];
                }
        }
#pragma unroll
        for (int ai = 0; ai < 2; ++ai) {
            const int blk = u.pm * 4 + ai * 2 + wr;
            if (fr < 2) {
                float* d = HF + (size_t)(blk * 2 + fr) * 5632 + u.pn * BM + cl;
#pragma unroll
                for (int bj = 0; bj < 2; ++bj)
#pragma unroll
                    for (int n = 0; n < 2; ++n) *(f32x4*)(d + bj * HALF + 4 * n) = acc[ai][bj][0][n];
            }
            if (fr >= 14) {
                float* d = HL + (size_t)(blk * 2 + fr - 14) * 5632 + u.pn * BM + cl;
#pragma unroll
                for (int bj = 0; bj < 2; ++bj)
#pragma unroll
                    for (int n = 0; n < 2; ++n) *(f32x4*)(d + bj * HALF + 4 * n) = acc[ai][bj][3][n];
            }
        }
#pragma unroll
        for (int bj = 0; bj < 2; ++bj)
#pragma unroll
            for (int n = 0; n < 2; ++n) {
                const int colo = bj * 2816 + ch + 4 * n;
                f32x4 w0 = *(const f32x4*)(cw + colo), w1 = *(const f32x4*)(cw + 5632 + colo), w2 = *(const f32x4*)(cw + 2 * 5632 + colo), bb = *(const f32x4*)(cb + colo);
                asm volatile("" : "+v"(w0), "+v"(w1), "+v"(w2), "+v"(bb));
#pragma unroll
                for (int ai = 0; ai < 2; ++ai)
#pragma unroll
                    for (int m = 3; m >= 0; --m) {
                        f32x4 x = acc[ai][bj][m][n]; asm volatile("" : "+v"(x));
                        f32x4 q1 = (f32x4){0.f, 0.f, 0.f, 0.f}, q2 = q1;
                        if (m > 0) { f32x4 xp = acc[ai][bj][m - 1][n]; asm volatile("" : "+v"(xp));
#pragma unroll
                            for (int e = 0; e < 4; ++e) { q1[e] = dppf<0x121>(0.f, xp[e]); q2[e] = dppf<0x122>(0.f, xp[e]); } }
                        f32x4 y;
#pragma unroll
                        for (int e = 0; e < 4; ++e) { const float p1 = dppf<0x111>(q1[e], x[e]), p2 = dppf<0x112>(q2[e], x[e]);
                            y[e] = bb[e] + w2[e] * x[e] + w1[e] * p1 + w0[e] * p2; }
                        asm volatile("" : "+v"(y));
                        acc[ai][bj][m][n] = y;
                    }
            }
#pragma unroll
        for (int ai = 0; ai < 2; ++ai)
#pragma unroll
            for (int m = 0; m < 4; ++m) {
                const int row = row0 + ai * HALF + m * 16;
                const f32x4 v0 = acc[ai][0][m][0] * silu4(acc[ai][1][m][0]), v1 = acc[ai][0][m][1] * silu4(acc[ai][1][m][1]);
                if (m > 0 || fr >= 2) *(u32x4*)(ACT + (size_t)row * 2816 + ch) = pk8(v0, v1);
            }
    }
};

template <int MODE> struct EpiKVQ {
    static constexpr bool PERM = true, AFTER_DRAIN = false, SEG = false;
    ptab_t tab;
    __device__ __forceinline__ void operator()(f32x4 (&acc)[2][2][4][2], const Unit& u, int wr, int wc, int, int) const {
        int lane_ = threadIdx.x & 63; asm volatile("" : "+v"(lane_)); const int fr = lane_ & 15, fq = lane_ >> 4;
        unsigned char* ws = ldp(tab, T_WS);
        const float* ss = (const float*)(ws + O_SS) + 2 * M_; const float* sW = (const float*)(ws + (MODE == 0 ? O_SW5 : O_SW6)); constexpr int nW = (MODE == 0) ? 2048 : 1024;
        const float* gain = (const float*)ldp(tab, MODE == 0 ? 13 : 15); bf16_t* DN = (bf16_t*)(ws + (MODE == 0 ? O_KN : O_QN)); bf16_t* VT = (bf16_t*)(ws + O_VT);
        const int b = u.pm >> 3, row0 = u.pm * BM + wr * 64 + fr, head = 4 * (u.pn & 3) + wc, dl = 8 * fq;
        f32x4 sw[2][2];
#pragma unroll
        for (int bj = 0; bj < 2; ++bj)
#pragma unroll
            for (int n = 0; n < 2; ++n) sw[bj][n] = *(const f32x4*)(sW + b * nW + u.pn * BM + bj * HALF + wc * 32 + dl + 4 * n);
        const bool isv = (MODE == 0) && (u.pn >= 4);
        if (!isv) {
            f32x4 gn[2][2];
#pragma unroll
            for (int bj = 0; bj < 2; ++bj)
#pragma unroll
                for (int n = 0; n < 2; ++n) gn[bj][n] = *(const f32x4*)(gain + 32 * bj + dl + 4 * n) * (MODE == 1 ? 0.125f : 1.f);
#pragma unroll
            for (int ai = 0; ai < 2; ++ai)
#pragma unroll
                for (int m = 0; m < 4; ++m) {
                    const int row = row0 + ai * HALF + m * 16;
                    const float rs = __builtin_amdgcn_rsqf(ss[row] * (1.f / 1024.f) + EPS);
                    f32x4 v[2][2]; float sq = 0.f;
#pragma unroll
                    for (int bj = 0; bj < 2; ++bj)
#pragma unroll
                        for (int n = 0; n < 2; ++n) { v[bj][n] = acc[ai][bj][m][n] * rs + sw[bj][n]; sq += dot4(v[bj][n]); }
                    sq += __shfl_xor(sq, 16); sq += __shfl_xor(sq, 32);
                    const float rh = __builtin_amdgcn_rsqf(sq * (1.f / 64.f) + EPS);
#pragma unroll
                    for (int bj = 0; bj < 2; ++bj) *(u32x4*)(DN + (size_t)row * 1024 + head * 64 + 32 * bj + dl) = pk8(v[bj][0] * gn[bj][0] * rh, v[bj][1] * gn[bj][1] * rh);
                }
        } else {
            bf16_t* vt = VT + (size_t)(b * 16 + head) * 64 * 2048;
#pragma unroll
            for (int ai = 0; ai < 2; ++ai)
#pragma unroll
                for (int m = 0; m < 4; ++m) {
                    const int row = row0 + ai * HALF + m * 16, s = row & 2047;
                    const float rs = __builtin_amdgcn_rsqf(ss[row] * (1.f / 1024.f) + EPS);
#pragma unroll
                    for (int bj = 0; bj < 2; ++bj)
#pragma unroll
                        for (int n = 0; n < 2; ++n) {
                            const f32x4 v = acc[ai][bj][m][n] * rs + sw[bj][n];
#pragma unroll
                            for (int e = 0; e < 4; e += 2) { const unsigned w = pk_bf16(v[e], v[e + 1]); const int d = 32 * bj + dl + 4 * n + e;
                                vt[(size_t)d * 2048 + s] = (bf16_t)(w & 0xffffu); vt[(size_t)(d + 1) * 2048 + s] = (bf16_t)(w >> 16); }
                        }
                }
        }
    }
};
template <class Epi, class Sched, bool ALIGN_EPI = false, bool SP2 = false>
__device__ __forceinline__ void gemm_phase(PG8_LAS unsigned char* lds, const Gemm g, const Sched& S, const Epi& E) {
    const int tid = threadIdx.x, wid = __builtin_amdgcn_readfirstlane(tid >> 6), lane = tid & 63, wr = wid >> 2, wc = wid & 3, fr = lane & 15, fq = lane >> 4;
    const int K = g.ld, nt = g.K / BK;
    unsigned voffA[2], voffB[2];
#pragma unroll
    for (int i = 0; i < 2; ++i) { int R, C; stage_rc(tid * 16 + i * 8192, R, C); const int Rb = Epi::PERM ? ((R & ~31) + perm32(R & 31)) : R;
        voffA[i] = (unsigned)(R * K + C) * 2u; voffB[i] = (unsigned)(Rb * K + C) * 2u; }
    const size_t kstep = (size_t)(BK * 2);
    const size_t hstep = (size_t)HALF * K * 2;
    const size_t tstep = 2 * hstep;
    const unsigned ldsw = (unsigned)wid * 1024u;
    const int aoff = lds_byte(wr * 64 + fr, fq * 8), boff = lds_byte(wc * 32 + fr, fq * 8);
#define PG8_SA(b, h) (((b) * 2 + (h)) * HTB)
#define PG8_SB(b, h) ((4 + (b) * 2 + (h)) * HTB)
#define PG8_STAGE(bufoff, gbase, voff) do { _Pragma("unroll") for (int _i = 0; _i < 2; ++_i) \
        __builtin_amdgcn_global_load_lds((const unsigned*)((const char*)(gbase) + (voff)[_i]), (PG8_LAS unsigned*)(lds + (bufoff) + ldsw + _i * 8192), 16, 0, 0); } while (0)
#define PG8_LDA(dst, b, h) do { _Pragma("unroll") for (int m = 0; m < 4; ++m) _Pragma("unroll") for (int k = 0; k < 2; ++k) dst[m][k] = *(const PG8_LAS bf16x8*)(lds + PG8_SA(b, h) + aoff + m * 2048 + k * 1024); } while (0)
#define PG8_LDB(dst, b, h) do { _Pragma("unroll") for (int n = 0; n < 2; ++n) _Pragma("unroll") for (int k = 0; k < 2; ++k) dst[n][k] = *(const PG8_LAS bf16x8*)(lds + PG8_SB(b, h) + boff + n * 2048 + k * 1024); } while (0)
#define PG8_MMA(ai, bj, At, Bt) do { __builtin_amdgcn_s_setprio(1); _Pragma("unroll") for (int m = 0; m < 4; ++m) _Pragma("unroll") for (int n = 0; n < 2; ++n) _Pragma("unroll") for (int k = 0; k < 2; ++k) \
        acc[ai][bj][m][n] = __builtin_amdgcn_mfma_f32_16x16x32_bf16(Bt[n][k], At[m][k], acc[ai][bj][m][n], 0, 0, 0); __builtin_amdgcn_s_setprio(0); } while (0)
#define PG8_WAIT_V(n) asm volatile("s_waitcnt vmcnt(" #n ")" ::: "memory")
#define PG8_WAIT_L(n) asm volatile("s_waitcnt lgkmcnt(" #n ")" ::: "memory")
#define PG8_BAR __builtin_amdgcn_s_barrier()
#define PG8_SCHED __builtin_amdgcn_sched_barrier(0)
    Unit cur, nxt; int ui = 0;
    if (!S.next(0, cur)) return;
    f32x4 acc[2][2][4][2];
#pragma unroll
    for (int a = 0; a < 2; ++a)
#pragma unroll
        for (int b = 0; b < 2; ++b)
#pragma unroll
            for (int m = 0; m < 4; ++m)
#pragma unroll
                for (int n = 0; n < 2; ++n) acc[a][b][m][n] = (f32x4){0.f, 0.f, 0.f, 0.f};
    bf16x8 At[4][2], B0[2][2], B1[2][2];
    const size_t sstep = (size_t)g.K * 2;
    const char* cA = (const char*)g.A + (size_t)cur.pm * tstep + cur.kk * sstep; const char* cB = (const char*)g.Bt + (size_t)cur.pn * tstep + cur.kk * sstep;
    S.a_ready(cur);
    if constexpr (SP2) {
        PG8_STAGE(PG8_SB(0, 0), cB, voffB); PG8_STAGE(PG8_SB(0, 1), cB + hstep, voffB); PG8_STAGE(PG8_SA(0, 0), cA, voffA); PG8_STAGE(PG8_SA(0, 1), cA + hstep, voffA);
        if (wr == 1) PG8_BAR;
        PG8_WAIT_V(2); PG8_BAR;
        PG8_STAGE(PG8_SB(1, 0), cB + kstep, voffB); PG8_STAGE(PG8_SA(1, 0), cA + kstep, voffA); PG8_STAGE(PG8_SB(1, 1), cB + hstep + kstep, voffB);
        PG8_WAIT_V(6); PG8_BAR;
    } else {
        PG8_STAGE(PG8_SB(0, 0), cB, voffB); PG8_STAGE(PG8_SA(0, 0), cA, voffA); PG8_STAGE(PG8_SB(0, 1), cB + hstep, voffB); PG8_STAGE(PG8_SA(0, 1), cA + hstep, voffA);
        if (wr == 1) PG8_BAR;
        PG8_WAIT_V(4); PG8_BAR;
        PG8_STAGE(PG8_SB(1, 0), cB + kstep, voffB); PG8_STAGE(PG8_SA(1, 0), cA + kstep, voffA); PG8_STAGE(PG8_SB(1, 1), cB + hstep + kstep, voffB);
        PG8_WAIT_V(6); PG8_BAR;
    }
    for (;;) {
        const bool has_next = S.next(ui + 1, nxt);
        const char* nA = has_next ? (const char*)g.A + (size_t)nxt.pm * tstep + nxt.kk * sstep : cA; const char* nB = has_next ? (const char*)g.Bt + (size_t)nxt.pn * tstep + nxt.kk * sstep : cB;
        for (int t = 0; t < nt; t += 2) {
            const bool last = (t == nt - 2);
            const char* a1 = cA + (size_t)(t + 1) * kstep;
            const char* a2 = last ? nA : cA + (size_t)(t + 2) * kstep; const char* b2 = last ? nB : cB + (size_t)(t + 2) * kstep;
            const char* a3 = a2 + kstep; const char* b3 = b2 + kstep;
            if (last && has_next) S.a_ready(nxt);
            if constexpr (SP2) {
            PG8_LDB(B0, 0, 0); PG8_LDB(B1, 0, 1); PG8_SCHED; PG8_LDA(At, 0, 0); PG8_STAGE(PG8_SA(1, 1), a1 + hstep, voffA);
            PG8_WAIT_V(8); PG8_WAIT_L(0); PG8_BAR; PG8_MMA(0, 0, At, B0); PG8_MMA(0, 1, At, B1); PG8_BAR; PG8_SCHED;
            PG8_LDA(At, 0, 1); PG8_STAGE(PG8_SB(0, 0), b2, voffB); PG8_STAGE(PG8_SB(0, 1), b2 + hstep, voffB); PG8_STAGE(PG8_SA(0, 0), a2, voffA);
            PG8_WAIT_V(8); PG8_WAIT_L(0); PG8_BAR; PG8_MMA(1, 0, At, B0); PG8_MMA(1, 1, At, B1); PG8_BAR; PG8_SCHED;
            PG8_LDB(B0, 1, 0); PG8_LDB(B1, 1, 1); PG8_SCHED; PG8_LDA(At, 1, 0); PG8_STAGE(PG8_SA(0, 1), a2 + hstep, voffA);
            PG8_WAIT_V(8); PG8_WAIT_L(0); PG8_BAR; PG8_MMA(0, 0, At, B0); PG8_MMA(0, 1, At, B1); PG8_BAR; PG8_SCHED;
            PG8_LDA(At, 1, 1); PG8_STAGE(PG8_SB(1, 0), b3, voffB); PG8_STAGE(PG8_SB(1, 1), b3 + hstep, voffB); PG8_STAGE(PG8_SA(1, 0), a3, voffA);
            PG8_WAIT_V(8); PG8_WAIT_L(0); PG8_BAR; PG8_MMA(1, 0, At, B0); PG8_MMA(1, 1, At, B1); PG8_BAR; PG8_SCHED;
            } else {
            PG8_LDB(B0, 0, 0); PG8_SCHED; PG8_LDA(At, 0, 0); PG8_STAGE(PG8_SA(1, 1), a1 + hstep, voffA);
            PG8_WAIT_L(8); PG8_BAR; PG8_WAIT_L(0); PG8_MMA(0, 0, At, B0); PG8_BAR; PG8_SCHED;
            PG8_LDB(B1, 0, 1); PG8_STAGE(PG8_SB(0, 0), b2, voffB);
            PG8_BAR; PG8_WAIT_L(0); PG8_MMA(0, 1, At, B1); PG8_BAR;
            PG8_LDA(At, 0, 1); PG8_STAGE(PG8_SA(0, 0), a2, voffA);
            PG8_BAR; PG8_WAIT_L(0); PG8_MMA(1, 0, At, B0); PG8_BAR; PG8_SCHED;
            PG8_STAGE(PG8_SB(0, 1), b2 + hstep, voffB);
            PG8_WAIT_V(6); PG8_BAR; PG8_MMA(1, 1, At, B1); PG8_BAR;
            PG8_LDB(B0, 1, 0); PG8_SCHED; PG8_LDA(At, 1, 0); PG8_STAGE(PG8_SA(0, 1), a2 + hstep, voffA);
            PG8_WAIT_L(8); PG8_BAR; PG8_WAIT_L(0); PG8_MMA(0, 0, At, B0); PG8_BAR; PG8_SCHED;
            PG8_LDB(B1, 1, 1); PG8_STAGE(PG8_SB(1, 0), b3, voffB);
            PG8_BAR; PG8_WAIT_L(0); PG8_MMA(0, 1, At, B1); PG8_BAR;
            PG8_LDA(At, 1, 1); PG8_STAGE(PG8_SA(1, 0), a3, voffA);
            PG8_BAR; PG8_WAIT_L(0); PG8_MMA(1, 0, At, B0); PG8_BAR; PG8_SCHED;
            PG8_STAGE(PG8_SB(1, 1), b3 + hstep, voffB);
            PG8_WAIT_V(6); PG8_BAR; PG8_MMA(1, 1, At, B1); PG8_BAR;
            }
        }
        if constexpr (ALIGN_EPI) { if (wr == 0) PG8_BAR; }
        if constexpr (Epi::SEG) E.seg(acc, cur.kk, ui >> 2, wr);
        if (!Epi::SEG || cur.kk == 3) {
            if constexpr (!Epi::AFTER_DRAIN) { E(acc, cur, wr, wc, fr, fq); S.done(cur); }
            if (!has_next) break;
#pragma unroll
            for (int a = 0; a < 2; ++a)
#pragma unroll
                for (int b = 0; b < 2; ++b)
#pragma unroll
                    for (int m = 0; m < 4; ++m)
#pragma unroll
                        for (int n = 0; n < 2; ++n) acc[a][b][m][n] = (f32x4){0.f, 0.f, 0.f, 0.f};
        }
        cur = nxt; cA = nA; cB = nB; ++ui;
        if constexpr (ALIGN_EPI) { if (wr == 1) PG8_BAR; }
    }
    PG8_WAIT_V(0);
    if constexpr (!ALIGN_EPI) { if (wr == 0) PG8_BAR; }
    PG8_BAR;
    if constexpr (Epi::AFTER_DRAIN) { E.fused(acc, cur, wr, wc, fr, fq, lds, wid, lane); S.done(cur); }
#undef PG8_SA
#undef PG8_SB
#undef PG8_STAGE
#undef PG8_LDA
#undef PG8_LDB
#undef PG8_MMA
#undef PG8_WAIT_V
#undef PG8_WAIT_L
#undef PG8_BAR
#undef PG8_SCHED
}
}

#define LAS __attribute__((address_space(3)))
typedef unsigned short bf16;
typedef float f32x4 __attribute__((ext_vector_type(4)));
typedef float f32x16 __attribute__((ext_vector_type(16)));
typedef short bf16x8 __attribute__((ext_vector_type(8)));
typedef short s16x4 __attribute__((ext_vector_type(4)));
typedef unsigned u32x4 __attribute__((ext_vector_type(4)));
typedef unsigned u32x2 __attribute__((ext_vector_type(2)));
using pg8::pk_bf16; using pg8::EPS;

#ifndef REP_PHASE
#define REP_PHASE -1
#endif
#define REPS(k) ((REP_PHASE == (k)) ? 2 : 1)
#ifndef MK_ONE_LAUNCH
#define MK_ONE_LAUNCH 1
#endif
constexpr int NWAVES = 8, NTHREADS = 512;
constexpr int NB = 16, SEQ = 2048, D = 1024, M = NB * SEQ, FF = 2816, FF2 = 5632, RN = 6144;
constexpr int NPHASE = 14;

constexpr size_t MiB = 1u << 20;
constexpr size_t WS_CTL = 0;
constexpr size_t WS_MODS = pg8::O_MODS, WS_KVM = pg8::O_KVM, WS_SW1 = pg8::O_SW1, WS_SW3 = pg8::O_SW3, WS_SW5 = pg8::O_SW5, WS_SW6 = pg8::O_SW6, WS_SS = pg8::O_SS, WS_SSO = pg8::O_SSO;
static_assert(pg8::O_SMALL_END <= 6 * MiB && pg8::M_ == M, "small region");
constexpr size_t WS_WT1 = 6 * MiB;
constexpr size_t WS_WT2 = WS_WT1 + (size_t)6144 * 1024 * 2;
constexpr size_t WS_WT3 = WS_WT2 + (size_t)1024 * 2048 * 2;
constexpr size_t WS_WT4 = WS_WT3 + (size_t)2 * 5632 * 1024 * 2;
constexpr size_t WS_WT5 = WS_WT4 + (size_t)2 * 1024 * 2816 * 2;
constexpr size_t WS_WT6 = WS_WT5 + (size_t)2048 * 1024 * 2;
constexpr size_t WS_WT7 = WS_WT6 + (size_t)1024 * 1024 * 2;
static_assert(WS_WT7 + (size_t)1024 * 1024 * 2 <= 64 * MiB, "weights region");
constexpr size_t WS_A = pg8::O_A, WS_Q = pg8::O_Q, WS_KD = pg8::O_KD, WS_V = pg8::O_V, WS_SG = pg8::O_SG, WS_ACT = pg8::O_ACT, WS_HF = pg8::O_HF, WS_HL = pg8::O_HL, WS_AM1 = pg8::O_AM1,
                 WS_KN = pg8::O_KN, WS_VT = pg8::O_VT, WS_QN = pg8::O_QN, WS_OSB = pg8::O_OSB;
constexpr size_t WS_END = 512 * MiB;
static_assert((size_t)512 * 2 * 5632 * 4 <= 22 * MiB && WS_HL + 22 * MiB <= WS_AM1 && WS_AM1 + 64 * MiB <= WS_OSB && WS_OSB + 64 * MiB <= WS_END && WS_ACT + (size_t)M * FF * 2 <= WS_HF, "big region");

constexpr int LDS_BYTES = 147456;
constexpr int MISC_OFF = LDS_BYTES - 512;
using pg8::ptab_t; using pg8::ldp; using pg8::T_OUT; using pg8::T_WS;

#define LBAR() do { asm volatile("s_waitcnt lgkmcnt(0)" ::: "memory"); __builtin_amdgcn_s_barrier(); asm volatile("" ::: "memory"); } while (0)

#define XB_TMO      128
#define XB_XCNT(j)  (256  + 64 * (j))
#define XB_XSUB(j)  (1280 + 64 * (j))
#define XB_XGEN(j)  (2304 + 64 * (j))
#define XB_TOP      3328
#define XB_TOPGEN   3392
#define XCD_BAR_WORDS 3456
#define XB_SPIN_CAP (1u << 20)
__device__ __forceinline__ unsigned xb_ld(unsigned* p)              { return __hip_atomic_load(p, __ATOMIC_RELAXED, __HIP_MEMORY_SCOPE_AGENT); }
__device__ __forceinline__ unsigned xb_add(unsigned* p, unsigned v) { return __hip_atomic_fetch_add(p, v, __ATOMIC_RELAXED, __HIP_MEMORY_SCOPE_AGENT); }
__device__ __forceinline__ unsigned xb_xcc_id() { return (unsigned)__builtin_amdgcn_s_getreg((3 << 11) | 20) & 0xFu; }
#define XB_SPIN(cond, bar) do { unsigned _sp = 0; while (cond) { __builtin_amdgcn_s_sleep(1); \
    if ((++_sp & 255u) == 0u) { if (xb_ld(&(bar)[XB_TMO])) break; if (_sp > XB_SPIN_CAP) { atomicAdd(&(bar)[XB_TMO], 1u); break; } } } } while (0)
struct XcdBarrier { unsigned* bar; unsigned x; volatile LAS unsigned* st; };
__device__ __forceinline__ XcdBarrier xcd_barrier_post(unsigned* bar, volatile LAS unsigned* st) {
    XcdBarrier b; b.bar = bar; b.x = xb_xcc_id(); b.st = st;
    if (threadIdx.x == 0) (void)xb_add(&bar[XB_XCNT(b.x)], 1u);
    return b;
}
__device__ __forceinline__ void xcd_barrier_complete(unsigned* bar, unsigned x, unsigned& nloc, unsigned& nx) {
    const unsigned G = gridDim.x * gridDim.y * gridDim.z;
    unsigned sum, cnt, mine, sp = 0u;
    for (;;) {
        sum = 0u; cnt = 0u; mine = 0u;
#pragma unroll
        for (unsigned j = 0; j < 16; ++j) { const unsigned c = xb_ld(&bar[XB_XCNT(j)]); sum += c; cnt += (c > 0u) ? 1u : 0u; mine = (j == x) ? c : mine; }
        if (sum == G) break;
        __builtin_amdgcn_s_sleep(1);
        if ((++sp & 255u) == 0u) { if (xb_ld(&bar[XB_TMO])) break; if (sp > XB_SPIN_CAP) { atomicAdd(&bar[XB_TMO], 1u); break; } }
    }
    nloc = mine > 0u ? mine : 1u; nx = cnt > 0u ? cnt : 1u;
}
__device__ __forceinline__ void xcd_barrier(const XcdBarrier& b) {
    asm volatile("s_waitcnt vmcnt(0)" ::: "memory");
    __syncthreads();
    if (threadIdx.x == 0) {
        unsigned* bar = b.bar;
        __builtin_amdgcn_s_waitcnt(0);
        unsigned nloc = b.st[0], nx = b.st[1];
        if (nloc == 0u) { xcd_barrier_complete(bar, b.x, nloc, nx); b.st[0] = nloc; b.st[1] = nx; }
        const unsigned old = xb_add(&bar[XB_XSUB(b.x)], 1u);
        const unsigned gen = old / nloc;
        if (old + 1u == (gen + 1u) * nloc) {
            __builtin_amdgcn_fence(__ATOMIC_RELEASE, "agent");
            asm volatile("s_waitcnt vmcnt(0)" ::: "memory");
            const unsigned og = xb_add(&bar[XB_TOP], 1u);
            const unsigned tg = og / nx;
            if (og + 1u == (tg + 1u) * nx) xb_add(&bar[XB_TOPGEN], 1u);
            else XB_SPIN(xb_ld(&bar[XB_TOPGEN]) == tg, bar);
            __builtin_amdgcn_fence(__ATOMIC_ACQUIRE, "agent");
            xb_add(&bar[XB_XGEN(b.x)], 1u);
            asm volatile("s_waitcnt vmcnt(0)" ::: "memory");
        } else {
            XB_SPIN(xb_ld(&bar[XB_XGEN(b.x)]) == gen, bar);
            __builtin_amdgcn_fence(__ATOMIC_ACQUIRE, "agent");
            asm volatile("s_waitcnt vmcnt(0)" ::: "memory");
        }
    }
    __syncthreads();
}

__device__ __forceinline__ float wave_sum(float v) {
#pragma unroll
    for (int o = 1; o < 64; o <<= 1) v += __shfl_xor(v, o);
    return v;
}
__device__ __forceinline__ float bf2f(unsigned short u) { return __builtin_bit_cast(float, (unsigned)u << 16); }

struct Args { const void* in[21]; float* out; unsigned char* ws; int ph_lo, ph_hi; };

__device__ __forceinline__ void p0_transpose_item(const float* W, int K, int N, bf16* WT, int k0, int sc, int nd0, LAS float* scr, int lane) {
#pragma unroll 8
    for (int i = 0; i < 32; ++i) { const int kk = 2 * i + (lane >> 5); scr[kk * 33 + (lane & 31)] = W[(size_t)(k0 + kk) * N + sc + (lane & 31)]; }
    asm volatile("s_waitcnt lgkmcnt(0)" ::: "memory");
    const int c = lane & 7;
#pragma unroll
    for (int j = 0; j < 4; ++j) { const int n = (lane >> 3) + 8 * j; const LAS float* s = scr + (8 * c) * 33 + n;
        u32x4 o; o.x = pk_bf16(s[0 * 33], s[1 * 33]); o.y = pk_bf16(s[2 * 33], s[3 * 33]); o.z = pk_bf16(s[4 * 33], s[5 * 33]); o.w = pk_bf16(s[6 * 33], s[7 * 33]);
        *(u32x4*)(WT + (size_t)(nd0 + n) * K + k0 + 8 * c) = o; }
    asm volatile("s_waitcnt lgkmcnt(0)" ::: "memory");
}
__device__ __forceinline__ int src_col(int type, int nd0) {
    if (type == 0) return nd0;
    const int pn = nd0 >> 8, r = nd0 & 255, bj = r >> 7;
    if (type == 1) return bj * FF + 128 * pn + (r & 127);
    const int wc = (r & 127) >> 5, head = 4 * (pn & 3) + wc;
    return (pn >= 4 ? 1024 : 0) + head * 64 + 32 * bj;
}
__device__ __forceinline__ void p0_phase(ptab_t tab, LAS unsigned char* lds, int vcu, int G) {
    const int tid = threadIdx.x, lane = tid & 63, w = __builtin_amdgcn_readfirstlane(tid >> 6);
    unsigned char* ws = ldp(tab, T_WS);
    { float* z = (float*)(ws + WS_SS) + M; const int n = 3 * M + 4 * M;
      for (int i = vcu * NTHREADS + tid; i < n / 4; i += G * NTHREADS) ((f32x4*)z)[i] = (f32x4){0.f, 0.f, 0.f, 0.f}; }
    if (vcu < 224) {
        LAS float* cact = (LAS float*)lds;
        LAS float* part = (LAS float*)(lds + 65536);
        const float* c = (const float*)ldp(tab, 1);
        for (int i = tid; i < 16 * 1024; i += NTHREADS) { const float x = c[i]; cact[i] = pg8::silu_f(x); }
        LBAR();
        const int col = vcu * 64;
        const float* W; int N, cw; const float* bias; float* dst; int dstride;
        if (col < 12288) { const int l = col / 6144; cw = col - l * 6144; W = (const float*)ldp(tab, 3) + (size_t)l * 1024 * 6144; N = 6144; bias = (const float*)ldp(tab, 4) + l * 6144; dst = (float*)(ws + WS_MODS) + (size_t)l * 16 * 6144; dstride = 6144; }
        else { cw = col - 12288; W = (const float*)ldp(tab, 9); N = 2048; bias = (const float*)ldp(tab, 10); dst = (float*)(ws + WS_KVM); dstride = 2048; }
        float acc[16];
#pragma unroll
        for (int b = 0; b < 16; ++b) acc[b] = 0.f;
        const float* wp = W + (size_t)(128 * w) * N + cw + lane;
#pragma unroll 2
        for (int kk = 0; kk < 128; kk += 4) {
            const float w0 = wp[(size_t)(kk + 0) * N], w1 = wp[(size_t)(kk + 1) * N], w2 = wp[(size_t)(kk + 2) * N], w3 = wp[(size_t)(kk + 3) * N];
#pragma unroll
            for (int b = 0; b < 16; ++b) { const f32x4 cv = *(const LAS f32x4*)(cact + b * 1024 + 128 * w + kk); acc[b] += (cv[0] * w0 + cv[1] * w1) + (cv[2] * w2 + cv[3] * w3); }
        }
#pragma unroll
        for (int b = 0; b < 16; ++b) part[(w * 16 + b) * 64 + lane] = acc[b];
        LBAR();
        for (int o = tid; o < 1024; o += NTHREADS) { const int b = o >> 6, l = o & 63; float s = bias[cw + l];
#pragma unroll
            for (int ww = 0; ww < 8; ++ww) s += part[(ww * 16 + b) * 64 + l];
            dst[(size_t)b * dstride + cw + l] = s; }
        LBAR();
    }
    {
        LAS float* scr = (LAS float*)(lds + w * 8448);
        const int gw = vcu * NWAVES + w, NGW = G * NWAVES;
        constexpr int I0 = 16 * 192, I1 = 32 * 32, I2 = 16 * 176, I4 = 44 * 32, I6 = 16 * 64, I7 = 16 * 32;
        constexpr int NIT = I0 + I1 + 2 * I2 + 2 * I4 + I6 + 2 * I7;
        for (int it = gw; it < NIT; it += NGW) {
            int r = it; const float* W; int K, N, type; bf16* WT;
            if (r < I0) { W = (const float*)ldp(tab, 7); K = 1024; N = 6144; type = 0; WT = (bf16*)(ws + WS_WT1); }
            else if ((r -= I0) < I1) { W = (const float*)ldp(tab, 8); K = 2048; N = 1024; type = 0; WT = (bf16*)(ws + WS_WT2); }
            else if ((r -= I1) < 2 * I2) { const int l = r / I2; r -= l * I2; W = (const float*)ldp(tab, 17) + (size_t)l * 1024 * FF2; K = 1024; N = FF2; type = 1; WT = (bf16*)(ws + WS_WT3) + (size_t)l * FF2 * 1024; }
            else if ((r -= 2 * I2) < 2 * I4) { const int l = r / I4; r -= l * I4; W = (const float*)ldp(tab, 20) + (size_t)l * FF * 1024; K = FF; N = 1024; type = 0; WT = (bf16*)(ws + WS_WT4) + (size_t)l * 1024 * FF; }
            else if ((r -= 2 * I4) < I6) { W = (const float*)ldp(tab, 12); K = 1024; N = 2048; type = 2; WT = (bf16*)(ws + WS_WT5); }
            else if ((r -= I6) < I7) { W = (const float*)ldp(tab, 14); K = 1024; N = 1024; type = 2; WT = (bf16*)(ws + WS_WT6); }
            else { r -= I7; W = (const float*)ldp(tab, 16); K = 1024; N = 1024; type = 0; WT = (bf16*)(ws + WS_WT7); }
            const int nblk = N / 32, kb = r / nblk, nb = r - kb * nblk;
            p0_transpose_item(W, K, N, WT, 64 * kb, src_col(type, 32 * nb), 32 * nb, scr, lane);
        }
    }
}

__device__ __forceinline__ void p1_phase(ptab_t tab, LAS unsigned char* lds, int vcu, int G) {
    const int tid = threadIdx.x, lane = tid & 63, w = __builtin_amdgcn_readfirstlane(tid >> 6);
    unsigned char* ws = ldp(tab, T_WS);
    const float* mods = (const float*)(ws + WS_MODS);
    const int gw = vcu * NWAVES + w, NGW = G * NWAVES;
    {
        const float* x = (const float*)ldp(tab, 0); const float* g = (const float*)ldp(tab, 5);
        bf16* A0 = (bf16*)(ws + WS_A); float* ss0 = (float*)(ws + WS_SS);
        const int rpw = M / NGW;
        for (int r0 = gw * rpw; r0 < M; r0 += NGW * rpw) {
            const int b = r0 / SEQ;
            f32x4 gs[4];
#pragma unroll
            for (int j = 0; j < 4; ++j) { const int col = 4 * lane + 256 * j; gs[j] = *(const f32x4*)(g + col) * (*(const f32x4*)(mods + (size_t)b * 6144 + 1024 + col) + 1.f); }
            for (int r = r0; r < r0 + rpw; r += 4) {
                f32x4 v[4][4]; float s[4];
#pragma unroll
                for (int q = 0; q < 4; ++q)
#pragma unroll
                    for (int j = 0; j < 4; ++j) v[q][j] = *(const f32x4*)(x + (size_t)(r + q) * D + 4 * lane + 256 * j);
#pragma unroll
                for (int q = 0; q < 4; ++q) { s[q] = (pg8::dot4(v[q][0]) + pg8::dot4(v[q][1])) + (pg8::dot4(v[q][2]) + pg8::dot4(v[q][3])); }
#pragma unroll
                for (int o = 1; o < 64; o <<= 1) {
#pragma unroll
                    for (int q = 0; q < 4; ++q) s[q] += __shfl_xor(s[q], o);
                }
                if (lane < 4) ss0[r + lane] = (lane == 0) ? s[0] : (lane == 1) ? s[1] : (lane == 2) ? s[2] : s[3];
#pragma unroll
                for (int q = 0; q < 4; ++q)
#pragma unroll
                    for (int j = 0; j < 4; ++j) { const f32x4 o = v[q][j] * gs[j]; u32x2 p; p.x = pk_bf16(o[0], o[1]); p.y = pk_bf16(o[2], o[3]); *(u32x2*)(A0 + (size_t)(r + q) * D + 4 * lane + 256 * j) = p; }
            }
        }
    }
    {
        LAS float* sh = (LAS float*)lds;
        for (int ty = 0; ty < 5; ++ty) {
            const float* sp; int sst, N; const bf16* WT; float* dst;
            if (ty == 0)      { sp = mods;                         sst = 6144; N = RN;   WT = (const bf16*)(ws + WS_WT1); dst = (float*)(ws + WS_SW1); }
            else if (ty == 1) { sp = mods + 3072;                  sst = 6144; N = FF2;  WT = (const bf16*)(ws + WS_WT3); dst = (float*)(ws + WS_SW3); }
            else if (ty == 2) { sp = mods + 16 * 6144 + 3072;      sst = 6144; N = FF2;  WT = (const bf16*)(ws + WS_WT3) + (size_t)FF2 * 1024; dst = (float*)(ws + WS_SW3) + 16 * FF2; }
            else if (ty == 3) { sp = (const float*)(ws + WS_KVM);  sst = 2048; N = 2048; WT = (const bf16*)(ws + WS_WT5); dst = (float*)(ws + WS_SW5); }
            else              { sp = mods + 16 * 6144;             sst = 6144; N = 1024; WT = (const bf16*)(ws + WS_WT6); dst = (float*)(ws + WS_SW6); }
            LBAR();
            for (int i = tid; i < 16 * 1024; i += NTHREADS) sh[i] = sp[(size_t)(i >> 10) * sst + (i & 1023)];
            LBAR();
            for (int n = gw; n < N; n += NGW) {
                const u32x4 w0 = *(const u32x4*)(WT + (size_t)n * 1024 + 8 * lane), w1 = *(const u32x4*)(WT + (size_t)n * 1024 + 512 + 8 * lane);
                float wf[16];
#pragma unroll
                for (int i = 0; i < 4; ++i) { wf[2 * i] = __builtin_bit_cast(float, w0[i] << 16); wf[2 * i + 1] = __builtin_bit_cast(float, w0[i] & 0xffff0000u);
                                              wf[8 + 2 * i] = __builtin_bit_cast(float, w1[i] << 16); wf[8 + 2 * i + 1] = __builtin_bit_cast(float, w1[i] & 0xffff0000u); }
                float p[16];
#pragma unroll
                for (int b = 0; b < 16; ++b) {
                    const LAS float* s0 = sh + b * 1024 + 8 * lane;
                    const f32x4 a0 = *(const LAS f32x4*)s0, a1 = *(const LAS f32x4*)(s0 + 4), a2 = *(const LAS f32x4*)(s0 + 512), a3 = *(const LAS f32x4*)(s0 + 516);
                    p[b] = (a0[0] * wf[0] + a0[1] * wf[1]) + (a0[2] * wf[2] + a0[3] * wf[3]) + (a1[0] * wf[4] + a1[1] * wf[5]) + (a1[2] * wf[6] + a1[3] * wf[7])
                         + (a2[0] * wf[8] + a2[1] * wf[9]) + (a2[2] * wf[10] + a2[3] * wf[11]) + (a3[0] * wf[12] + a3[1] * wf[13]) + (a3[2] * wf[14] + a3[3] * wf[15]);
                }
#pragma unroll
                for (int j = 0; j < 8; ++j) { const bool up = lane & 32; const float keep = up ? p[j + 8] : p[j], send = up ? p[j] : p[j + 8]; p[j] = keep + __shfl_xor(send, 32); }
#pragma unroll
                for (int j = 0; j < 4; ++j) { const bool up = lane & 16; const float keep = up ? p[j + 4] : p[j], send = up ? p[j] : p[j + 4]; p[j] = keep + __shfl_xor(send, 16); }
#pragma unroll
                for (int j = 0; j < 2; ++j) { const bool up = lane & 8; const float keep = up ? p[j + 2] : p[j], send = up ? p[j] : p[j + 2]; p[j] = keep + __shfl_xor(send, 8); }
                { const bool up = lane & 4; const float keep = up ? p[1] : p[0], send = up ? p[0] : p[1]; p[0] = keep + __shfl_xor(send, 4); }
                p[0] += __shfl_xor(p[0], 2); p[0] += __shfl_xor(p[0], 1);
                const float mine = p[0]; const int myb = ((lane >> 5) & 1) * 8 + ((lane >> 4) & 1) * 4 + ((lane >> 3) & 1) * 2 + ((lane >> 2) & 1);
                if ((lane & 3) == 0) dst[(size_t)myb * N + n] = mine;
            }
        }
    }
}

constexpr int RT_QROWB = 528, RT_VROWB = 272, RT_PROWB = 144;
constexpr int RT_QS = 0, RT_KS = 64 * RT_QROWB, RT_VS = 2 * 64 * RT_QROWB, RT_PS = RT_VS + 64 * RT_VROWB, RT_BYTES = RT_PS + 64 * RT_PROWB;
static_assert(RT_BYTES <= MISC_OFF, "retention LDS");
__device__ __forceinline__ s16x4 tr16(const LAS unsigned char* p) { typedef short v4i16_t __attribute__((ext_vector_type(4))); return __builtin_bit_cast(s16x4, __builtin_amdgcn_ds_read_tr16_b64_v4i16((LAS v4i16_t*)p)); }
#define MFMA16(a, b, c) __builtin_amdgcn_mfma_f32_16x16x32_bf16((a), (b), (c), 0, 0, 0)
#define MFMA32(a, b, c) __builtin_amdgcn_mfma_f32_32x32x16_bf16((a), (b), (c), 0, 0, 0)
__device__ __forceinline__ bf16x8 cat8(s16x4 lo, s16x4 hi) { return (bf16x8){lo[0], lo[1], lo[2], lo[3], hi[0], hi[1], hi[2], hi[3]}; }
__device__ __forceinline__ bf16x8 pack8(const f32x4 a, const f32x4 b) { return __builtin_bit_cast(bf16x8, pg8::pk8(a, b)); }

__device__ __forceinline__ void ret_unit(LAS unsigned char* lds, const bf16* Q, const bf16* KD, const bf16* V, bf16* SG, float* SSO, int unit, bool dry) {
    const int tid = threadIdx.x, lane = tid & 63, w = __builtin_amdgcn_readfirstlane(tid >> 6);
    const int b = unit >> 4, h = (unit >> 2) & 3, vs = unit & 3;
    const int c16 = lane & 15, g4 = lane >> 4;
    const float lg2 = __builtin_amdgcn_logf(1.f - __builtin_amdgcn_exp2f(-5.f - (float)h));
    const float gC = __builtin_amdgcn_exp2f(lg2 * 64.f);
    const char* gQ = (const char*)(Q + (size_t)b * SEQ * 1024 + h * 256);
    const char* gK = (const char*)(KD + (size_t)b * SEQ * 1024 + h * 256);
    const char* gV = (const char*)(V + (size_t)b * SEQ * 2048 + h * 512 + vs * 128);
    u32x4 pq[4], pk[4], pv[2];
#define RT_LOAD(c) do { _Pragma("unroll") for (int j = 0; j < 4; ++j) { const int cc = tid + 512 * j, row = cc >> 5, ck = cc & 31; const size_t go = (size_t)((c) * 64 + row) * 2048 + ck * 16; \
        pq[j] = *(const u32x4*)(gQ + go); pk[j] = *(const u32x4*)(gK + go); } \
        _Pragma("unroll") for (int j = 0; j < 2; ++j) { const int cc = tid + 512 * j, row = cc >> 4, ck = cc & 15; pv[j] = *(const u32x4*)(gV + (size_t)((c) * 64 + row) * 4096 + ck * 16); } } while (0)
#define RT_STORE() do { _Pragma("unroll") for (int j = 0; j < 4; ++j) { const int cc = tid + 512 * j, row = cc >> 5, ck = cc & 31; *(LAS u32x4*)(lds + RT_QS + row * RT_QROWB + ck * 16) = pq[j]; *(LAS u32x4*)(lds + RT_KS + row * RT_QROWB + ck * 16) = pk[j]; } \
        _Pragma("unroll") for (int j = 0; j < 2; ++j) { const int cc = tid + 512 * j, row = cc >> 4, ck = cc & 15; *(LAS u32x4*)(lds + RT_VS + row * RT_VROWB + ck * 16) = pv[j]; } } while (0)
    f32x4 st[16], oc[4], sT[2]; bf16x8 vf[2];
#pragma unroll
    for (int i = 0; i < 16; ++i) st[i] = (f32x4){0.f, 0.f, 0.f, 0.f};
#pragma unroll
    for (int i = 0; i < 4; ++i) oc[i] = (f32x4){0.f, 0.f, 0.f, 0.f};
    const int ntS = w & 3, mtb = 2 * (w >> 2);
    const LAS unsigned char* qrowS = lds + RT_QS + (16 * ntS + c16) * RT_QROWB + g4 * 16;
    const LAS unsigned char* krowS = lds + RT_KS + (16 * mtb + c16) * RT_QROWB + g4 * 16;
    const LAS unsigned char* qrowC = lds + RT_QS + c16 * RT_QROWB + g4 * 8;
    const LAS unsigned char* ktr = lds + RT_KS + (8 * g4 + (c16 >> 2)) * RT_QROWB + (c16 & 3) * 8;
    const LAS unsigned char* vtr = lds + RT_VS + (8 * g4 + (c16 >> 2)) * RT_VROWB + w * 32 + (c16 & 3) * 8;
    const LAS unsigned char* prow = lds + RT_PS + c16 * RT_PROWB + g4 * 16;
    LAS unsigned char* pst = lds + RT_PS + (16 * ntS + c16) * RT_PROWB + g4 * 8;
    RT_LOAD(0);
    for (int c = 0; c < 32; ++c) {
        LBAR();
        RT_STORE();
        if (c + 1 < 32) RT_LOAD(c + 1);
        LBAR();
#pragma unroll
        for (int ks = 0; ks < 2; ++ks) vf[ks] = cat8(tr16(vtr + (32 * ks) * RT_VROWB), tr16(vtr + (32 * ks + 4) * RT_VROWB));
        sT[0] = (f32x4){0.f, 0.f, 0.f, 0.f}; sT[1] = (f32x4){0.f, 0.f, 0.f, 0.f};
#pragma unroll
        for (int ks = 0; ks < 8; ++ks) {
            const bf16x8 bq = *(const LAS bf16x8*)(qrowS + ks * 64);
#pragma unroll
            for (int i = 0; i < 2; ++i) { const bf16x8 ak = *(const LAS bf16x8*)(krowS + i * 16 * RT_QROWB + ks * 64); sT[i] = MFMA16(ak, bq, sT[i]); }
        }
        {
            const int n = 16 * ntS + c16; const float fac = __builtin_amdgcn_exp2f(lg2 * (float)(n - 63));
#pragma unroll
            for (int i = 0; i < 2; ++i) {
                const int m0 = 16 * (mtb + i) + 4 * g4; float v[4];
#pragma unroll
                for (int e = 0; e < 4; ++e) v[e] = (n >= m0 + e) ? sT[i][e] * fac : 0.f;
                u32x2 p; p.x = pk_bf16(v[0], v[1]); p.y = pk_bf16(v[2], v[3]);
                *(LAS u32x2*)(pst + (mtb + i) * 32) = p;
            }
        }
        __builtin_amdgcn_sched_barrier(0);
#pragma unroll
        for (int ks = 0; ks < 8; ++ks) {
            const bf16x8 as = pack8(st[2 * ks], st[2 * ks + 1]);
#pragma unroll
            for (int nt = 0; nt < 4; ++nt) {
                const s16x4 lo = *(const LAS s16x4*)(qrowC + nt * 16 * RT_QROWB + ks * 64), hi = *(const LAS s16x4*)(qrowC + nt * 16 * RT_QROWB + ks * 64 + 32);
                oc[nt] = MFMA16(as, cat8(lo, hi), oc[nt]);
            }
            __builtin_amdgcn_sched_barrier(0);
        }
#pragma unroll
        for (int i = 0; i < 16; ++i) {
            f32x4 sacc = st[i] * gC;
#pragma unroll
            for (int ks = 0; ks < 2; ++ks) { const bf16x8 kt = cat8(tr16(ktr + (32 * ks) * RT_QROWB + i * 32), tr16(ktr + (32 * ks + 4) * RT_QROWB + i * 32)); sacc = MFMA16(kt, vf[ks], sacc); }
            st[i] = sacc;
            if ((i & 3) == 3) __builtin_amdgcn_sched_barrier(0);
        }
        LBAR();
#pragma unroll
        for (int nt = 0; nt < 4; ++nt) { const float gq = __builtin_amdgcn_exp2f(lg2 * (float)(16 * nt + c16 + 1)); oc[nt] *= gq; }
#pragma unroll
        for (int ks = 0; ks < 2; ++ks)
#pragma unroll
            for (int nt = 0; nt < 4; ++nt) if (32 * ks <= 16 * nt + 15) { const bf16x8 bp = *(const LAS bf16x8*)(prow + nt * 16 * RT_PROWB + ks * 64); oc[nt] = MFMA16(vf[ks], bp, oc[nt]); }
#pragma unroll
        for (int nt = 0; nt < 4; ++nt) {
            const int row = b * SEQ + c * 64 + 16 * nt + c16;
            float sq = pg8::dot4(oc[nt]); sq += __shfl_xor(sq, 16); sq += __shfl_xor(sq, 32);
            if (g4 == 0 && !dry) atomicAdd(SSO + (size_t)row * 4 + h, sq);
            bf16* gp = SG + (size_t)row * 2048 + h * 512 + vs * 128 + 16 * w + 4 * g4;
            const u32x2 sg = *(const u32x2*)gp;
            const float o0 = oc[nt][0] * __builtin_bit_cast(float, sg.x << 16), o1 = oc[nt][1] * __builtin_bit_cast(float, sg.x & 0xffff0000u);
            const float o2 = oc[nt][2] * __builtin_bit_cast(float, sg.y << 16), o3 = oc[nt][3] * __builtin_bit_cast(float, sg.y & 0xffff0000u);
            u32x2 p; p.x = pk_bf16(o0, o1); p.y = pk_bf16(o2, o3); if (!dry) *(u32x2*)gp = p;
            oc[nt] = (f32x4){0.f, 0.f, 0.f, 0.f};
        }
    }
    LBAR();
#undef RT_LOAD
#undef RT_STORE
}

__device__ __forceinline__ int crow(int r, int hi) { return (r & 3) + 8 * (r >> 2) + 4 * hi; }
__device__ __forceinline__ void sb_unit(const bf16* QN, const bf16* KN, const bf16* VT, bf16* O, int bh, int qblk, int lane) {
    const int r32 = lane & 31, hh = lane >> 5, b = bh >> 4, h = bh & 15;
    const size_t row0 = (size_t)b * SEQ + 32 * qblk;
    bf16x8 qf[4];
#pragma unroll
    for (int s = 0; s < 4; ++s) qf[s] = *(const bf16x8*)(QN + (row0 + r32) * 1024 + h * 64 + 16 * s + 8 * hh);
    f32x16 oT[2];
#pragma unroll
    for (int i = 0; i < 16; ++i) { oT[0][i] = 0.f; oT[1][i] = 0.f; }
    float R = 0.f;
    const bf16* kbase = KN + ((size_t)b * SEQ + r32) * 1024 + h * 64 + 8 * hh;
    const bf16* vbase = VT + ((size_t)bh * 64 + r32) * 2048 + 4 * hh;
    for (int kt = qblk; kt >= 0; --kt) {
        bf16x8 kf[4];
#pragma unroll
        for (int s = 0; s < 4; ++s) kf[s] = *(const bf16x8*)(kbase + (size_t)(32 * kt) * 1024 + 16 * s);
        s16x4 vlo[2][2], vhi[2][2];
#pragma unroll
        for (int dt = 0; dt < 2; ++dt)
#pragma unroll
            for (int sp = 0; sp < 2; ++sp) { const bf16* p = vbase + (size_t)(32 * dt) * 2048 + 32 * kt + 16 * sp; vlo[dt][sp] = *(const s16x4*)p; vhi[dt][sp] = *(const s16x4*)(p + 8); }
        f32x16 z;
#pragma unroll
        for (int i = 0; i < 16; ++i) z[i] = 0.f;
#pragma unroll
        for (int s = 0; s < 4; ++s) z = MFMA32(kf[s], qf[s], z);
        float sp_[16], lb[16];
        const bool diag = (kt == qblk);
#pragma unroll
        for (int i = 0; i < 16; ++i) {
            const float zz = z[i];
            const float t = __builtin_amdgcn_exp2f(-1.44269504089f * __builtin_fabsf(zz));
            float s = __builtin_fmaxf(zz, 0.f) + 0.69314718056f * __builtin_amdgcn_logf(1.f + t);
            const bool valid = !diag || (crow(i, hh) < r32);
            sp_[i] = valid ? s : 0.f;
            lb[i] = valid ? (zz - s) : -INFINITY;
        }
        float gsum[4], pgs[4];
#pragma unroll
        for (int q = 0; q < 4; ++q) { gsum[q] = (sp_[4 * q] + sp_[4 * q + 1]) + (sp_[4 * q + 2] + sp_[4 * q + 3]); pgs[q] = __shfl_xor(gsum[q], 32); }
        float later = 0.f;
        f32x16 pa;
#pragma unroll
        for (int q = 3; q >= 0; --q) {
            const float L = later + (hh == 0 ? pgs[q] : 0.f);
            const float s3 = L, s2 = s3 + sp_[4 * q + 3], s1 = s2 + sp_[4 * q + 2], s0 = s1 + sp_[4 * q + 1];
            pa[4 * q + 0] = __builtin_amdgcn_exp2f(1.44269504089f * (lb[4 * q + 0] - R - s0));
            pa[4 * q + 1] = __builtin_amdgcn_exp2f(1.44269504089f * (lb[4 * q + 1] - R - s1));
            pa[4 * q + 2] = __builtin_amdgcn_exp2f(1.44269504089f * (lb[4 * q + 2] - R - s2));
            pa[4 * q + 3] = __builtin_amdgcn_exp2f(1.44269504089f * (lb[4 * q + 3] - R - s3));
            later += gsum[q] + pgs[q];
        }
        R += later;
#pragma unroll
        for (int sp = 0; sp < 2; ++sp) {
            const bf16x8 pf = pack8((f32x4){pa[8 * sp], pa[8 * sp + 1], pa[8 * sp + 2], pa[8 * sp + 3]}, (f32x4){pa[8 * sp + 4], pa[8 * sp + 5], pa[8 * sp + 6], pa[8 * sp + 7]});
#pragma unroll
            for (int dt = 0; dt < 2; ++dt) oT[dt] = MFMA32(cat8(vlo[dt][sp], vhi[dt][sp]), pf, oT[dt]);
        }
        if (__all(R > 64.f)) break;
    }
#pragma unroll
    for (int dt = 0; dt < 2; ++dt)
#pragma unroll
        for (int q = 0; q < 4; ++q) {
            u32x2 p; p.x = pk_bf16(oT[dt][4 * q], oT[dt][4 * q + 1]); p.y = pk_bf16(oT[dt][4 * q + 2], oT[dt][4 * q + 3]);
            *(u32x2*)(O + (row0 + r32) * 1024 + h * 64 + 32 * dt + 8 * q + 4 * hh) = p;
        }
}

__device__ __forceinline__ void fix_phase(const float* HF, const float* HL, const float* cw, const float* cb, bf16* ACT, int vcu, int G) {
    const int NIT = 512 * 2 * (FF / 4);
    for (int it = vcu * NTHREADS + threadIdx.x; it < NIT; it += G * NTHREADS) {
        const int cg4 = it % (FF / 4), bi = it / (FF / 4), i = bi & 1, blk = bi >> 1;
        const int c0 = 4 * cg4, pn = c0 >> 7, j = c0 & 127, nv = 256 * pn + j;
        const bool first = (blk & 31) == 0;
        f32x4 val, gat;
#pragma unroll
        for (int half = 0; half < 2; ++half) {
            const int nn = nv + 128 * half, co = half * FF + c0;
            const f32x4 u0 = *(const f32x4*)(HF + (size_t)(blk * 2 + i) * FF2 + nn);
            f32x4 u1, u2; const f32x4 zero = (f32x4){0.f, 0.f, 0.f, 0.f};
            if (i == 1) { u1 = *(const f32x4*)(HF + (size_t)(blk * 2) * FF2 + nn); u2 = first ? zero : *(const f32x4*)(HL + (size_t)((blk - 1) * 2 + 1) * FF2 + nn); }
            else { u1 = first ? zero : *(const f32x4*)(HL + (size_t)((blk - 1) * 2 + 1) * FF2 + nn); u2 = first ? zero : *(const f32x4*)(HL + (size_t)((blk - 1) * 2) * FF2 + nn); }
            const f32x4 y = *(const f32x4*)(cb + co) + *(const f32x4*)(cw + 2 * FF2 + co) * u0 + *(const f32x4*)(cw + FF2 + co) * u1 + *(const f32x4*)(cw + co) * u2;
            if (half == 0) val = y; else gat = y;
        }
        const f32x4 o = val * pg8::silu4(gat);
        u32x2 p; p.x = pk_bf16(o[0], o[1]); p.y = pk_bf16(o[2], o[3]);
        *(u32x2*)(ACT + (size_t)(64 * blk + i) * FF + c0) = p;
    }
}

__device__ __forceinline__ XcdBarrier mk_bar(ptab_t tab, LAS unsigned char* lds) { XcdBarrier b; b.bar = (unsigned*)(ldp(tab, T_WS) + WS_CTL) + 1024; b.x = xb_xcc_id(); b.st = (volatile LAS unsigned*)(lds + MISC_OFF) + 8; return b; }
__global__ void __launch_bounds__(NTHREADS, 2) yoco_fwd(Args a) {
    extern __shared__ __attribute__((aligned(16))) unsigned char lds_raw[];
    LAS unsigned char* lds = (LAS unsigned char*)lds_raw;
    volatile LAS unsigned* MISC = (volatile LAS unsigned*)(lds + MISC_OFF);
    LAS unsigned long long* tabw = (LAS unsigned long long*)(lds + MISC_OFF + 64);
    const ptab_t tab = (ptab_t)(lds + MISC_OFF + 64);
    if (threadIdx.x < 16) MISC[threadIdx.x] = 0u;
    if (threadIdx.x == 64) {
#pragma unroll
        for (int i = 0; i < 21; ++i) tabw[i] = (unsigned long long)a.in[i];
        tabw[T_OUT] = (unsigned long long)a.out; tabw[T_WS] = (unsigned long long)a.ws;
        MISC[0] = (unsigned)a.ph_lo; MISC[1] = (unsigned)a.ph_hi;
    }
    __syncthreads();
    if (a.ph_hi - a.ph_lo > 1) (void)xcd_barrier_post((unsigned*)(a.ws + WS_CTL) + 1024, MISC + 8);
#define PH_LO ((int)__builtin_amdgcn_readfirstlane(MISC[0]))
#define PH_HI ((int)__builtin_amdgcn_readfirstlane(MISC[1]))
#define IN(k) (PH_LO <= (k) && (k) < PH_HI)
#define SEAM(k) do { if (IN(k) && IN((k) + 1)) xcd_barrier(mk_bar(tab, lds)); } while (0)
#define GRID ((int)gridDim.x)
#define BX ((int)blockIdx.x)
#define VCU ((GRID % 8 == 0) ? (BX % 8) * (GRID / 8) + BX / 8 : BX)
#define WSP (ldp(tab, T_WS))

#ifndef SKIP_P0
    if (IN(0)) { for (int rep = 0; rep < REPS(0); ++rep) { p0_phase(tab, lds, VCU, GRID); LBAR(); } }
#endif
    if (IN(0) && IN(1)) {
        if (MK_ONE_LAUNCH) { cg::this_grid().sync(); }
        else xcd_barrier(mk_bar(tab, lds));
    }
#ifndef SKIP_P1
    if (IN(1)) { for (int rep = 0; rep < REPS(1); ++rep) p1_phase(tab, lds, VCU, GRID); }
#endif
    SEAM(1);
    if (IN(2)) {
        pg8::Gemm g{(const bf16*)(WSP + WS_A), (const bf16*)(WSP + WS_WT1), M, RN, D, D}; pg8::StaticOrder S; S.init(M, RN, GRID, BX);
        pg8::EpiRetIn E{tab};
        for (int rep = 0; rep < REPS(2); ++rep) pg8::gemm_phase<pg8::EpiRetIn, pg8::StaticOrder, true, true>(lds, g, S, E);
    }
    SEAM(2);
#ifndef SKIP_RET
    if (IN(3)) {
        unsigned char* ws = WSP;
        for (int rep = 0; rep < REPS(3); ++rep) for (int u = VCU; u < 256; u += GRID) ret_unit(lds, (const bf16*)(ws + WS_Q), (const bf16*)(ws + WS_KD), (const bf16*)(ws + WS_V), (bf16*)(ws + WS_SG), (float*)(ws + WS_SSO), u, rep == 0 && REPS(3) == 2);
    }
#endif
    SEAM(3);
    if (IN(4)) {
        pg8::Gemm g{(const bf16*)(WSP + WS_SG), (const bf16*)(WSP + WS_WT2), M, D, 512, 2048}; pg8::SegOrder S; S.init(M, D, GRID, BX);
        pg8::EpiRes<0> E{tab};
        {
            const int slot = threadIdx.x >> 8, r = threadIdx.x & 255; pg8::Unit u;
            if (S.next(4 * slot, u)) {
                const f32x4 s4 = *(const f32x4*)((const float*)(WSP + WS_SSO) + (size_t)(u.pm * 256 + r) * 4);
                const float e0 = s4[0] * (1.f / 512.f) + EPS, e1 = s4[1] * (1.f / 512.f) + EPS, e2 = s4[2] * (1.f / 512.f) + EPS, e3 = s4[3] * (1.f / 512.f) + EPS;
                f32x4 o; o[0] = __builtin_sqrtf(e1 / e0); o[1] = __builtin_sqrtf(e2 / e1); o[2] = __builtin_sqrtf(e3 / e2); o[3] = 1.f / __builtin_sqrtf(e3);
                *(LAS f32x4*)(lds + 131072 + (slot * 256 + r) * 16) = o;
            }
            LBAR();
        }
        pg8::gemm_phase<pg8::EpiRes<0>, pg8::SegOrder, true, true>(lds, g, S, E);
    }
    SEAM(4);
#pragma unroll 1
    for (int l = 0; l < 2; ++l) {
        const int pb = (l == 0) ? 5 : 11;
        if (IN(pb)) {
            pg8::Gemm g{(const bf16*)(WSP + WS_A), (const bf16*)(WSP + WS_WT3) + (size_t)l * FF2 * 1024, M, FF2, D, D}; pg8::StaticOrder S; S.init(M, FF2, GRID, BX);
            pg8::EpiFfnIn E{tab, l};
            for (int rep = 0; rep < ((l == 0) ? REPS(5) : 1); ++rep) pg8::gemm_phase<pg8::EpiFfnIn, pg8::StaticOrder, true, true>(lds, g, S, E);
        }
        SEAM(pb);
        if (IN(pb + 1)) { unsigned char* ws = WSP; fix_phase((const float*)(ws + WS_HF), (const float*)(ws + WS_HL), (const float*)ldp(tab, 18) + l * 3 * FF2, (const float*)ldp(tab, 19) + l * FF2, (bf16*)(ws + WS_ACT), VCU, GRID); }
        SEAM(pb + 1);
        if (IN(pb + 2)) {
            pg8::Gemm g{(const bf16*)(WSP + WS_ACT), (const bf16*)(WSP + WS_WT4) + (size_t)l * 1024 * FF, M, D, FF, FF}; pg8::StaticOrder S; S.init(M, D, GRID, BX);
            if (l == 0) { pg8::EpiRes<1> E{tab}; pg8::gemm_phase<pg8::EpiRes<1>, pg8::StaticOrder, true, true>(lds, g, S, E); }
            else        { pg8::EpiRes<3> E{tab}; pg8::gemm_phase<pg8::EpiRes<3>, pg8::StaticOrder, true, true>(lds, g, S, E); }
        }
        if (l == 1) break;
        SEAM(7);
        if (IN(8)) {
            { pg8::Gemm g{(const bf16*)(WSP + WS_A), (const bf16*)(WSP + WS_WT5), M, 2048, D, D}; pg8::StaticOrder S; S.init(M, 2048, GRID, BX);
              pg8::EpiKVQ<0> E{tab};
              for (int rep = 0; rep < REPS(8); ++rep) pg8::gemm_phase<pg8::EpiKVQ<0>, pg8::StaticOrder, true, true>(lds, g, S, E); }
            { pg8::Gemm g{(const bf16*)(WSP + WS_AM1), (const bf16*)(WSP + WS_WT6), M, D, D, D}; pg8::StaticOrder S; S.init(M, D, GRID, BX);
              pg8::EpiKVQ<1> E{tab};
              pg8::gemm_phase<pg8::EpiKVQ<1>, pg8::StaticOrder, true, true>(lds, g, S, E); }
        }
        SEAM(8);
#ifndef SKIP_SB
        if (IN(9)) {
            unsigned char* ws = WSP; const int vcu = VCU, wave = __builtin_amdgcn_readfirstlane(threadIdx.x >> 6), lane = threadIdx.x & 63;
            for (int rep = 0; rep < REPS(9); ++rep)
            for (int i = 0; i < 8; ++i) { const int bh = (vcu >> 3) + 32 * i, qg = ((vcu & 7) + i) & 7;
                if (bh < 256) sb_unit((const bf16*)(ws + WS_QN), (const bf16*)(ws + WS_KN), (const bf16*)(ws + WS_VT), (bf16*)(ws + WS_OSB), bh, qg * 8 + wave, lane); }
        }
#endif
        SEAM(9);
        if (IN(10)) {
            pg8::Gemm g{(const bf16*)(WSP + WS_OSB), (const bf16*)(WSP + WS_WT7), M, D, D, D}; pg8::StaticOrder S; S.init(M, D, GRID, BX);
            pg8::EpiRes<2> E{tab};
            pg8::gemm_phase<pg8::EpiRes<2>, pg8::StaticOrder, true, true>(lds, g, S, E);
        }
        SEAM(10);
    }
#undef IN
#undef SEAM
}

extern "C" void kernel_launch(void* const* d_in, const int* in_sizes, int n_in, void* d_out, int out_size, void* d_ws, size_t ws_size, hipStream_t stream) {
    static int grid = 0;
    if (grid == 0) {
        if (n_in != 21 || in_sizes[0] != M * D || out_size != M * D || ws_size < WS_END) { fprintf(stderr, "kernel_launch: unexpected problem: n_in %d in0 %d out %d ws %zu (need %zu)\n", n_in, n_in > 0 ? in_sizes[0] : -1, out_size, ws_size, (size_t)WS_END); grid = -1; return; }
        int dev = 0, cus = 0, per_cu = 0;
        if (hipGetDevice(&dev) != hipSuccess || hipDeviceGetAttribute(&cus, hipDeviceAttributeMultiprocessorCount, dev) != hipSuccess) { grid = -1; return; }
        if (hipFuncSetAttribute((const void*)yoco_fwd, hipFuncAttributeMaxDynamicSharedMemorySize, LDS_BYTES) != hipSuccess) { fprintf(stderr, "kernel_launch: hipFuncSetAttribute failed\n"); grid = -1; return; }
        if (hipOccupancyMaxActiveBlocksPerMultiprocessor(&per_cu, (const void*)yoco_fwd, NTHREADS, LDS_BYTES) != hipSuccess || per_cu < 1) { fprintf(stderr, "kernel_launch: occupancy query says %d\n", per_cu); (void)hipGetLastError(); per_cu = 1; }
        grid = cus;
        if (grid > 256) grid = 256;
    }
    if (grid < 0) return;
    (void)hipMemsetAsync((char*)d_ws + WS_CTL, 0, 65536, stream);
    Args a{};
    for (int i = 0; i < 21; ++i) a.in[i] = d_in[i];
    a.out = (float*)d_out; a.ws = (unsigned char*)d_ws;
#if MK_ONE_LAUNCH
    a.ph_lo = 0; a.ph_hi = NPHASE;
    void* args[] = {&a};
    hipError_t e = hipLaunchCooperativeKernel((const void*)yoco_fwd, dim3(grid), dim3(NTHREADS), args, LDS_BYTES, stream);
    if (e != hipSuccess) fprintf(stderr, "kernel_launch: cooperative launch failed: %s\n", hipGetErrorString(e));
#else
    for (int p = 0; p < NPHASE; ++p) { a.ph_lo = p; a.ph_hi = p + 1; hipLaunchKernelGGL(yoco_fwd, dim3(grid), dim3(NTHREADS), LDS_BYTES, stream, a); }
#endif
}
```

```cpp
#include <hip/hip_runtime.h>
#include <hip/hip_cooperative_groups.h>
#include <cstdio>
#include <cstdint>
namespace cg = cooperative_groups;
namespace pg8 {
#define PG8_LAS __attribute__((address_space(3)))
typedef unsigned short bf16_t;
typedef short bf16x8 __attribute__((ext_vector_type(8)));
typedef float f32x4 __attribute__((ext_vector_type(4)));
typedef unsigned u32x4 __attribute__((ext_vector_type(4)));
constexpr int BM = 256, BK = 64, HALF = 128, HTB = HALF * BK * 2  , STAGE_BYTES = 8 * HTB, NXCD = 8, WGM = 8;

__host__ __device__ __forceinline__ int lds_byte(int r, int c) { const int st = (r >> 4) * 2 + (c >> 5), rr = r & 15, cc = c & 31, ob = rr * 64 + cc * 2; return st * 1024 + (ob ^ (((ob >> 9) & 1) << 5)); }
__host__ __device__ __forceinline__ void stage_rc(int b, int& R, int& C) { const int st = b / 1024, sb = b % 1024, swz = sb ^ (((sb >> 9) & 1) << 5); R = (st >> 1) * 16 + swz / 64; C = (st & 1) * 32 + (swz % 64) / 2; }
__host__ __device__ __forceinline__ int perm32(int rho) { const int n = rho >> 4, i = rho & 15; return 8 * (i >> 2) + 4 * n + (i & 3); }

struct Unit { int pm, pn, kk; };
struct Gemm { const bf16_t* A; const bf16_t* Bt; int M, N, K, ld; };

struct StaticOrder {
    int nM, nN, nwg, G, c;
    __host__ __device__ void init(int M, int N, int G_, int c_) { nM = M / BM; nN = N / BM; nwg = nM * nN; G = G_; c = c_; }
    __host__ __device__ bool next(int i, Unit& u) const {
        const long L = (long)i * G + c; if (L >= nwg) return false;
        int wgid = (int)L; { const int q = nwg / NXCD, r = nwg % NXCD, xcd = wgid % NXCD, off = wgid / NXCD; wgid = (xcd < r ? xcd * (q + 1) : r * (q + 1) + (xcd - r) * q) + off; }
        const int nig = WGM * nN, gid = wgid / nig, fm = gid * WGM, gsz = (nM - fm) < WGM ? (nM - fm) : WGM;
        u.pm = fm + ((wgid % nig) % gsz); u.pn = (wgid % nig) / gsz; u.kk = 0; return true;
    }
    __device__ __forceinline__ void a_ready(const Unit&) const {}
    __device__ __forceinline__ void done(const Unit&) const {}
};

struct SegOrder : StaticOrder {
    __host__ __device__ bool next(int i, Unit& u) const { if (!StaticOrder::next(i >> 2, u)) return false; u.kk = i & 3; return true; }
};
typedef float f32x2 __attribute__((ext_vector_type(2)));
typedef __bf16 bf16x2_t __attribute__((ext_vector_type(2)));
constexpr float EPS = 1e-6f;
__device__ __forceinline__ unsigned pk_bf16(float lo, float hi) { f32x2 v = {lo, hi}; bf16x2_t b = __builtin_convertvector(v, bf16x2_t); return __builtin_bit_cast(unsigned, b); }
__device__ __forceinline__ u32x4 pk8(const f32x4 a, const f32x4 b) { u32x4 w; w.x = pk_bf16(a[0], a[1]); w.y = pk_bf16(a[2], a[3]); w.z = pk_bf16(b[0], b[1]); w.w = pk_bf16(b[2], b[3]); return w; }
__device__ __forceinline__ float silu_f(float x) { return x * __builtin_amdgcn_rcpf(1.f + __builtin_amdgcn_exp2f(-1.44269504089f * x)); }
__device__ __forceinline__ f32x4 silu4(f32x4 v) { f32x4 o; o[0] = silu_f(v[0]); o[1] = silu_f(v[1]); o[2] = silu_f(v[2]); o[3] = silu_f(v[3]); return o; }
__device__ __forceinline__ float dot4(const f32x4 a) { return (a[0] * a[0] + a[1] * a[1]) + (a[2] * a[2] + a[3] * a[3]); }
template <int CTRL> __device__ __forceinline__ float dppf(float old, float src) { return __builtin_bit_cast(float, __builtin_amdgcn_update_dpp(__builtin_bit_cast(int, old), __builtin_bit_cast(int, src), CTRL, 0xf, 0xf, false)); }


typedef const PG8_LAS unsigned long long* ptab_t;
enum { T_OUT = 21, T_WS = 22 };
__device__ __forceinline__ unsigned char* ldp(ptab_t tab, int k) { const unsigned long long v = tab[k]; const unsigned lo = __builtin_amdgcn_readfirstlane((unsigned)v), hi = __builtin_amdgcn_readfirstlane((unsigned)(v >> 32)); return (unsigned char*)(__attribute__((address_space(1))) unsigned char*)(((unsigned long long)hi << 32) | lo); }
__device__ __forceinline__ void dma4(const void* src_lane, PG8_LAS unsigned char* dst_wave_base) { __builtin_amdgcn_global_load_lds((const unsigned*)src_lane, (PG8_LAS unsigned*)dst_wave_base, 4, 0, 0); }
constexpr int LDS_TOTAL = 155648, LDS_MISC = LDS_TOTAL - 512, LDS_XTRA = 131072;
constexpr size_t MiB_ = 1u << 20;
constexpr int M_ = 32768;
constexpr size_t O_MODS = 65536, O_KVM = O_MODS + (size_t)2 * 16 * 6144 * 4, O_SW1 = O_KVM + (size_t)16 * 2048 * 4, O_SW3 = O_SW1 + (size_t)16 * 6144 * 4, O_SW5 = O_SW3 + (size_t)2 * 16 * 5632 * 4,
                 O_SW6 = O_SW5 + (size_t)16 * 2048 * 4, O_SS = O_SW6 + (size_t)16 * 1024 * 4, O_SSO = O_SS + (size_t)4 * M_ * 4, O_SMALL_END = O_SSO + (size_t)M_ * 16 * 4;
constexpr size_t O_A = 64 * MiB_, O_BIG = 128 * MiB_, O_Q = O_BIG, O_KD = O_BIG + 64 * MiB_, O_V = O_BIG + 128 * MiB_, O_SG = O_BIG + 256 * MiB_;
constexpr size_t O_H16 = O_BIG, O_ACT = O_BIG + 64 * MiB_, O_HF = O_ACT + 176 * MiB_, O_HL = O_HF + 22 * MiB_, O_AM1 = O_BIG + 284 * MiB_, O_KN = O_BIG + 64 * MiB_, O_VT = O_BIG + 128 * MiB_, O_QN = O_BIG + 192 * MiB_, O_OSB = O_BIG + 256 * MiB_;

struct EpiRetIn {
    static constexpr bool PERM = true, AFTER_DRAIN = false, SEG = false;
    ptab_t tab;
    __device__ __forceinline__ void prefetch(const Unit& u, int slot, PG8_LAS unsigned char* lds, int wid, int lane) const {
        unsigned char* ws = ldp(tab, T_WS); PG8_LAS unsigned char* base = lds + LDS_XTRA + slot * 3072; const int b = u.pm >> 3;
        if (wid < 4) { dma4((const float*)(ws + O_SS) + u.pm * BM + 64 * wid + lane, base + 256 * wid); dma4((const float*)(ws + O_SW1) + b * 6144 + u.pn * BM + 64 * wid + lane, base + 2048 + 256 * wid); }
        else dma4((const int*)ldp(tab, 2) + u.pm * BM + 64 * (wid - 4) + lane, base + 1024 + 256 * (wid - 4));
    }
    __device__ __forceinline__ void operator()(f32x4 (&acc)[2][2][4][2], const Unit& u, int wr, int wc, int slot, int) const {
        int lane_ = threadIdx.x & 63; asm volatile("" : "+v"(lane_)); const int fr = lane_ & 15, fq = lane_ >> 4;
        unsigned char* ws = ldp(tab, T_WS);
        const PG8_LAS unsigned char* tb = (const PG8_LAS unsigned char*)tab - 64 - LDS_MISC + LDS_XTRA + slot * 3072;
        const PG8_LAS float* ss = (const PG8_LAS float*)tb - u.pm * BM; const PG8_LAS int* pos = (const PG8_LAS int*)(tb + 1024) - u.pm * BM;
        const PG8_LAS float* sW = (const PG8_LAS float*)(tb + 2048) - ((u.pm >> 3) * 6144 + u.pn * 256);
        bf16_t* Q = (bf16_t*)(ws + O_Q); bf16_t* KD = (bf16_t*)(ws + O_KD); bf16_t* V = (bf16_t*)(ws + O_V); bf16_t* SG = (bf16_t*)(ws + O_SG);
        const int b = u.pm >> 3, cl = wc * 32 + 8 * fq, row0 = u.pm * BM + wr * 64 + fr;
        f32x4 sw[2][2];
#pragma unroll
        for (int bj = 0; bj < 2; ++bj)
#pragma unroll
            for (int n = 0; n < 2; ++n) sw[bj][n] = *(const f32x4*)(sW + b * 6144 + u.pn * 256 + bj * 128 + cl + 4 * n);
        if (u.pn < 8) {
            const bool isk = u.pn >= 4; const int h = u.pn & 3;
            bf16_t* dst = (isk ? KD : Q) + h * 256 + cl;
            float inv[8];
#pragma unroll
            for (int i = 0; i < 8; ++i) inv[i] = __builtin_amdgcn_exp2f(-(float)(cl + i) * 0.10381025296523f) * 0.15915494309189535f;
            const float lg = __builtin_amdgcn_logf(1.f - __builtin_amdgcn_exp2f(-5.f - (float)h));
#pragma unroll
            for (int ai = 0; ai < 2; ++ai)
#pragma unroll
                for (int m = 0; m < 4; ++m) {
                    const int row = row0 + ai * HALF + m * 16;
                    const float p = (float)pos[row], rs = __builtin_amdgcn_rsqf(ss[row] * (1.f / 1024.f) + EPS);
                    const float ksc = isk ? 0.0625f * __builtin_amdgcn_exp2f(lg * (float)(63 - (row & 63))) : 1.f;
                    f32x4 o1[2], o2[2];
#pragma unroll
                    for (int n = 0; n < 2; ++n)
#pragma unroll
                        for (int e = 0; e < 4; ++e) {
                            const float x1 = acc[ai][0][m][n][e] * rs + sw[0][n][e], x2 = acc[ai][1][m][n][e] * rs + sw[1][n][e];
                            const float r = __builtin_amdgcn_fractf(p * inv[4 * n + e]);
                            const float s = __builtin_amdgcn_sinf(r), c = __builtin_amdgcn_cosf(r);
                            o1[n][e] = (x1 * c - x2 * s) * ksc; o2[n][e] = (x1 * s + x2 * c) * ksc;
                        }
                    *(u32x4*)(dst + (size_t)row * 1024) = pk8(o1[0], o1[1]);
                    *(u32x4*)(dst + (size_t)row * 1024 + 128) = pk8(o2[0], o2[1]);
                }
        } else {
            const bool isg = u.pn >= 16;
            bf16_t* dst = (isg ? SG : V) + ((u.pn - 8) & 7) * 256 + cl;
#pragma unroll
            for (int ai = 0; ai < 2; ++ai)
#pragma unroll
                for (int m = 0; m < 4; ++m) {
                    const int row = row0 + ai * HALF + m * 16;
                    const float rs = __builtin_amdgcn_rsqf(ss[row] * (1.f / 1024.f) + EPS);
#pragma unroll
                    for (int bj = 0; bj < 2; ++bj) {
                        f32x4 v0 = acc[ai][bj][m][0] * rs + sw[bj][0], v1 = acc[ai][bj][m][1] * rs + sw[bj][1];
                        if (isg) { v0 = silu4(v0); v1 = silu4(v1); }
                        *(u32x4*)(dst + (size_t)row * 2048 + bj * HALF) = pk8(v0, v1);
                    }
                }
        }
    }
};

template <int WHICH> struct EpiRes {
    static constexpr int NOUT = (WHICH == 1) ? 2 : (WHICH == 3 ? 0 : 1);
    static constexpr bool HOOK = (WHICH == 0), SSACC = (WHICH != 3);
    static constexpr int MC = (NOUT == 2) ? 2 : 4;
    static constexpr int MB = (NOUT == 2) ? 1 : 2;
    static constexpr bool PERM = true, AFTER_DRAIN = false, SEG = HOOK;
    ptab_t tab;
    __device__ __forceinline__ void prefetch(const Unit&, int, PG8_LAS unsigned char*, int, int) const {}
    __device__ __forceinline__ void seg(f32x4 (&acc)[2][2][4][2], int kk, int tile, int wr) const {
        int lane_ = threadIdx.x & 63; asm volatile("" : "+v"(lane_)); const int fr = lane_ & 15;
        const PG8_LAS float* tb = (const PG8_LAS float*)((const PG8_LAS unsigned char*)tab - 64 - LDS_MISC + LDS_XTRA) + (tile * 256 + wr * 64 + fr) * 4 + kk;
#pragma unroll
        for (int ai = 0; ai < 2; ++ai)
#pragma unroll
            for (int m = 0; m < 4; ++m) {
                const float ratio = tb[(ai * HALF + m * 16) * 4];
#pragma unroll
                for (int bj = 0; bj < 2; ++bj)
#pragma unroll
                    for (int n = 0; n < 2; ++n) acc[ai][bj][m][n] *= ratio;
            }
    }
    __device__ __forceinline__ void operator()(f32x4 (&acc)[2][2][4][2], const Unit& u, int wr, int wc, int, int) const {
        int lane_ = threadIdx.x & 63; asm volatile("" : "+v"(lane_)); const int fr = lane_ & 15, fq = lane_ >> 4;
        unsigned char* ws = ldp(tab, T_WS); float* hout = (float*)ldp(tab, T_OUT); bf16_t* h16 = (bf16_t*)(ws + O_H16);
        const float* mods = (const float*)(ws + O_MODS);
        const float* hin = (const float*)ldp(tab, 0);
        const float* gate = mods + (WHICH >= 2 ? 16 * 6144 : 0) + ((WHICH == 0 || WHICH == 2) ? 2048 : 5120);
        const float* g0 = nullptr; const float* sc0 = nullptr; int st0 = 6144; bf16_t* o0 = (bf16_t*)(ws + O_A);
        const float* g1 = nullptr; const float* sc1 = nullptr; const int st1 = 6144; bf16_t* o1 = (bf16_t*)(ws + O_AM1);
        if (WHICH == 0) { g0 = (const float*)ldp(tab, 6); sc0 = mods + 4096; }
        if (WHICH == 1) { g0 = (const float*)ldp(tab, 11); sc0 = (const float*)(ws + O_KVM) + 1024; st0 = 2048; g1 = (const float*)ldp(tab, 5) + 1024; sc1 = mods + 16 * 6144 + 1024; }
        if (WHICH == 2) { g0 = (const float*)ldp(tab, 6) + 1024; sc0 = mods + 16 * 6144 + 4096; }
        float* ss = (float*)(ws + O_SS) + (WHICH + 1) * M_;
        const int b = u.pm >> 3, cl = wc * 32 + 8 * fq, row0 = u.pm * BM + wr * 64 + fr;
        f32x4 gt[2][2], gs0[2][2], gs1[2][2];
#pragma unroll
        for (int bj = 0; bj < 2; ++bj)
#pragma unroll
            for (int n = 0; n < 2; ++n) {
                const int col = u.pn * BM + bj * HALF + cl + 4 * n;
                gt[bj][n] = *(const f32x4*)(gate + b * 6144 + col);
                if (NOUT >= 1) gs0[bj][n] = *(const f32x4*)(g0 + col) * (*(const f32x4*)(sc0 + b * st0 + col) + 1.f);
                if (NOUT >= 2) gs1[bj][n] = *(const f32x4*)(g1 + col) * (*(const f32x4*)(sc1 + b * st1 + col) + 1.f);
            }
        if (WHICH == 0) {
#pragma unroll
        for (int ai = 0; ai < 2; ++ai)
#pragma unroll
            for (int mp = 0; mp < 4; mp += MB) {
                f32x4 pre[MB][2][2];
#pragma unroll
                for (int m = 0; m < MB; ++m)
#pragma unroll
                    for (int bj = 0; bj < 2; ++bj) { const size_t off = (size_t)(row0 + ai * HALF + (mp + m) * 16) * 1024 + u.pn * BM + bj * HALF + cl; pre[m][bj][0] = *(const f32x4*)(hin + off); pre[m][bj][1] = *(const f32x4*)(hin + off + 4); }
#pragma unroll
                for (int m = 0; m < MB; ++m) {
                    const int row = row0 + ai * HALF + (mp + m) * 16;
                    float sq = 0.f;
#pragma unroll
                    for (int bj = 0; bj < 2; ++bj) {
                        const size_t off = (size_t)row * 1024 + u.pn * BM + bj * HALF + cl;
                        const f32x4 h0 = pre[m][bj][0] + gt[bj][0] * acc[ai][bj][mp + m][0], h1 = pre[m][bj][1] + gt[bj][1] * acc[ai][bj][mp + m][1];
                        *(u32x4*)(h16 + off) = pk8(h0, h1);
                        if (SSACC) sq += dot4(h0) + dot4(h1);
                        if (NOUT >= 1) *(u32x4*)(o0 + off) = pk8(h0 * gs0[bj][0], h1 * gs0[bj][1]);
                    }
                    if (SSACC) { sq += __shfl_xor(sq, 16); sq += __shfl_xor(sq, 32); if (fq == 0) atomicAdd(ss + row, sq); }
                }
                asm volatile("" ::: "memory");
            }
        } else {
#pragma unroll
            for (int ai = 0; ai < 2; ++ai)
#pragma unroll
            for (int mp = 0; mp < 4; mp += MC) {
                u32x4 hb[MC][2];
#pragma unroll
                for (int m = 0; m < MC; ++m)
#pragma unroll
                    for (int bj = 0; bj < 2; ++bj) hb[m][bj] = *(const u32x4*)(h16 + (size_t)(row0 + ai * HALF + (mp + m) * 16) * 1024 + u.pn * BM + bj * HALF + cl);
#pragma unroll
                for (int mm = 0; mm < MC; ++mm) {
                    const int m = mp + mm;
                    const int row = row0 + ai * HALF + m * 16;
                    float sq = 0.f;
#pragma unroll
                    for (int bj = 0; bj < 2; ++bj) {
                        const size_t off = (size_t)row * 1024 + u.pn * BM + bj * HALF + cl;
                        const u32x4 q = hb[mm][bj];
                        const f32x4 p0 = (f32x4){__builtin_bit_cast(float, q.x << 16), __builtin_bit_cast(float, q.x & 0xffff0000u), __builtin_bit_cast(float, q.y << 16), __builtin_bit_cast(float, q.y & 0xffff0000u)};
                        const f32x4 p1 = (f32x4){__builtin_bit_cast(float, q.z << 16), __builtin_bit_cast(float, q.z & 0xffff0000u), __builtin_bit_cast(float, q.w << 16), __builtin_bit_cast(float, q.w & 0xffff0000u)};
                        const f32x4 h0 = p0 + gt[bj][0] * acc[ai][bj][m][0], h1 = p1 + gt[bj][1] * acc[ai][bj][m][1];
                        if (WHICH == 3) { *(f32x4*)(hout + off) = h0; *(f32x4*)(hout + off + 4) = h1; } else *(u32x4*)(h16 + off) = pk8(h0, h1);
                        if (SSACC) sq += dot4(h0) + dot4(h1);
                        if (NOUT >= 1) *(u32x4*)(o0 + off) = pk8(h0 * gs0[bj][0], h1 * gs0[bj][1]);
                        if (NOUT >= 2) *(u32x4*)(o1 + off) = pk8(h0 * gs1[bj][0], h1 * gs1[bj][1]);
                    }
                    if (SSACC) { sq += __shfl_xor(sq, 16); sq += __shfl_xor(sq, 32); if (fq == 0) atomicAdd(ss + row, sq); }
                }
                asm volatile("" ::: "memory");
            }
        }
    }
};

struct EpiFfnIn {
    static constexpr bool PERM = true, AFTER_DRAIN = false, SEG = false;
    ptab_t tab; int l;
    __device__ __forceinline__ void prefetch(const Unit& u, int slot, PG8_LAS unsigned char* lds, int wid, int lane) const {
        unsigned char* ws = ldp(tab, T_WS); PG8_LAS unsigned char* base = lds + LDS_XTRA + slot * 6144; const int b = u.pm >> 3;
        if (wid < 4) dma4((const float*)(ws + O_SS) + (l == 0 ? 1 : 3) * M_ + u.pm * BM + 64 * wid + lane, base + 256 * wid);
        else dma4((const float*)(ws + O_SW3) + l * 16 * 5632 + b * 5632 + u.pn * BM + 64 * (wid - 4) + lane, base + 1024 + 256 * (wid - 4));
        const int v = wid >> 1, bj = wid & 1;
        const float* src = (v < 3 ? (const float*)ldp(tab, 18) + l * 3 * 5632 + v * 5632 : (const float*)ldp(tab, 19) + l * 5632) + bj * 2816 + u.pn * HALF + lane;
        dma4(src, base + 2048 + v * 1024 + (128 * bj) * 4); dma4(src + 64, base + 2048 + v * 1024 + (128 * bj + 64) * 4);
    }
    __device__ __forceinline__ void operator()(f32x4 (&acc)[2][2][4][2], const Unit& u, int wr, int wc, int slot, int) const {
        int lane_ = threadIdx.x & 63; asm volatile("" : "+v"(lane_)); const int fr = lane_ & 15, fq = lane_ >> 4;
        unsigned char* ws = ldp(tab, T_WS);
        const PG8_LAS unsigned char* tb = (const PG8_LAS unsigned char*)tab - 64 - LDS_MISC + LDS_XTRA + slot * 6144;
        const PG8_LAS float* ss = (const PG8_LAS float*)tb - u.pm * BM;
        const PG8_LAS float* sW = (const PG8_LAS float*)(tb + 1024) - ((u.pm >> 3) * 5632 + u.pn * BM);
        const PG8_LAS float* tcw = (const PG8_LAS float*)(tb + 2048);
        bf16_t* ACT = (bf16_t*)(ws + O_ACT); bf16_t* HF = (bf16_t*)(ws + O_HF); bf16_t* HL = (bf16_t*)(ws + O_HL);
        const int b = u.pm >> 3, cl = wc * 32 + 8 * fq, row0 = u.pm * BM + wr * 64 + fr, ch = u.pn * HALF + cl;
        {
            f32x4 sw[2][2];
#pragma unroll
            for (int bj = 0; bj < 2; ++bj)
#pragma unroll
                for (int n = 0; n < 2; ++n) sw[bj][n] = *(const f32x4*)(sW + b * 5632 + u.pn * BM + bj * HALF + cl + 4 * n);
#pragma unroll
            for (int ai = 0; ai < 2; ++ai)
#pragma unroll
                for (int m = 0; m < 4; ++m) {
                    const float rs = __builtin_amdgcn_rsqf(ss[row0 + ai * HALF + m * 16] * (1.f / 1024.f) + EPS);
#pragma unroll
                    for (int bj = 0; bj < 2; ++bj)
#pragma unroll
                        for (int n = 0; n < 2; ++n) acc[ai][bj][m][n] = acc[ai][bj][m][n] * rs + sw[bj][n];
                }
        }
#pragma unroll
        for (int ai = 0; ai < 2; ++ai) {
            const int blk = u.pm * 4 + ai * 2 + wr;
            if (fr < 2) {
                bf16_t* d = HF + (size_t)(blk * 2 + fr) * 5632 + u.pn * BM + cl;
#pragma unroll
                for (int bj = 0; bj < 2; ++bj) *(u32x4*)(d + bj * HALF) = pk8(acc[ai][bj][0][0], acc[ai][bj][0][1]);
            }
            if (fr >= 14) {
                bf16_t* d = HL + (size_t)(blk * 2 + fr - 14) * 5632 + u.pn * BM + cl;
#pragma unroll
                for (int bj = 0; bj < 2; ++bj) *(u32x4*)(d + bj * HALF) = pk8(acc[ai][bj][3][0], acc[ai][bj][3][1]);
            }
        }
#pragma unroll
        for (int bj = 0; bj < 2; ++bj)
#pragma unroll
            for (int n = 0; n < 2; ++n) {
                const int tcol = bj * HALF + cl + 4 * n;
                f32x4 w0 = *(const PG8_LAS f32x4*)(tcw + tcol), w1 = *(const PG8_LAS f32x4*)(tcw + 256 + tcol), w2 = *(const PG8_LAS f32x4*)(tcw + 512 + tcol), bb = *(const PG8_LAS f32x4*)(tcw + 768 + tcol);
                asm volatile("" : "+v"(w0), "+v"(w1), "+v"(w2), "+v"(bb));
#pragma unroll
                for (int ai = 0; ai < 2; ++ai)
#pragma unroll
                    for (int m = 3; m >= 0; --m) {
                        const f32x4 x = acc[ai][bj][m][n];
                        float y0 = bb[0] + w2[0] * x[0], y1 = bb[1] + w2[1] * x[1], y2 = bb[2] + w2[2] * x[2], y3 = bb[3] + w2[3] * x[3];
#define CONV_DPP8(SRC, C1, C0) asm volatile("s_nop 1\n\t" \
                            "v_fmac_f32_dpp %0, %4, %8 " C1 " row_mask:0xf bank_mask:0xf\n\tv_fmac_f32_dpp %1, %5, %9 " C1 " row_mask:0xf bank_mask:0xf\n\t" \
                            "v_fmac_f32_dpp %2, %6, %10 " C1 " row_mask:0xf bank_mask:0xf\n\tv_fmac_f32_dpp %3, %7, %11 " C1 " row_mask:0xf bank_mask:0xf\n\t" \
                            "v_fmac_f32_dpp %0, %4, %12 " C0 " row_mask:0xf bank_mask:0xf\n\tv_fmac_f32_dpp %1, %5, %13 " C0 " row_mask:0xf bank_mask:0xf\n\t" \
                            "v_fmac_f32_dpp %2, %6, %14 " C0 " row_mask:0xf bank_mask:0xf\n\tv_fmac_f32_dpp %3, %7, %15 " C0 " row_mask:0xf bank_mask:0xf" \
                            : "+v"(y0), "+v"(y1), "+v"(y2), "+v"(y3) : "v"(SRC[0]), "v"(SRC[1]), "v"(SRC[2]), "v"(SRC[3]), "v"(w1[0]), "v"(w1[1]), "v"(w1[2]), "v"(w1[3]), "v"(w0[0]), "v"(w0[1]), "v"(w0[2]), "v"(w0[3]))
                        CONV_DPP8(x, "row_shr:1", "row_shr:2");
                        if (m > 0) { const f32x4 xp = acc[ai][bj][m - 1][n]; CONV_DPP8(xp, "row_shl:15", "row_shl:14"); }
#undef CONV_DPP8
                        f32x4 y; y[0] = y0; y[1] = y1; y[2] = y2; y[3] = y3;
                        acc[ai][bj][m][n] = y;
                    }
            }
#pragma unroll
        for (int ai = 0; ai < 2; ++ai)
#pragma unroll
            for (int m = 0; m < 4; ++m) {
                const int row = row0 + ai * HALF + m * 16;
                const f32x4 v0 = acc[ai][0][m][0] * silu4(acc[ai][1][m][0]), v1 = acc[ai][0][m][1] * silu4(acc[ai][1][m][1]);
                if (m > 0 || fr >= 2) *(u32x4*)(ACT + (size_t)row * 2816 + ch) = pk8(v0, v1);
            }
    }
};

template <int MODE> struct EpiKVQ {
    static constexpr bool PERM = true, AFTER_DRAIN = false, SEG = false;
    ptab_t tab;
    static constexpr int nW = (MODE == 0) ? 2048 : 1024;
    __device__ __forceinline__ void prefetch(const Unit& u, int slot, PG8_LAS unsigned char* lds, int wid, int lane) const {
        unsigned char* ws = ldp(tab, T_WS); PG8_LAS unsigned char* base = lds + LDS_XTRA + 18432 + slot * 2048; const int b = u.pm >> 3;
        if (wid < 4) dma4((const float*)(ws + O_SS) + 2 * M_ + u.pm * BM + 64 * wid + lane, base + 256 * wid);
        else dma4((const float*)(ws + (MODE == 0 ? O_SW5 : O_SW6)) + b * nW + u.pn * BM + 64 * (wid - 4) + lane, base + 1024 + 256 * (wid - 4));
    }
    __device__ __forceinline__ void operator()(f32x4 (&acc)[2][2][4][2], const Unit& u, int wr, int wc, int slot, int) const {
        int lane_ = threadIdx.x & 63; asm volatile("" : "+v"(lane_)); const int fr = lane_ & 15, fq = lane_ >> 4;
        unsigned char* ws = ldp(tab, T_WS);
        const PG8_LAS unsigned char* tb = (const PG8_LAS unsigned char*)tab - 64 - LDS_MISC + LDS_XTRA + 18432 + slot * 2048;
        const PG8_LAS float* ss = (const PG8_LAS float*)tb - u.pm * BM;
        const PG8_LAS float* sW = (const PG8_LAS float*)(tb + 1024) - ((u.pm >> 3) * nW + u.pn * BM);
        const float* gain = (const float*)ldp(tab, MODE == 0 ? 13 : 15); bf16_t* DN = (bf16_t*)(ws + (MODE == 0 ? O_KN : O_QN)); bf16_t* VT = (bf16_t*)(ws + O_VT);
        const int b = u.pm >> 3, row0 = u.pm * BM + wr * 64 + fr, head = 4 * (u.pn & 3) + wc, dl = 8 * fq;
        f32x4 sw[2][2];
#pragma unroll
        for (int bj = 0; bj < 2; ++bj)
#pragma unroll
            for (int n = 0; n < 2; ++n) sw[bj][n] = *(const f32x4*)(sW + b * nW + u.pn * BM + bj * HALF + wc * 32 + dl + 4 * n);
        const bool isv = (MODE == 0) && (u.pn >= 4);
        if (!isv) {
            f32x4 gn[2][2];
#pragma unroll
            for (int bj = 0; bj < 2; ++bj)
#pragma unroll
                for (int n = 0; n < 2; ++n) gn[bj][n] = *(const f32x4*)(gain + 32 * bj + dl + 4 * n) * (MODE == 1 ? 0.125f * 1.44269504089f : 1.f);
#pragma unroll
            for (int ai = 0; ai < 2; ++ai)
#pragma unroll
                for (int m = 0; m < 4; ++m) {
                    const int row = row0 + ai * HALF + m * 16;
                    const float rs = __builtin_amdgcn_rsqf(ss[row] * (1.f / 1024.f) + EPS);
                    f32x4 v[2][2]; float sq = 0.f;
#pragma unroll
                    for (int bj = 0; bj < 2; ++bj)
#pragma unroll
                        for (int n = 0; n < 2; ++n) { v[bj][n] = acc[ai][bj][m][n] * rs + sw[bj][n]; sq += dot4(v[bj][n]); }
                    sq += __shfl_xor(sq, 16); sq += __shfl_xor(sq, 32);
                    const float rh = __builtin_amdgcn_rsqf(sq * (1.f / 64.f) + EPS);
#pragma unroll
                    for (int bj = 0; bj < 2; ++bj) *(u32x4*)(DN + ((size_t)(b * 16 + head) * 2048 + (row & 2047)) * 64 + 32 * bj + dl) = pk8(v[bj][0] * gn[bj][0] * rh, v[bj][1] * gn[bj][1] * rh);
                }
        } else {
            const int wv = wr * 4 + wc;
            PG8_LAS unsigned char* scr = (PG8_LAS unsigned char*)tab - 64 - LDS_MISC + LDS_XTRA + wv * 2304;
            PG8_LAS unsigned char* wrp = scr + fr * 144 + fq * 16;
            const int ln = fq * 16 + fr;
            const PG8_LAS unsigned char* rdp = scr + ((ln & 15) >> 2) * 144 + (16 * (ln >> 4) + 4 * (ln & 3)) * 2;
            bf16_t* vbase = VT + (size_t)(b * 16 + head) * 64 * 2048;
            typedef short v4i16_t __attribute__((ext_vector_type(4)));
#pragma unroll
            for (int ai = 0; ai < 2; ++ai)
#pragma unroll
                for (int m = 0; m < 4; ++m) {
                    const int row = row0 + ai * HALF + m * 16, s0 = (row - fr) & 2047;
                    const float rs = __builtin_amdgcn_rsqf(ss[row] * (1.f / 1024.f) + EPS);
#pragma unroll
                    for (int bj = 0; bj < 2; ++bj) *(PG8_LAS u32x4*)(wrp + bj * 64) = pk8(acc[ai][bj][m][0] * rs + sw[bj][0], acc[ai][bj][m][1] * rs + sw[bj][1]);
                    asm volatile("s_waitcnt lgkmcnt(0)" ::: "memory");
                    bf16_t* fbase = vbase + (size_t)((((s0 >> 5) * 2 + (ln >> 5)) * 2 + ((s0 >> 4) & 1)) * 64 + (ln & 31)) * 8;
#pragma unroll
                    for (int hq = 0; hq < 2; ++hq) {
                        const v4i16_t lo = __builtin_amdgcn_ds_read_tr16_b64_v4i16((PG8_LAS v4i16_t*)(rdp + (4 * hq) * 144)), hi = __builtin_amdgcn_ds_read_tr16_b64_v4i16((PG8_LAS v4i16_t*)(rdp + (4 * hq + 8) * 144));
                        const bf16x8 o = (bf16x8){lo[0], lo[1], lo[2], lo[3], hi[0], hi[1], hi[2], hi[3]};
                        *(bf16x8*)(fbase + hq * 32 * 8) = o;
                    }
                    asm volatile("s_waitcnt lgkmcnt(0)" ::: "memory");
                }
        }
    }
};
template <class Epi, class Sched, bool ALIGN_EPI = false, bool SP2 = false>
__device__ __forceinline__ void gemm_phase(PG8_LAS unsigned char* lds, const Gemm g, const Sched& S, const Epi& E) {
    int tid_ = threadIdx.x; asm volatile("" : "+v"(tid_));
    const int tid = tid_, wid = __builtin_amdgcn_readfirstlane(tid >> 6), lane = tid & 63, wr = wid >> 2, wc = wid & 3, fr = lane & 15, fq = lane >> 4;
    const int K = g.ld, nt = g.K / BK;
    unsigned voffA[2], voffB[2];
#pragma unroll
    for (int i = 0; i < 2; ++i) { int R, C; stage_rc(tid * 16 + i * 8192, R, C); const int Rb = Epi::PERM ? ((R & ~31) + perm32(R & 31)) : R;
        voffA[i] = (unsigned)(R * K + C) * 2u; voffB[i] = (unsigned)(Rb * K + C) * 2u; }
    const size_t kstep = (size_t)(BK * 2);
    const size_t hstep = (size_t)HALF * K * 2;
    const size_t tstep = 2 * hstep;
    const unsigned ldsw = (unsigned)wid * 1024u;
    const int aoff = lds_byte(wr * 64 + fr, fq * 8), boff = lds_byte(wc * 32 + fr, fq * 8);
#define PG8_SA(b, h) (((b) * 2 + (h)) * HTB)
#define PG8_SB(b, h) ((4 + (b) * 2 + (h)) * HTB)
#define PG8_STAGE(bufoff, gbase, voff) do { _Pragma("unroll") for (int _i = 0; _i < 2; ++_i) \
        __builtin_amdgcn_global_load_lds((const unsigned*)((const char*)(gbase) + (voff)[_i]), (PG8_LAS unsigned*)(lds + (bufoff) + ldsw + _i * 8192), 16, 0, 0); } while (0)
#define PG8_LDA(dst, b, h) do { _Pragma("unroll") for (int m = 0; m < 4; ++m) _Pragma("unroll") for (int k = 0; k < 2; ++k) dst[m][k] = *(const PG8_LAS bf16x8*)(lds + PG8_SA(b, h) + aoff + m * 2048 + k * 1024); } while (0)
#define PG8_LDB(dst, b, h) do { _Pragma("unroll") for (int n = 0; n < 2; ++n) _Pragma("unroll") for (int k = 0; k < 2; ++k) dst[n][k] = *(const PG8_LAS bf16x8*)(lds + PG8_SB(b, h) + boff + n * 2048 + k * 1024); } while (0)
#define PG8_MMA(ai, bj, At, Bt) do { __builtin_amdgcn_s_setprio(1); _Pragma("unroll") for (int m = 0; m < 4; ++m) _Pragma("unroll") for (int n = 0; n < 2; ++n) _Pragma("unroll") for (int k = 0; k < 2; ++k) \
        acc[ai][bj][m][n] = __builtin_amdgcn_mfma_f32_16x16x32_bf16(Bt[n][k], At[m][k], acc[ai][bj][m][n], 0, 0, 0); __builtin_amdgcn_s_setprio(0); } while (0)
#define PG8_WAIT_V(n) asm volatile("s_waitcnt vmcnt(" #n ")" ::: "memory")
#define PG8_WAIT_L(n) asm volatile("s_waitcnt lgkmcnt(" #n ")" ::: "memory")
#define PG8_BAR __builtin_amdgcn_s_barrier()
#define PG8_SCHED __builtin_amdgcn_sched_barrier(0)
    Unit cur, nxt; int ui = 0;
    if (!S.next(0, cur)) return;
    f32x4 acc[2][2][4][2];
#pragma unroll
    for (int a = 0; a < 2; ++a)
#pragma unroll
        for (int b = 0; b < 2; ++b)
#pragma unroll
            for (int m = 0; m < 4; ++m)
#pragma unroll
                for (int n = 0; n < 2; ++n) acc[a][b][m][n] = (f32x4){0.f, 0.f, 0.f, 0.f};
    bf16x8 At[4][2], B0[2][2], B1[2][2];
    const size_t sstep = (size_t)g.K * 2;
    const char* cA = (const char*)g.A + (size_t)cur.pm * tstep + cur.kk * sstep; const char* cB = (const char*)g.Bt + (size_t)cur.pn * tstep + cur.kk * sstep;
    S.a_ready(cur);
    E.prefetch(cur, 0, lds, wid, lane);
    if constexpr (SP2) {
        PG8_STAGE(PG8_SB(0, 0), cB, voffB); PG8_STAGE(PG8_SB(0, 1), cB + hstep, voffB); PG8_STAGE(PG8_SA(0, 0), cA, voffA); PG8_STAGE(PG8_SA(0, 1), cA + hstep, voffA);
        if (wr == 1) PG8_BAR;
        PG8_WAIT_V(2); PG8_BAR;
        PG8_STAGE(PG8_SB(1, 0), cB + kstep, voffB); PG8_STAGE(PG8_SA(1, 0), cA + kstep, voffA); PG8_STAGE(PG8_SB(1, 1), cB + hstep + kstep, voffB);
        PG8_WAIT_V(6); PG8_BAR;
    } else {
        PG8_STAGE(PG8_SB(0, 0), cB, voffB); PG8_STAGE(PG8_SA(0, 0), cA, voffA); PG8_STAGE(PG8_SB(0, 1), cB + hstep, voffB); PG8_STAGE(PG8_SA(0, 1), cA + hstep, voffA);
        if (wr == 1) PG8_BAR;
        PG8_WAIT_V(4); PG8_BAR;
        PG8_STAGE(PG8_SB(1, 0), cB + kstep, voffB); PG8_STAGE(PG8_SA(1, 0), cA + kstep, voffA); PG8_STAGE(PG8_SB(1, 1), cB + hstep + kstep, voffB);
        PG8_WAIT_V(6); PG8_BAR;
    }
    for (;;) {
        const bool has_next = S.next(ui + 1, nxt);
        const char* nA = has_next ? (const char*)g.A + (size_t)nxt.pm * tstep + nxt.kk * sstep : cA; const char* nB = has_next ? (const char*)g.Bt + (size_t)nxt.pn * tstep + nxt.kk * sstep : cB;
        for (int t = 0; t < nt; t += 2) {
            const bool last = (t == nt - 2);
            const char* a1 = cA + (size_t)(t + 1) * kstep;
            const char* a2 = last ? nA : cA + (size_t)(t + 2) * kstep; const char* b2 = last ? nB : cB + (size_t)(t + 2) * kstep;
            const char* a3 = a2 + kstep; const char* b3 = b2 + kstep;
            if (last && has_next) { S.a_ready(nxt); E.prefetch(nxt, (ui + 1) & 1, lds, wid, lane); }
            if constexpr (SP2) {
            PG8_LDB(B0, 0, 0); PG8_LDB(B1, 0, 1); PG8_SCHED; PG8_LDA(At, 0, 0); PG8_STAGE(PG8_SA(1, 1), a1 + hstep, voffA);
            PG8_WAIT_V(8); PG8_WAIT_L(0); PG8_BAR; PG8_MMA(0, 0, At, B0); PG8_MMA(0, 1, At, B1); PG8_BAR; PG8_SCHED;
            PG8_LDA(At, 0, 1); PG8_STAGE(PG8_SB(0, 0), b2, voffB); PG8_STAGE(PG8_SB(0, 1), b2 + hstep, voffB); PG8_STAGE(PG8_SA(0, 0), a2, voffA);
            PG8_WAIT_V(8); PG8_WAIT_L(0); PG8_BAR; PG8_MMA(1, 0, At, B0); PG8_MMA(1, 1, At, B1); PG8_BAR; PG8_SCHED;
            PG8_LDB(B0, 1, 0); PG8_LDB(B1, 1, 1); PG8_SCHED; PG8_LDA(At, 1, 0); PG8_STAGE(PG8_SA(0, 1), a2 + hstep, voffA);
            PG8_WAIT_V(8); PG8_WAIT_L(0); PG8_BAR; PG8_MMA(0, 0, At, B0); PG8_MMA(0, 1, At, B1); PG8_BAR; PG8_SCHED;
            PG8_LDA(At, 1, 1); PG8_STAGE(PG8_SB(1, 0), b3, voffB); PG8_STAGE(PG8_SB(1, 1), b3 + hstep, voffB); PG8_STAGE(PG8_SA(1, 0), a3, voffA);
            PG8_WAIT_V(8); PG8_WAIT_L(0); PG8_BAR; PG8_MMA(1, 0, At, B0); PG8_MMA(1, 1, At, B1); PG8_BAR; PG8_SCHED;
            } else {
            PG8_LDB(B0, 0, 0); PG8_SCHED; PG8_LDA(At, 0, 0); PG8_STAGE(PG8_SA(1, 1), a1 + hstep, voffA);
            PG8_WAIT_L(8); PG8_BAR; PG8_WAIT_L(0); PG8_MMA(0, 0, At, B0); PG8_BAR; PG8_SCHED;
            PG8_LDB(B1, 0, 1); PG8_STAGE(PG8_SB(0, 0), b2, voffB);
            PG8_BAR; PG8_WAIT_L(0); PG8_MMA(0, 1, At, B1); PG8_BAR;
            PG8_LDA(At, 0, 1); PG8_STAGE(PG8_SA(0, 0), a2, voffA);
            PG8_BAR; PG8_WAIT_L(0); PG8_MMA(1, 0, At, B0); PG8_BAR; PG8_SCHED;
            PG8_STAGE(PG8_SB(0, 1), b2 + hstep, voffB);
            PG8_WAIT_V(6); PG8_BAR; PG8_MMA(1, 1, At, B1); PG8_BAR;
            PG8_LDB(B0, 1, 0); PG8_SCHED; PG8_LDA(At, 1, 0); PG8_STAGE(PG8_SA(0, 1), a2 + hstep, voffA);
            PG8_WAIT_L(8); PG8_BAR; PG8_WAIT_L(0); PG8_MMA(0, 0, At, B0); PG8_BAR; PG8_SCHED;
            PG8_LDB(B1, 1, 1); PG8_STAGE(PG8_SB(1, 0), b3, voffB);
            PG8_BAR; PG8_WAIT_L(0); PG8_MMA(0, 1, At, B1); PG8_BAR;
            PG8_LDA(At, 1, 1); PG8_STAGE(PG8_SA(1, 0), a3, voffA);
            PG8_BAR; PG8_WAIT_L(0); PG8_MMA(1, 0, At, B0); PG8_BAR; PG8_SCHED;
            PG8_STAGE(PG8_SB(1, 1), b3 + hstep, voffB);
            PG8_WAIT_V(6); PG8_BAR; PG8_MMA(1, 1, At, B1); PG8_BAR;
            }
        }
        if constexpr (ALIGN_EPI) { if (wr == 0) PG8_BAR; }
        if constexpr (Epi::SEG) E.seg(acc, cur.kk, ui >> 2, wr);
        if (!Epi::SEG || cur.kk == 3) {
            if constexpr (!Epi::AFTER_DRAIN) { E(acc, cur, wr, wc, ui & 1, fq); S.done(cur); }
            if (!has_next) break;
#pragma unroll
            for (int a = 0; a < 2; ++a)
#pragma unroll
                for (int b = 0; b < 2; ++b)
#pragma unroll
                    for (int m = 0; m < 4; ++m)
#pragma unroll
                        for (int n = 0; n < 2; ++n) acc[a][b][m][n] = (f32x4){0.f, 0.f, 0.f, 0.f};
        }
        cur = nxt; cA = nA; cB = nB; ++ui;
        if constexpr (ALIGN_EPI) { if (wr == 1) PG8_BAR; }
    }
    PG8_WAIT_V(0);
    if constexpr (!ALIGN_EPI) { if (wr == 0) PG8_BAR; }
    PG8_BAR;
    if constexpr (Epi::AFTER_DRAIN) { E.fused(acc, cur, wr, wc, fr, fq, lds, wid, lane); S.done(cur); }
#undef PG8_SA
#undef PG8_SB
#undef PG8_STAGE
#undef PG8_LDA
#undef PG8_LDB
#undef PG8_MMA
#undef PG8_WAIT_V
#undef PG8_WAIT_L
#undef PG8_BAR
#undef PG8_SCHED
}
}

#define LAS __attribute__((address_space(3)))
typedef unsigned short bf16;
typedef float f32x4 __attribute__((ext_vector_type(4)));
typedef float f32x16 __attribute__((ext_vector_type(16)));
typedef short bf16x8 __attribute__((ext_vector_type(8)));
typedef short s16x4 __attribute__((ext_vector_type(4)));
typedef unsigned u32x4 __attribute__((ext_vector_type(4)));
typedef unsigned u32x2 __attribute__((ext_vector_type(2)));
using pg8::pk_bf16; using pg8::EPS;

#ifndef REP_PHASE
#define REP_PHASE -1
#endif
#define REPS(k) ((REP_PHASE == (k)) ? 2 : 1)
#ifndef PROBE_TS
#define PROBE_TS -1
#endif
#ifndef RET_V2
#define RET_V2 1
#endif
#if RET_V2
#define RET_UNIT ret_unit2
#else
#define RET_UNIT ret_unit
#endif
#ifndef MK_ONE_LAUNCH
#define MK_ONE_LAUNCH 1
#endif
constexpr int NWAVES = 8, NTHREADS = 512;
constexpr int NB = 16, SEQ = 2048, D = 1024, M = NB * SEQ, FF = 2816, FF2 = 5632, RN = 6144;
constexpr int NPHASE = 14;

constexpr size_t MiB = 1u << 20;
constexpr size_t WS_CTL = 0;
constexpr size_t WS_MODS = pg8::O_MODS, WS_KVM = pg8::O_KVM, WS_SW1 = pg8::O_SW1, WS_SW3 = pg8::O_SW3, WS_SW5 = pg8::O_SW5, WS_SW6 = pg8::O_SW6, WS_SS = pg8::O_SS, WS_SSO = pg8::O_SSO;
static_assert(pg8::O_SMALL_END <= 6 * MiB && pg8::M_ == M, "small region");
constexpr size_t WS_WT1 = 6 * MiB;
constexpr size_t WS_WT2 = WS_WT1 + (size_t)6144 * 1024 * 2;
constexpr size_t WS_WT3 = WS_WT2 + (size_t)1024 * 2048 * 2;
constexpr size_t WS_WT4 = WS_WT3 + (size_t)2 * 5632 * 1024 * 2;
constexpr size_t WS_WT5 = WS_WT4 + (size_t)2 * 1024 * 2816 * 2;
constexpr size_t WS_WT6 = WS_WT5 + (size_t)2048 * 1024 * 2;
constexpr size_t WS_WT7 = WS_WT6 + (size_t)1024 * 1024 * 2;
static_assert(WS_WT7 + (size_t)1024 * 1024 * 2 <= 64 * MiB, "weights region");
constexpr size_t WS_A = pg8::O_A, WS_Q = pg8::O_Q, WS_KD = pg8::O_KD, WS_V = pg8::O_V, WS_SG = pg8::O_SG, WS_ACT = pg8::O_ACT, WS_HF = pg8::O_HF, WS_HL = pg8::O_HL, WS_AM1 = pg8::O_AM1,
                 WS_KN = pg8::O_KN, WS_VT = pg8::O_VT, WS_QN = pg8::O_QN, WS_OSB = pg8::O_OSB;
constexpr size_t WS_END = 512 * MiB;
static_assert((size_t)512 * 2 * 5632 * 4 <= 22 * MiB && WS_HL + 22 * MiB <= WS_AM1 && WS_AM1 + 64 * MiB <= WS_END && WS_OSB + 64 * MiB <= WS_END && WS_ACT + (size_t)M * FF * 2 <= WS_HF && pg8::O_H16 + 64 * MiB <= WS_ACT && WS_QN + 64 * MiB <= WS_OSB, "big region");

constexpr int LDS_BYTES = pg8::LDS_TOTAL;
constexpr int MISC_OFF = LDS_BYTES - 512;
using pg8::ptab_t; using pg8::ldp; using pg8::T_OUT; using pg8::T_WS;

#define LBAR() do { asm volatile("s_waitcnt lgkmcnt(0)" ::: "memory"); __builtin_amdgcn_s_barrier(); asm volatile("" ::: "memory"); } while (0)

#define XB_TMO      128
#define XB_XCNT(j)  (256  + 64 * (j))
#define XB_XSUB(j)  (1280 + 64 * (j))
#define XB_XGEN(j)  (2304 + 64 * (j))
#define XB_TOP      3328
#define XB_TOPGEN   3392
#define XCD_BAR_WORDS 3456
#define XB_SPIN_CAP (1u << 20)
__device__ __forceinline__ unsigned xb_ld(unsigned* p)              { return __hip_atomic_load(p, __ATOMIC_RELAXED, __HIP_MEMORY_SCOPE_AGENT); }
__device__ __forceinline__ unsigned xb_add(unsigned* p, unsigned v) { return __hip_atomic_fetch_add(p, v, __ATOMIC_RELAXED, __HIP_MEMORY_SCOPE_AGENT); }
__device__ __forceinline__ unsigned xb_xcc_id() { return (unsigned)__builtin_amdgcn_s_getreg((3 << 11) | 20) & 0xFu; }
#define XB_SPIN(cond, bar) do { unsigned _sp = 0; while (cond) { __builtin_amdgcn_s_sleep(1); \
    if ((++_sp & 255u) == 0u) { if (xb_ld(&(bar)[XB_TMO])) break; if (_sp > XB_SPIN_CAP) { atomicAdd(&(bar)[XB_TMO], 1u); break; } } } } while (0)
struct XcdBarrier { unsigned* bar; unsigned x; volatile LAS unsigned* st; };
__device__ __forceinline__ XcdBarrier xcd_barrier_post(unsigned* bar, volatile LAS unsigned* st) {
    XcdBarrier b; b.bar = bar; b.x = xb_xcc_id(); b.st = st;
    if (threadIdx.x == 0) (void)xb_add(&bar[XB_XCNT(b.x)], 1u);
    return b;
}
__device__ __forceinline__ void xcd_barrier_complete(unsigned* bar, unsigned x, unsigned& nloc, unsigned& nx) {
    const unsigned G = gridDim.x * gridDim.y * gridDim.z;
    unsigned sum, cnt, mine, sp = 0u;
    for (;;) {
        sum = 0u; cnt = 0u; mine = 0u;
#pragma unroll
        for (unsigned j = 0; j < 16; ++j) { const unsigned c = xb_ld(&bar[XB_XCNT(j)]); sum += c; cnt += (c > 0u) ? 1u : 0u; mine = (j == x) ? c : mine; }
        if (sum == G) break;
        __builtin_amdgcn_s_sleep(1);
        if ((++sp & 255u) == 0u) { if (xb_ld(&bar[XB_TMO])) break; if (sp > XB_SPIN_CAP) { atomicAdd(&bar[XB_TMO], 1u); break; } }
    }
    nloc = mine > 0u ? mine : 1u; nx = cnt > 0u ? cnt : 1u;
}
__device__ __forceinline__ void xcd_barrier(const XcdBarrier& b) {
    asm volatile("s_waitcnt vmcnt(0)" ::: "memory");
    __syncthreads();
    if (threadIdx.x == 0) {
        unsigned* bar = b.bar;
        __builtin_amdgcn_s_waitcnt(0);
        unsigned nloc = b.st[0], nx = b.st[1];
        if (nloc == 0u) { xcd_barrier_complete(bar, b.x, nloc, nx); b.st[0] = nloc; b.st[1] = nx; }
        const unsigned old = xb_add(&bar[XB_XSUB(b.x)], 1u);
        const unsigned gen = old / nloc;
        if (old + 1u == (gen + 1u) * nloc) {
            __builtin_amdgcn_fence(__ATOMIC_RELEASE, "agent");
            asm volatile("s_waitcnt vmcnt(0)" ::: "memory");
            const unsigned og = xb_add(&bar[XB_TOP], 1u);
            const unsigned tg = og / nx;
            if (og + 1u == (tg + 1u) * nx) xb_add(&bar[XB_TOPGEN], 1u);
            else XB_SPIN(xb_ld(&bar[XB_TOPGEN]) == tg, bar);
            __builtin_amdgcn_fence(__ATOMIC_ACQUIRE, "agent");
            xb_add(&bar[XB_XGEN(b.x)], 1u);
            asm volatile("s_waitcnt vmcnt(0)" ::: "memory");
        } else {
            XB_SPIN(xb_ld(&bar[XB_XGEN(b.x)]) == gen, bar);
            __builtin_amdgcn_fence(__ATOMIC_ACQUIRE, "agent");
            asm volatile("s_waitcnt vmcnt(0)" ::: "memory");
        }
    }
    __syncthreads();
}

__device__ __forceinline__ float wave_sum(float v) {
#pragma unroll
    for (int o = 1; o < 64; o <<= 1) v += __shfl_xor(v, o);
    return v;
}
__device__ __forceinline__ float bf2f(unsigned short u) { return __builtin_bit_cast(float, (unsigned)u << 16); }

struct Args { const void* in[21]; float* out; unsigned char* ws; int ph_lo, ph_hi; };

__device__ __forceinline__ void p0_transpose_item(const float* W, int K, int N, bf16* WT, int k0, int sc0, int sc1, int nd0, LAS float* scr, int lane) {
    const int r4 = lane >> 4, c4 = lane & 15;
    const float* src = W + (size_t)(k0 + r4) * N + ((c4 < 8) ? sc0 + 4 * c4 : sc1 + 4 * (c4 - 8));
    f32x4 v[16];
#pragma unroll
    for (int i = 0; i < 16; ++i) v[i] = *(const f32x4*)(src + (size_t)(4 * i) * N);
#pragma unroll
    for (int i = 0; i < 16; ++i) { LAS float* d = scr + (4 * i + r4) * 65 + 4 * c4; d[0] = v[i][0]; d[1] = v[i][1]; d[2] = v[i][2]; d[3] = v[i][3]; }
    asm volatile("s_waitcnt lgkmcnt(0)" ::: "memory");
    const int c8 = lane & 7, n8 = lane >> 3;
#pragma unroll
    for (int j = 0; j < 8; ++j) { const int n = n8 + 8 * j; const LAS float* s = scr + (8 * c8) * 65 + n;
        u32x4 o; o.x = pk_bf16(s[0 * 65], s[1 * 65]); o.y = pk_bf16(s[2 * 65], s[3 * 65]); o.z = pk_bf16(s[4 * 65], s[5 * 65]); o.w = pk_bf16(s[6 * 65], s[7 * 65]);
        *(u32x4*)(WT + (size_t)(nd0 + n) * K + k0 + 8 * c8) = o; }
    asm volatile("s_waitcnt lgkmcnt(0)" ::: "memory");
}
__device__ __forceinline__ int src_col(int type, int nd0) {
    if (type == 0) return nd0;
    const int pn = nd0 >> 8, r = nd0 & 255, bj = r >> 7;
    if (type == 1) return bj * FF + 128 * pn + (r & 127);
    const int wc = (r & 127) >> 5, head = 4 * (pn & 3) + wc;
    return (pn >= 4 ? 1024 : 0) + head * 64 + 32 * bj;
}
__device__ __forceinline__ void p0_phase(ptab_t tab, LAS unsigned char* lds, int vcu, int G) {
    const int tid = threadIdx.x, lane = tid & 63, w = __builtin_amdgcn_readfirstlane(tid >> 6);
    unsigned char* ws = ldp(tab, T_WS);
    { float* z = (float*)(ws + WS_SS) + M; const int n = 3 * M;
      for (int i = vcu * NTHREADS + tid; i < n / 4; i += G * NTHREADS) ((f32x4*)z)[i] = (f32x4){0.f, 0.f, 0.f, 0.f}; }
    if (vcu < 224) {
        LAS float* cact = (LAS float*)lds;
        LAS float* part = (LAS float*)(lds + 65536);
        const float* c = (const float*)ldp(tab, 1);
        {
            f32x4 cv[8];
#pragma unroll
            for (int j = 0; j < 8; ++j) cv[j] = *(const f32x4*)(c + 4 * (tid + NTHREADS * j));
#pragma unroll
            for (int j = 0; j < 8; ++j) *(LAS f32x4*)(cact + 4 * (tid + NTHREADS * j)) = pg8::silu4(cv[j]);
        }
        LBAR();
        const int col = vcu * 64;
        const float* W; int N, cw; const float* bias; float* dst; int dstride;
        if (col < 12288) { const int l = col / 6144; cw = col - l * 6144; W = (const float*)ldp(tab, 3) + (size_t)l * 1024 * 6144; N = 6144; bias = (const float*)ldp(tab, 4) + l * 6144; dst = (float*)(ws + WS_MODS) + (size_t)l * 16 * 6144; dstride = 6144; }
        else { cw = col - 12288; W = (const float*)ldp(tab, 9); N = 2048; bias = (const float*)ldp(tab, 10); dst = (float*)(ws + WS_KVM); dstride = 2048; }
        float acc[16];
#pragma unroll
        for (int b = 0; b < 16; ++b) acc[b] = 0.f;
        const float* wp = W + (size_t)(128 * w) * N + cw + lane;
#pragma unroll 4
        for (int kk = 0; kk < 128; kk += 4) {
            const float w0 = wp[(size_t)(kk + 0) * N], w1 = wp[(size_t)(kk + 1) * N], w2 = wp[(size_t)(kk + 2) * N], w3 = wp[(size_t)(kk + 3) * N];
#pragma unroll
            for (int b = 0; b < 16; ++b) { const f32x4 cv = *(const LAS f32x4*)(cact + b * 1024 + 128 * w + kk); acc[b] += (cv[0] * w0 + cv[1] * w1) + (cv[2] * w2 + cv[3] * w3); }
        }
#pragma unroll
        for (int b = 0; b < 16; ++b) part[(w * 16 + b) * 64 + lane] = acc[b];
        LBAR();
        for (int o = tid; o < 1024; o += NTHREADS) { const int b = o >> 6, l = o & 63; float s = bias[cw + l];
#pragma unroll
            for (int ww = 0; ww < 8; ++ww) s += part[(ww * 16 + b) * 64 + l];
            dst[(size_t)b * dstride + cw + l] = s; }
        LBAR();
    }
    {
        LAS float* scr = (LAS float*)(lds + w * 16640);
        const int gw = vcu * NWAVES + w, NGW = G * NWAVES;
        constexpr int I0 = 16 * 96, I1 = 32 * 16, I2 = 16 * 88, I4 = 44 * 16, I6 = 16 * 32, I7 = 16 * 16;
        constexpr int NIT = I0 + I1 + 2 * I2 + 2 * I4 + I6 + 2 * I7;
        for (int it = gw; it < NIT; it += NGW) {
            int r = it; const float* W; int K, N, type; bf16* WT;
            if (r < I0) { W = (const float*)ldp(tab, 7); K = 1024; N = 6144; type = 0; WT = (bf16*)(ws + WS_WT1); }
            else if ((r -= I0) < I1) { W = (const float*)ldp(tab, 8); K = 2048; N = 1024; type = 0; WT = (bf16*)(ws + WS_WT2); }
            else if ((r -= I1) < 2 * I2) { const int l = r / I2; r -= l * I2; W = (const float*)ldp(tab, 17) + (size_t)l * 1024 * FF2; K = 1024; N = FF2; type = 1; WT = (bf16*)(ws + WS_WT3) + (size_t)l * FF2 * 1024; }
            else if ((r -= 2 * I2) < 2 * I4) { const int l = r / I4; r -= l * I4; W = (const float*)ldp(tab, 20) + (size_t)l * FF * 1024; K = FF; N = 1024; type = 0; WT = (bf16*)(ws + WS_WT4) + (size_t)l * 1024 * FF; }
            else if ((r -= 2 * I4) < I6) { W = (const float*)ldp(tab, 12); K = 1024; N = 2048; type = 2; WT = (bf16*)(ws + WS_WT5); }
            else if ((r -= I6) < I7) { W = (const float*)ldp(tab, 14); K = 1024; N = 1024; type = 2; WT = (bf16*)(ws + WS_WT6); }
            else { r -= I7; W = (const float*)ldp(tab, 16); K = 1024; N = 1024; type = 0; WT = (bf16*)(ws + WS_WT7); }
            const int nblk = N / 64, kb = r / nblk, nb = r - kb * nblk;
            p0_transpose_item(W, K, N, WT, 64 * kb, src_col(type, 64 * nb), src_col(type, 64 * nb + 32), 64 * nb, scr, lane);
        }
    }
}

__device__ __forceinline__ void p1_phase(ptab_t tab, LAS unsigned char* lds, int vcu, int G) {
    const int tid = threadIdx.x, lane = tid & 63, w = __builtin_amdgcn_readfirstlane(tid >> 6);
    unsigned char* ws = ldp(tab, T_WS);
    const float* mods = (const float*)(ws + WS_MODS);
    const int t0 = (G * 77) >> 8, t1 = (G * 147) >> 8, t2 = (G * 217) >> 8, t3 = (G * 243) >> 8;
    const int ty = (vcu < t0) ? 0 : (vcu < t1) ? 1 : (vcu < t2) ? 2 : (vcu < t3) ? 3 : 4;
    const int wbase = (ty == 0) ? 0 : (ty == 1) ? t0 : (ty == 2) ? t1 : (ty == 3) ? t2 : t3, wend = (ty == 0) ? t0 : (ty == 1) ? t1 : (ty == 2) ? t2 : (ty == 3) ? t3 : G;
    const float* sp; int sst, N; const bf16* WT; float* dst;
    if (ty == 0)      { sp = mods;                         sst = 6144; N = RN;   WT = (const bf16*)(ws + WS_WT1); dst = (float*)(ws + WS_SW1); }
    else if (ty == 1) { sp = mods + 3072;                  sst = 6144; N = FF2;  WT = (const bf16*)(ws + WS_WT3); dst = (float*)(ws + WS_SW3); }
    else if (ty == 2) { sp = mods + 16 * 6144 + 3072;      sst = 6144; N = FF2;  WT = (const bf16*)(ws + WS_WT3) + (size_t)FF2 * 1024; dst = (float*)(ws + WS_SW3) + 16 * FF2; }
    else if (ty == 3) { sp = (const float*)(ws + WS_KVM);  sst = 2048; N = 2048; WT = (const bf16*)(ws + WS_WT5); dst = (float*)(ws + WS_SW5); }
    else              { sp = mods + 16 * 6144;             sst = 6144; N = 1024; WT = (const bf16*)(ws + WS_WT6); dst = (float*)(ws + WS_SW6); }
    LAS float* sh = (LAS float*)lds;
#pragma unroll 8
    for (int i = tid; i < 16 * 1024; i += NTHREADS) sh[i] = sp[(size_t)(i >> 10) * sst + (i & 1023)];
    LBAR();
    if (w < 4) {
        const float* x = (const float*)ldp(tab, 0); const float* g = (const float*)ldp(tab, 5);
        bf16* A0 = (bf16*)(ws + WS_A); float* ss0 = (float*)(ws + WS_SS);
        const int gw4 = vcu * 4 + w, NGW4 = G * 4, rpw = M / NGW4;
        for (int r0 = gw4 * rpw; r0 < M; r0 += NGW4 * rpw) {
            const int b = r0 / SEQ;
            f32x4 gs[4];
#pragma unroll
            for (int j = 0; j < 4; ++j) { const int col = 4 * lane + 256 * j; gs[j] = *(const f32x4*)(g + col) * (*(const f32x4*)(mods + (size_t)b * 6144 + 1024 + col) + 1.f); }
#pragma unroll 1
            for (int r = r0; r < r0 + rpw; r += 4) {
                f32x4 v[4][4]; float s[4];
#pragma unroll
                for (int q = 0; q < 4; ++q)
#pragma unroll
                    for (int j = 0; j < 4; ++j) v[q][j] = *(const f32x4*)(x + (size_t)(r + q) * D + 4 * lane + 256 * j);
#pragma unroll
                for (int q = 0; q < 4; ++q) { s[q] = (pg8::dot4(v[q][0]) + pg8::dot4(v[q][1])) + (pg8::dot4(v[q][2]) + pg8::dot4(v[q][3])); }
#pragma unroll
                for (int o = 1; o < 64; o <<= 1) {
#pragma unroll
                    for (int q = 0; q < 4; ++q) s[q] += __shfl_xor(s[q], o);
                }
                if (lane < 4) ss0[r + lane] = (lane == 0) ? s[0] : (lane == 1) ? s[1] : (lane == 2) ? s[2] : s[3];
#pragma unroll
                for (int q = 0; q < 4; ++q)
#pragma unroll
                    for (int j = 0; j < 4; ++j) { const f32x4 o = v[q][j] * gs[j]; u32x2 pp; pp.x = pk_bf16(o[0], o[1]); pp.y = pk_bf16(o[2], o[3]); *(u32x2*)(A0 + (size_t)(r + q) * D + 4 * lane + 256 * j) = pp; }
            }
        }
    } else {
        const int gw = (vcu - wbase) * 4 + (w - 4), NGW = (wend - wbase) * 4;
        u32x4 nw0 = (u32x4){0u, 0u, 0u, 0u}, nw1 = nw0;
        if (gw < N) { nw0 = *(const u32x4*)(WT + (size_t)gw * 1024 + 8 * lane); nw1 = *(const u32x4*)(WT + (size_t)gw * 1024 + 512 + 8 * lane); }
        for (int n = gw; n < N; n += NGW) {
            asm volatile("" ::: "memory");
            const u32x4 w0 = nw0, w1 = nw1;
            if (n + NGW < N) { nw0 = *(const u32x4*)(WT + (size_t)(n + NGW) * 1024 + 8 * lane); nw1 = *(const u32x4*)(WT + (size_t)(n + NGW) * 1024 + 512 + 8 * lane); }
            float wf[16];
#pragma unroll
            for (int i = 0; i < 4; ++i) { wf[2 * i] = __builtin_bit_cast(float, w0[i] << 16); wf[2 * i + 1] = __builtin_bit_cast(float, w0[i] & 0xffff0000u);
                                          wf[8 + 2 * i] = __builtin_bit_cast(float, w1[i] << 16); wf[8 + 2 * i + 1] = __builtin_bit_cast(float, w1[i] & 0xffff0000u); }
            float p[16];
#pragma unroll
            for (int b = 0; b < 16; ++b) {
                const LAS float* s0 = sh + b * 1024 + 8 * lane;
                const f32x4 a0 = *(const LAS f32x4*)s0, a1 = *(const LAS f32x4*)(s0 + 4), a2 = *(const LAS f32x4*)(s0 + 512), a3 = *(const LAS f32x4*)(s0 + 516);
                p[b] = (a0[0] * wf[0] + a0[1] * wf[1]) + (a0[2] * wf[2] + a0[3] * wf[3]) + (a1[0] * wf[4] + a1[1] * wf[5]) + (a1[2] * wf[6] + a1[3] * wf[7])
                     + (a2[0] * wf[8] + a2[1] * wf[9]) + (a2[2] * wf[10] + a2[3] * wf[11]) + (a3[0] * wf[12] + a3[1] * wf[13]) + (a3[2] * wf[14] + a3[3] * wf[15]);
            }
#pragma unroll
            for (int j = 0; j < 8; ++j) { const bool up = lane & 32; const float keep = up ? p[j + 8] : p[j], send = up ? p[j] : p[j + 8]; p[j] = keep + __shfl_xor(send, 32); }
#pragma unroll
            for (int j = 0; j < 4; ++j) { const bool up = lane & 16; const float keep = up ? p[j + 4] : p[j], send = up ? p[j] : p[j + 4]; p[j] = keep + __shfl_xor(send, 16); }
#pragma unroll
            for (int j = 0; j < 2; ++j) { const bool up = lane & 8; const float keep = up ? p[j + 2] : p[j], send = up ? p[j] : p[j + 2]; p[j] = keep + __shfl_xor(send, 8); }
            { const bool up = lane & 4; const float keep = up ? p[1] : p[0], send = up ? p[0] : p[1]; p[0] = keep + __shfl_xor(send, 4); }
            p[0] += __shfl_xor(p[0], 2); p[0] += __shfl_xor(p[0], 1);
            const float mine = p[0]; const int myb = ((lane >> 5) & 1) * 8 + ((lane >> 4) & 1) * 4 + ((lane >> 3) & 1) * 2 + ((lane >> 2) & 1);
            if ((lane & 3) == 0) dst[(size_t)myb * N + n] = mine;
        }
    }
}

constexpr int RT_QROWB = 528, RT_VROWB = 272, RT_PROWB = 144;
constexpr int RT_QS = 0, RT_KS = 64 * RT_QROWB, RT_VS = 2 * 64 * RT_QROWB, RT_PS = RT_VS + 64 * RT_VROWB, RT_SQ = RT_PS + 64 * RT_PROWB, RT_BYTES = RT_SQ + 512;
static_assert(RT_BYTES <= MISC_OFF, "retention LDS");
__device__ __forceinline__ s16x4 tr16(const LAS unsigned char* p) { typedef short v4i16_t __attribute__((ext_vector_type(4))); return __builtin_bit_cast(s16x4, __builtin_amdgcn_ds_read_tr16_b64_v4i16((LAS v4i16_t*)p)); }
#define MFMA16(a, b, c) __builtin_amdgcn_mfma_f32_16x16x32_bf16((a), (b), (c), 0, 0, 0)
#define MFMA32(a, b, c) __builtin_amdgcn_mfma_f32_32x32x16_bf16((a), (b), (c), 0, 0, 0)
__device__ __forceinline__ bf16x8 cat8(s16x4 lo, s16x4 hi) { return (bf16x8){lo[0], lo[1], lo[2], lo[3], hi[0], hi[1], hi[2], hi[3]}; }
__device__ __forceinline__ bf16x8 pack8(const f32x4 a, const f32x4 b) { return __builtin_bit_cast(bf16x8, pg8::pk8(a, b)); }

__device__ __forceinline__ void ret_unit(LAS unsigned char* lds, const bf16* Q, const bf16* KD, const bf16* V, bf16* SG, float* SSO, int unit, bool dry) {
    const int tid = threadIdx.x, lane = tid & 63, w = __builtin_amdgcn_readfirstlane(tid >> 6);
    const int b = unit >> 4, h = (unit >> 2) & 3, vs = unit & 3;
    const int c16 = lane & 15, g4 = lane >> 4;
    const float lg2 = __builtin_amdgcn_logf(1.f - __builtin_amdgcn_exp2f(-5.f - (float)h));
    const float gC = __builtin_amdgcn_exp2f(lg2 * 64.f);
    const __amdgpu_buffer_rsrc_t rs = __builtin_amdgcn_make_buffer_rsrc((void*)Q, 0, 0x7fffffff, 0x00020000);
    const unsigned offK = (unsigned)((const char*)KD - (const char*)Q), offV = (unsigned)((const char*)V - (const char*)Q), offG = (unsigned)((const char*)SG - (const char*)Q);
    const unsigned uQ = ((unsigned)b * SEQ * 1024 + h * 256) * 2, uV = ((unsigned)b * SEQ * 2048 + h * 512 + vs * 128) * 2;
    const unsigned vQ = (tid >> 5) * 2048 + (tid & 31) * 16, vV = (tid >> 4) * 4096 + (tid & 15) * 16;
    const unsigned vG = c16 * 4096 + (16 * w + 4 * g4) * 2;
    u32x4 pq[4], pk[4], pv[2];
#define RT_LOAD(c) do { _Pragma("unroll") for (int j = 0; j < 4; ++j) { const unsigned so = uQ + (unsigned)((c) * 64 + 16 * j) * 2048; \
        pq[j] = __builtin_bit_cast(u32x4, __builtin_amdgcn_raw_buffer_load_b128(rs, vQ, so, 0)); pk[j] = __builtin_bit_cast(u32x4, __builtin_amdgcn_raw_buffer_load_b128(rs, vQ, so + offK, 0)); } \
        _Pragma("unroll") for (int j = 0; j < 2; ++j) pv[j] = __builtin_bit_cast(u32x4, __builtin_amdgcn_raw_buffer_load_b128(rs, vV, offV + uV + (unsigned)((c) * 64 + 32 * j) * 4096, 0)); } while (0)
#define RT_STORE() do { _Pragma("unroll") for (int j = 0; j < 4; ++j) { const int cc = tid + 512 * j, row = cc >> 5, ck = cc & 31; *(LAS u32x4*)(lds + RT_QS + row * RT_QROWB + ck * 16) = pq[j]; *(LAS u32x4*)(lds + RT_KS + row * RT_QROWB + ck * 16) = pk[j]; } \
        _Pragma("unroll") for (int j = 0; j < 2; ++j) { const int cc = tid + 512 * j, row = cc >> 4, ck = cc & 15; *(LAS u32x4*)(lds + RT_VS + row * RT_VROWB + ck * 16) = pv[j]; } } while (0)
    f32x4 st[16], oc[4], sT[2]; bf16x8 vf[2];
#pragma unroll
    for (int i = 0; i < 16; ++i) st[i] = (f32x4){0.f, 0.f, 0.f, 0.f};
#pragma unroll
    for (int i = 0; i < 4; ++i) oc[i] = (f32x4){0.f, 0.f, 0.f, 0.f};
    const int ntS = w & 3, mtb = 2 * (w >> 2);
    const LAS unsigned char* qrowS = lds + RT_QS + (16 * ntS + c16) * RT_QROWB + g4 * 16;
    const LAS unsigned char* krowS = lds + RT_KS + (16 * mtb + c16) * RT_QROWB + g4 * 16;
    const LAS unsigned char* qrowC = lds + RT_QS + c16 * RT_QROWB + g4 * 8;
    const LAS unsigned char* ktr = lds + RT_KS + (8 * g4 + (c16 >> 2)) * RT_QROWB + (c16 & 3) * 8;
    const LAS unsigned char* vtr = lds + RT_VS + (8 * g4 + (c16 >> 2)) * RT_VROWB + w * 32 + (c16 & 3) * 8;
    const LAS unsigned char* prow = lds + RT_PS + c16 * RT_PROWB + g4 * 16;
    LAS unsigned char* pst = lds + RT_PS + (16 * ntS + c16) * RT_PROWB + g4 * 8;
    if (tid < 128) ((LAS float*)(lds + RT_SQ))[tid] = 0.f;
    RT_LOAD(0);
    for (int c = 0; c < 32; ++c) {
        LBAR();
        RT_STORE();
        asm volatile("" ::: "memory");
        if (c + 1 < 32) RT_LOAD(c + 1);
        u32x2 sgv[4];
#pragma unroll
        for (int nt = 0; nt < 4; ++nt) sgv[nt] = __builtin_bit_cast(u32x2, __builtin_amdgcn_raw_buffer_load_b64(rs, vG, offG + uV + (unsigned)(c * 64 + 16 * nt) * 4096, 0));
        if (w == 0 && c > 0 && !dry) {
            LAS float* sl = (LAS float*)(lds + RT_SQ) + ((c - 1) & 1) * 64;
            SSO[(size_t)(b * SEQ + (c - 1) * 64 + lane) * 16 + h * 4 + vs] = sl[lane]; sl[lane] = 0.f;
        }
        LBAR();
#pragma unroll
        for (int ks = 0; ks < 2; ++ks) vf[ks] = cat8(tr16(vtr + (32 * ks) * RT_VROWB), tr16(vtr + (32 * ks + 4) * RT_VROWB));
        sT[0] = (f32x4){0.f, 0.f, 0.f, 0.f}; sT[1] = (f32x4){0.f, 0.f, 0.f, 0.f};
#pragma unroll
        for (int ks = 0; ks < 8; ++ks) {
            const bf16x8 bq = *(const LAS bf16x8*)(qrowS + ks * 64);
#pragma unroll
            for (int i = 0; i < 2; ++i) { const bf16x8 ak = *(const LAS bf16x8*)(krowS + i * 16 * RT_QROWB + ks * 64); sT[i] = MFMA16(ak, bq, sT[i]); }
        }
        {
            const int n = 16 * ntS + c16; const float fac = __builtin_amdgcn_exp2f(lg2 * (float)(n - 63));
#pragma unroll
            for (int i = 0; i < 2; ++i) {
                const int m0 = 16 * (mtb + i) + 4 * g4; float v[4];
#pragma unroll
                for (int e = 0; e < 4; ++e) v[e] = (n >= m0 + e) ? sT[i][e] * fac : 0.f;
                u32x2 p; p.x = pk_bf16(v[0], v[1]); p.y = pk_bf16(v[2], v[3]);
                *(LAS u32x2*)(pst + (mtb + i) * 32) = p;
            }
        }
        __builtin_amdgcn_sched_barrier(0);
        {
            s16x4 qlo[2][4], qhi[2][4];
#pragma unroll
            for (int nt = 0; nt < 4; ++nt) { qlo[0][nt] = *(const LAS s16x4*)(qrowC + nt * 16 * RT_QROWB); qhi[0][nt] = *(const LAS s16x4*)(qrowC + nt * 16 * RT_QROWB + 32); }
#pragma unroll
            for (int ks = 0; ks < 8; ++ks) {
                if (ks < 7) {
#pragma unroll
                    for (int nt = 0; nt < 4; ++nt) { qlo[(ks + 1) & 1][nt] = *(const LAS s16x4*)(qrowC + nt * 16 * RT_QROWB + (ks + 1) * 64); qhi[(ks + 1) & 1][nt] = *(const LAS s16x4*)(qrowC + nt * 16 * RT_QROWB + (ks + 1) * 64 + 32); }
                }
                __builtin_amdgcn_sched_barrier(0);
                const bf16x8 as = pack8(st[2 * ks], st[2 * ks + 1]);
#pragma unroll
                for (int nt = 0; nt < 4; ++nt) oc[nt] = MFMA16(as, cat8(qlo[ks & 1][nt], qhi[ks & 1][nt]), oc[nt]);
                __builtin_amdgcn_sched_barrier(0);
            }
        }
        {
            s16x4 kt[2][4];
#pragma unroll
            for (int ks = 0; ks < 2; ++ks) { kt[0][2 * ks] = tr16(ktr + (32 * ks) * RT_QROWB); kt[0][2 * ks + 1] = tr16(ktr + (32 * ks + 4) * RT_QROWB); }
#pragma unroll
            for (int i = 0; i < 16; ++i) {
                if (i < 15) {
#pragma unroll
                    for (int ks = 0; ks < 2; ++ks) { kt[(i + 1) & 1][2 * ks] = tr16(ktr + (32 * ks) * RT_QROWB + (i + 1) * 32); kt[(i + 1) & 1][2 * ks + 1] = tr16(ktr + (32 * ks + 4) * RT_QROWB + (i + 1) * 32); }
                }
                __builtin_amdgcn_sched_barrier(0);
                f32x4 sacc = st[i] * gC;
#pragma unroll
                for (int ks = 0; ks < 2; ++ks) sacc = MFMA16(cat8(kt[i & 1][2 * ks], kt[i & 1][2 * ks + 1]), vf[ks], sacc);
                st[i] = sacc;
                __builtin_amdgcn_sched_barrier(0);
            }
        }
        LBAR();
#pragma unroll
        for (int nt = 0; nt < 4; ++nt) { const float gq = __builtin_amdgcn_exp2f(lg2 * (float)(16 * nt + c16 + 1)); oc[nt] *= gq; }
#pragma unroll
        for (int ks = 0; ks < 2; ++ks)
#pragma unroll
            for (int nt = 0; nt < 4; ++nt) if (32 * ks <= 16 * nt + 15) { const bf16x8 bp = *(const LAS bf16x8*)(prow + nt * 16 * RT_PROWB + ks * 64); oc[nt] = MFMA16(vf[ks], bp, oc[nt]); }
#pragma unroll
        for (int nt = 0; nt < 4; ++nt) {
            float sq = pg8::dot4(oc[nt]); sq += __shfl_xor(sq, 16); sq += __shfl_xor(sq, 32);
            if (g4 == 0) (void)__hip_atomic_fetch_add((LAS float*)(lds + RT_SQ) + (c & 1) * 64 + 16 * nt + c16, sq, __ATOMIC_RELAXED, __HIP_MEMORY_SCOPE_WORKGROUP);
            const u32x2 sg = sgv[nt];
            const float o0 = oc[nt][0] * __builtin_bit_cast(float, sg.x << 16), o1 = oc[nt][1] * __builtin_bit_cast(float, sg.x & 0xffff0000u);
            const float o2 = oc[nt][2] * __builtin_bit_cast(float, sg.y << 16), o3 = oc[nt][3] * __builtin_bit_cast(float, sg.y & 0xffff0000u);
            u32x2 p; p.x = pk_bf16(o0, o1); p.y = pk_bf16(o2, o3);
            if (!dry) __builtin_amdgcn_raw_buffer_store_b64(__builtin_bit_cast(__attribute__((ext_vector_type(2))) unsigned, p), rs, vG, offG + uV + (unsigned)(c * 64 + 16 * nt) * 4096, 0);
            oc[nt] = (f32x4){0.f, 0.f, 0.f, 0.f};
        }
    }
    LBAR();
    if (w == 0 && !dry) { LAS float* sl = (LAS float*)(lds + RT_SQ) + 64; SSO[(size_t)(b * SEQ + 31 * 64 + lane) * 16 + h * 4 + vs] = sl[lane]; sl[lane] = 0.f; }
    LBAR();
#undef RT_LOAD
#undef RT_STORE
}

constexpr int R2_QS = 0, R2_KS = 64 * RT_QROWB, R2_VS = 2 * 64 * RT_QROWB, R2_PS = R2_VS + 2 * 64 * RT_VROWB, R2_SQ = R2_PS + 64 * RT_PROWB, R2_SG = R2_SQ + 512, R2_BYTES = R2_SG + 64 * RT_VROWB;
static_assert(R2_BYTES <= MISC_OFF, "retention v2 LDS");
__device__ __forceinline__ void ret_unit2(LAS unsigned char* lds, const bf16* Q, const bf16* KD, const bf16* V, bf16* SG, float* SSO, int unit, bool dry) {
    const int tid = threadIdx.x, lane = tid & 63, w = __builtin_amdgcn_readfirstlane(tid >> 6);
    const int b = unit >> 4, h = (unit >> 2) & 3, vs = unit & 3;
    const int r32 = lane & 31, hh = lane >> 5;
    const float lg2 = __builtin_amdgcn_logf(1.f - __builtin_amdgcn_exp2f(-5.f - (float)h));
    const __amdgpu_buffer_rsrc_t rs = __builtin_amdgcn_make_buffer_rsrc((void*)Q, 0, 0x7fffffff, 0x00020000);
    const unsigned offK = (unsigned)((const char*)KD - (const char*)Q), offV = (unsigned)((const char*)V - (const char*)Q), offG = (unsigned)((const char*)SG - (const char*)Q);
    const unsigned uQ = ((unsigned)b * SEQ * 1024 + h * 256) * 2, uV = ((unsigned)b * SEQ * 2048 + h * 512 + vs * 128) * 2;
    if (tid < 128) ((LAS float*)(lds + R2_SQ))[tid] = 0.f;
    if (w >= 4) {
        const int ht = tid - 256, hw = w - 4, mt2 = hw >> 1, nt2 = hw & 1;
        const unsigned vQ = (ht >> 5) * 2048 + (ht & 31) * 16, vV = (ht >> 4) * 4096 + (ht & 15) * 16;
        u32x4 pq[8], pk[8], pv[4], pg[4];
#define H_LOAD(c) do { _Pragma("unroll") for (int j = 0; j < 8; ++j) { const unsigned so = uQ + (unsigned)((c) * 64 + 8 * j) * 2048; \
            pq[j] = __builtin_bit_cast(u32x4, __builtin_amdgcn_raw_buffer_load_b128(rs, vQ, so, 0)); pk[j] = __builtin_bit_cast(u32x4, __builtin_amdgcn_raw_buffer_load_b128(rs, vQ, so + offK, 0)); } \
            _Pragma("unroll") for (int j = 0; j < 4; ++j) { pv[j] = __builtin_bit_cast(u32x4, __builtin_amdgcn_raw_buffer_load_b128(rs, vV, offV + uV + (unsigned)((c) * 64 + 16 * j) * 4096, 0)); \
            pg[j] = __builtin_bit_cast(u32x4, __builtin_amdgcn_raw_buffer_load_b128(rs, vV, offG + uV + (unsigned)((c) * 64 + 16 * j) * 4096, 0)); } } while (0)
#define H_STORE(c) do { _Pragma("unroll") for (int j = 0; j < 8; ++j) { const int row = (ht >> 5) + 8 * j, ck = ht & 31; *(LAS u32x4*)(lds + R2_QS + row * RT_QROWB + ck * 16) = pq[j]; *(LAS u32x4*)(lds + R2_KS + row * RT_QROWB + ck * 16) = pk[j]; } \
            _Pragma("unroll") for (int j = 0; j < 4; ++j) { const int row = (ht >> 4) + 16 * j, ck = ht & 15; *(LAS u32x4*)(lds + R2_VS + ((c) & 1) * 64 * RT_VROWB + row * RT_VROWB + ck * 16) = pv[j]; } } while (0)
#define H_STORE_G() do { _Pragma("unroll") for (int j = 0; j < 4; ++j) { const int row = (ht >> 4) + 16 * j, ck = ht & 15; *(LAS u32x4*)(lds + R2_SG + row * RT_VROWB + ck * 16) = pg[j]; } } while (0)
        const LAS unsigned char* qrowS = lds + R2_QS + (32 * nt2 + r32) * RT_QROWB + hh * 16;
        const LAS unsigned char* krowS = lds + R2_KS + (32 * mt2 + r32) * RT_QROWB + hh * 16;
        LAS unsigned char* pst = lds + R2_PS + (32 * nt2 + r32) * RT_PROWB + (32 * mt2 + 4 * hh) * 2;
        const int n_loc = 32 * nt2 + r32; const float fac = __builtin_amdgcn_exp2f(lg2 * (float)(n_loc - 63));
        H_LOAD(0);
        for (int c = 0; c < 32; ++c) {
            H_STORE(c);
            LBAR();
            H_STORE_G();
            asm volatile("" ::: "memory");
            if (c + 1 < 32) H_LOAD(c + 1);
            f32x16 sT;
#pragma unroll
            for (int i = 0; i < 16; ++i) sT[i] = 0.f;
            if (mt2 <= nt2) {
#pragma unroll
                for (int s = 0; s < 16; ++s) { const bf16x8 ak = *(const LAS bf16x8*)(krowS + s * 32), bq = *(const LAS bf16x8*)(qrowS + s * 32); sT = MFMA32(ak, bq, sT); }
            }
#pragma unroll
            for (int g = 0; g < 4; ++g) {
                const int m0 = 32 * mt2 + 8 * g + 4 * hh; float v[4];
#pragma unroll
                for (int e = 0; e < 4; ++e) v[e] = (n_loc >= m0 + e) ? sT[4 * g + e] * fac : 0.f;
                u32x2 pp; pp.x = pk_bf16(v[0], v[1]); pp.y = pk_bf16(v[2], v[3]);
                *(LAS u32x2*)(pst + g * 16) = pp;
            }
            if (hw == 0 && c > 0 && !dry) {
                LAS float* sl = (LAS float*)(lds + R2_SQ) + ((c - 1) & 1) * 64;
                SSO[(size_t)(b * SEQ + (c - 1) * 64 + lane) * 16 + h * 4 + vs] = sl[lane]; sl[lane] = 0.f;
            }
            LBAR();
        }
        LBAR();
        if (hw == 0 && !dry) { LAS float* sl = (LAS float*)(lds + R2_SQ) + 64; SSO[(size_t)(b * SEQ + 31 * 64 + lane) * 16 + h * 4 + vs] = sl[lane]; sl[lane] = 0.f; }
        LBAR();
#undef H_LOAD
#undef H_STORE
#undef H_STORE_G
    } else {
        const float gC = __builtin_amdgcn_exp2f(lg2 * 64.f);
        f32x16 st[8], oc[2]; bf16x8 vf[4];
#pragma unroll
        for (int t = 0; t < 8; ++t)
#pragma unroll
            for (int i = 0; i < 16; ++i) st[t][i] = 0.f;
#pragma unroll
        for (int i = 0; i < 16; ++i) { oc[0][i] = 0.f; oc[1][i] = 0.f; }
        for (int c = 0; c < 32; ++c) {
            int ln = lane; asm volatile("" : "+v"(ln));
            const int r32 = ln & 31, hh = ln >> 5, blk = (ln >> 4) & 1, q4 = (ln & 15) >> 2, p4 = ln & 3;
            const unsigned vG = r32 * 4096 + (32 * w + 4 * hh) * 2;
            const LAS unsigned char* qrowC = lds + R2_QS + r32 * RT_QROWB + hh * 8;
            const LAS unsigned char* ktr = lds + R2_KS + (8 * hh + q4) * RT_QROWB + (16 * blk + 4 * p4) * 2;
            const LAS unsigned char* vtr = lds + R2_VS + (8 * hh + q4) * RT_VROWB + (32 * w + 16 * blk + 4 * p4) * 2;
            const LAS unsigned char* prow = lds + R2_PS + r32 * RT_PROWB + hh * 16;
            LBAR();
            const LAS unsigned char* vb = vtr + (c & 1) * 64 * RT_VROWB;
#pragma unroll
            for (int ks = 0; ks < 4; ++ks) vf[ks] = cat8(tr16(vb + (16 * ks) * RT_VROWB), tr16(vb + (16 * ks + 4) * RT_VROWB));
            {
                s16x4 qlo[3][2], qhi[3][2];
#pragma unroll
                for (int kk = 0; kk < 2; ++kk)
#pragma unroll
                    for (int nt = 0; nt < 2; ++nt) { qlo[kk][nt] = *(const LAS s16x4*)(qrowC + nt * 32 * RT_QROWB + kk * 32); qhi[kk][nt] = *(const LAS s16x4*)(qrowC + nt * 32 * RT_QROWB + kk * 32 + 16); }
#pragma unroll
                for (int k = 0; k < 16; ++k) {
                    if (k < 14) {
#pragma unroll
                        for (int nt = 0; nt < 2; ++nt) { qlo[(k + 2) % 3][nt] = *(const LAS s16x4*)(qrowC + nt * 32 * RT_QROWB + (k + 2) * 32); qhi[(k + 2) % 3][nt] = *(const LAS s16x4*)(qrowC + nt * 32 * RT_QROWB + (k + 2) * 32 + 16); }
                    }
                    __builtin_amdgcn_sched_barrier(0);
                    const int t = k >> 1, s = k & 1;
                    const bf16x8 as = pack8((f32x4){st[t][8 * s], st[t][8 * s + 1], st[t][8 * s + 2], st[t][8 * s + 3]}, (f32x4){st[t][8 * s + 4], st[t][8 * s + 5], st[t][8 * s + 6], st[t][8 * s + 7]});
#pragma unroll
                    for (int nt = 0; nt < 2; ++nt) oc[nt] = MFMA32(as, cat8(qlo[k % 3][nt], qhi[k % 3][nt]), oc[nt]);
                    __builtin_amdgcn_sched_barrier(0);
                }
            }
            {
#pragma unroll
                for (int t = 0; t < 8; ++t) st[t] *= gC;
                s16x4 kf[4][2];
#define KT_ADDR(u_) (ktr + (16 * (((u_) >> 1) & 3)) * RT_QROWB + (2 * ((u_) >> 3) + ((u_) & 1)) * 64)
#pragma unroll
                for (int u = 0; u < 3; ++u) { kf[u][0] = tr16(KT_ADDR(u)); kf[u][1] = tr16(KT_ADDR(u) + 4 * RT_QROWB); }
#pragma unroll
                for (int u = 0; u < 32; ++u) {
                    if (u + 3 < 32) { kf[(u + 3) & 3][0] = tr16(KT_ADDR(u + 3)); kf[(u + 3) & 3][1] = tr16(KT_ADDR(u + 3) + 4 * RT_QROWB); }
                    __builtin_amdgcn_sched_barrier(0);
                    const int t = 2 * (u >> 3) + (u & 1), ks = (u >> 1) & 3;
                    st[t] = MFMA32(cat8(kf[u & 3][0], kf[u & 3][1]), vf[ks], st[t]);
                    __builtin_amdgcn_sched_barrier(0);
                }
#undef KT_ADDR
            }
            LBAR();
            { const float gq0 = __builtin_amdgcn_exp2f(lg2 * (float)(r32 + 1)), gq1 = __builtin_amdgcn_exp2f(lg2 * (float)(r32 + 33)); oc[0] *= gq0; oc[1] *= gq1; }
#pragma unroll
            for (int ks = 0; ks < 4; ++ks)
#pragma unroll
                for (int nt = 0; nt < 2; ++nt) if (16 * ks <= 32 * nt + 31) { const bf16x8 bp = *(const LAS bf16x8*)(prow + nt * 32 * RT_PROWB + ks * 32); oc[nt] = MFMA32(vf[ks], bp, oc[nt]); }
#pragma unroll
            for (int nt = 0; nt < 2; ++nt) {
                float sq = 0.f;
#pragma unroll
                for (int i = 0; i < 16; ++i) sq += oc[nt][i] * oc[nt][i];
                sq += __shfl_xor(sq, 32);
                if (hh == 0) (void)__hip_atomic_fetch_add((LAS float*)(lds + R2_SQ) + (c & 1) * 64 + 32 * nt + r32, sq, __ATOMIC_RELAXED, __HIP_MEMORY_SCOPE_WORKGROUP);
#pragma unroll
                for (int g = 0; g < 4; ++g) {
                    const u32x2 sg = *(const LAS u32x2*)(lds + R2_SG + (32 * nt + r32) * RT_VROWB + (32 * w + 8 * g + 4 * hh) * 2);
                    const float o0 = oc[nt][4 * g] * __builtin_bit_cast(float, sg.x << 16), o1 = oc[nt][4 * g + 1] * __builtin_bit_cast(float, sg.x & 0xffff0000u);
                    const float o2 = oc[nt][4 * g + 2] * __builtin_bit_cast(float, sg.y << 16), o3 = oc[nt][4 * g + 3] * __builtin_bit_cast(float, sg.y & 0xffff0000u);
                    u32x2 pp; pp.x = pk_bf16(o0, o1); pp.y = pk_bf16(o2, o3);
                    if (!dry) __builtin_amdgcn_raw_buffer_store_b64(__builtin_bit_cast(__attribute__((ext_vector_type(2))) unsigned, pp), rs, vG, offG + uV + (unsigned)(c * 64 + 32 * nt) * 4096 + g * 16, 0);
                }
#pragma unroll
                for (int i = 0; i < 16; ++i) oc[nt][i] = 0.f;
            }
        }
        LBAR();
        LBAR();
    }
}

__device__ __forceinline__ int crow(int r, int hi) { return (r & 3) + 8 * (r >> 2) + 4 * hi; }
__device__ __forceinline__ void sb_wave(const bf16* QN, const bf16* KN, const bf16* VF, bf16* O, int vcu, int wave, int lane) {
    const int r32 = lane & 31, hh = lane >> 5;
#define SB_IDX(i_, bh_, qb_) const int bh_ = (vcu >> 3) + 32 * (i_), qb_ = ((((vcu & 7) + (i_)) & 7) << 3) + wave
#define SB_KBASE(bh_) (KN + ((size_t)(bh_) * SEQ + r32) * 64 + 8 * hh)
#define SB_VBASE(bh_) (VF + (size_t)(bh_) * 64 * 2048 + lane * 8)
    bf16x8 qN[4], kfU[4], vfU[2][2];
#define SB_LOAD_UNIT(bh_, qb_) do { const bf16* qp_ = QN + ((size_t)(bh_) * SEQ + 32 * (qb_) + r32) * 64 + 8 * hh; \
        _Pragma("unroll") for (int s = 0; s < 4; ++s) { qN[s] = *(const bf16x8*)(qp_ + 16 * s); kfU[s] = *(const bf16x8*)(SB_KBASE(bh_) + (size_t)(32 * (qb_)) * 64 + 16 * s); } \
        _Pragma("unroll") for (int dt = 0; dt < 2; ++dt) _Pragma("unroll") for (int sp = 0; sp < 2; ++sp) vfU[dt][sp] = *(const bf16x8*)(SB_VBASE(bh_) + (size_t)((((qb_) * 2 + dt) * 2 + sp) * 512)); } while (0)
    { SB_IDX(0, bh0, qb0); SB_LOAD_UNIT(bh0, qb0); }
#pragma unroll 1
    for (int i = 0; i < 8; ++i) {
        SB_IDX(i, bh, qblk);
        const int b = bh >> 4, h = bh & 15;
        const size_t row0 = (size_t)b * SEQ + 32 * qblk;
        bf16x8 qf[4], kfn[4], vfn[2][2];
#pragma unroll
        for (int s = 0; s < 4; ++s) { qf[s] = qN[s]; kfn[s] = kfU[s]; }
#pragma unroll
        for (int dt = 0; dt < 2; ++dt)
#pragma unroll
            for (int sp = 0; sp < 2; ++sp) vfn[dt][sp] = vfU[dt][sp];
        if (i + 1 < 8) { SB_IDX(i + 1, bh1, qb1); SB_LOAD_UNIT(bh1, qb1); }
        f32x16 oT[2];
#pragma unroll
        for (int q = 0; q < 16; ++q) { oT[0][q] = 0.f; oT[1][q] = 0.f; }
        float R = 0.f;
        const bf16* kbase = SB_KBASE(bh);
        const bf16* vbase = SB_VBASE(bh);
#define SB_LOAD(kt_) do { _Pragma("unroll") for (int s = 0; s < 4; ++s) kfn[s] = *(const bf16x8*)(kbase + (size_t)(32 * (kt_)) * 64 + 16 * s); \
        _Pragma("unroll") for (int dt = 0; dt < 2; ++dt) _Pragma("unroll") for (int sp = 0; sp < 2; ++sp) vfn[dt][sp] = *(const bf16x8*)(vbase + (size_t)((((kt_) * 2 + dt) * 2 + sp) * 512)); } while (0)
        for (int kt = qblk; kt >= 0; --kt) {
            bf16x8 kf[4], vf[2][2];
#pragma unroll
            for (int s = 0; s < 4; ++s) kf[s] = kfn[s];
#pragma unroll
            for (int dt = 0; dt < 2; ++dt)
#pragma unroll
                for (int sp = 0; sp < 2; ++sp) vf[dt][sp] = vfn[dt][sp];
            if (kt > 0) SB_LOAD(kt - 1);
            f32x16 z;
#pragma unroll
            for (int q = 0; q < 16; ++q) z[q] = 0.f;
#pragma unroll
            for (int s = 0; s < 4; ++s) z = MFMA32(kf[s], qf[s], z);
            float sp_[16], lb[16];
            const bool diag = (kt == qblk);
#pragma unroll
            for (int q = 0; q < 16; ++q) {
                const float zz = z[q];
                const float t = __builtin_amdgcn_exp2f(-__builtin_fabsf(zz));
                const float s = __builtin_fmaxf(zz, 0.f) + __builtin_amdgcn_logf(1.f + t);
                const bool valid = !diag || (crow(q, hh) < r32);
                sp_[q] = valid ? s : 0.f;
                lb[q] = valid ? (zz - s) : -INFINITY;
            }
            float gsum[4], pgs[4];
#pragma unroll
            for (int q = 0; q < 4; ++q) { gsum[q] = (sp_[4 * q] + sp_[4 * q + 1]) + (sp_[4 * q + 2] + sp_[4 * q + 3]); pgs[q] = __shfl_xor(gsum[q], 32); }
            float later = R;
            f32x16 pa;
#pragma unroll
            for (int q = 3; q >= 0; --q) {
                const float L = later + (hh == 0 ? pgs[q] : 0.f);
                const float s3 = L, s2 = s3 + sp_[4 * q + 3], s1 = s2 + sp_[4 * q + 2], s0 = s1 + sp_[4 * q + 1];
                pa[4 * q + 0] = __builtin_amdgcn_exp2f(lb[4 * q + 0] - s0);
                pa[4 * q + 1] = __builtin_amdgcn_exp2f(lb[4 * q + 1] - s1);
                pa[4 * q + 2] = __builtin_amdgcn_exp2f(lb[4 * q + 2] - s2);
                pa[4 * q + 3] = __builtin_amdgcn_exp2f(lb[4 * q + 3] - s3);
                later += gsum[q] + pgs[q];
            }
            R = later;
#pragma unroll
            for (int sp = 0; sp < 2; ++sp) {
                const bf16x8 pf = pack8((f32x4){pa[8 * sp], pa[8 * sp + 1], pa[8 * sp + 2], pa[8 * sp + 3]}, (f32x4){pa[8 * sp + 4], pa[8 * sp + 5], pa[8 * sp + 6], pa[8 * sp + 7]});
#pragma unroll
                for (int dt = 0; dt < 2; ++dt) oT[dt] = MFMA32(vf[dt][sp], pf, oT[dt]);
            }
            if (__all(R > 46.2f)) break;
        }
#undef SB_LOAD
#pragma unroll
        for (int dt = 0; dt < 2; ++dt)
#pragma unroll
            for (int q = 0; q < 4; ++q) {
                u32x2 pp; pp.x = pk_bf16(oT[dt][4 * q], oT[dt][4 * q + 1]); pp.y = pk_bf16(oT[dt][4 * q + 2], oT[dt][4 * q + 3]);
                *(u32x2*)(O + (row0 + r32) * 1024 + h * 64 + 32 * dt + 8 * q + 4 * hh) = pp;
            }
    }
#undef SB_IDX
#undef SB_KBASE
#undef SB_VBASE
#undef SB_LOAD_UNIT
}

__device__ __forceinline__ void fix_phase(const bf16* HF, const bf16* HL, const float* cw, const float* cb, bf16* ACT, int vcu, int G) {
    const int NIT = 512 * 2 * (FF / 4), stride = G * NTHREADS;
    for (int it0 = vcu * NTHREADS + threadIdx.x; it0 < NIT; it0 += 3 * stride) {
        f32x4 u0[3][2], u1[3][2], u2[3][2], w0[3][2], w1[3][2], w2[3][2], bb[3][2];
#pragma unroll
        for (int q = 0; q < 3; ++q) {
            const int it = (it0 + q * stride < NIT) ? it0 + q * stride : it0;
            const int cg4 = it % (FF / 4), bi = it / (FF / 4), i = bi & 1, blk = bi >> 1;
            const int c0 = 4 * cg4, pn = c0 >> 7, j = c0 & 127, nv = 256 * pn + j;
            const bool first = (blk & 31) == 0;
            const int pb = first ? blk : blk - 1;
#pragma unroll
            for (int half = 0; half < 2; ++half) {
                const int nn = nv + 128 * half, co = half * FF + c0;
#define FIX_LD4(P) ({ const u32x2 t_ = *(const u32x2*)(P); (f32x4){__builtin_bit_cast(float, t_.x << 16), __builtin_bit_cast(float, t_.x & 0xffff0000u), __builtin_bit_cast(float, t_.y << 16), __builtin_bit_cast(float, t_.y & 0xffff0000u)}; })
                u0[q][half] = FIX_LD4(HF + (size_t)(blk * 2 + i) * FF2 + nn);
                const f32x4 hf0 = FIX_LD4(HF + (size_t)(blk * 2) * FF2 + nn), hl1 = FIX_LD4(HL + (size_t)(pb * 2 + 1) * FF2 + nn), hl0 = FIX_LD4(HL + (size_t)(pb * 2) * FF2 + nn);
#undef FIX_LD4
                const f32x4 zero = (f32x4){0.f, 0.f, 0.f, 0.f}, pl1 = first ? zero : hl1, pl0 = first ? zero : hl0;
                u1[q][half] = (i == 1) ? hf0 : pl1; u2[q][half] = (i == 1) ? pl1 : pl0;
                w0[q][half] = *(const f32x4*)(cw + co); w1[q][half] = *(const f32x4*)(cw + FF2 + co); w2[q][half] = *(const f32x4*)(cw + 2 * FF2 + co); bb[q][half] = *(const f32x4*)(cb + co);
            }
        }
#pragma unroll
        for (int q = 0; q < 3; ++q) {
            const int it = it0 + q * stride;
            if (it < NIT) {
                const int cg4 = it % (FF / 4), bi = it / (FF / 4), i = bi & 1, blk = bi >> 1, c0 = 4 * cg4;
                const f32x4 val = bb[q][0] + w2[q][0] * u0[q][0] + w1[q][0] * u1[q][0] + w0[q][0] * u2[q][0];
                const f32x4 gat = bb[q][1] + w2[q][1] * u0[q][1] + w1[q][1] * u1[q][1] + w0[q][1] * u2[q][1];
                const f32x4 o = val * pg8::silu4(gat);
                u32x2 p2; p2.x = pk_bf16(o[0], o[1]); p2.y = pk_bf16(o[2], o[3]);
                *(u32x2*)(ACT + (size_t)(64 * blk + i) * FF + c0) = p2;
            }
        }
    }
}

__device__ __forceinline__ XcdBarrier mk_bar(ptab_t tab, LAS unsigned char* lds) { XcdBarrier b; b.bar = (unsigned*)(ldp(tab, T_WS) + WS_CTL) + 1024; b.x = xb_xcc_id(); b.st = (volatile LAS unsigned*)(lds + MISC_OFF) + 8; return b; }
__global__ void __launch_bounds__(NTHREADS, 2) yoco_fwd(Args a) {
    extern __shared__ __attribute__((aligned(16))) unsigned char lds_raw[];
    LAS unsigned char* lds = (LAS unsigned char*)lds_raw;
    volatile LAS unsigned* MISC = (volatile LAS unsigned*)(lds + MISC_OFF);
    LAS unsigned long long* tabw = (LAS unsigned long long*)(lds + MISC_OFF + 64);
    const ptab_t tab = (ptab_t)(lds + MISC_OFF + 64);
    if (threadIdx.x < 16) MISC[threadIdx.x] = 0u;
    if (threadIdx.x == 64) {
#pragma unroll
        for (int i = 0; i < 21; ++i) tabw[i] = (unsigned long long)a.in[i];
        tabw[T_OUT] = (unsigned long long)a.out; tabw[T_WS] = (unsigned long long)a.ws;
        MISC[0] = (unsigned)a.ph_lo; MISC[1] = (unsigned)a.ph_hi;
    }
    __syncthreads();
    if (a.ph_hi - a.ph_lo > 1) (void)xcd_barrier_post((unsigned*)(a.ws + WS_CTL) + 1024, MISC + 8);
#define PH_LO ((int)__builtin_amdgcn_readfirstlane(MISC[0]))
#define PH_HI ((int)__builtin_amdgcn_readfirstlane(MISC[1]))
#define IN(k) (PH_LO <= (k) && (k) < PH_HI)
#define STAMP(k) do { if (PROBE_TS >= 0 && threadIdx.x == 0) { const unsigned long long t_ = __builtin_amdgcn_s_memrealtime(); *(volatile LAS unsigned long long*)(lds + MISC_OFF + 256 + 8 * (k)) = t_; } } while (0)
#define SEAM(k) do { if (IN(k) && IN((k) + 1)) xcd_barrier(mk_bar(tab, lds)); STAMP((k) + 1); } while (0)
#define GRID ((int)gridDim.x)
#define BX ((int)blockIdx.x)
#define VCU ((GRID % 8 == 0) ? (BX % 8) * (GRID / 8) + BX / 8 : BX)
#define WSP (ldp(tab, T_WS))

    STAMP(0);
#ifndef SKIP_P0
    if (IN(0)) { for (int rep = 0; rep < REPS(0); ++rep) { p0_phase(tab, lds, VCU, GRID); LBAR(); } }
#endif
    if (IN(0) && IN(1)) {
        if (MK_ONE_LAUNCH && PH_LO < 0) { cg::this_grid().sync(); }
        xcd_barrier(mk_bar(tab, lds));
    }
    STAMP(1);
#ifndef SKIP_P1
    if (IN(1)) { for (int rep = 0; rep < REPS(1); ++rep) p1_phase(tab, lds, VCU, GRID); }
#endif
    SEAM(1);
    if (IN(2)) {
        pg8::Gemm g{(const bf16*)(WSP + WS_A), (const bf16*)(WSP + WS_WT1), M, RN, D, D}; pg8::StaticOrder S; S.init(M, RN, GRID, BX);
        pg8::EpiRetIn E{tab};
        for (int rep = 0; rep < REPS(2); ++rep) pg8::gemm_phase<pg8::EpiRetIn, pg8::StaticOrder, true, true>(lds, g, S, E);
    }
    SEAM(2);
#ifndef SKIP_RET
    if (IN(3)) {
        unsigned char* ws = WSP;
        for (int rep = 0; rep < REPS(3); ++rep) for (int u = VCU; u < 256; u += GRID) RET_UNIT(lds, (const bf16*)(ws + WS_Q), (const bf16*)(ws + WS_KD), (const bf16*)(ws + WS_V), (bf16*)(ws + WS_SG), (float*)(ws + WS_SSO), u, rep == 0 && REPS(3) == 2);
    }
#endif
    SEAM(3);
    if (IN(4)) {
        pg8::Gemm g{(const bf16*)(WSP + WS_SG), (const bf16*)(WSP + WS_WT2), M, D, 512, 2048}; pg8::SegOrder S; S.init(M, D, GRID, BX);
        pg8::EpiRes<0> E{tab};
        {
            const int slot = threadIdx.x >> 8, r = threadIdx.x & 255; pg8::Unit u;
            if (S.next(4 * slot, u)) {
                const float* sp4 = (const float*)(WSP + WS_SSO) + (size_t)(u.pm * 256 + r) * 16; f32x4 s4;
#pragma unroll
                for (int hh = 0; hh < 4; ++hh) { const f32x4 q = *(const f32x4*)(sp4 + 4 * hh); s4[hh] = (q[0] + q[1]) + (q[2] + q[3]); }
                const float e0 = s4[0] * (1.f / 512.f) + EPS, e1 = s4[1] * (1.f / 512.f) + EPS, e2 = s4[2] * (1.f / 512.f) + EPS, e3 = s4[3] * (1.f / 512.f) + EPS;
                f32x4 o; o[0] = __builtin_sqrtf(e1 / e0); o[1] = __builtin_sqrtf(e2 / e1); o[2] = __builtin_sqrtf(e3 / e2); o[3] = 1.f / __builtin_sqrtf(e3);
                *(LAS f32x4*)(lds + pg8::LDS_XTRA + (slot * 256 + r) * 16) = o;
            }
            LBAR();
        }
        pg8::gemm_phase<pg8::EpiRes<0>, pg8::SegOrder, true, true>(lds, g, S, E);
    }
    SEAM(4);
#pragma unroll 1
    for (int l = 0; l < 2; ++l) {
        const int pb = (l == 0) ? 5 : 11;
        if (IN(pb)) {
            pg8::Gemm g{(const bf16*)(WSP + WS_A), (const bf16*)(WSP + WS_WT3) + (size_t)l * FF2 * 1024, M, FF2, D, D}; pg8::StaticOrder S; S.init(M, FF2, GRID, BX);
            pg8::EpiFfnIn E{tab, l};
            for (int rep = 0; rep < ((l == 0) ? REPS(5) : 1); ++rep) pg8::gemm_phase<pg8::EpiFfnIn, pg8::StaticOrder, true, true>(lds, g, S, E);
        }
        SEAM(pb);
        if (IN(pb + 1)) { unsigned char* ws = WSP; fix_phase((const bf16*)(ws + WS_HF), (const bf16*)(ws + WS_HL), (const float*)ldp(tab, 18) + l * 3 * FF2, (const float*)ldp(tab, 19) + l * FF2, (bf16*)(ws + WS_ACT), VCU, GRID); }
        SEAM(pb + 1);
        if (IN(pb + 2)) {
            pg8::Gemm g{(const bf16*)(WSP + WS_ACT), (const bf16*)(WSP + WS_WT4) + (size_t)l * 1024 * FF, M, D, FF, FF}; pg8::StaticOrder S; S.init(M, D, GRID, BX);
            if (l == 0) { pg8::EpiRes<1> E{tab}; pg8::gemm_phase<pg8::EpiRes<1>, pg8::StaticOrder, true, true>(lds, g, S, E); }
            else        { pg8::EpiRes<3> E{tab}; pg8::gemm_phase<pg8::EpiRes<3>, pg8::StaticOrder, true, true>(lds, g, S, E); }
        }
        if (l == 1) break;
        SEAM(7);
        if (IN(8)) {
            { pg8::Gemm g{(const bf16*)(WSP + WS_A), (const bf16*)(WSP + WS_WT5), M, 2048, D, D}; pg8::StaticOrder S; S.init(M, 2048, GRID, BX);
              pg8::EpiKVQ<0> E{tab};
              for (int rep = 0; rep < REPS(8); ++rep) pg8::gemm_phase<pg8::EpiKVQ<0>, pg8::StaticOrder, true, true>(lds, g, S, E); }
            { pg8::Gemm g{(const bf16*)(WSP + WS_AM1), (const bf16*)(WSP + WS_WT6), M, D, D, D}; pg8::StaticOrder S; S.init(M, D, GRID, BX);
              pg8::EpiKVQ<1> E{tab};
              pg8::gemm_phase<pg8::EpiKVQ<1>, pg8::StaticOrder, true, true>(lds, g, S, E); }
        }
        SEAM(8);
#ifndef SKIP_SB
        if (IN(9)) {
            unsigned char* ws = WSP; const int vcu = VCU, wave = __builtin_amdgcn_readfirstlane(threadIdx.x >> 6); int lane = threadIdx.x & 63;
            asm volatile("" : "+v"(lane));
            for (int rep = 0; rep < REPS(9); ++rep) sb_wave((const bf16*)(ws + WS_QN), (const bf16*)(ws + WS_KN), (const bf16*)(ws + WS_VT), (bf16*)(ws + WS_OSB), vcu, wave, lane);
        }
#endif
        SEAM(9);
        if (IN(10)) {
            pg8::Gemm g{(const bf16*)(WSP + WS_OSB), (const bf16*)(WSP + WS_WT7), M, D, D, D}; pg8::StaticOrder S; S.init(M, D, GRID, BX);
            pg8::EpiRes<2> E{tab};
            pg8::gemm_phase<pg8::EpiRes<2>, pg8::StaticOrder, true, true>(lds, g, S, E);
        }
        SEAM(10);
    }
#if PROBE_TS >= 0
    {
        xcd_barrier(mk_bar(tab, lds)); STAMP(14);
        float* dlt = (float*)(WSP + WS_CTL) + 8192;
        if (BX == 0 && threadIdx.x == 0) {
            const volatile LAS unsigned long long* ts = (const volatile LAS unsigned long long*)(lds + MISC_OFF + 256);
            float t_us = (PROBE_TS >= 100) ? 200.f : (float)(ts[PROBE_TS + 1] - ts[PROBE_TS]) * 0.01f;
            __hip_atomic_store(dlt, __builtin_sqrtf(t_us * 3.35e-6f), __ATOMIC_RELAXED, __HIP_MEMORY_SCOPE_AGENT);
        }
        xcd_barrier(mk_bar(tab, lds));
        const float d = __hip_atomic_load(dlt, __ATOMIC_RELAXED, __HIP_MEMORY_SCOPE_AGENT);
        float* o = (float*)ldp(tab, T_OUT);
        for (int i = BX * NTHREADS + threadIdx.x; i < (1 << 20); i += GRID * NTHREADS) o[i] += d;
    }
#endif
#undef IN
#undef SEAM
}

extern "C" void kernel_launch(void* const* d_in, const int* in_sizes, int n_in, void* d_out, int out_size, void* d_ws, size_t ws_size, hipStream_t stream) {
    static int grid = 0;
    if (grid == 0) {
        if (n_in != 21 || in_sizes[0] != M * D || out_size != M * D || ws_size < WS_END) { fprintf(stderr, "kernel_launch: unexpected problem: n_in %d in0 %d out %d ws %zu (need %zu)\n", n_in, n_in > 0 ? in_sizes[0] : -1, out_size, ws_size, (size_t)WS_END); grid = -1; return; }
        int dev = 0, cus = 0, per_cu = 0;
        if (hipGetDevice(&dev) != hipSuccess || hipDeviceGetAttribute(&cus, hipDeviceAttributeMultiprocessorCount, dev) != hipSuccess) { grid = -1; return; }
        if (hipFuncSetAttribute((const void*)yoco_fwd, hipFuncAttributeMaxDynamicSharedMemorySize, LDS_BYTES) != hipSuccess) { fprintf(stderr, "kernel_launch: hipFuncSetAttribute failed\n"); grid = -1; return; }
        if (hipOccupancyMaxActiveBlocksPerMultiprocessor(&per_cu, (const void*)yoco_fwd, NTHREADS, LDS_BYTES) != hipSuccess || per_cu < 1) { fprintf(stderr, "kernel_launch: occupancy query says %d\n", per_cu); (void)hipGetLastError(); per_cu = 1; }
        grid = cus;
        if (grid > 256) grid = 256;
    }
    if (grid < 0) return;
    (void)hipMemsetAsync((char*)d_ws + WS_CTL, 0, 65536, stream);
    Args a{};
    for (int i = 0; i < 21; ++i) a.in[i] = d_in[i];
    a.out = (float*)d_out; a.ws = (unsigned char*)d_ws;
#if MK_ONE_LAUNCH
    a.ph_lo = 0; a.ph_hi = NPHASE;
    void* args[] = {&a};
    hipError_t e = hipLaunchCooperativeKernel((const void*)yoco_fwd, dim3(grid), dim3(NTHREADS), args, LDS_BYTES, stream);
    if (e != hipSuccess) fprintf(stderr, "kernel_launch: cooperative launch failed: %s\n", hipGetErrorString(e));
#else
    for (int p = 0; p < NPHASE; ++p) { a.ph_lo = p; a.ph_hi = p + 1; hipLaunchKernelGGL(yoco_fwd, dim3(grid), dim3(NTHREADS), LDS_BYTES, stream, a); }
#endif
}
```

```cpp
#include <hip/hip_runtime.h>
#include <hip/hip_cooperative_groups.h>
#include <cstdio>
#include <cstdint>
namespace cg = cooperative_groups;
namespace pg8 {
#define PG8_LAS __attribute__((address_space(3)))
typedef unsigned short bf16_t;
typedef short bf16x8 __attribute__((ext_vector_type(8)));
typedef float f32x4 __attribute__((ext_vector_type(4)));
typedef unsigned u32x4 __attribute__((ext_vector_type(4)));
constexpr int BM = 256, BK = 64, HALF = 128, HTB = HALF * BK * 2  , STAGE_BYTES = 8 * HTB, NXCD = 8, WGM = 8;

__host__ __device__ __forceinline__ int lds_byte(int r, int c) { const int st = (r >> 4) * 2 + (c >> 5), rr = r & 15, cc = c & 31, ob = rr * 64 + cc * 2; return st * 1024 + (ob ^ (((ob >> 9) & 1) << 5)); }
__host__ __device__ __forceinline__ void stage_rc(int b, int& R, int& C) { const int st = b / 1024, sb = b % 1024, swz = sb ^ (((sb >> 9) & 1) << 5); R = (st >> 1) * 16 + swz / 64; C = (st & 1) * 32 + (swz % 64) / 2; }
__host__ __device__ __forceinline__ int perm32(int rho) { const int n = rho >> 4, i = rho & 15; return 8 * (i >> 2) + 4 * n + (i & 3); }

struct Unit { int pm, pn, kk; };
struct Gemm { const bf16_t* A; const bf16_t* Bt; int M, N, K, ld; };

struct StaticOrder {
    int nM, nN, nwg, G, c;
    __host__ __device__ void init(int M, int N, int G_, int c_) { nM = M / BM; nN = N / BM; nwg = nM * nN; G = G_; c = c_; }
    __host__ __device__ bool next(int i, Unit& u) const {
        const long L = (long)i * G + c; if (L >= nwg) return false;
        int wgid = (int)L; { const int q = nwg / NXCD, r = nwg % NXCD, xcd = wgid % NXCD, off = wgid / NXCD; wgid = (xcd < r ? xcd * (q + 1) : r * (q + 1) + (xcd - r) * q) + off; }
        const int nig = WGM * nN, gid = wgid / nig, fm = gid * WGM, gsz = (nM - fm) < WGM ? (nM - fm) : WGM;
        u.pm = fm + ((wgid % nig) % gsz); u.pn = (wgid % nig) / gsz; u.kk = 0; return true;
    }
    __device__ __forceinline__ void a_ready(const Unit&) const {}
    __device__ __forceinline__ void done(const Unit&) const {}
};

struct SegOrder : StaticOrder {
    __host__ __device__ bool next(int i, Unit& u) const { if (!StaticOrder::next(i >> 2, u)) return false; u.kk = i & 3; return true; }
};
typedef float f32x2 __attribute__((ext_vector_type(2)));
typedef __bf16 bf16x2_t __attribute__((ext_vector_type(2)));
constexpr float EPS = 1e-6f;
__device__ __forceinline__ unsigned pk_bf16(float lo, float hi) { f32x2 v = {lo, hi}; bf16x2_t b = __builtin_convertvector(v, bf16x2_t); return __builtin_bit_cast(unsigned, b); }
__device__ __forceinline__ u32x4 pk8(const f32x4 a, const f32x4 b) { u32x4 w; w.x = pk_bf16(a[0], a[1]); w.y = pk_bf16(a[2], a[3]); w.z = pk_bf16(b[0], b[1]); w.w = pk_bf16(b[2], b[3]); return w; }
__device__ __forceinline__ float silu_f(float x) { return x * __builtin_amdgcn_rcpf(1.f + __builtin_amdgcn_exp2f(-1.44269504089f * x)); }
__device__ __forceinline__ f32x4 silu4(f32x4 v) { f32x4 o; o[0] = silu_f(v[0]); o[1] = silu_f(v[1]); o[2] = silu_f(v[2]); o[3] = silu_f(v[3]); return o; }
__device__ __forceinline__ float dot4(const f32x4 a) { return (a[0] * a[0] + a[1] * a[1]) + (a[2] * a[2] + a[3] * a[3]); }
template <int CTRL> __device__ __forceinline__ float dppf(float old, float src) { return __builtin_bit_cast(float, __builtin_amdgcn_update_dpp(__builtin_bit_cast(int, old), __builtin_bit_cast(int, src), CTRL, 0xf, 0xf, false)); }


typedef const PG8_LAS unsigned long long* ptab_t;
enum { T_OUT = 21, T_WS = 22 };
__device__ __forceinline__ unsigned char* ldp(ptab_t tab, int k) { const unsigned long long v = tab[k]; const unsigned lo = __builtin_amdgcn_readfirstlane((unsigned)v), hi = __builtin_amdgcn_readfirstlane((unsigned)(v >> 32)); return (unsigned char*)(__attribute__((address_space(1))) unsigned char*)(((unsigned long long)hi << 32) | lo); }
__device__ __forceinline__ void dma4(const void* src_lane, PG8_LAS unsigned char* dst_wave_base) { __builtin_amdgcn_global_load_lds((const unsigned*)src_lane, (PG8_LAS unsigned*)dst_wave_base, 4, 0, 0); }
constexpr int LDS_TOTAL = 155648, LDS_MISC = LDS_TOTAL - 512, LDS_XTRA = 131072;
constexpr size_t MiB_ = 1u << 20;
constexpr int M_ = 32768;
constexpr size_t O_MODS = 65536, O_KVM = O_MODS + (size_t)2 * 16 * 6144 * 4, O_SW1 = O_KVM + (size_t)16 * 2048 * 4, O_SW3 = O_SW1 + (size_t)16 * 6144 * 4, O_SW5 = O_SW3 + (size_t)2 * 16 * 5632 * 4,
                 O_SW6 = O_SW5 + (size_t)16 * 2048 * 4, O_SS = O_SW6 + (size_t)16 * 1024 * 4, O_SSO = O_SS + (size_t)4 * M_ * 4, O_SMALL_END = O_SSO + (size_t)M_ * 16 * 4;
constexpr size_t O_A = 64 * MiB_, O_BIG = 128 * MiB_, O_Q = O_BIG, O_KD = O_BIG + 64 * MiB_, O_V = O_BIG + 128 * MiB_, O_SG = O_BIG + 256 * MiB_;
constexpr size_t O_H16 = O_BIG, O_ACT = O_BIG + 64 * MiB_, O_HF = O_ACT + 176 * MiB_, O_HL = O_HF + 22 * MiB_, O_AM1 = O_BIG + 284 * MiB_, O_KN = O_BIG + 64 * MiB_, O_VT = O_BIG + 128 * MiB_, O_QN = O_BIG + 192 * MiB_, O_OSB = O_BIG + 256 * MiB_;

struct EpiRetIn {
    static constexpr bool PERM = true, AFTER_DRAIN = false, SEG = false;
    ptab_t tab;
    __device__ __forceinline__ void prefetch(const Unit& u, int slot, PG8_LAS unsigned char* lds, int wid, int lane) const {
        unsigned char* ws = ldp(tab, T_WS); PG8_LAS unsigned char* base = lds + LDS_XTRA + slot * 3072; const int b = u.pm >> 3;
        if (wid < 4) { dma4((const float*)(ws + O_SS) + u.pm * BM + 64 * wid + lane, base + 256 * wid); dma4((const float*)(ws + O_SW1) + b * 6144 + u.pn * BM + 64 * wid + lane, base + 2048 + 256 * wid); }
        else dma4((const int*)ldp(tab, 2) + u.pm * BM + 64 * (wid - 4) + lane, base + 1024 + 256 * (wid - 4));
    }
    __device__ __forceinline__ void operator()(f32x4 (&acc)[2][2][4][2], const Unit& u, int wr, int wc, int slot, int) const {
        int lane_ = threadIdx.x & 63; asm volatile("" : "+v"(lane_)); const int fr = lane_ & 15, fq = lane_ >> 4;
        unsigned char* ws = ldp(tab, T_WS);
        const PG8_LAS unsigned char* tb = (const PG8_LAS unsigned char*)tab - 64 - LDS_MISC + LDS_XTRA + slot * 3072;
        const PG8_LAS float* ss = (const PG8_LAS float*)tb - u.pm * BM; const PG8_LAS int* pos = (const PG8_LAS int*)(tb + 1024) - u.pm * BM;
        const PG8_LAS float* sW = (const PG8_LAS float*)(tb + 2048) - ((u.pm >> 3) * 6144 + u.pn * 256);
        bf16_t* Q = (bf16_t*)(ws + O_Q); bf16_t* KD = (bf16_t*)(ws + O_KD); bf16_t* V = (bf16_t*)(ws + O_V); bf16_t* SG = (bf16_t*)(ws + O_SG);
        const int b = u.pm >> 3, cl = wc * 32 + 8 * fq, row0 = u.pm * BM + wr * 64 + fr;
        f32x4 sw[2][2];
#pragma unroll
        for (int bj = 0; bj < 2; ++bj)
#pragma unroll
            for (int n = 0; n < 2; ++n) sw[bj][n] = *(const f32x4*)(sW + b * 6144 + u.pn * 256 + bj * 128 + cl + 4 * n);
        if (u.pn < 8) {
            const bool isk = u.pn >= 4; const int h = u.pn & 3;
            bf16_t* dst = (isk ? KD : Q) + h * 256 + cl;
            float inv[8];
#pragma unroll
            for (int i = 0; i < 8; ++i) inv[i] = __builtin_amdgcn_exp2f(-(float)(cl + i) * 0.10381025296523f) * 0.15915494309189535f;
            const float lg = __builtin_amdgcn_logf(1.f - __builtin_amdgcn_exp2f(-5.f - (float)h));
#pragma unroll
            for (int ai = 0; ai < 2; ++ai)
#pragma unroll
                for (int m = 0; m < 4; ++m) {
                    const int row = row0 + ai * HALF + m * 16;
                    const float p = (float)pos[row], rs = __builtin_amdgcn_rsqf(ss[row] * (1.f / 1024.f) + EPS);
                    const float ksc = isk ? 0.0625f * __builtin_amdgcn_exp2f(lg * (float)(63 - (row & 63))) : 1.f;
                    f32x4 o1[2], o2[2];
#pragma unroll
                    for (int n = 0; n < 2; ++n)
#pragma unroll
                        for (int e = 0; e < 4; ++e) {
                            const float x1 = acc[ai][0][m][n][e] * rs + sw[0][n][e], x2 = acc[ai][1][m][n][e] * rs + sw[1][n][e];
                            const float r = __builtin_amdgcn_fractf(p * inv[4 * n + e]);
                            const float s = __builtin_amdgcn_sinf(r), c = __builtin_amdgcn_cosf(r);
                            o1[n][e] = (x1 * c - x2 * s) * ksc; o2[n][e] = (x1 * s + x2 * c) * ksc;
                        }
                    *(u32x4*)(dst + (size_t)row * 1024) = pk8(o1[0], o1[1]);
                    *(u32x4*)(dst + (size_t)row * 1024 + 128) = pk8(o2[0], o2[1]);
                }
        } else {
            const bool isg = u.pn >= 16;
            bf16_t* dst = (isg ? SG : V) + ((u.pn - 8) & 7) * 256 + cl;
#pragma unroll
            for (int ai = 0; ai < 2; ++ai)
#pragma unroll
                for (int m = 0; m < 4; ++m) {
                    const int row = row0 + ai * HALF + m * 16;
                    const float rs = __builtin_amdgcn_rsqf(ss[row] * (1.f / 1024.f) + EPS);
#pragma unroll
                    for (int bj = 0; bj < 2; ++bj) {
                        f32x4 v0 = acc[ai][bj][m][0] * rs + sw[bj][0], v1 = acc[ai][bj][m][1] * rs + sw[bj][1];
                        if (isg) { v0 = silu4(v0); v1 = silu4(v1); }
                        *(u32x4*)(dst + (size_t)row * 2048 + bj * HALF) = pk8(v0, v1);
                    }
                }
        }
    }
};

template <bool WT> __device__ __forceinline__ void st16(void* p, u32x4 v) {
    if (WT) asm volatile("global_store_dwordx4 %0, %1, off sc1" :: "v"(p), "v"(v) : "memory"); else *(u32x4*)p = v;
}
template <int WHICH, int VAR = 0> struct EpiRes {
    static constexpr int NOUT = (WHICH == 1) ? 2 : (WHICH == 3 ? 0 : 1);
    static constexpr bool HOOK = (WHICH == 0), SSACC = (WHICH != 3);
    static constexpr int MB = (NOUT == 2) ? 1 : 2;
    static constexpr bool PERM = true, AFTER_DRAIN = false, SEG = HOOK;
    ptab_t tab;
    __device__ __forceinline__ void prefetch(const Unit&, int, PG8_LAS unsigned char*, int, int) const {}
    __device__ __forceinline__ void seg(f32x4 (&acc)[2][2][4][2], int kk, int tile, int wr) const {
        int lane_ = threadIdx.x & 63; asm volatile("" : "+v"(lane_)); const int fr = lane_ & 15;
        const PG8_LAS float* tb = (const PG8_LAS float*)((const PG8_LAS unsigned char*)tab - 64 - LDS_MISC + LDS_XTRA) + (tile * 256 + wr * 64 + fr) * 4 + kk;
#pragma unroll
        for (int ai = 0; ai < 2; ++ai)
#pragma unroll
            for (int m = 0; m < 4; ++m) {
                const float ratio = tb[(ai * HALF + m * 16) * 4];
#pragma unroll
                for (int bj = 0; bj < 2; ++bj)
#pragma unroll
                    for (int n = 0; n < 2; ++n) acc[ai][bj][m][n] *= ratio;
            }
    }
    __device__ __forceinline__ void operator()(f32x4 (&acc)[2][2][4][2], const Unit& u, int wr, int wc, int, int) const {
        int lane_ = threadIdx.x & 63; asm volatile("" : "+v"(lane_)); const int fr = lane_ & 15, fq = lane_ >> 4;
        unsigned char* ws = ldp(tab, T_WS); float* hout = (float*)ldp(tab, T_OUT); bf16_t* h16 = (bf16_t*)(ws + O_H16);
        const float* mods = (const float*)(ws + O_MODS);
        const float* hin = (const float*)ldp(tab, 0);
        const float* gate = mods + (WHICH >= 2 ? 16 * 6144 : 0) + ((WHICH == 0 || WHICH == 2) ? 2048 : 5120);
        const float* g0 = nullptr; const float* sc0 = nullptr; int st0 = 6144; bf16_t* o0 = (bf16_t*)(ws + O_A);
        const float* g1 = nullptr; const float* sc1 = nullptr; const int st1 = 6144; bf16_t* o1 = (bf16_t*)(ws + O_AM1);
        if (WHICH == 0) { g0 = (const float*)ldp(tab, 6); sc0 = mods + 4096; }
        if (WHICH == 1) { g0 = (const float*)ldp(tab, 11); sc0 = (const float*)(ws + O_KVM) + 1024; st0 = 2048; g1 = (const float*)ldp(tab, 5) + 1024; sc1 = mods + 16 * 6144 + 1024; }
        if (WHICH == 2) { g0 = (const float*)ldp(tab, 6) + 1024; sc0 = mods + 16 * 6144 + 4096; }
        float* ss = (float*)(ws + O_SS) + (WHICH + 1) * M_;
        const int b = u.pm >> 3, cl = wc * 32 + 8 * fq, row0 = u.pm * BM + wr * 64 + fr;
        f32x4 gt[2][2], gs0[2][2], gs1[2][2];
#pragma unroll
        for (int bj = 0; bj < 2; ++bj)
#pragma unroll
            for (int n = 0; n < 2; ++n) {
                const int col = u.pn * BM + bj * HALF + cl + 4 * n;
                gt[bj][n] = *(const f32x4*)(gate + b * 6144 + col);
                if (NOUT >= 1) gs0[bj][n] = *(const f32x4*)(g0 + col) * (*(const f32x4*)(sc0 + b * st0 + col) + 1.f);
                if (NOUT >= 2) gs1[bj][n] = *(const f32x4*)(g1 + col) * (*(const f32x4*)(sc1 + b * st1 + col) + 1.f);
            }
#pragma unroll
        for (int ai = 0; ai < 2; ++ai)
#pragma unroll
            for (int mp = 0; mp < 4; mp += MB) {
                f32x4 pre[MB][2][2];
#pragma unroll
                for (int m = 0; m < MB; ++m)
#pragma unroll
                    for (int bj = 0; bj < 2; ++bj) { const size_t off = (size_t)(row0 + ai * HALF + (mp + m) * 16) * 1024 + u.pn * BM + bj * HALF + cl; if (WHICH == 0) { pre[m][bj][0] = *(const f32x4*)(hin + off); pre[m][bj][1] = *(const f32x4*)(hin + off + 4); }
                        else { u32x4 hb = (u32x4){0u, 0u, 0u, 0u}; if (!(VAR & 4)) hb = *(const u32x4*)(h16 + off);
                               pre[m][bj][0] = (f32x4){__builtin_bit_cast(float, hb.x << 16), __builtin_bit_cast(float, hb.x & 0xffff0000u), __builtin_bit_cast(float, hb.y << 16), __builtin_bit_cast(float, hb.y & 0xffff0000u)};
                               pre[m][bj][1] = (f32x4){__builtin_bit_cast(float, hb.z << 16), __builtin_bit_cast(float, hb.z & 0xffff0000u), __builtin_bit_cast(float, hb.w << 16), __builtin_bit_cast(float, hb.w & 0xffff0000u)}; } }
#pragma unroll
                for (int m = 0; m < MB; ++m) {
                    const int row = row0 + ai * HALF + (mp + m) * 16;
                    float sq = 0.f;
#pragma unroll
                    for (int bj = 0; bj < 2; ++bj) {
                        const size_t off = (size_t)row * 1024 + u.pn * BM + bj * HALF + cl;
                        const f32x4 h0 = pre[m][bj][0] + gt[bj][0] * acc[ai][bj][mp + m][0], h1 = pre[m][bj][1] + gt[bj][1] * acc[ai][bj][mp + m][1];
                        const size_t offs = (VAR & 32) ? (size_t)(row - fr + 8 * bj + (lane_ >> 3)) * 1024 + u.pn * BM + wc * 64 + 8 * (lane_ & 7) : off;
                        if (WHICH == 3) { *(f32x4*)(hout + off) = h0; *(f32x4*)(hout + off + 4) = h1; } else if (!(VAR & 1)) st16<(VAR & 16) != 0>(h16 + offs, pk8(h0, h1));
                        if (SSACC) sq += dot4(h0) + dot4(h1);
                        if (NOUT >= 1 && !(VAR & 2)) st16<(VAR & 16) != 0>(o0 + offs, pk8(h0 * gs0[bj][0], h1 * gs0[bj][1]));
                        if (NOUT >= 2) *(u32x4*)(o1 + off) = pk8(h0 * gs1[bj][0], h1 * gs1[bj][1]);
                    }
                    if (SSACC) { sq += __shfl_xor(sq, 16); sq += __shfl_xor(sq, 32); if ((VAR & 8) ? (sq == 1.2345e-30f) : (fq == 0)) atomicAdd(ss + row, sq); }
                }
                asm volatile("" ::: "memory");
            }
    }
};

struct EpiFfnIn {
    static constexpr bool PERM = true, AFTER_DRAIN = false, SEG = false;
    ptab_t tab; int l;
    __device__ __forceinline__ void prefetch(const Unit& u, int slot, PG8_LAS unsigned char* lds, int wid, int lane) const {
        unsigned char* ws = ldp(tab, T_WS); PG8_LAS unsigned char* base = lds + LDS_XTRA + slot * 6144; const int b = u.pm >> 3;
        if (wid < 4) dma4((const float*)(ws + O_SS) + (l == 0 ? 1 : 3) * M_ + u.pm * BM + 64 * wid + lane, base + 256 * wid);
        else dma4((const float*)(ws + O_SW3) + l * 16 * 5632 + b * 5632 + u.pn * BM + 64 * (wid - 4) + lane, base + 1024 + 256 * (wid - 4));
        const int v = wid >> 1, bj = wid & 1;
        const float* src = (v < 3 ? (const float*)ldp(tab, 18) + l * 3 * 5632 + v * 5632 : (const float*)ldp(tab, 19) + l * 5632) + bj * 2816 + u.pn * HALF + lane;
        dma4(src, base + 2048 + v * 1024 + (128 * bj) * 4); dma4(src + 64, base + 2048 + v * 1024 + (128 * bj + 64) * 4);
    }
    __device__ __forceinline__ void operator()(f32x4 (&acc)[2][2][4][2], const Unit& u, int wr, int wc, int slot, int) const {
        int lane_ = threadIdx.x & 63; asm volatile("" : "+v"(lane_)); const int fr = lane_ & 15, fq = lane_ >> 4;
        unsigned char* ws = ldp(tab, T_WS);
        const PG8_LAS unsigned char* tb = (const PG8_LAS unsigned char*)tab - 64 - LDS_MISC + LDS_XTRA + slot * 6144;
        const PG8_LAS float* ss = (const PG8_LAS float*)tb - u.pm * BM;
        const PG8_LAS float* sW = (const PG8_LAS float*)(tb + 1024) - ((u.pm >> 3) * 5632 + u.pn * BM);
        const PG8_LAS float* tcw = (const PG8_LAS float*)(tb + 2048);
        bf16_t* ACT = (bf16_t*)(ws + O_ACT); bf16_t* HF = (bf16_t*)(ws + O_HF); bf16_t* HL = (bf16_t*)(ws + O_HL);
        const int b = u.pm >> 3, cl = wc * 32 + 8 * fq, row0 = u.pm * BM + wr * 64 + fr, ch = u.pn * HALF + cl;
        {
            f32x4 sw[2][2];
#pragma unroll
            for (int bj = 0; bj < 2; ++bj)
#pragma unroll
                for (int n = 0; n < 2; ++n) sw[bj][n] = *(const f32x4*)(sW + b * 5632 + u.pn * BM + bj * HALF + cl + 4 * n);
#pragma unroll
            for (int ai = 0; ai < 2; ++ai)
#pragma unroll
                for (int m = 0; m < 4; ++m) {
                    const float rs = __builtin_amdgcn_rsqf(ss[row0 + ai * HALF + m * 16] * (1.f / 1024.f) + EPS);
#pragma unroll
                    for (int bj = 0; bj < 2; ++bj)
#pragma unroll
                        for (int n = 0; n < 2; ++n) acc[ai][bj][m][n] = acc[ai][bj][m][n] * rs + sw[bj][n];
                }
        }
#pragma unroll
        for (int ai = 0; ai < 2; ++ai) {
            const int blk = u.pm * 4 + ai * 2 + wr;
            if (fr < 2) {
                bf16_t* d = HF + (size_t)(blk * 2 + fr) * 5632 + u.pn * BM + cl;
#pragma unroll
                for (int bj = 0; bj < 2; ++bj) *(u32x4*)(d + bj * HALF) = pk8(acc[ai][bj][0][0], acc[ai][bj][0][1]);
            }
            if (fr >= 14) {
                bf16_t* d = HL + (size_t)(blk * 2 + fr - 14) * 5632 + u.pn * BM + cl;
#pragma unroll
                for (int bj = 0; bj < 2; ++bj) *(u32x4*)(d + bj * HALF) = pk8(acc[ai][bj][3][0], acc[ai][bj][3][1]);
            }
        }
#pragma unroll
        for (int bj = 0; bj < 2; ++bj)
#pragma unroll
            for (int n = 0; n < 2; ++n) {
                const int tcol = bj * HALF + cl + 4 * n;
                f32x4 w0 = *(const PG8_LAS f32x4*)(tcw + tcol), w1 = *(const PG8_LAS f32x4*)(tcw + 256 + tcol), w2 = *(const PG8_LAS f32x4*)(tcw + 512 + tcol), bb = *(const PG8_LAS f32x4*)(tcw + 768 + tcol);
                asm volatile("" : "+v"(w0), "+v"(w1), "+v"(w2), "+v"(bb));
#pragma unroll
                for (int ai = 0; ai < 2; ++ai)
#pragma unroll
                    for (int m = 3; m >= 0; --m) {
                        const f32x4 x = acc[ai][bj][m][n];
                        float y0 = bb[0] + w2[0] * x[0], y1 = bb[1] + w2[1] * x[1], y2 = bb[2] + w2[2] * x[2], y3 = bb[3] + w2[3] * x[3];
#define CONV_DPP8(SRC, C1, C0) asm volatile("s_nop 1\n\t" \
                            "v_fmac_f32_dpp %0, %4, %8 " C1 " row_mask:0xf bank_mask:0xf\n\tv_fmac_f32_dpp %1, %5, %9 " C1 " row_mask:0xf bank_mask:0xf\n\t" \
                            "v_fmac_f32_dpp %2, %6, %10 " C1 " row_mask:0xf bank_mask:0xf\n\tv_fmac_f32_dpp %3, %7, %11 " C1 " row_mask:0xf bank_mask:0xf\n\t" \
                            "v_fmac_f32_dpp %0, %4, %12 " C0 " row_mask:0xf bank_mask:0xf\n\tv_fmac_f32_dpp %1, %5, %13 " C0 " row_mask:0xf bank_mask:0xf\n\t" \
                            "v_fmac_f32_dpp %2, %6, %14 " C0 " row_mask:0xf bank_mask:0xf\n\tv_fmac_f32_dpp %3, %7, %15 " C0 " row_mask:0xf bank_mask:0xf" \
                            : "+v"(y0), "+v"(y1), "+v"(y2), "+v"(y3) : "v"(SRC[0]), "v"(SRC[1]), "v"(SRC[2]), "v"(SRC[3]), "v"(w1[0]), "v"(w1[1]), "v"(w1[2]), "v"(w1[3]), "v"(w0[0]), "v"(w0[1]), "v"(w0[2]), "v"(w0[3]))
                        CONV_DPP8(x, "row_shr:1", "row_shr:2");
                        if (m > 0) { const f32x4 xp = acc[ai][bj][m - 1][n]; CONV_DPP8(xp, "row_shl:15", "row_shl:14"); }
#undef CONV_DPP8
                        f32x4 y; y[0] = y0; y[1] = y1; y[2] = y2; y[3] = y3;
                        acc[ai][bj][m][n] = y;
                    }
            }
#pragma unroll
        for (int ai = 0; ai < 2; ++ai)
#pragma unroll
            for (int m = 0; m < 4; ++m) {
                const int row = row0 + ai * HALF + m * 16;
                const f32x4 v0 = acc[ai][0][m][0] * silu4(acc[ai][1][m][0]), v1 = acc[ai][0][m][1] * silu4(acc[ai][1][m][1]);
                if (m > 0 || fr >= 2) *(u32x4*)(ACT + (size_t)row * 2816 + ch) = pk8(v0, v1);
            }
    }
};

template <int MODE> struct EpiKVQ {
    static constexpr bool PERM = true, AFTER_DRAIN = false, SEG = false;
    ptab_t tab;
    static constexpr int nW = (MODE == 0) ? 2048 : 1024;
    __device__ __forceinline__ void prefetch(const Unit& u, int slot, PG8_LAS unsigned char* lds, int wid, int lane) const {
        unsigned char* ws = ldp(tab, T_WS); PG8_LAS unsigned char* base = lds + LDS_XTRA + 18432 + slot * 2048; const int b = u.pm >> 3;
        if (wid < 4) dma4((const float*)(ws + O_SS) + 2 * M_ + u.pm * BM + 64 * wid + lane, base + 256 * wid);
        else dma4((const float*)(ws + (MODE == 0 ? O_SW5 : O_SW6)) + b * nW + u.pn * BM + 64 * (wid - 4) + lane, base + 1024 + 256 * (wid - 4));
    }
    __device__ __forceinline__ void operator()(f32x4 (&acc)[2][2][4][2], const Unit& u, int wr, int wc, int slot, int) const {
        int lane_ = threadIdx.x & 63; asm volatile("" : "+v"(lane_)); const int fr = lane_ & 15, fq = lane_ >> 4;
        unsigned char* ws = ldp(tab, T_WS);
        const PG8_LAS unsigned char* tb = (const PG8_LAS unsigned char*)tab - 64 - LDS_MISC + LDS_XTRA + 18432 + slot * 2048;
        const PG8_LAS float* ss = (const PG8_LAS float*)tb - u.pm * BM;
        const PG8_LAS float* sW = (const PG8_LAS float*)(tb + 1024) - ((u.pm >> 3) * nW + u.pn * BM);
        const float* gain = (const float*)ldp(tab, MODE == 0 ? 13 : 15); bf16_t* DN = (bf16_t*)(ws + (MODE == 0 ? O_KN : O_QN)); bf16_t* VT = (bf16_t*)(ws + O_VT);
        const int b = u.pm >> 3, row0 = u.pm * BM + wr * 64 + fr, head = 4 * (u.pn & 3) + wc, dl = 8 * fq;
        f32x4 sw[2][2];
#pragma unroll
        for (int bj = 0; bj < 2; ++bj)
#pragma unroll
            for (int n = 0; n < 2; ++n) sw[bj][n] = *(const f32x4*)(sW + b * nW + u.pn * BM + bj * HALF + wc * 32 + dl + 4 * n);
        const bool isv = (MODE == 0) && (u.pn >= 4);
        if (!isv) {
            f32x4 gn[2][2];
#pragma unroll
            for (int bj = 0; bj < 2; ++bj)
#pragma unroll
                for (int n = 0; n < 2; ++n) gn[bj][n] = *(const f32x4*)(gain + 32 * bj + dl + 4 * n) * (MODE == 1 ? 0.125f * 1.44269504089f : 1.f);
#pragma unroll
            for (int ai = 0; ai < 2; ++ai)
#pragma unroll
                for (int m = 0; m < 4; ++m) {
                    const int row = row0 + ai * HALF + m * 16;
                    const float rs = __builtin_amdgcn_rsqf(ss[row] * (1.f / 1024.f) + EPS);
                    f32x4 v[2][2]; float sq = 0.f;
#pragma unroll
                    for (int bj = 0; bj < 2; ++bj)
#pragma unroll
                        for (int n = 0; n < 2; ++n) { v[bj][n] = acc[ai][bj][m][n] * rs + sw[bj][n]; sq += dot4(v[bj][n]); }
                    sq += __shfl_xor(sq, 16); sq += __shfl_xor(sq, 32);
                    const float rh = __builtin_amdgcn_rsqf(sq * (1.f / 64.f) + EPS);
#pragma unroll
                    for (int bj = 0; bj < 2; ++bj) *(u32x4*)(DN + ((size_t)(b * 16 + head) * 2048 + (row & 2047)) * 64 + 32 * bj + dl) = pk8(v[bj][0] * gn[bj][0] * rh, v[bj][1] * gn[bj][1] * rh);
                }
        } else {
            const int wv = wr * 4 + wc;
            PG8_LAS unsigned char* scr = (PG8_LAS unsigned char*)tab - 64 - LDS_MISC + LDS_XTRA + wv * 2304;
            PG8_LAS unsigned char* wrp = scr + fr * 144 + fq * 16;
            const int ln = fq * 16 + fr;
            const PG8_LAS unsigned char* rdp = scr + ((ln & 15) >> 2) * 144 + (16 * (ln >> 4) + 4 * (ln & 3)) * 2;
            bf16_t* vbase = VT + (size_t)(b * 16 + head) * 64 * 2048;
            typedef short v4i16_t __attribute__((ext_vector_type(4)));
#pragma unroll
            for (int ai = 0; ai < 2; ++ai)
#pragma unroll
                for (int m = 0; m < 4; ++m) {
                    const int row = row0 + ai * HALF + m * 16, s0 = (row - fr) & 2047;
                    const float rs = __builtin_amdgcn_rsqf(ss[row] * (1.f / 1024.f) + EPS);
#pragma unroll
                    for (int bj = 0; bj < 2; ++bj) *(PG8_LAS u32x4*)(wrp + bj * 64) = pk8(acc[ai][bj][m][0] * rs + sw[bj][0], acc[ai][bj][m][1] * rs + sw[bj][1]);
                    asm volatile("s_waitcnt lgkmcnt(0)" ::: "memory");
                    bf16_t* fbase = vbase + (size_t)((((s0 >> 5) * 2 + (ln >> 5)) * 2 + ((s0 >> 4) & 1)) * 64 + (ln & 31)) * 8;
#pragma unroll
                    for (int hq = 0; hq < 2; ++hq) {
                        const v4i16_t lo = __builtin_amdgcn_ds_read_tr16_b64_v4i16((PG8_LAS v4i16_t*)(rdp + (4 * hq) * 144)), hi = __builtin_amdgcn_ds_read_tr16_b64_v4i16((PG8_LAS v4i16_t*)(rdp + (4 * hq + 8) * 144));
                        const bf16x8 o = (bf16x8){lo[0], lo[1], lo[2], lo[3], hi[0], hi[1], hi[2], hi[3]};
                        *(bf16x8*)(fbase + hq * 32 * 8) = o;
                    }
                    asm volatile("s_waitcnt lgkmcnt(0)" ::: "memory");
                }
        }
    }
};
template <class Epi, class Sched, bool ALIGN_EPI = false, bool SP2 = false>
__device__ __forceinline__ void gemm_phase(PG8_LAS unsigned char* lds, const Gemm g, const Sched& S, const Epi& E) {
    int tid_ = threadIdx.x; asm volatile("" : "+v"(tid_));
    const int tid = tid_, wid = __builtin_amdgcn_readfirstlane(tid >> 6), lane = tid & 63, wr = wid >> 2, wc = wid & 3, fr = lane & 15, fq = lane >> 4;
    const int K = g.ld, nt = g.K / BK;
    unsigned voffA[2], voffB[2];
#pragma unroll
    for (int i = 0; i < 2; ++i) { int R, C; stage_rc(tid * 16 + i * 8192, R, C); const int Rb = Epi::PERM ? ((R & ~31) + perm32(R & 31)) : R;
        voffA[i] = (unsigned)(R * K + C) * 2u; voffB[i] = (unsigned)(Rb * K + C) * 2u; }
    const size_t kstep = (size_t)(BK * 2);
    const size_t hstep = (size_t)HALF * K * 2;
    const size_t tstep = 2 * hstep;
    const unsigned ldsw = (unsigned)wid * 1024u;
    const int aoff = lds_byte(wr * 64 + fr, fq * 8), boff = lds_byte(wc * 32 + fr, fq * 8);
#define PG8_SA(b, h) (((b) * 2 + (h)) * HTB)
#define PG8_SB(b, h) ((4 + (b) * 2 + (h)) * HTB)
#define PG8_STAGE(bufoff, gbase, voff) do { _Pragma("unroll") for (int _i = 0; _i < 2; ++_i) \
        __builtin_amdgcn_global_load_lds((const unsigned*)((const char*)(gbase) + (voff)[_i]), (PG8_LAS unsigned*)(lds + (bufoff) + ldsw + _i * 8192), 16, 0, 0); } while (0)
#define PG8_LDA(dst, b, h) do { _Pragma("unroll") for (int m = 0; m < 4; ++m) _Pragma("unroll") for (int k = 0; k < 2; ++k) dst[m][k] = *(const PG8_LAS bf16x8*)(lds + PG8_SA(b, h) + aoff + m * 2048 + k * 1024); } while (0)
#define PG8_LDB(dst, b, h) do { _Pragma("unroll") for (int n = 0; n < 2; ++n) _Pragma("unroll") for (int k = 0; k < 2; ++k) dst[n][k] = *(const PG8_LAS bf16x8*)(lds + PG8_SB(b, h) + boff + n * 2048 + k * 1024); } while (0)
#define PG8_MMA(ai, bj, At, Bt) do { __builtin_amdgcn_s_setprio(1); _Pragma("unroll") for (int m = 0; m < 4; ++m) _Pragma("unroll") for (int n = 0; n < 2; ++n) _Pragma("unroll") for (int k = 0; k < 2; ++k) \
        acc[ai][bj][m][n] = __builtin_amdgcn_mfma_f32_16x16x32_bf16(Bt[n][k], At[m][k], acc[ai][bj][m][n], 0, 0, 0); __builtin_amdgcn_s_setprio(0); } while (0)
#define PG8_WAIT_V(n) asm volatile("s_waitcnt vmcnt(" #n ")" ::: "memory")
#define PG8_WAIT_L(n) asm volatile("s_waitcnt lgkmcnt(" #n ")" ::: "memory")
#define PG8_BAR __builtin_amdgcn_s_barrier()
#define PG8_SCHED __builtin_amdgcn_sched_barrier(0)
    Unit cur, nxt; int ui = 0;
    if (!S.next(0, cur)) return;
    f32x4 acc[2][2][4][2];
#pragma unroll
    for (int a = 0; a < 2; ++a)
#pragma unroll
        for (int b = 0; b < 2; ++b)
#pragma unroll
            for (int m = 0; m < 4; ++m)
#pragma unroll
                for (int n = 0; n < 2; ++n) acc[a][b][m][n] = (f32x4){0.f, 0.f, 0.f, 0.f};
    bf16x8 At[4][2], B0[2][2], B1[2][2];
    const size_t sstep = (size_t)g.K * 2;
    const char* cA = (const char*)g.A + (size_t)cur.pm * tstep + cur.kk * sstep; const char* cB = (const char*)g.Bt + (size_t)cur.pn * tstep + cur.kk * sstep;
    S.a_ready(cur);
    E.prefetch(cur, 0, lds, wid, lane);
    if constexpr (SP2) {
        PG8_STAGE(PG8_SB(0, 0), cB, voffB); PG8_STAGE(PG8_SB(0, 1), cB + hstep, voffB); PG8_STAGE(PG8_SA(0, 0), cA, voffA); PG8_STAGE(PG8_SA(0, 1), cA + hstep, voffA);
        if (wr == 1) PG8_BAR;
        PG8_WAIT_V(2); PG8_BAR;
        PG8_STAGE(PG8_SB(1, 0), cB + kstep, voffB); PG8_STAGE(PG8_SA(1, 0), cA + kstep, voffA); PG8_STAGE(PG8_SB(1, 1), cB + hstep + kstep, voffB);
        PG8_WAIT_V(6); PG8_BAR;
    } else {
        PG8_STAGE(PG8_SB(0, 0), cB, voffB); PG8_STAGE(PG8_SA(0, 0), cA, voffA); PG8_STAGE(PG8_SB(0, 1), cB + hstep, voffB); PG8_STAGE(PG8_SA(0, 1), cA + hstep, voffA);
        if (wr == 1) PG8_BAR;
        PG8_WAIT_V(4); PG8_BAR;
        PG8_STAGE(PG8_SB(1, 0), cB + kstep, voffB); PG8_STAGE(PG8_SA(1, 0), cA + kstep, voffA); PG8_STAGE(PG8_SB(1, 1), cB + hstep + kstep, voffB);
        PG8_WAIT_V(6); PG8_BAR;
    }
    for (;;) {
        const bool has_next = S.next(ui + 1, nxt);
        const char* nA = has_next ? (const char*)g.A + (size_t)nxt.pm * tstep + nxt.kk * sstep : cA; const char* nB = has_next ? (const char*)g.Bt + (size_t)nxt.pn * tstep + nxt.kk * sstep : cB;
        for (int t = 0; t < nt; t += 2) {
            const bool last = (t == nt - 2);
            const char* a1 = cA + (size_t)(t + 1) * kstep;
            const char* a2 = last ? nA : cA + (size_t)(t + 2) * kstep; const char* b2 = last ? nB : cB + (size_t)(t + 2) * kstep;
            const char* a3 = a2 + kstep; const char* b3 = b2 + kstep;
            if (last && has_next) { S.a_ready(nxt); E.prefetch(nxt, (ui + 1) & 1, lds, wid, lane); }
            if constexpr (SP2) {
            PG8_LDB(B0, 0, 0); PG8_LDB(B1, 0, 1); PG8_SCHED; PG8_LDA(At, 0, 0); PG8_STAGE(PG8_SA(1, 1), a1 + hstep, voffA);
            PG8_WAIT_V(8); PG8_WAIT_L(0); PG8_BAR; PG8_MMA(0, 0, At, B0); PG8_MMA(0, 1, At, B1); PG8_BAR; PG8_SCHED;
            PG8_LDA(At, 0, 1); PG8_STAGE(PG8_SB(0, 0), b2, voffB); PG8_STAGE(PG8_SB(0, 1), b2 + hstep, voffB); PG8_STAGE(PG8_SA(0, 0), a2, voffA);
            PG8_WAIT_V(8); PG8_WAIT_L(0); PG8_BAR; PG8_MMA(1, 0, At, B0); PG8_MMA(1, 1, At, B1); PG8_BAR; PG8_SCHED;
            PG8_LDB(B0, 1, 0); PG8_LDB(B1, 1, 1); PG8_SCHED; PG8_LDA(At, 1, 0); PG8_STAGE(PG8_SA(0, 1), a2 + hstep, voffA);
            PG8_WAIT_V(8); PG8_WAIT_L(0); PG8_BAR; PG8_MMA(0, 0, At, B0); PG8_MMA(0, 1, At, B1); PG8_BAR; PG8_SCHED;
            PG8_LDA(At, 1, 1); PG8_STAGE(PG8_SB(1, 0), b3, voffB); PG8_STAGE(PG8_SB(1, 1), b3 + hstep, voffB); PG8_STAGE(PG8_SA(1, 0), a3, voffA);
            PG8_WAIT_V(8); PG8_WAIT_L(0); PG8_BAR; PG8_MMA(1, 0, At, B0); PG8_MMA(1, 1, At, B1); PG8_BAR; PG8_SCHED;
            } else {
            PG8_LDB(B0, 0, 0); PG8_SCHED; PG8_LDA(At, 0, 0); PG8_STAGE(PG8_SA(1, 1), a1 + hstep, voffA);
            PG8_WAIT_L(8); PG8_BAR; PG8_WAIT_L(0); PG8_MMA(0, 0, At, B0); PG8_BAR; PG8_SCHED;
            PG8_LDB(B1, 0, 1); PG8_STAGE(PG8_SB(0, 0), b2, voffB);
            PG8_BAR; PG8_WAIT_L(0); PG8_MMA(0, 1, At, B1); PG8_BAR;
            PG8_LDA(At, 0, 1); PG8_STAGE(PG8_SA(0, 0), a2, voffA);
            PG8_BAR; PG8_WAIT_L(0); PG8_MMA(1, 0, At, B0); PG8_BAR; PG8_SCHED;
            PG8_STAGE(PG8_SB(0, 1), b2 + hstep, voffB);
            PG8_WAIT_V(6); PG8_BAR; PG8_MMA(1, 1, At, B1); PG8_BAR;
            PG8_LDB(B0, 1, 0); PG8_SCHED; PG8_LDA(At, 1, 0); PG8_STAGE(PG8_SA(0, 1), a2 + hstep, voffA);
            PG8_WAIT_L(8); PG8_BAR; PG8_WAIT_L(0); PG8_MMA(0, 0, At, B0); PG8_BAR; PG8_SCHED;
            PG8_LDB(B1, 1, 1); PG8_STAGE(PG8_SB(1, 0), b3, voffB);
            PG8_BAR; PG8_WAIT_L(0); PG8_MMA(0, 1, At, B1); PG8_BAR;
            PG8_LDA(At, 1, 1); PG8_STAGE(PG8_SA(1, 0), a3, voffA);
            PG8_BAR; PG8_WAIT_L(0); PG8_MMA(1, 0, At, B0); PG8_BAR; PG8_SCHED;
            PG8_STAGE(PG8_SB(1, 1), b3 + hstep, voffB);
            PG8_WAIT_V(6); PG8_BAR; PG8_MMA(1, 1, At, B1); PG8_BAR;
            }
        }
        if constexpr (ALIGN_EPI) { if (wr == 0) PG8_BAR; }
        if constexpr (Epi::SEG) E.seg(acc, cur.kk, ui >> 2, wr);
        if (!Epi::SEG || cur.kk == 3) {
            if constexpr (!Epi::AFTER_DRAIN) { E(acc, cur, wr, wc, ui & 1, fq); S.done(cur); }
            if (!has_next) break;
#pragma unroll
            for (int a = 0; a < 2; ++a)
#pragma unroll
                for (int b = 0; b < 2; ++b)
#pragma unroll
                    for (int m = 0; m < 4; ++m)
#pragma unroll
                        for (int n = 0; n < 2; ++n) acc[a][b][m][n] = (f32x4){0.f, 0.f, 0.f, 0.f};
        }
        cur = nxt; cA = nA; cB = nB; ++ui;
        if constexpr (ALIGN_EPI) { if (wr == 1) PG8_BAR; }
    }
    PG8_WAIT_V(0);
    if constexpr (!ALIGN_EPI) { if (wr == 0) PG8_BAR; }
    PG8_BAR;
    if constexpr (Epi::AFTER_DRAIN) { E.fused(acc, cur, wr, wc, fr, fq, lds, wid, lane); S.done(cur); }
#undef PG8_SA
#undef PG8_SB
#undef PG8_STAGE
#undef PG8_LDA
#undef PG8_LDB
#undef PG8_MMA
#undef PG8_WAIT_V
#undef PG8_WAIT_L
#undef PG8_BAR
#undef PG8_SCHED
}
}

#define LAS __attribute__((address_space(3)))
typedef unsigned short bf16;
typedef float f32x4 __attribute__((ext_vector_type(4)));
typedef float f32x16 __attribute__((ext_vector_type(16)));
typedef short bf16x8 __attribute__((ext_vector_type(8)));
typedef short s16x4 __attribute__((ext_vector_type(4)));
typedef unsigned u32x4 __attribute__((ext_vector_type(4)));
typedef unsigned u32x2 __attribute__((ext_vector_type(2)));
using pg8::pk_bf16; using pg8::EPS;

#ifndef REP_PHASE
#ifndef PROBE_X
#define PROBE_X -1
#endif
#ifndef PROBE_GAIN
#define PROBE_GAIN 1
#endif
#define REP_PHASE -1
#endif
#define REPS(k) ((REP_PHASE == (k)) ? 2 : 1)
#ifndef PROBE_TS
#define PROBE_TS -1
#endif
#ifndef RET_V2
#define RET_V2 1
#endif
#if RET_V2
#define RET_UNIT ret_unit2
#else
#define RET_UNIT ret_unit
#endif
#ifndef MK_ONE_LAUNCH
#define MK_ONE_LAUNCH 1
#endif
constexpr int NWAVES = 8, NTHREADS = 512;
constexpr int NB = 16, SEQ = 2048, D = 1024, M = NB * SEQ, FF = 2816, FF2 = 5632, RN = 6144;
constexpr int NPHASE = 14;

constexpr size_t MiB = 1u << 20;
constexpr size_t WS_CTL = 0;
constexpr size_t WS_MODS = pg8::O_MODS, WS_KVM = pg8::O_KVM, WS_SW1 = pg8::O_SW1, WS_SW3 = pg8::O_SW3, WS_SW5 = pg8::O_SW5, WS_SW6 = pg8::O_SW6, WS_SS = pg8::O_SS, WS_SSO = pg8::O_SSO;
static_assert(pg8::O_SMALL_END <= 6 * MiB && pg8::M_ == M, "small region");
constexpr size_t WS_WT1 = 6 * MiB;
constexpr size_t WS_WT2 = WS_WT1 + (size_t)6144 * 1024 * 2;
constexpr size_t WS_WT3 = WS_WT2 + (size_t)1024 * 2048 * 2;
constexpr size_t WS_WT4 = WS_WT3 + (size_t)2 * 5632 * 1024 * 2;
constexpr size_t WS_WT5 = WS_WT4 + (size_t)2 * 1024 * 2816 * 2;
constexpr size_t WS_WT6 = WS_WT5 + (size_t)2048 * 1024 * 2;
constexpr size_t WS_WT7 = WS_WT6 + (size_t)1024 * 1024 * 2;
static_assert(WS_WT7 + (size_t)1024 * 1024 * 2 <= 64 * MiB, "weights region");
constexpr size_t WS_A = pg8::O_A, WS_Q = pg8::O_Q, WS_KD = pg8::O_KD, WS_V = pg8::O_V, WS_SG = pg8::O_SG, WS_ACT = pg8::O_ACT, WS_HF = pg8::O_HF, WS_HL = pg8::O_HL, WS_AM1 = pg8::O_AM1,
                 WS_KN = pg8::O_KN, WS_VT = pg8::O_VT, WS_QN = pg8::O_QN, WS_OSB = pg8::O_OSB;
constexpr size_t WS_END = 512 * MiB;
static_assert((size_t)512 * 2 * 5632 * 4 <= 22 * MiB && WS_HL + 22 * MiB <= WS_AM1 && WS_AM1 + 64 * MiB <= WS_END && WS_OSB + 64 * MiB <= WS_END && WS_ACT + (size_t)M * FF * 2 <= WS_HF && pg8::O_H16 + 64 * MiB <= WS_ACT && WS_QN + 64 * MiB <= WS_OSB, "big region");

constexpr int LDS_BYTES = pg8::LDS_TOTAL;
constexpr int MISC_OFF = LDS_BYTES - 512;
using pg8::ptab_t; using pg8::ldp; using pg8::T_OUT; using pg8::T_WS;

#define LBAR() do { asm volatile("s_waitcnt lgkmcnt(0)" ::: "memory"); __builtin_amdgcn_s_barrier(); asm volatile("" ::: "memory"); } while (0)

#define XB_TMO      128
#define XB_XCNT(j)  (256  + 64 * (j))
#define XB_XSUB(j)  (1280 + 64 * (j))
#define XB_XGEN(j)  (2304 + 64 * (j))
#define XB_TOP      3328
#define XB_TOPGEN   3392
#define XCD_BAR_WORDS 3456
#define XB_SPIN_CAP (1u << 20)
__device__ __forceinline__ unsigned xb_ld(unsigned* p)              { return __hip_atomic_load(p, __ATOMIC_RELAXED, __HIP_MEMORY_SCOPE_AGENT); }
__device__ __forceinline__ unsigned xb_add(unsigned* p, unsigned v) { return __hip_atomic_fetch_add(p, v, __ATOMIC_RELAXED, __HIP_MEMORY_SCOPE_AGENT); }
__device__ __forceinline__ unsigned xb_xcc_id() { return (unsigned)__builtin_amdgcn_s_getreg((3 << 11) | 20) & 0xFu; }
#define XB_SPIN(cond, bar) do { unsigned _sp = 0; while (cond) { __builtin_amdgcn_s_sleep(1); \
    if ((++_sp & 255u) == 0u) { if (xb_ld(&(bar)[XB_TMO])) break; if (_sp > XB_SPIN_CAP) { atomicAdd(&(bar)[XB_TMO], 1u); break; } } } } while (0)
struct XcdBarrier { unsigned* bar; unsigned x; volatile LAS unsigned* st; };
__device__ __forceinline__ XcdBarrier xcd_barrier_post(unsigned* bar, volatile LAS unsigned* st) {
    XcdBarrier b; b.bar = bar; b.x = xb_xcc_id(); b.st = st;
    if (threadIdx.x == 0) (void)xb_add(&bar[XB_XCNT(b.x)], 1u);
    return b;
}
__device__ __forceinline__ void xcd_barrier_complete(unsigned* bar, unsigned x, unsigned& nloc, unsigned& nx) {
    const unsigned G = gridDim.x * gridDim.y * gridDim.z;
    unsigned sum, cnt, mine, sp = 0u;
    for (;;) {
        sum = 0u; cnt = 0u; mine = 0u;
#pragma unroll
        for (unsigned j = 0; j < 16; ++j) { const unsigned c = xb_ld(&bar[XB_XCNT(j)]); sum += c; cnt += (c > 0u) ? 1u : 0u; mine = (j == x) ? c : mine; }
        if (sum == G) break;
        __builtin_amdgcn_s_sleep(1);
        if ((++sp & 255u) == 0u) { if (xb_ld(&bar[XB_TMO])) break; if (sp > XB_SPIN_CAP) { atomicAdd(&bar[XB_TMO], 1u); break; } }
    }
    nloc = mine > 0u ? mine : 1u; nx = cnt > 0u ? cnt : 1u;
}
__device__ __forceinline__ void xcd_barrier(const XcdBarrier& b) {
    asm volatile("s_waitcnt vmcnt(0)" ::: "memory");
    __syncthreads();
    if (threadIdx.x == 0) {
        unsigned* bar = b.bar;
        __builtin_amdgcn_s_waitcnt(0);
        unsigned nloc = b.st[0], nx = b.st[1];
        if (nloc == 0u) { xcd_barrier_complete(bar, b.x, nloc, nx); b.st[0] = nloc; b.st[1] = nx; }
        const unsigned old = xb_add(&bar[XB_XSUB(b.x)], 1u);
        const unsigned gen = old / nloc;
        if (old + 1u == (gen + 1u) * nloc) {
            __builtin_amdgcn_fence(__ATOMIC_RELEASE, "agent");
            asm volatile("s_waitcnt vmcnt(0)" ::: "memory");
            const unsigned og = xb_add(&bar[XB_TOP], 1u);
            const unsigned tg = og / nx;
            if (og + 1u == (tg + 1u) * nx) xb_add(&bar[XB_TOPGEN], 1u);
            else XB_SPIN(xb_ld(&bar[XB_TOPGEN]) == tg, bar);
            __builtin_amdgcn_fence(__ATOMIC_ACQUIRE, "agent");
            xb_add(&bar[XB_XGEN(b.x)], 1u);
            asm volatile("s_waitcnt vmcnt(0)" ::: "memory");
        } else {
            XB_SPIN(xb_ld(&bar[XB_XGEN(b.x)]) == gen, bar);
            __builtin_amdgcn_fence(__ATOMIC_ACQUIRE, "agent");
            asm volatile("s_waitcnt vmcnt(0)" ::: "memory");
        }
    }
    __syncthreads();
}

__device__ __forceinline__ float wave_sum(float v) {
#pragma unroll
    for (int o = 1; o < 64; o <<= 1) v += __shfl_xor(v, o);
    return v;
}
__device__ __forceinline__ float bf2f(unsigned short u) { return __builtin_bit_cast(float, (unsigned)u << 16); }

struct Args { const void* in[21]; float* out; unsigned char* ws; int ph_lo, ph_hi; };

__device__ __forceinline__ void p0_transpose_item(const float* W, int K, int N, bf16* WT, int k0, int sc0, int sc1, int nd0, LAS float* scr, int lane) {
    const int r4 = lane >> 4, c4 = lane & 15;
    const float* src = W + (size_t)(k0 + r4) * N + ((c4 < 8) ? sc0 + 4 * c4 : sc1 + 4 * (c4 - 8));
    f32x4 v[16];
#pragma unroll
    for (int i = 0; i < 16; ++i) v[i] = *(const f32x4*)(src + (size_t)(4 * i) * N);
#pragma unroll
    for (int i = 0; i < 16; ++i) { LAS float* d = scr + (4 * i + r4) * 65 + 4 * c4; d[0] = v[i][0]; d[1] = v[i][1]; d[2] = v[i][2]; d[3] = v[i][3]; }
    asm volatile("s_waitcnt lgkmcnt(0)" ::: "memory");
    const int c8 = lane & 7, n8 = lane >> 3;
#pragma unroll
    for (int j = 0; j < 8; ++j) { const int n = n8 + 8 * j; const LAS float* s = scr + (8 * c8) * 65 + n;
        u32x4 o; o.x = pk_bf16(s[0 * 65], s[1 * 65]); o.y = pk_bf16(s[2 * 65], s[3 * 65]); o.z = pk_bf16(s[4 * 65], s[5 * 65]); o.w = pk_bf16(s[6 * 65], s[7 * 65]);
        *(u32x4*)(WT + (size_t)(nd0 + n) * K + k0 + 8 * c8) = o; }
    asm volatile("s_waitcnt lgkmcnt(0)" ::: "memory");
}
__device__ __forceinline__ int src_col(int type, int nd0) {
    if (type == 0) return nd0;
    const int pn = nd0 >> 8, r = nd0 & 255, bj = r >> 7;
    if (type == 1) return bj * FF + 128 * pn + (r & 127);
    const int wc = (r & 127) >> 5, head = 4 * (pn & 3) + wc;
    return (pn >= 4 ? 1024 : 0) + head * 64 + 32 * bj;
}
__device__ __forceinline__ void p0_phase(ptab_t tab, LAS unsigned char* lds, int vcu, int G) {
    const int tid = threadIdx.x, lane = tid & 63, w = __builtin_amdgcn_readfirstlane(tid >> 6);
    unsigned char* ws = ldp(tab, T_WS);
    { float* z = (float*)(ws + WS_SS) + M; const int n = 3 * M;
      for (int i = vcu * NTHREADS + tid; i < n / 4; i += G * NTHREADS) ((f32x4*)z)[i] = (f32x4){0.f, 0.f, 0.f, 0.f}; }
    if (vcu < 224) {
        LAS float* cact = (LAS float*)lds;
        LAS float* part = (LAS float*)(lds + 65536);
        const float* c = (const float*)ldp(tab, 1);
        {
            f32x4 cv[8];
#pragma unroll
            for (int j = 0; j < 8; ++j) cv[j] = *(const f32x4*)(c + 4 * (tid + NTHREADS * j));
#pragma unroll
            for (int j = 0; j < 8; ++j) *(LAS f32x4*)(cact + 4 * (tid + NTHREADS * j)) = pg8::silu4(cv[j]);
        }
        LBAR();
        const int col = vcu * 64;
        const float* W; int N, cw; const float* bias; float* dst; int dstride;
        if (col < 12288) { const int l = col / 6144; cw = col - l * 6144; W = (const float*)ldp(tab, 3) + (size_t)l * 1024 * 6144; N = 6144; bias = (const float*)ldp(tab, 4) + l * 6144; dst = (float*)(ws + WS_MODS) + (size_t)l * 16 * 6144; dstride = 6144; }
        else { cw = col - 12288; W = (const float*)ldp(tab, 9); N = 2048; bias = (const float*)ldp(tab, 10); dst = (float*)(ws + WS_KVM); dstride = 2048; }
        const int c4 = lane & 15, r4 = lane >> 4;
        f32x4 acc[16];
#pragma unroll
        for (int b = 0; b < 16; ++b) acc[b] = (f32x4){0.f, 0.f, 0.f, 0.f};
        const float* wp = W + (size_t)(128 * w + 32 * r4) * N + cw + 4 * c4;
        const LAS float* cp = cact + 128 * w + 32 * r4;
#pragma unroll 1
        for (int i0 = 0; i0 < 32; i0 += 16) {
            f32x4 wv[16];
#pragma unroll
            for (int i = 0; i < 16; ++i) wv[i] = *(const f32x4*)(wp + (size_t)(i0 + i) * N);
#pragma unroll
            for (int j = 0; j < 4; ++j) {
                asm volatile("" ::: "memory");
#pragma unroll
                for (int b = 0; b < 16; ++b) { const f32x4 cv = *(const LAS f32x4*)(cp + b * 1024 + i0 + 4 * j); acc[b] += (cv[0] * wv[4 * j] + cv[1] * wv[4 * j + 1]) + (cv[2] * wv[4 * j + 2] + cv[3] * wv[4 * j + 3]); }
            }
        }
#pragma unroll
        for (int b = 0; b < 16; ++b) {
#pragma unroll
            for (int e = 0; e < 4; ++e) { float v = acc[b][e]; v += __shfl_xor(v, 16); v += __shfl_xor(v, 32); acc[b][e] = v; }
            if (r4 == 0) *(LAS f32x4*)(part + (w * 16 + b) * 64 + 4 * c4) = acc[b];
        }
        LBAR();
        for (int o = tid; o < 1024; o += NTHREADS) { const int b = o >> 6, l = o & 63; float s = bias[cw + l];
#pragma unroll
            for (int ww = 0; ww < 8; ++ww) s += part[(ww * 16 + b) * 64 + l];
            dst[(size_t)b * dstride + cw + l] = s; }
        LBAR();
    }
    {
        LAS float* scr = (LAS float*)(lds + w * 16640);
        constexpr int I0 = 16 * 96, I1 = 32 * 16, I2 = 16 * 88, I4 = 44 * 16, I6 = 16 * 32, I7 = 16 * 16;
        constexpr int NIT = I0 + I1 + 2 * I2 + 2 * I4 + I6 + 2 * I7;
        const int gw = vcu * NWAVES + w, NGW = G * NWAVES;
        for (int it = gw; it < NIT; it += NGW) {
            int r = it; const float* W; int K, N, type; bf16* WT;
            if (r < I0) { W = (const float*)ldp(tab, 7); K = 1024; N = 6144; type = 0; WT = (bf16*)(ws + WS_WT1); }
            else if ((r -= I0) < I1) { W = (const float*)ldp(tab, 8); K = 2048; N = 1024; type = 0; WT = (bf16*)(ws + WS_WT2); }
            else if ((r -= I1) < 2 * I2) { const int l = r / I2; r -= l * I2; W = (const float*)ldp(tab, 17) + (size_t)l * 1024 * FF2; K = 1024; N = FF2; type = 1; WT = (bf16*)(ws + WS_WT3) + (size_t)l * FF2 * 1024; }
            else if ((r -= 2 * I2) < 2 * I4) { const int l = r / I4; r -= l * I4; W = (const float*)ldp(tab, 20) + (size_t)l * FF * 1024; K = FF; N = 1024; type = 0; WT = (bf16*)(ws + WS_WT4) + (size_t)l * 1024 * FF; }
            else if ((r -= 2 * I4) < I6) { W = (const float*)ldp(tab, 12); K = 1024; N = 2048; type = 2; WT = (bf16*)(ws + WS_WT5); }
            else if ((r -= I6) < I7) { W = (const float*)ldp(tab, 14); K = 1024; N = 1024; type = 2; WT = (bf16*)(ws + WS_WT6); }
            else { r -= I7; W = (const float*)ldp(tab, 16); K = 1024; N = 1024; type = 0; WT = (bf16*)(ws + WS_WT7); }
            const int nblk = N / 64, kb = r / nblk, nb = r - kb * nblk;
            p0_transpose_item(W, K, N, WT, 64 * kb, src_col(type, 64 * nb), src_col(type, 64 * nb + 32), 64 * nb, scr, lane);
        }
    }
}

__device__ __forceinline__ void p1_phase(ptab_t tab, LAS unsigned char* lds, int vcu, int G) {
    const int tid = threadIdx.x, lane = tid & 63, w = __builtin_amdgcn_readfirstlane(tid >> 6);
    unsigned char* ws = ldp(tab, T_WS);
    const float* mods = (const float*)(ws + WS_MODS);
    const int t0 = (G * 77) >> 8, t1 = (G * 147) >> 8, t2 = (G * 217) >> 8, t3 = (G * 243) >> 8;
    const int ty = (vcu < t0) ? 0 : (vcu < t1) ? 1 : (vcu < t2) ? 2 : (vcu < t3) ? 3 : 4;
    const int wbase = (ty == 0) ? 0 : (ty == 1) ? t0 : (ty == 2) ? t1 : (ty == 3) ? t2 : t3, wend = (ty == 0) ? t0 : (ty == 1) ? t1 : (ty == 2) ? t2 : (ty == 3) ? t3 : G;
    const float* sp; int sst, N; const bf16* WT; float* dst;
    if (ty == 0)      { sp = mods;                         sst = 6144; N = RN;   WT = (const bf16*)(ws + WS_WT1); dst = (float*)(ws + WS_SW1); }
    else if (ty == 1) { sp = mods + 3072;                  sst = 6144; N = FF2;  WT = (const bf16*)(ws + WS_WT3); dst = (float*)(ws + WS_SW3); }
    else if (ty == 2) { sp = mods + 16 * 6144 + 3072;      sst = 6144; N = FF2;  WT = (const bf16*)(ws + WS_WT3) + (size_t)FF2 * 1024; dst = (float*)(ws + WS_SW3) + 16 * FF2; }
    else if (ty == 3) { sp = (const float*)(ws + WS_KVM);  sst = 2048; N = 2048; WT = (const bf16*)(ws + WS_WT5); dst = (float*)(ws + WS_SW5); }
    else              { sp = mods + 16 * 6144;             sst = 6144; N = 1024; WT = (const bf16*)(ws + WS_WT6); dst = (float*)(ws + WS_SW6); }
    LAS float* sh = (LAS float*)lds;
#pragma unroll 8
    for (int i = tid; i < 16 * 1024; i += NTHREADS) sh[i] = sp[(size_t)(i >> 10) * sst + (i & 1023)];
    LBAR();
    if (w < 4) {
        const float* x = (const float*)ldp(tab, 0); const float* g = (const float*)ldp(tab, 5);
        bf16* A0 = (bf16*)(ws + WS_A); float* ss0 = (float*)(ws + WS_SS);
        const int gw4 = vcu * 4 + w, NGW4 = G * 4, rpw = M / NGW4;
        for (int r0 = gw4 * rpw; r0 < M; r0 += NGW4 * rpw) {
            const int b = r0 / SEQ;
            f32x4 gs[4];
#pragma unroll
            for (int j = 0; j < 4; ++j) { const int col = 4 * lane + 256 * j; gs[j] = *(const f32x4*)(g + col) * (*(const f32x4*)(mods + (size_t)b * 6144 + 1024 + col) + 1.f); }
#pragma unroll 1
            for (int r = r0; r < r0 + rpw; r += 4) {
                f32x4 v[4][4]; float s[4];
#pragma unroll
                for (int q = 0; q < 4; ++q)
#pragma unroll
                    for (int j = 0; j < 4; ++j) v[q][j] = *(const f32x4*)(x + (size_t)(r + q) * D + 4 * lane + 256 * j);
#pragma unroll
                for (int q = 0; q < 4; ++q) { s[q] = (pg8::dot4(v[q][0]) + pg8::dot4(v[q][1])) + (pg8::dot4(v[q][2]) + pg8::dot4(v[q][3])); }
#pragma unroll
                for (int o = 1; o < 64; o <<= 1) {
#pragma unroll
                    for (int q = 0; q < 4; ++q) s[q] += __shfl_xor(s[q], o);
                }
                if (lane < 4) ss0[r + lane] = (lane == 0) ? s[0] : (lane == 1) ? s[1] : (lane == 2) ? s[2] : s[3];
#pragma unroll
                for (int q = 0; q < 4; ++q)
#pragma unroll
                    for (int j = 0; j < 4; ++j) { const f32x4 o = v[q][j] * gs[j]; u32x2 pp; pp.x = pk_bf16(o[0], o[1]); pp.y = pk_bf16(o[2], o[3]); *(u32x2*)(A0 + (size_t)(r + q) * D + 4 * lane + 256 * j) = pp; }
            }
        }
    } else {
        const int gw = (vcu - wbase) * 4 + (w - 4), NGW = (wend - wbase) * 4;
        u32x4 nw0 = (u32x4){0u, 0u, 0u, 0u}, nw1 = nw0;
        if (gw < N) { nw0 = *(const u32x4*)(WT + (size_t)gw * 1024 + 8 * lane); nw1 = *(const u32x4*)(WT + (size_t)gw * 1024 + 512 + 8 * lane); }
        for (int n = gw; n < N; n += NGW) {
            asm volatile("" ::: "memory");
            const u32x4 w0 = nw0, w1 = nw1;
            if (n + NGW < N) { nw0 = *(const u32x4*)(WT + (size_t)(n + NGW) * 1024 + 8 * lane); nw1 = *(const u32x4*)(WT + (size_t)(n + NGW) * 1024 + 512 + 8 * lane); }
            float wf[16];
#pragma unroll
            for (int i = 0; i < 4; ++i) { wf[2 * i] = __builtin_bit_cast(float, w0[i] << 16); wf[2 * i + 1] = __builtin_bit_cast(float, w0[i] & 0xffff0000u);
                                          wf[8 + 2 * i] = __builtin_bit_cast(float, w1[i] << 16); wf[8 + 2 * i + 1] = __builtin_bit_cast(float, w1[i] & 0xffff0000u); }
            float p[16];
#pragma unroll
            for (int b = 0; b < 16; ++b) {
                const LAS float* s0 = sh + b * 1024 + 8 * lane;
                const f32x4 a0 = *(const LAS f32x4*)s0, a1 = *(const LAS f32x4*)(s0 + 4), a2 = *(const LAS f32x4*)(s0 + 512), a3 = *(const LAS f32x4*)(s0 + 516);
                p[b] = (a0[0] * wf[0] + a0[1] * wf[1]) + (a0[2] * wf[2] + a0[3] * wf[3]) + (a1[0] * wf[4] + a1[1] * wf[5]) + (a1[2] * wf[6] + a1[3] * wf[7])
                     + (a2[0] * wf[8] + a2[1] * wf[9]) + (a2[2] * wf[10] + a2[3] * wf[11]) + (a3[0] * wf[12] + a3[1] * wf[13]) + (a3[2] * wf[14] + a3[3] * wf[15]);
            }
#pragma unroll
            for (int j = 0; j < 8; ++j) { const bool up = lane & 32; const float keep = up ? p[j + 8] : p[j], send = up ? p[j] : p[j + 8]; p[j] = keep + __shfl_xor(send, 32); }
#pragma unroll
            for (int j = 0; j < 4; ++j) { const bool up = lane & 16; const float keep = up ? p[j + 4] : p[j], send = up ? p[j] : p[j + 4]; p[j] = keep + __shfl_xor(send, 16); }
#pragma unroll
            for (int j = 0; j < 2; ++j) { const bool up = lane & 8; const float keep = up ? p[j + 2] : p[j], send = up ? p[j] : p[j + 2]; p[j] = keep + __shfl_xor(send, 8); }
            { const bool up = lane & 4; const float keep = up ? p[1] : p[0], send = up ? p[0] : p[1]; p[0] = keep + __shfl_xor(send, 4); }
            p[0] += __shfl_xor(p[0], 2); p[0] += __shfl_xor(p[0], 1);
            const float mine = p[0]; const int myb = ((lane >> 5) & 1) * 8 + ((lane >> 4) & 1) * 4 + ((lane >> 3) & 1) * 2 + ((lane >> 2) & 1);
            if ((lane & 3) == 0) dst[(size_t)myb * N + n] = mine;
        }
    }
}

constexpr int RT_QROWB = 528, RT_VROWB = 272, RT_PROWB = 144;
constexpr int RT_QS = 0, RT_KS = 64 * RT_QROWB, RT_VS = 2 * 64 * RT_QROWB, RT_PS = RT_VS + 64 * RT_VROWB, RT_SQ = RT_PS + 64 * RT_PROWB, RT_BYTES = RT_SQ + 512;
static_assert(RT_BYTES <= MISC_OFF, "retention LDS");
__device__ __forceinline__ s16x4 tr16(const LAS unsigned char* p) { typedef short v4i16_t __attribute__((ext_vector_type(4))); return __builtin_bit_cast(s16x4, __builtin_amdgcn_ds_read_tr16_b64_v4i16((LAS v4i16_t*)p)); }
#define MFMA16(a, b, c) __builtin_amdgcn_mfma_f32_16x16x32_bf16((a), (b), (c), 0, 0, 0)
#define MFMA32(a, b, c) __builtin_amdgcn_mfma_f32_32x32x16_bf16((a), (b), (c), 0, 0, 0)
__device__ __forceinline__ bf16x8 cat8(s16x4 lo, s16x4 hi) { return (bf16x8){lo[0], lo[1], lo[2], lo[3], hi[0], hi[1], hi[2], hi[3]}; }
__device__ __forceinline__ bf16x8 pack8(const f32x4 a, const f32x4 b) { return __builtin_bit_cast(bf16x8, pg8::pk8(a, b)); }

__device__ __forceinline__ void ret_unit(LAS unsigned char* lds, const bf16* Q, const bf16* KD, const bf16* V, bf16* SG, float* SSO, int unit, bool dry) {
    const int tid = threadIdx.x, lane = tid & 63, w = __builtin_amdgcn_readfirstlane(tid >> 6);
    const int b = unit >> 4, h = (unit >> 2) & 3, vs = unit & 3;
    const int c16 = lane & 15, g4 = lane >> 4;
    const float lg2 = __builtin_amdgcn_logf(1.f - __builtin_amdgcn_exp2f(-5.f - (float)h));
    const float gC = __builtin_amdgcn_exp2f(lg2 * 64.f);
    const __amdgpu_buffer_rsrc_t rs = __builtin_amdgcn_make_buffer_rsrc((void*)Q, 0, 0x7fffffff, 0x00020000);
    const unsigned offK = (unsigned)((const char*)KD - (const char*)Q), offV = (unsigned)((const char*)V - (const char*)Q), offG = (unsigned)((const char*)SG - (const char*)Q);
    const unsigned uQ = ((unsigned)b * SEQ * 1024 + h * 256) * 2, uV = ((unsigned)b * SEQ * 2048 + h * 512 + vs * 128) * 2;
    const unsigned vQ = (tid >> 5) * 2048 + (tid & 31) * 16, vV = (tid >> 4) * 4096 + (tid & 15) * 16;
    const unsigned vG = c16 * 4096 + (16 * w + 4 * g4) * 2;
    u32x4 pq[4], pk[4], pv[2];
#define RT_LOAD(c) do { _Pragma("unroll") for (int j = 0; j < 4; ++j) { const unsigned so = uQ + (unsigned)((c) * 64 + 16 * j) * 2048; \
        pq[j] = __builtin_bit_cast(u32x4, __builtin_amdgcn_raw_buffer_load_b128(rs, vQ, so, 0)); pk[j] = __builtin_bit_cast(u32x4, __builtin_amdgcn_raw_buffer_load_b128(rs, vQ, so + offK, 0)); } \
        _Pragma("unroll") for (int j = 0; j < 2; ++j) pv[j] = __builtin_bit_cast(u32x4, __builtin_amdgcn_raw_buffer_load_b128(rs, vV, offV + uV + (unsigned)((c) * 64 + 32 * j) * 4096, 0)); } while (0)
#define RT_STORE() do { _Pragma("unroll") for (int j = 0; j < 4; ++j) { const int cc = tid + 512 * j, row = cc >> 5, ck = cc & 31; *(LAS u32x4*)(lds + RT_QS + row * RT_QROWB + ck * 16) = pq[j]; *(LAS u32x4*)(lds + RT_KS + row * RT_QROWB + ck * 16) = pk[j]; } \
        _Pragma("unroll") for (int j = 0; j < 2; ++j) { const int cc = tid + 512 * j, row = cc >> 4, ck = cc & 15; *(LAS u32x4*)(lds + RT_VS + row * RT_VROWB + ck * 16) = pv[j]; } } while (0)
    f32x4 st[16], oc[4], sT[2]; bf16x8 vf[2];
#pragma unroll
    for (int i = 0; i < 16; ++i) st[i] = (f32x4){0.f, 0.f, 0.f, 0.f};
#pragma unroll
    for (int i = 0; i < 4; ++i) oc[i] = (f32x4){0.f, 0.f, 0.f, 0.f};
    const int ntS = w & 3, mtb = 2 * (w >> 2);
    const LAS unsigned char* qrowS = lds + RT_QS + (16 * ntS + c16) * RT_QROWB + g4 * 16;
    const LAS unsigned char* krowS = lds + RT_KS + (16 * mtb + c16) * RT_QROWB + g4 * 16;
    const LAS unsigned char* qrowC = lds + RT_QS + c16 * RT_QROWB + g4 * 8;
    const LAS unsigned char* ktr = lds + RT_KS + (8 * g4 + (c16 >> 2)) * RT_QROWB + (c16 & 3) * 8;
    const LAS unsigned char* vtr = lds + RT_VS + (8 * g4 + (c16 >> 2)) * RT_VROWB + w * 32 + (c16 & 3) * 8;
    const LAS unsigned char* prow = lds + RT_PS + c16 * RT_PROWB + g4 * 16;
    LAS unsigned char* pst = lds + RT_PS + (16 * ntS + c16) * RT_PROWB + g4 * 8;
    if (tid < 128) ((LAS float*)(lds + RT_SQ))[tid] = 0.f;
    RT_LOAD(0);
    for (int c = 0; c < 32; ++c) {
        LBAR();
        RT_STORE();
        asm volatile("" ::: "memory");
        if (c + 1 < 32) RT_LOAD(c + 1);
        u32x2 sgv[4];
#pragma unroll
        for (int nt = 0; nt < 4; ++nt) sgv[nt] = __builtin_bit_cast(u32x2, __builtin_amdgcn_raw_buffer_load_b64(rs, vG, offG + uV + (unsigned)(c * 64 + 16 * nt) * 4096, 0));
        if (w == 0 && c > 0 && !dry) {
            LAS float* sl = (LAS float*)(lds + RT_SQ) + ((c - 1) & 1) * 64;
            SSO[(size_t)(b * SEQ + (c - 1) * 64 + lane) * 16 + h * 4 + vs] = sl[lane]; sl[lane] = 0.f;
        }
        LBAR();
#pragma unroll
        for (int ks = 0; ks < 2; ++ks) vf[ks] = cat8(tr16(vtr + (32 * ks) * RT_VROWB), tr16(vtr + (32 * ks + 4) * RT_VROWB));
        sT[0] = (f32x4){0.f, 0.f, 0.f, 0.f}; sT[1] = (f32x4){0.f, 0.f, 0.f, 0.f};
#pragma unroll
        for (int ks = 0; ks < 8; ++ks) {
            const bf16x8 bq = *(const LAS bf16x8*)(qrowS + ks * 64);
#pragma unroll
            for (int i = 0; i < 2; ++i) { const bf16x8 ak = *(const LAS bf16x8*)(krowS + i * 16 * RT_QROWB + ks * 64); sT[i] = MFMA16(ak, bq, sT[i]); }
        }
        {
            const int n = 16 * ntS + c16; const float fac = __builtin_amdgcn_exp2f(lg2 * (float)(n - 63));
#pragma unroll
            for (int i = 0; i < 2; ++i) {
                const int m0 = 16 * (mtb + i) + 4 * g4; float v[4];
#pragma unroll
                for (int e = 0; e < 4; ++e) v[e] = (n >= m0 + e) ? sT[i][e] * fac : 0.f;
                u32x2 p; p.x = pk_bf16(v[0], v[1]); p.y = pk_bf16(v[2], v[3]);
                *(LAS u32x2*)(pst + (mtb + i) * 32) = p;
            }
        }
        __builtin_amdgcn_sched_barrier(0);
        {
            s16x4 qlo[2][4], qhi[2][4];
#pragma unroll
            for (int nt = 0; nt < 4; ++nt) { qlo[0][nt] = *(const LAS s16x4*)(qrowC + nt * 16 * RT_QROWB); qhi[0][nt] = *(const LAS s16x4*)(qrowC + nt * 16 * RT_QROWB + 32); }
#pragma unroll
            for (int ks = 0; ks < 8; ++ks) {
                if (ks < 7) {
#pragma unroll
                    for (int nt = 0; nt < 4; ++nt) { qlo[(ks + 1) & 1][nt] = *(const LAS s16x4*)(qrowC + nt * 16 * RT_QROWB + (ks + 1) * 64); qhi[(ks + 1) & 1][nt] = *(const LAS s16x4*)(qrowC + nt * 16 * RT_QROWB + (ks + 1) * 64 + 32); }
                }
                __builtin_amdgcn_sched_barrier(0);
                const bf16x8 as = pack8(st[2 * ks], st[2 * ks + 1]);
#pragma unroll
                for (int nt = 0; nt < 4; ++nt) oc[nt] = MFMA16(as, cat8(qlo[ks & 1][nt], qhi[ks & 1][nt]), oc[nt]);
                __builtin_amdgcn_sched_barrier(0);
            }
        }
        {
            s16x4 kt[2][4];
#pragma unroll
            for (int ks = 0; ks < 2; ++ks) { kt[0][2 * ks] = tr16(ktr + (32 * ks) * RT_QROWB); kt[0][2 * ks + 1] = tr16(ktr + (32 * ks + 4) * RT_QROWB); }
#pragma unroll
            for (int i = 0; i < 16; ++i) {
                if (i < 15) {
#pragma unroll
                    for (int ks = 0; ks < 2; ++ks) { kt[(i + 1) & 1][2 * ks] = tr16(ktr + (32 * ks) * RT_QROWB + (i + 1) * 32); kt[(i + 1) & 1][2 * ks + 1] = tr16(ktr + (32 * ks + 4) * RT_QROWB + (i + 1) * 32); }
                }
                __builtin_amdgcn_sched_barrier(0);
                f32x4 sacc = st[i] * gC;
#pragma unroll
                for (int ks = 0; ks < 2; ++ks) sacc = MFMA16(cat8(kt[i & 1][2 * ks], kt[i & 1][2 * ks + 1]), vf[ks], sacc);
                st[i] = sacc;
                __builtin_amdgcn_sched_barrier(0);
            }
        }
        LBAR();
#pragma unroll
        for (int nt = 0; nt < 4; ++nt) { const float gq = __builtin_amdgcn_exp2f(lg2 * (float)(16 * nt + c16 + 1)); oc[nt] *= gq; }
#pragma unroll
        for (int ks = 0; ks < 2; ++ks)
#pragma unroll
            for (int nt = 0; nt < 4; ++nt) if (32 * ks <= 16 * nt + 15) { const bf16x8 bp = *(const LAS bf16x8*)(prow + nt * 16 * RT_PROWB + ks * 64); oc[nt] = MFMA16(vf[ks], bp, oc[nt]); }
#pragma unroll
        for (int nt = 0; nt < 4; ++nt) {
            float sq = pg8::dot4(oc[nt]); sq += __shfl_xor(sq, 16); sq += __shfl_xor(sq, 32);
            if (g4 == 0) (void)__hip_atomic_fetch_add((LAS float*)(lds + RT_SQ) + (c & 1) * 64 + 16 * nt + c16, sq, __ATOMIC_RELAXED, __HIP_MEMORY_SCOPE_WORKGROUP);
            const u32x2 sg = sgv[nt];
            const float o0 = oc[nt][0] * __builtin_bit_cast(float, sg.x << 16), o1 = oc[nt][1] * __builtin_bit_cast(float, sg.x & 0xffff0000u);
            const float o2 = oc[nt][2] * __builtin_bit_cast(float, sg.y << 16), o3 = oc[nt][3] * __builtin_bit_cast(float, sg.y & 0xffff0000u);
            u32x2 p; p.x = pk_bf16(o0, o1); p.y = pk_bf16(o2, o3);
            if (!dry) __builtin_amdgcn_raw_buffer_store_b64(__builtin_bit_cast(__attribute__((ext_vector_type(2))) unsigned, p), rs, vG, offG + uV + (unsigned)(c * 64 + 16 * nt) * 4096, 0);
            oc[nt] = (f32x4){0.f, 0.f, 0.f, 0.f};
        }
    }
    LBAR();
    if (w == 0 && !dry) { LAS float* sl = (LAS float*)(lds + RT_SQ) + 64; SSO[(size_t)(b * SEQ + 31 * 64 + lane) * 16 + h * 4 + vs] = sl[lane]; sl[lane] = 0.f; }
    LBAR();
#undef RT_LOAD
#undef RT_STORE
}

constexpr int R2_QS = 0, R2_KS = 64 * RT_QROWB, R2_VS = 2 * 64 * RT_QROWB, R2_PS = R2_VS + 2 * 64 * RT_VROWB, R2_SQ = R2_PS + 64 * RT_PROWB, R2_SG = R2_SQ + 512, R2_BYTES = R2_SG + 64 * RT_VROWB;
static_assert(R2_BYTES <= MISC_OFF, "retention v2 LDS");
__device__ __forceinline__ void ret_unit2(LAS unsigned char* lds, const bf16* Q, const bf16* KD, const bf16* V, bf16* SG, float* SSO, int unit, bool dry) {
    const int tid = threadIdx.x, lane = tid & 63, w = __builtin_amdgcn_readfirstlane(tid >> 6);
    const int b = unit >> 4, h = (unit >> 2) & 3, vs = unit & 3;
    const int r32 = lane & 31, hh = lane >> 5;
    const float lg2 = __builtin_amdgcn_logf(1.f - __builtin_amdgcn_exp2f(-5.f - (float)h));
    const __amdgpu_buffer_rsrc_t rs = __builtin_amdgcn_make_buffer_rsrc((void*)Q, 0, 0x7fffffff, 0x00020000);
    const unsigned offK = (unsigned)((const char*)KD - (const char*)Q), offV = (unsigned)((const char*)V - (const char*)Q), offG = (unsigned)((const char*)SG - (const char*)Q);
    const unsigned uQ = ((unsigned)b * SEQ * 1024 + h * 256) * 2, uV = ((unsigned)b * SEQ * 2048 + h * 512 + vs * 128) * 2;
    if (tid < 128) ((LAS float*)(lds + R2_SQ))[tid] = 0.f;
    if (w >= 4) {
        const int ht = tid - 256, hw = w - 4, mt2 = hw >> 1, nt2 = hw & 1;
        const unsigned vQ = (ht >> 5) * 2048 + (ht & 31) * 16, vV = (ht >> 4) * 4096 + (ht & 15) * 16;
        u32x4 pq[8], pk[8], pv[4], pg[4];
#define H_LOAD(c) do { _Pragma("unroll") for (int j = 0; j < 8; ++j) { const unsigned so = uQ + (unsigned)((c) * 64 + 8 * j) * 2048; \
            pq[j] = __builtin_bit_cast(u32x4, __builtin_amdgcn_raw_buffer_load_b128(rs, vQ, so, 0)); pk[j] = __builtin_bit_cast(u32x4, __builtin_amdgcn_raw_buffer_load_b128(rs, vQ, so + offK, 0)); } \
            _Pragma("unroll") for (int j = 0; j < 4; ++j) { pv[j] = __builtin_bit_cast(u32x4, __builtin_amdgcn_raw_buffer_load_b128(rs, vV, offV + uV + (unsigned)((c) * 64 + 16 * j) * 4096, 0)); \
            pg[j] = __builtin_bit_cast(u32x4, __builtin_amdgcn_raw_buffer_load_b128(rs, vV, offG + uV + (unsigned)((c) * 64 + 16 * j) * 4096, 0)); } } while (0)
#define H_STORE(c) do { _Pragma("unroll") for (int j = 0; j < 8; ++j) { const int row = (ht >> 5) + 8 * j, ck = ht & 31; *(LAS u32x4*)(lds + R2_QS + row * RT_QROWB + ck * 16) = pq[j]; *(LAS u32x4*)(lds + R2_KS + row * RT_QROWB + ck * 16) = pk[j]; } \
            _Pragma("unroll") for (int j = 0; j < 4; ++j) { const int row = (ht >> 4) + 16 * j, ck = ht & 15; *(LAS u32x4*)(lds + R2_VS + ((c) & 1) * 64 * RT_VROWB + row * RT_VROWB + ck * 16) = pv[j]; } } while (0)
#define H_STORE_G() do { _Pragma("unroll") for (int j = 0; j < 4; ++j) { const int row = (ht >> 4) + 16 * j, ck = ht & 15; *(LAS u32x4*)(lds + R2_SG + row * RT_VROWB + ck * 16) = pg[j]; } } while (0)
        const LAS unsigned char* qrowS = lds + R2_QS + (32 * nt2 + r32) * RT_QROWB + hh * 16;
        const LAS unsigned char* krowS = lds + R2_KS + (32 * mt2 + r32) * RT_QROWB + hh * 16;
        LAS unsigned char* pst = lds + R2_PS + (32 * nt2 + r32) * RT_PROWB + (32 * mt2 + 4 * hh) * 2;
        const int n_loc = 32 * nt2 + r32; const float fac = __builtin_amdgcn_exp2f(lg2 * (float)(n_loc - 63));
        H_LOAD(0);
        for (int c = 0; c < 32; ++c) {
            H_STORE(c);
            LBAR();
            H_STORE_G();
            asm volatile("" ::: "memory");
            if (c + 1 < 32) H_LOAD(c + 1);
            f32x16 sT;
#pragma unroll
            for (int i = 0; i < 16; ++i) sT[i] = 0.f;
            if (mt2 <= nt2) {
#pragma unroll
                for (int s = 0; s < 16; ++s) { const bf16x8 ak = *(const LAS bf16x8*)(krowS + s * 32), bq = *(const LAS bf16x8*)(qrowS + s * 32); sT = MFMA32(ak, bq, sT); }
            }
#pragma unroll
            for (int g = 0; g < 4; ++g) {
                const int m0 = 32 * mt2 + 8 * g + 4 * hh; float v[4];
#pragma unroll
                for (int e = 0; e < 4; ++e) v[e] = (n_loc >= m0 + e) ? sT[4 * g + e] * fac : 0.f;
                u32x2 pp; pp.x = pk_bf16(v[0], v[1]); pp.y = pk_bf16(v[2], v[3]);
                *(LAS u32x2*)(pst + g * 16) = pp;
            }
            if (hw == 0 && c > 0 && !dry) {
                LAS float* sl = (LAS float*)(lds + R2_SQ) + ((c - 1) & 1) * 64;
                SSO[(size_t)(b * SEQ + (c - 1) * 64 + lane) * 16 + h * 4 + vs] = sl[lane]; sl[lane] = 0.f;
            }
            LBAR();
        }
        LBAR();
        if (hw == 0 && !dry) { LAS float* sl = (LAS float*)(lds + R2_SQ) + 64; SSO[(size_t)(b * SEQ + 31 * 64 + lane) * 16 + h * 4 + vs] = sl[lane]; sl[lane] = 0.f; }
        LBAR();
#undef H_LOAD
#undef H_STORE
#undef H_STORE_G
    } else {
        const float gC = __builtin_amdgcn_exp2f(lg2 * 64.f);
        f32x16 st[8], oc[2]; bf16x8 vf[4];
#pragma unroll
        for (int t = 0; t < 8; ++t)
#pragma unroll
            for (int i = 0; i < 16; ++i) st[t][i] = 0.f;
#pragma unroll
        for (int i = 0; i < 16; ++i) { oc[0][i] = 0.f; oc[1][i] = 0.f; }
        for (int c = 0; c < 32; ++c) {
            int ln = lane; asm volatile("" : "+v"(ln));
            const int r32 = ln & 31, hh = ln >> 5, blk = (ln >> 4) & 1, q4 = (ln & 15) >> 2, p4 = ln & 3;
            const unsigned vG = r32 * 4096 + (32 * w + 4 * hh) * 2;
            const LAS unsigned char* qrowC = lds + R2_QS + r32 * RT_QROWB + hh * 8;
            const LAS unsigned char* ktr = lds + R2_KS + (8 * hh + q4) * RT_QROWB + (16 * blk + 4 * p4) * 2;
            const LAS unsigned char* vtr = lds + R2_VS + (8 * hh + q4) * RT_VROWB + (32 * w + 16 * blk + 4 * p4) * 2;
            const LAS unsigned char* prow = lds + R2_PS + r32 * RT_PROWB + hh * 16;
            LBAR();
            const LAS unsigned char* vb = vtr + (c & 1) * 64 * RT_VROWB;
#pragma unroll
            for (int ks = 0; ks < 4; ++ks) vf[ks] = cat8(tr16(vb + (16 * ks) * RT_VROWB), tr16(vb + (16 * ks + 4) * RT_VROWB));
            {
                s16x4 qlo[3][2], qhi[3][2];
#pragma unroll
                for (int kk = 0; kk < 2; ++kk)
#pragma unroll
                    for (int nt = 0; nt < 2; ++nt) { qlo[kk][nt] = *(const LAS s16x4*)(qrowC + nt * 32 * RT_QROWB + kk * 32); qhi[kk][nt] = *(const LAS s16x4*)(qrowC + nt * 32 * RT_QROWB + kk * 32 + 16); }
#pragma unroll
                for (int k = 0; k < 16; ++k) {
                    if (k < 14) {
#pragma unroll
                        for (int nt = 0; nt < 2; ++nt) { qlo[(k + 2) % 3][nt] = *(const LAS s16x4*)(qrowC + nt * 32 * RT_QROWB + (k + 2) * 32); qhi[(k + 2) % 3][nt] = *(const LAS s16x4*)(qrowC + nt * 32 * RT_QROWB + (k + 2) * 32 + 16); }
                    }
                    __builtin_amdgcn_sched_barrier(0);
                    const int t = k >> 1, s = k & 1;
                    const bf16x8 as = pack8((f32x4){st[t][8 * s], st[t][8 * s + 1], st[t][8 * s + 2], st[t][8 * s + 3]}, (f32x4){st[t][8 * s + 4], st[t][8 * s + 5], st[t][8 * s + 6], st[t][8 * s + 7]});
#pragma unroll
                    for (int nt = 0; nt < 2; ++nt) oc[nt] = MFMA32(as, cat8(qlo[k % 3][nt], qhi[k % 3][nt]), oc[nt]);
                    __builtin_amdgcn_sched_barrier(0);
                }
            }
            {
#pragma unroll
                for (int t = 0; t < 8; ++t) st[t] *= gC;
                s16x4 kf[4][2];
#define KT_ADDR(u_) (ktr + (16 * (((u_) >> 1) & 3)) * RT_QROWB + (2 * ((u_) >> 3) + ((u_) & 1)) * 64)
#pragma unroll
                for (int u = 0; u < 3; ++u) { kf[u][0] = tr16(KT_ADDR(u)); kf[u][1] = tr16(KT_ADDR(u) + 4 * RT_QROWB); }
#pragma unroll
                for (int u = 0; u < 32; ++u) {
                    if (u + 3 < 32) { kf[(u + 3) & 3][0] = tr16(KT_ADDR(u + 3)); kf[(u + 3) & 3][1] = tr16(KT_ADDR(u + 3) + 4 * RT_QROWB); }
                    __builtin_amdgcn_sched_barrier(0);
                    const int t = 2 * (u >> 3) + (u & 1), ks = (u >> 1) & 3;
                    st[t] = MFMA32(cat8(kf[u & 3][0], kf[u & 3][1]), vf[ks], st[t]);
                    __builtin_amdgcn_sched_barrier(0);
                }
#undef KT_ADDR
            }
            LBAR();
            { const float gq0 = __builtin_amdgcn_exp2f(lg2 * (float)(r32 + 1)), gq1 = __builtin_amdgcn_exp2f(lg2 * (float)(r32 + 33)); oc[0] *= gq0; oc[1] *= gq1; }
#pragma unroll
            for (int ks = 0; ks < 4; ++ks)
#pragma unroll
                for (int nt = 0; nt < 2; ++nt) if (16 * ks <= 32 * nt + 31) { const bf16x8 bp = *(const LAS bf16x8*)(prow + nt * 32 * RT_PROWB + ks * 32); oc[nt] = MFMA32(vf[ks], bp, oc[nt]); }
#pragma unroll
            for (int nt = 0; nt < 2; ++nt) {
                float sq = 0.f;
#pragma unroll
                for (int i = 0; i < 16; ++i) sq += oc[nt][i] * oc[nt][i];
                sq += __shfl_xor(sq, 32);
                if (hh == 0) (void)__hip_atomic_fetch_add((LAS float*)(lds + R2_SQ) + (c & 1) * 64 + 32 * nt + r32, sq, __ATOMIC_RELAXED, __HIP_MEMORY_SCOPE_WORKGROUP);
#pragma unroll
                for (int g = 0; g < 4; ++g) {
                    const u32x2 sg = *(const LAS u32x2*)(lds + R2_SG + (32 * nt + r32) * RT_VROWB + (32 * w + 8 * g + 4 * hh) * 2);
                    const float o0 = oc[nt][4 * g] * __builtin_bit_cast(float, sg.x << 16), o1 = oc[nt][4 * g + 1] * __builtin_bit_cast(float, sg.x & 0xffff0000u);
                    const float o2 = oc[nt][4 * g + 2] * __builtin_bit_cast(float, sg.y << 16), o3 = oc[nt][4 * g + 3] * __builtin_bit_cast(float, sg.y & 0xffff0000u);
                    u32x2 pp; pp.x = pk_bf16(o0, o1); pp.y = pk_bf16(o2, o3);
                    if (!dry) __builtin_amdgcn_raw_buffer_store_b64(__builtin_bit_cast(__attribute__((ext_vector_type(2))) unsigned, pp), rs, vG, offG + uV + (unsigned)(c * 64 + 32 * nt) * 4096 + g * 16, 0);
                }
#pragma unroll
                for (int i = 0; i < 16; ++i) oc[nt][i] = 0.f;
            }
        }
        LBAR();
        LBAR();
    }
}

__device__ __forceinline__ int crow(int r, int hi) { return (r & 3) + 8 * (r >> 2) + 4 * hi; }
__device__ __forceinline__ void sb_wave(const bf16* QN, const bf16* KN, const bf16* VF, bf16* O, int vcu, int wave, int lane) {
    const int r32 = lane & 31, hh = lane >> 5;
#define SB_IDX(i_, bh_, qb_) const int bh_ = (vcu >> 3) + 32 * (i_), qb_ = ((((vcu & 7) + (i_)) & 7) << 3) + wave
#define SB_KBASE(bh_) (KN + ((size_t)(bh_) * SEQ + r32) * 64 + 8 * hh)
#define SB_VBASE(bh_) (VF + (size_t)(bh_) * 64 * 2048 + lane * 8)
    bf16x8 qN[4], kfU[4], vfU[2][2];
#define SB_LOAD_UNIT(bh_, qb_) do { const bf16* qp_ = QN + ((size_t)(bh_) * SEQ + 32 * (qb_) + r32) * 64 + 8 * hh; \
        _Pragma("unroll") for (int s = 0; s < 4; ++s) { qN[s] = *(const bf16x8*)(qp_ + 16 * s); kfU[s] = *(const bf16x8*)(SB_KBASE(bh_) + (size_t)(32 * (qb_)) * 64 + 16 * s); } \
        _Pragma("unroll") for (int dt = 0; dt < 2; ++dt) _Pragma("unroll") for (int sp = 0; sp < 2; ++sp) vfU[dt][sp] = *(const bf16x8*)(SB_VBASE(bh_) + (size_t)((((qb_) * 2 + dt) * 2 + sp) * 512)); } while (0)
    { SB_IDX(0, bh0, qb0); SB_LOAD_UNIT(bh0, qb0); }
#pragma unroll 1
    for (int i = 0; i < 8; ++i) {
        SB_IDX(i, bh, qblk);
        const int b = bh >> 4, h = bh & 15;
        const size_t row0 = (size_t)b * SEQ + 32 * qblk;
        bf16x8 qf[4], kfn[4], vfn[2][2];
#pragma unroll
        for (int s = 0; s < 4; ++s) { qf[s] = qN[s]; kfn[s] = kfU[s]; }
#pragma unroll
        for (int dt = 0; dt < 2; ++dt)
#pragma unroll
            for (int sp = 0; sp < 2; ++sp) vfn[dt][sp] = vfU[dt][sp];
        if (i + 1 < 8) { SB_IDX(i + 1, bh1, qb1); SB_LOAD_UNIT(bh1, qb1); }
        f32x16 oT[2];
#pragma unroll
        for (int q = 0; q < 16; ++q) { oT[0][q] = 0.f; oT[1][q] = 0.f; }
        float R = 0.f;
        const bf16* kbase = SB_KBASE(bh);
        const bf16* vbase = SB_VBASE(bh);
#define SB_LOAD(kt_) do { _Pragma("unroll") for (int s = 0; s < 4; ++s) kfn[s] = *(const bf16x8*)(kbase + (size_t)(32 * (kt_)) * 64 + 16 * s); \
        _Pragma("unroll") for (int dt = 0; dt < 2; ++dt) _Pragma("unroll") for (int sp = 0; sp < 2; ++sp) vfn[dt][sp] = *(const bf16x8*)(vbase + (size_t)((((kt_) * 2 + dt) * 2 + sp) * 512)); } while (0)
        for (int kt = qblk; kt >= 0; --kt) {
            bf16x8 kf[4], vf[2][2];
#pragma unroll
            for (int s = 0; s < 4; ++s) kf[s] = kfn[s];
#pragma unroll
            for (int dt = 0; dt < 2; ++dt)
#pragma unroll
                for (int sp = 0; sp < 2; ++sp) vf[dt][sp] = vfn[dt][sp];
            if (kt > 0) SB_LOAD(kt - 1);
            f32x16 z;
#pragma unroll
            for (int q = 0; q < 16; ++q) z[q] = 0.f;
#pragma unroll
            for (int s = 0; s < 4; ++s) z = MFMA32(kf[s], qf[s], z);
            float sp_[16], lb[16];
            const bool diag = (kt == qblk);
#pragma unroll
            for (int q = 0; q < 16; ++q) {
                const float zz = z[q];
                const float t = __builtin_amdgcn_exp2f(-__builtin_fabsf(zz));
                const float s = __builtin_fmaxf(zz, 0.f) + __builtin_amdgcn_logf(1.f + t);
                const bool valid = !diag || (crow(q, hh) < r32);
                sp_[q] = valid ? s : 0.f;
                lb[q] = valid ? (zz - s) : -INFINITY;
            }
            float gsum[4], pgs[4];
#pragma unroll
            for (int q = 0; q < 4; ++q) { gsum[q] = (sp_[4 * q] + sp_[4 * q + 1]) + (sp_[4 * q + 2] + sp_[4 * q + 3]); pgs[q] = __shfl_xor(gsum[q], 32); }
            float later = R;
            f32x16 pa;
#pragma unroll
            for (int q = 3; q >= 0; --q) {
                const float L = later + (hh == 0 ? pgs[q] : 0.f);
                const float s3 = L, s2 = s3 + sp_[4 * q + 3], s1 = s2 + sp_[4 * q + 2], s0 = s1 + sp_[4 * q + 1];
                pa[4 * q + 0] = __builtin_amdgcn_exp2f(lb[4 * q + 0] - s0);
                pa[4 * q + 1] = __builtin_amdgcn_exp2f(lb[4 * q + 1] - s1);
                pa[4 * q + 2] = __builtin_amdgcn_exp2f(lb[4 * q + 2] - s2);
                pa[4 * q + 3] = __builtin_amdgcn_exp2f(lb[4 * q + 3] - s3);
                later += gsum[q] + pgs[q];
            }
            R = later;
#pragma unroll
            for (int sp = 0; sp < 2; ++sp) {
                const bf16x8 pf = pack8((f32x4){pa[8 * sp], pa[8 * sp + 1], pa[8 * sp + 2], pa[8 * sp + 3]}, (f32x4){pa[8 * sp + 4], pa[8 * sp + 5], pa[8 * sp + 6], pa[8 * sp + 7]});
#pragma unroll
                for (int dt = 0; dt < 2; ++dt) oT[dt] = MFMA32(vf[dt][sp], pf, oT[dt]);
            }
            if (__all(R > 46.2f)) break;
        }
#undef SB_LOAD
#pragma unroll
        for (int dt = 0; dt < 2; ++dt)
#pragma unroll
            for (int q = 0; q < 4; ++q) {
                u32x2 pp; pp.x = pk_bf16(oT[dt][4 * q], oT[dt][4 * q + 1]); pp.y = pk_bf16(oT[dt][4 * q + 2], oT[dt][4 * q + 3]);
                *(u32x2*)(O + (row0 + r32) * 1024 + h * 64 + 32 * dt + 8 * q + 4 * hh) = pp;
            }
    }
#undef SB_IDX
#undef SB_KBASE
#undef SB_VBASE
#undef SB_LOAD_UNIT
}

__device__ __forceinline__ void fix_phase(const bf16* HF, const bf16* HL, const float* cw, const float* cb, bf16* ACT, int vcu, int G) {
    const int NIT = 512 * 2 * (FF / 4), stride = G * NTHREADS;
    for (int it0 = vcu * NTHREADS + threadIdx.x; it0 < NIT; it0 += 3 * stride) {
        f32x4 u0[3][2], u1[3][2], u2[3][2], w0[3][2], w1[3][2], w2[3][2], bb[3][2];
#pragma unroll
        for (int q = 0; q < 3; ++q) {
            const int it = (it0 + q * stride < NIT) ? it0 + q * stride : it0;
            const int cg4 = it % (FF / 4), bi = it / (FF / 4), i = bi & 1, blk = bi >> 1;
            const int c0 = 4 * cg4, pn = c0 >> 7, j = c0 & 127, nv = 256 * pn + j;
            const bool first = (blk & 31) == 0;
            const int pb = first ? blk : blk - 1;
#pragma unroll
            for (int half = 0; half < 2; ++half) {
                const int nn = nv + 128 * half, co = half * FF + c0;
#define FIX_LD4(P) ({ const u32x2 t_ = *(const u32x2*)(P); (f32x4){__builtin_bit_cast(float, t_.x << 16), __builtin_bit_cast(float, t_.x & 0xffff0000u), __builtin_bit_cast(float, t_.y << 16), __builtin_bit_cast(float, t_.y & 0xffff0000u)}; })
                u0[q][half] = FIX_LD4(HF + (size_t)(blk * 2 + i) * FF2 + nn);
                const f32x4 hf0 = FIX_LD4(HF + (size_t)(blk * 2) * FF2 + nn), hl1 = FIX_LD4(HL + (size_t)(pb * 2 + 1) * FF2 + nn), hl0 = FIX_LD4(HL + (size_t)(pb * 2) * FF2 + nn);
#undef FIX_LD4
                const f32x4 zero = (f32x4){0.f, 0.f, 0.f, 0.f}, pl1 = first ? zero : hl1, pl0 = first ? zero : hl0;
                u1[q][half] = (i == 1) ? hf0 : pl1; u2[q][half] = (i == 1) ? pl1 : pl0;
                w0[q][half] = *(const f32x4*)(cw + co); w1[q][half] = *(const f32x4*)(cw + FF2 + co); w2[q][half] = *(const f32x4*)(cw + 2 * FF2 + co); bb[q][half] = *(const f32x4*)(cb + co);
            }
        }
#pragma unroll
        for (int q = 0; q < 3; ++q) {
            const int it = it0 + q * stride;
            if (it < NIT) {
                const int cg4 = it % (FF / 4), bi = it / (FF / 4), i = bi & 1, blk = bi >> 1, c0 = 4 * cg4;
                const f32x4 val = bb[q][0] + w2[q][0] * u0[q][0] + w1[q][0] * u1[q][0] + w0[q][0] * u2[q][0];
                const f32x4 gat = bb[q][1] + w2[q][1] * u0[q][1] + w1[q][1] * u1[q][1] + w0[q][1] * u2[q][1];
                const f32x4 o = val * pg8::silu4(gat);
                u32x2 p2; p2.x = pk_bf16(o[0], o[1]); p2.y = pk_bf16(o[2], o[3]);
                *(u32x2*)(ACT + (size_t)(64 * blk + i) * FF + c0) = p2;
            }
        }
    }
}

__device__ __forceinline__ XcdBarrier mk_bar(ptab_t tab, LAS unsigned char* lds) { XcdBarrier b; b.bar = (unsigned*)(ldp(tab, T_WS) + WS_CTL) + 1024; b.x = xb_xcc_id(); b.st = (volatile LAS unsigned*)(lds + MISC_OFF) + 8; return b; }
__global__ void __launch_bounds__(NTHREADS, 2) yoco_fwd(Args a) {
    extern __shared__ __attribute__((aligned(16))) unsigned char lds_raw[];
    LAS unsigned char* lds = (LAS unsigned char*)lds_raw;
    volatile LAS unsigned* MISC = (volatile LAS unsigned*)(lds + MISC_OFF);
    LAS unsigned long long* tabw = (LAS unsigned long long*)(lds + MISC_OFF + 64);
    const ptab_t tab = (ptab_t)(lds + MISC_OFF + 64);
    if (threadIdx.x < 16) MISC[threadIdx.x] = 0u;
    if (threadIdx.x == 64) {
#pragma unroll
        for (int i = 0; i < 21; ++i) tabw[i] = (unsigned long long)a.in[i];
        tabw[T_OUT] = (unsigned long long)a.out; tabw[T_WS] = (unsigned long long)a.ws;
        MISC[0] = (unsigned)a.ph_lo; MISC[1] = (unsigned)a.ph_hi;
    }
    __syncthreads();
    if (a.ph_hi - a.ph_lo > 1) (void)xcd_barrier_post((unsigned*)(a.ws + WS_CTL) + 1024, MISC + 8);
#define PH_LO ((int)__builtin_amdgcn_readfirstlane(MISC[0]))
#define PH_HI ((int)__builtin_amdgcn_readfirstlane(MISC[1]))
#define IN(k) (PH_LO <= (k) && (k) < PH_HI)
#define STAMP(k) do { if (PROBE_TS >= 0 && threadIdx.x == 0) { const unsigned long long t_ = __builtin_amdgcn_s_memrealtime(); *(volatile LAS unsigned long long*)(lds + MISC_OFF + 256 + 8 * (k)) = t_; } } while (0)
#define SEAM(k) do { if (IN(k) && IN((k) + 1)) xcd_barrier(mk_bar(tab, lds)); STAMP((k) + 1); } while (0)
#define GRID ((int)gridDim.x)
#define BX ((int)blockIdx.x)
#define VCU ((GRID % 8 == 0) ? (BX % 8) * (GRID / 8) + BX / 8 : BX)
#define WSP (ldp(tab, T_WS))

    STAMP(0);
#ifndef SKIP_P0
    if (IN(0)) { for (int rep = 0; rep < REPS(0); ++rep) { p0_phase(tab, lds, VCU, GRID); LBAR(); } }
#endif
    if (IN(0) && IN(1)) {
        if (MK_ONE_LAUNCH && PH_LO < 0) { cg::this_grid().sync(); }
        xcd_barrier(mk_bar(tab, lds));
    }
    STAMP(1);
#ifndef SKIP_P1
    if (IN(1)) { for (int rep = 0; rep < REPS(1); ++rep) p1_phase(tab, lds, VCU, GRID); }
#endif
    SEAM(1);
    if (IN(2)) {
        pg8::Gemm g{(const bf16*)(WSP + WS_A), (const bf16*)(WSP + WS_WT1), M, RN, D, D}; pg8::StaticOrder S; S.init(M, RN, GRID, BX);
        pg8::EpiRetIn E{tab};
        for (int rep = 0; rep < REPS(2); ++rep) pg8::gemm_phase<pg8::EpiRetIn, pg8::StaticOrder, true, true>(lds, g, S, E);
    }
    SEAM(2);
#ifndef SKIP_RET
    if (IN(3)) {
        unsigned char* ws = WSP;
        for (int rep = 0; rep < REPS(3); ++rep) for (int u = VCU; u < 256; u += GRID) RET_UNIT(lds, (const bf16*)(ws + WS_Q), (const bf16*)(ws + WS_KD), (const bf16*)(ws + WS_V), (bf16*)(ws + WS_SG), (float*)(ws + WS_SSO), u, rep == 0 && REPS(3) == 2);
    }
#endif
    SEAM(3);
    if (IN(4)) {
        pg8::Gemm g{(const bf16*)(WSP + WS_SG), (const bf16*)(WSP + WS_WT2), M, D, 512, 2048}; pg8::SegOrder S; S.init(M, D, GRID, BX);
        pg8::EpiRes<0> E{tab};
        {
            const int slot = threadIdx.x >> 8, r = threadIdx.x & 255; pg8::Unit u;
            if (S.next(4 * slot, u)) {
                const float* sp4 = (const float*)(WSP + WS_SSO) + (size_t)(u.pm * 256 + r) * 16; f32x4 s4;
#pragma unroll
                for (int hh = 0; hh < 4; ++hh) { const f32x4 q = *(const f32x4*)(sp4 + 4 * hh); s4[hh] = (q[0] + q[1]) + (q[2] + q[3]); }
                const float e0 = s4[0] * (1.f / 512.f) + EPS, e1 = s4[1] * (1.f / 512.f) + EPS, e2 = s4[2] * (1.f / 512.f) + EPS, e3 = s4[3] * (1.f / 512.f) + EPS;
                f32x4 o; o[0] = __builtin_sqrtf(e1 / e0); o[1] = __builtin_sqrtf(e2 / e1); o[2] = __builtin_sqrtf(e3 / e2); o[3] = 1.f / __builtin_sqrtf(e3);
                *(LAS f32x4*)(lds + pg8::LDS_XTRA + (slot * 256 + r) * 16) = o;
            }
            LBAR();
        }
        pg8::gemm_phase<pg8::EpiRes<0>, pg8::SegOrder, true, true>(lds, g, S, E);
    }
    SEAM(4);
#pragma unroll 1
    for (int l = 0; l < 2; ++l) {
        const int pb = (l == 0) ? 5 : 11;
        if (IN(pb)) {
            pg8::Gemm g{(const bf16*)(WSP + WS_A), (const bf16*)(WSP + WS_WT3) + (size_t)l * FF2 * 1024, M, FF2, D, D}; pg8::StaticOrder S; S.init(M, FF2, GRID, BX);
            pg8::EpiFfnIn E{tab, l};
            for (int rep = 0; rep < ((l == 0) ? REPS(5) : 1); ++rep) pg8::gemm_phase<pg8::EpiFfnIn, pg8::StaticOrder, true, true>(lds, g, S, E);
        }
        SEAM(pb);
        if (IN(pb + 1)) { unsigned char* ws = WSP; fix_phase((const bf16*)(ws + WS_HF), (const bf16*)(ws + WS_HL), (const float*)ldp(tab, 18) + l * 3 * FF2, (const float*)ldp(tab, 19) + l * FF2, (bf16*)(ws + WS_ACT), VCU, GRID); }
        SEAM(pb + 1);
        if (IN(pb + 2)) {
            pg8::Gemm g{(const bf16*)(WSP + WS_ACT), (const bf16*)(WSP + WS_WT4) + (size_t)l * 1024 * FF, M, D, FF, FF}; pg8::StaticOrder S; S.init(M, D, GRID, BX);
            if (l == 0) { pg8::EpiRes<1> E{tab}; pg8::gemm_phase<pg8::EpiRes<1>, pg8::StaticOrder, true, true>(lds, g, S, E); }
            else        { pg8::EpiRes<3> E{tab}; pg8::gemm_phase<pg8::EpiRes<3>, pg8::StaticOrder, true, true>(lds, g, S, E); }
        }
        if (l == 1) break;
        SEAM(7);
        if (IN(8)) {
            { pg8::Gemm g{(const bf16*)(WSP + WS_A), (const bf16*)(WSP + WS_WT5), M, 2048, D, D}; pg8::StaticOrder S; S.init(M, 2048, GRID, BX);
              pg8::EpiKVQ<0> E{tab};
              for (int rep = 0; rep < REPS(8); ++rep) pg8::gemm_phase<pg8::EpiKVQ<0>, pg8::StaticOrder, true, true>(lds, g, S, E); }
            { pg8::Gemm g{(const bf16*)(WSP + WS_AM1), (const bf16*)(WSP + WS_WT6), M, D, D, D}; pg8::StaticOrder S; S.init(M, D, GRID, BX);
              pg8::EpiKVQ<1> E{tab};
              pg8::gemm_phase<pg8::EpiKVQ<1>, pg8::StaticOrder, true, true>(lds, g, S, E); }
        }
        SEAM(8);
#ifndef SKIP_SB
        if (IN(9)) {
            unsigned char* ws = WSP; const int vcu = VCU, wave = __builtin_amdgcn_readfirstlane(threadIdx.x >> 6); int lane = threadIdx.x & 63;
            asm volatile("" : "+v"(lane));
            for (int rep = 0; rep < REPS(9); ++rep) sb_wave((const bf16*)(ws + WS_QN), (const bf16*)(ws + WS_KN), (const bf16*)(ws + WS_VT), (bf16*)(ws + WS_OSB), vcu, wave, lane);
        }
#endif
        SEAM(9);
        if (IN(10)) {
            pg8::Gemm g{(const bf16*)(WSP + WS_OSB), (const bf16*)(WSP + WS_WT7), M, D, D, D}; pg8::StaticOrder S; S.init(M, D, GRID, BX);
            pg8::EpiRes<2> E{tab};
            pg8::gemm_phase<pg8::EpiRes<2>, pg8::StaticOrder, true, true>(lds, g, S, E);
        }
        SEAM(10);
    }
#if PROBE_X >= 0
    {
        xcd_barrier(mk_bar(tab, lds)); STAMP(14);
        pg8::Gemm g{(const bf16*)(WSP + WS_OSB), (const bf16*)(WSP + WS_WT7), M, D, D, D}; pg8::StaticOrder S; S.init(M, D, GRID, BX);
        if (PROBE_X < 64) { pg8::EpiRes<2, PROBE_X & 63> E{tab};
        pg8::gemm_phase<pg8::EpiRes<2, PROBE_X & 63>, pg8::StaticOrder, true, true>(lds, g, S, E); }
    }
#endif
#if PROBE_TS >= 0
    {
        xcd_barrier(mk_bar(tab, lds)); STAMP(PROBE_X >= 0 ? 15 : 14);
        float* dlt = (float*)(WSP + WS_CTL) + 8192;
        if (BX == 0 && threadIdx.x == 0) {
            const volatile LAS unsigned long long* ts = (const volatile LAS unsigned long long*)(lds + MISC_OFF + 256);
            float t_us = (PROBE_TS >= 100) ? 200.f : (float)(ts[PROBE_TS + 1] - ts[PROBE_TS]) * 0.01f;
            __hip_atomic_store(dlt, __builtin_sqrtf(t_us * (3.35e-6f * PROBE_GAIN)), __ATOMIC_RELAXED, __HIP_MEMORY_SCOPE_AGENT);
        }
        xcd_barrier(mk_bar(tab, lds));
        const float d = __hip_atomic_load(dlt, __ATOMIC_RELAXED, __HIP_MEMORY_SCOPE_AGENT);
        float* o = (float*)ldp(tab, T_OUT);
        for (int i = BX * NTHREADS + threadIdx.x; i < (1 << 20); i += GRID * NTHREADS) o[i] += d;
    }
#endif
#undef IN
#undef SEAM
}

extern "C" void kernel_launch(void* const* d_in, const int* in_sizes, int n_in, void* d_out, int out_size, void* d_ws, size_t ws_size, hipStream_t stream) {
    static int grid = 0;
    if (grid == 0) {
        if (n_in != 21 || in_sizes[0] != M * D || out_size != M * D || ws_size < WS_END) { fprintf(stderr, "kernel_launch: unexpected problem: n_in %d in0 %d out %d ws %zu (need %zu)\n", n_in, n_in > 0 ? in_sizes[0] : -1, out_size, ws_size, (size_t)WS_END); grid = -1; return; }
        int dev = 0, cus = 0, per_cu = 0;
        if (hipGetDevice(&dev) != hipSuccess || hipDeviceGetAttribute(&cus, hipDeviceAttributeMultiprocessorCount, dev) != hipSuccess) { grid = -1; return; }
        if (hipFuncSetAttribute((const void*)yoco_fwd, hipFuncAttributeMaxDynamicSharedMemorySize, LDS_BYTES) != hipSuccess) { fprintf(stderr, "kernel_launch: hipFuncSetAttribute failed\n"); grid = -1; return; }
        if (hipOccupancyMaxActiveBlocksPerMultiprocessor(&per_cu, (const void*)yoco_fwd, NTHREADS, LDS_BYTES) != hipSuccess || per_cu < 1) { fprintf(stderr, "kernel_launch: occupancy query says %d\n", per_cu); (void)hipGetLastError(); per_cu = 1; }
        grid = cus;
        if (grid > 256) grid = 256;
    }
    if (grid < 0) return;
    (void)hipMemsetAsync((char*)d_ws + WS_CTL, 0, 65536, stream);
    Args a{};
    for (int i = 0; i < 21; ++i) a.in[i] = d_in[i];
    a.out = (float*)d_out; a.ws = (unsigned char*)d_ws;
#if MK_ONE_LAUNCH
    a.ph_lo = 0; a.ph_hi = NPHASE;
    void* args[] = {&a};
    hipError_t e = hipLaunchCooperativeKernel((const void*)yoco_fwd, dim3(grid), dim3(NTHREADS), args, LDS_BYTES, stream);
    if (e != hipSuccess) fprintf(stderr, "kernel_launch: cooperative launch failed: %s\n", hipGetErrorString(e));
#else
    for (int p = 0; p < NPHASE; ++p) { a.ph_lo = p; a.ph_hi = p + 1; hipLaunchKernelGGL(yoco_fwd, dim3(grid), dim3(NTHREADS), LDS_BYTES, stream, a); }
#endif
}
```

```cpp
#include <hip/hip_runtime.h>
#include <hip/hip_cooperative_groups.h>
#include <cstdio>
#include <cstdint>
namespace cg = cooperative_groups;
namespace pg8 {
#define PG8_LAS __attribute__((address_space(3)))
typedef unsigned short bf16_t;
typedef short bf16x8 __attribute__((ext_vector_type(8)));
typedef float f32x4 __attribute__((ext_vector_type(4)));
typedef unsigned u32x4 __attribute__((ext_vector_type(4)));
constexpr int BM = 256, BK = 64, HALF = 128, HTB = HALF * BK * 2  , STAGE_BYTES = 8 * HTB, NXCD = 8, WGM = 8;

__host__ __device__ __forceinline__ int lds_byte(int r, int c) { const int st = (r >> 4) * 2 + (c >> 5), rr = r & 15, cc = c & 31, ob = rr * 64 + cc * 2; return st * 1024 + (ob ^ (((ob >> 9) & 1) << 5)); }
__host__ __device__ __forceinline__ void stage_rc(int b, int& R, int& C) { const int st = b / 1024, sb = b % 1024, swz = sb ^ (((sb >> 9) & 1) << 5); R = (st >> 1) * 16 + swz / 64; C = (st & 1) * 32 + (swz % 64) / 2; }
__host__ __device__ __forceinline__ int perm32(int rho) { const int n = rho >> 4, i = rho & 15; return 8 * (i >> 2) + 4 * n + (i & 3); }

struct Unit { int pm, pn, kk; };
struct Gemm { const bf16_t* A; const bf16_t* Bt; int M, N, K, ld; };

struct StaticOrder {
    int nM, nN, nwg, G, c;
    __host__ __device__ void init(int M, int N, int G_, int c_) { nM = M / BM; nN = N / BM; nwg = nM * nN; G = G_; c = c_; }
    __host__ __device__ bool next(int i, Unit& u) const {
        const long L = (long)i * G + c; if (L >= nwg) return false;
        int wgid = (int)L; { const int q = nwg / NXCD, r = nwg % NXCD, xcd = wgid % NXCD, off = wgid / NXCD; wgid = (xcd < r ? xcd * (q + 1) : r * (q + 1) + (xcd - r) * q) + off; }
        const int nig = WGM * nN, gid = wgid / nig, fm = gid * WGM, gsz = (nM - fm) < WGM ? (nM - fm) : WGM;
        u.pm = fm + ((wgid % nig) % gsz); u.pn = (wgid % nig) / gsz; u.kk = 0; return true;
    }
    __device__ __forceinline__ void a_ready(const Unit&) const {}
    __device__ __forceinline__ void done(const Unit&) const {}
};

struct SegOrder : StaticOrder {
    __host__ __device__ bool next(int i, Unit& u) const { if (!StaticOrder::next(i >> 2, u)) return false; u.kk = i & 3; return true; }
};
typedef float f32x2 __attribute__((ext_vector_type(2)));
typedef __bf16 bf16x2_t __attribute__((ext_vector_type(2)));
constexpr float EPS = 1e-6f;
__device__ __forceinline__ unsigned pk_bf16(float lo, float hi) { f32x2 v = {lo, hi}; bf16x2_t b = __builtin_convertvector(v, bf16x2_t); return __builtin_bit_cast(unsigned, b); }
__device__ __forceinline__ u32x4 pk8(const f32x4 a, const f32x4 b) { u32x4 w; w.x = pk_bf16(a[0], a[1]); w.y = pk_bf16(a[2], a[3]); w.z = pk_bf16(b[0], b[1]); w.w = pk_bf16(b[2], b[3]); return w; }
__device__ __forceinline__ float silu_f(float x) { return x * __builtin_amdgcn_rcpf(1.f + __builtin_amdgcn_exp2f(-1.44269504089f * x)); }
__device__ __forceinline__ f32x4 silu4(f32x4 v) { f32x4 o; o[0] = silu_f(v[0]); o[1] = silu_f(v[1]); o[2] = silu_f(v[2]); o[3] = silu_f(v[3]); return o; }
__device__ __forceinline__ float dot4(const f32x4 a) { return (a[0] * a[0] + a[1] * a[1]) + (a[2] * a[2] + a[3] * a[3]); }
template <int CTRL> __device__ __forceinline__ float dppf(float old, float src) { return __builtin_bit_cast(float, __builtin_amdgcn_update_dpp(__builtin_bit_cast(int, old), __builtin_bit_cast(int, src), CTRL, 0xf, 0xf, false)); }


typedef const PG8_LAS unsigned long long* ptab_t;
enum { T_OUT = 21, T_WS = 22 };
__device__ __forceinline__ unsigned char* ldp(ptab_t tab, int k) { const unsigned long long v = tab[k]; const unsigned lo = __builtin_amdgcn_readfirstlane((unsigned)v), hi = __builtin_amdgcn_readfirstlane((unsigned)(v >> 32)); return (unsigned char*)(__attribute__((address_space(1))) unsigned char*)(((unsigned long long)hi << 32) | lo); }
__device__ __forceinline__ void dma4(const void* src_lane, PG8_LAS unsigned char* dst_wave_base) { __builtin_amdgcn_global_load_lds((const unsigned*)src_lane, (PG8_LAS unsigned*)dst_wave_base, 4, 0, 0); }
constexpr int LDS_TOTAL = 155648, LDS_MISC = LDS_TOTAL - 512, LDS_XTRA = 131072;
constexpr size_t MiB_ = 1u << 20;
constexpr int M_ = 32768;
constexpr size_t O_MODS = 65536, O_KVM = O_MODS + (size_t)2 * 16 * 6144 * 4, O_SW1 = O_KVM + (size_t)16 * 2048 * 4, O_SW3 = O_SW1 + (size_t)16 * 6144 * 4, O_SW5 = O_SW3 + (size_t)2 * 16 * 5632 * 4,
                 O_SW6 = O_SW5 + (size_t)16 * 2048 * 4, O_SS = O_SW6 + (size_t)16 * 1024 * 4, O_SSO = O_SS + (size_t)4 * M_ * 4, O_SMALL_END = O_SSO + (size_t)M_ * 16 * 4;
constexpr size_t O_A = 64 * MiB_, O_BIG = 128 * MiB_, O_Q = O_BIG, O_KD = O_BIG + 64 * MiB_, O_V = O_BIG + 128 * MiB_, O_SG = O_BIG + 256 * MiB_;
constexpr size_t O_H16 = O_BIG, O_ACT = O_BIG + 64 * MiB_, O_HF = O_ACT + 176 * MiB_, O_HL = O_HF + 22 * MiB_, O_AM1 = O_BIG + 284 * MiB_, O_KN = O_BIG + 64 * MiB_, O_VT = O_BIG + 128 * MiB_, O_QN = O_BIG + 192 * MiB_, O_OSB = O_BIG + 256 * MiB_;

struct EpiRetIn {
    static constexpr bool PERM = true, AFTER_DRAIN = false, SEG = false;
    ptab_t tab;
    __device__ __forceinline__ void prefetch(const Unit& u, int slot, PG8_LAS unsigned char* lds, int wid, int lane) const {
        unsigned char* ws = ldp(tab, T_WS); PG8_LAS unsigned char* base = lds + LDS_XTRA + slot * 3072; const int b = u.pm >> 3;
        if (wid < 4) { dma4((const float*)(ws + O_SS) + u.pm * BM + 64 * wid + lane, base + 256 * wid); dma4((const float*)(ws + O_SW1) + b * 6144 + u.pn * BM + 64 * wid + lane, base + 2048 + 256 * wid); }
        else dma4((const int*)ldp(tab, 2) + u.pm * BM + 64 * (wid - 4) + lane, base + 1024 + 256 * (wid - 4));
    }
    __device__ __forceinline__ void operator()(f32x4 (&acc)[2][2][4][2], const Unit& u, int wr, int wc, int slot, int) const {
        int lane_ = threadIdx.x & 63; asm volatile("" : "+v"(lane_)); const int fr = lane_ & 15, fq = lane_ >> 4;
        unsigned char* ws = ldp(tab, T_WS);
        const PG8_LAS unsigned char* tb = (const PG8_LAS unsigned char*)tab - 64 - LDS_MISC + LDS_XTRA + slot * 3072;
        const PG8_LAS float* ss = (const PG8_LAS float*)tb - u.pm * BM; const PG8_LAS int* pos = (const PG8_LAS int*)(tb + 1024) - u.pm * BM;
        const PG8_LAS float* sW = (const PG8_LAS float*)(tb + 2048) - ((u.pm >> 3) * 6144 + u.pn * 256);
        bf16_t* Q = (bf16_t*)(ws + O_Q); bf16_t* KD = (bf16_t*)(ws + O_KD); bf16_t* V = (bf16_t*)(ws + O_V); bf16_t* SG = (bf16_t*)(ws + O_SG);
        const int b = u.pm >> 3, cl = wc * 32 + 8 * fq, row0 = u.pm * BM + wr * 64 + fr;
        f32x4 sw[2][2];
#pragma unroll
        for (int bj = 0; bj < 2; ++bj)
#pragma unroll
            for (int n = 0; n < 2; ++n) sw[bj][n] = *(const f32x4*)(sW + b * 6144 + u.pn * 256 + bj * 128 + cl + 4 * n);
        if (u.pn < 8) {
            const bool isk = u.pn >= 4; const int h = u.pn & 3;
            bf16_t* dst = (isk ? KD : Q) + h * 256 + cl;
            float inv[8];
#pragma unroll
            for (int i = 0; i < 8; ++i) inv[i] = __builtin_amdgcn_exp2f(-(float)(cl + i) * 0.10381025296523f) * 0.15915494309189535f;
            const float lg = __builtin_amdgcn_logf(1.f - __builtin_amdgcn_exp2f(-5.f - (float)h));
#pragma unroll
            for (int ai = 0; ai < 2; ++ai)
#pragma unroll
                for (int m = 0; m < 4; ++m) {
                    const int row = row0 + ai * HALF + m * 16;
                    const float p = (float)pos[row], rs = __builtin_amdgcn_rsqf(ss[row] * (1.f / 1024.f) + EPS);
                    const float ksc = isk ? 0.0625f * __builtin_amdgcn_exp2f(lg * (float)(63 - (row & 63))) : 1.f;
                    f32x4 o1[2], o2[2];
#pragma unroll
                    for (int n = 0; n < 2; ++n)
#pragma unroll
                        for (int e = 0; e < 4; ++e) {
                            const float x1 = acc[ai][0][m][n][e] * rs + sw[0][n][e], x2 = acc[ai][1][m][n][e] * rs + sw[1][n][e];
                            const float r = __builtin_amdgcn_fractf(p * inv[4 * n + e]);
                            const float s = __builtin_amdgcn_sinf(r), c = __builtin_amdgcn_cosf(r);
                            o1[n][e] = (x1 * c - x2 * s) * ksc; o2[n][e] = (x1 * s + x2 * c) * ksc;
                        }
                    *(u32x4*)(dst + (size_t)row * 1024) = pk8(o1[0], o1[1]);
                    *(u32x4*)(dst + (size_t)row * 1024 + 128) = pk8(o2[0], o2[1]);
                }
        } else {
            const bool isg = u.pn >= 16;
            bf16_t* dst = (isg ? SG : V) + ((u.pn - 8) & 7) * 256 + cl;
#pragma unroll
            for (int ai = 0; ai < 2; ++ai)
#pragma unroll
                for (int m = 0; m < 4; ++m) {
                    const int row = row0 + ai * HALF + m * 16;
                    const float rs = __builtin_amdgcn_rsqf(ss[row] * (1.f / 1024.f) + EPS);
#pragma unroll
                    for (int bj = 0; bj < 2; ++bj) {
                        f32x4 v0 = acc[ai][bj][m][0] * rs + sw[bj][0], v1 = acc[ai][bj][m][1] * rs + sw[bj][1];
                        if (isg) { v0 = silu4(v0); v1 = silu4(v1); }
                        *(u32x4*)(dst + (size_t)row * 2048 + bj * HALF) = pk8(v0, v1);
                    }
                }
        }
    }
};

template <bool WT> __device__ __forceinline__ void st16(void* p, u32x4 v) {
    if (WT) asm volatile("global_store_dwordx4 %0, %1, off sc1" :: "v"(p), "v"(v) : "memory"); else *(u32x4*)p = v;
}
template <int WHICH, int VAR = 0> struct EpiRes {
    static constexpr int NOUT = (WHICH == 1) ? 2 : (WHICH == 3 ? 0 : 1);
    static constexpr bool HOOK = (WHICH == 0), SSACC = (WHICH != 3);
    static constexpr int MB = (NOUT == 2) ? 1 : 2;
    static constexpr bool PERM = true, AFTER_DRAIN = false, SEG = HOOK;
    ptab_t tab;
    __device__ __forceinline__ void prefetch(const Unit&, int, PG8_LAS unsigned char*, int, int) const {}
    __device__ __forceinline__ void seg(f32x4 (&acc)[2][2][4][2], int kk, int tile, int wr) const {
        int lane_ = threadIdx.x & 63; asm volatile("" : "+v"(lane_)); const int fr = lane_ & 15;
        const PG8_LAS float* tb = (const PG8_LAS float*)((const PG8_LAS unsigned char*)tab - 64 - LDS_MISC + LDS_XTRA) + (tile * 256 + wr * 64 + fr) * 4 + kk;
#pragma unroll
        for (int ai = 0; ai < 2; ++ai)
#pragma unroll
            for (int m = 0; m < 4; ++m) {
                const float ratio = tb[(ai * HALF + m * 16) * 4];
#pragma unroll
                for (int bj = 0; bj < 2; ++bj)
#pragma unroll
                    for (int n = 0; n < 2; ++n) acc[ai][bj][m][n] *= ratio;
            }
    }
    __device__ __forceinline__ void operator()(f32x4 (&acc)[2][2][4][2], const Unit& u, int wr, int wc, int, int) const {
        int lane_ = threadIdx.x & 63; asm volatile("" : "+v"(lane_)); const int fr = lane_ & 15, fq = lane_ >> 4;
        unsigned char* ws = ldp(tab, T_WS); float* hout = (float*)ldp(tab, T_OUT); bf16_t* h16 = (bf16_t*)(ws + O_H16);
        const float* mods = (const float*)(ws + O_MODS);
        const float* hin = (const float*)ldp(tab, 0);
        const float* gate = mods + (WHICH >= 2 ? 16 * 6144 : 0) + ((WHICH == 0 || WHICH == 2) ? 2048 : 5120);
        const float* g0 = nullptr; const float* sc0 = nullptr; int st0 = 6144; bf16_t* o0 = (bf16_t*)(ws + O_A);
        const float* g1 = nullptr; const float* sc1 = nullptr; const int st1 = 6144; bf16_t* o1 = (bf16_t*)(ws + O_AM1);
        if (WHICH == 0) { g0 = (const float*)ldp(tab, 6); sc0 = mods + 4096; }
        if (WHICH == 1) { g0 = (const float*)ldp(tab, 11); sc0 = (const float*)(ws + O_KVM) + 1024; st0 = 2048; g1 = (const float*)ldp(tab, 5) + 1024; sc1 = mods + 16 * 6144 + 1024; }
        if (WHICH == 2) { g0 = (const float*)ldp(tab, 6) + 1024; sc0 = mods + 16 * 6144 + 4096; }
        float* ss = (float*)(ws + O_SS) + (WHICH + 1) * M_;
        const int b = u.pm >> 3, cl = wc * 32 + 8 * fq, row0 = u.pm * BM + wr * 64 + fr;
        f32x4 gt[2][2], gs0[2][2], gs1[2][2];
#pragma unroll
        for (int bj = 0; bj < 2; ++bj)
#pragma unroll
            for (int n = 0; n < 2; ++n) {
                const int col = u.pn * BM + bj * HALF + cl + 4 * n;
                gt[bj][n] = *(const f32x4*)(gate + b * 6144 + col);
                if (NOUT >= 1) gs0[bj][n] = *(const f32x4*)(g0 + col) * (*(const f32x4*)(sc0 + b * st0 + col) + 1.f);
                if (NOUT >= 2) gs1[bj][n] = *(const f32x4*)(g1 + col) * (*(const f32x4*)(sc1 + b * st1 + col) + 1.f);
            }
#pragma unroll
        for (int ai = 0; ai < 2; ++ai)
#pragma unroll
            for (int mp = 0; mp < 4; mp += MB) {
                f32x4 pre[MB][2][2];
#pragma unroll
                for (int m = 0; m < MB; ++m)
#pragma unroll
                    for (int bj = 0; bj < 2; ++bj) { const size_t off = (size_t)(row0 + ai * HALF + (mp + m) * 16) * 1024 + u.pn * BM + bj * HALF + cl; if (WHICH == 0) { pre[m][bj][0] = *(const f32x4*)(hin + off); pre[m][bj][1] = *(const f32x4*)(hin + off + 4); }
                        else { u32x4 hb = (u32x4){0u, 0u, 0u, 0u}; if (!(VAR & 4)) hb = *(const u32x4*)(h16 + off);
                               pre[m][bj][0] = (f32x4){__builtin_bit_cast(float, hb.x << 16), __builtin_bit_cast(float, hb.x & 0xffff0000u), __builtin_bit_cast(float, hb.y << 16), __builtin_bit_cast(float, hb.y & 0xffff0000u)};
                               pre[m][bj][1] = (f32x4){__builtin_bit_cast(float, hb.z << 16), __builtin_bit_cast(float, hb.z & 0xffff0000u), __builtin_bit_cast(float, hb.w << 16), __builtin_bit_cast(float, hb.w & 0xffff0000u)}; } }
#pragma unroll
                for (int m = 0; m < MB; ++m) {
                    const int row = row0 + ai * HALF + (mp + m) * 16;
                    float sq = 0.f;
#pragma unroll
                    for (int bj = 0; bj < 2; ++bj) {
                        const size_t off = (size_t)row * 1024 + u.pn * BM + bj * HALF + cl;
                        const f32x4 h0 = pre[m][bj][0] + gt[bj][0] * acc[ai][bj][mp + m][0], h1 = pre[m][bj][1] + gt[bj][1] * acc[ai][bj][mp + m][1];
                        const size_t offs = (VAR & 32) ? (size_t)(row - fr + 8 * bj + (lane_ >> 3)) * 1024 + u.pn * BM + wc * 64 + 8 * (lane_ & 7) : off;
                        if (WHICH == 3) { *(f32x4*)(hout + off) = h0; *(f32x4*)(hout + off + 4) = h1; } else if (!(VAR & 1)) st16<(VAR & 16) != 0>(h16 + offs, pk8(h0, h1));
                        if (SSACC) sq += dot4(h0) + dot4(h1);
                        if (NOUT >= 1 && !(VAR & 2)) st16<(VAR & 16) != 0>(o0 + offs, pk8(h0 * gs0[bj][0], h1 * gs0[bj][1]));
                        if (NOUT >= 2) *(u32x4*)(o1 + off) = pk8(h0 * gs1[bj][0], h1 * gs1[bj][1]);
                    }
                    if (SSACC) { sq += __shfl_xor(sq, 16); sq += __shfl_xor(sq, 32); if ((VAR & 8) ? (sq == 1.2345e-30f) : (fq == 0)) atomicAdd(ss + row, sq); }
                }
                asm volatile("" ::: "memory");
            }
    }
};

struct EpiFfnIn {
    static constexpr bool PERM = true, AFTER_DRAIN = false, SEG = false;
    ptab_t tab; int l;
    __device__ __forceinline__ void prefetch(const Unit& u, int slot, PG8_LAS unsigned char* lds, int wid, int lane) const {
        unsigned char* ws = ldp(tab, T_WS); PG8_LAS unsigned char* base = lds + LDS_XTRA + slot * 6144; const int b = u.pm >> 3;
        if (wid < 4) dma4((const float*)(ws + O_SS) + (l == 0 ? 1 : 3) * M_ + u.pm * BM + 64 * wid + lane, base + 256 * wid);
        else dma4((const float*)(ws + O_SW3) + l * 16 * 5632 + b * 5632 + u.pn * BM + 64 * (wid - 4) + lane, base + 1024 + 256 * (wid - 4));
        const int v = wid >> 1, bj = wid & 1;
        const float* src = (v < 3 ? (const float*)ldp(tab, 18) + l * 3 * 5632 + v * 5632 : (const float*)ldp(tab, 19) + l * 5632) + bj * 2816 + u.pn * HALF + lane;
        dma4(src, base + 2048 + v * 1024 + (128 * bj) * 4); dma4(src + 64, base + 2048 + v * 1024 + (128 * bj + 64) * 4);
    }
    __device__ __forceinline__ void operator()(f32x4 (&acc)[2][2][4][2], const Unit& u, int wr, int wc, int slot, int) const {
        int lane_ = threadIdx.x & 63; asm volatile("" : "+v"(lane_)); const int fr = lane_ & 15, fq = lane_ >> 4;
        unsigned char* ws = ldp(tab, T_WS);
        const PG8_LAS unsigned char* tb = (const PG8_LAS unsigned char*)tab - 64 - LDS_MISC + LDS_XTRA + slot * 6144;
        const PG8_LAS float* ss = (const PG8_LAS float*)tb - u.pm * BM;
        const PG8_LAS float* sW = (const PG8_LAS float*)(tb + 1024) - ((u.pm >> 3) * 5632 + u.pn * BM);
        const PG8_LAS float* tcw = (const PG8_LAS float*)(tb + 2048);
        bf16_t* ACT = (bf16_t*)(ws + O_ACT); bf16_t* HF = (bf16_t*)(ws + O_HF); bf16_t* HL = (bf16_t*)(ws + O_HL);
        const int b = u.pm >> 3, cl = wc * 32 + 8 * fq, row0 = u.pm * BM + wr * 64 + fr, ch = u.pn * HALF + cl;
        {
            f32x4 sw[2][2];
#pragma unroll
            for (int bj = 0; bj < 2; ++bj)
#pragma unroll
                for (int n = 0; n < 2; ++n) sw[bj][n] = *(const f32x4*)(sW + b * 5632 + u.pn * BM + bj * HALF + cl + 4 * n);
#pragma unroll
            for (int ai = 0; ai < 2; ++ai)
#pragma unroll
                for (int m = 0; m < 4; ++m) {
                    const float rs = __builtin_amdgcn_rsqf(ss[row0 + ai * HALF + m * 16] * (1.f / 1024.f) + EPS);
#pragma unroll
                    for (int bj = 0; bj < 2; ++bj)
#pragma unroll
                        for (int n = 0; n < 2; ++n) acc[ai][bj][m][n] = acc[ai][bj][m][n] * rs + sw[bj][n];
                }
        }
#pragma unroll
        for (int ai = 0; ai < 2; ++ai) {
            const int blk = u.pm * 4 + ai * 2 + wr;
            if (fr < 2) {
                bf16_t* d = HF + (size_t)(blk * 2 + fr) * 5632 + u.pn * BM + cl;
#pragma unroll
                for (int bj = 0; bj < 2; ++bj) *(u32x4*)(d + bj * HALF) = pk8(acc[ai][bj][0][0], acc[ai][bj][0][1]);
            }
            if (fr >= 14) {
                bf16_t* d = HL + (size_t)(blk * 2 + fr - 14) * 5632 + u.pn * BM + cl;
#pragma unroll
                for (int bj = 0; bj < 2; ++bj) *(u32x4*)(d + bj * HALF) = pk8(acc[ai][bj][3][0], acc[ai][bj][3][1]);
            }
        }
#pragma unroll
        for (int bj = 0; bj < 2; ++bj)
#pragma unroll
            for (int n = 0; n < 2; ++n) {
                const int tcol = bj * HALF + cl + 4 * n;
                f32x4 w0 = *(const PG8_LAS f32x4*)(tcw + tcol), w1 = *(const PG8_LAS f32x4*)(tcw + 256 + tcol), w2 = *(const PG8_LAS f32x4*)(tcw + 512 + tcol), bb = *(const PG8_LAS f32x4*)(tcw + 768 + tcol);
                asm volatile("" : "+v"(w0), "+v"(w1), "+v"(w2), "+v"(bb));
#pragma unroll
                for (int ai = 0; ai < 2; ++ai)
#pragma unroll
                    for (int m = 3; m >= 0; --m) {
                        const f32x4 x = acc[ai][bj][m][n];
                        float y0 = bb[0] + w2[0] * x[0], y1 = bb[1] + w2[1] * x[1], y2 = bb[2] + w2[2] * x[2], y3 = bb[3] + w2[3] * x[3];
#define CONV_DPP8(SRC, C1, C0) asm volatile("s_nop 1\n\t" \
                            "v_fmac_f32_dpp %0, %4, %8 " C1 " row_mask:0xf bank_mask:0xf\n\tv_fmac_f32_dpp %1, %5, %9 " C1 " row_mask:0xf bank_mask:0xf\n\t" \
                            "v_fmac_f32_dpp %2, %6, %10 " C1 " row_mask:0xf bank_mask:0xf\n\tv_fmac_f32_dpp %3, %7, %11 " C1 " row_mask:0xf bank_mask:0xf\n\t" \
                            "v_fmac_f32_dpp %0, %4, %12 " C0 " row_mask:0xf bank_mask:0xf\n\tv_fmac_f32_dpp %1, %5, %13 " C0 " row_mask:0xf bank_mask:0xf\n\t" \
                            "v_fmac_f32_dpp %2, %6, %14 " C0 " row_mask:0xf bank_mask:0xf\n\tv_fmac_f32_dpp %3, %7, %15 " C0 " row_mask:0xf bank_mask:0xf" \
                            : "+v"(y0), "+v"(y1), "+v"(y2), "+v"(y3) : "v"(SRC[0]), "v"(SRC[1]), "v"(SRC[2]), "v"(SRC[3]), "v"(w1[0]), "v"(w1[1]), "v"(w1[2]), "v"(w1[3]), "v"(w0[0]), "v"(w0[1]), "v"(w0[2]), "v"(w0[3]))
                        CONV_DPP8(x, "row_shr:1", "row_shr:2");
                        if (m > 0) { const f32x4 xp = acc[ai][bj][m - 1][n]; CONV_DPP8(xp, "row_shl:15", "row_shl:14"); }
#undef CONV_DPP8
                        f32x4 y; y[0] = y0; y[1] = y1; y[2] = y2; y[3] = y3;
                        acc[ai][bj][m][n] = y;
                    }
            }
#pragma unroll
        for (int ai = 0; ai < 2; ++ai)
#pragma unroll
            for (int m = 0; m < 4; ++m) {
                const int row = row0 + ai * HALF + m * 16;
                const f32x4 v0 = acc[ai][0][m][0] * silu4(acc[ai][1][m][0]), v1 = acc[ai][0][m][1] * silu4(acc[ai][1][m][1]);
                if (m > 0 || fr >= 2) *(u32x4*)(ACT + (size_t)row * 2816 + ch) = pk8(v0, v1);
            }
    }
};

template <int MODE> struct EpiKVQ {
    static constexpr bool PERM = true, AFTER_DRAIN = false, SEG = false;
    ptab_t tab;
    static constexpr int nW = (MODE == 0) ? 2048 : 1024;
    __device__ __forceinline__ void prefetch(const Unit& u, int slot, PG8_LAS unsigned char* lds, int wid, int lane) const {
        unsigned char* ws = ldp(tab, T_WS); PG8_LAS unsigned char* base = lds + LDS_XTRA + 18432 + slot * 2048; const int b = u.pm >> 3;
        if (wid < 4) dma4((const float*)(ws + O_SS) + 2 * M_ + u.pm * BM + 64 * wid + lane, base + 256 * wid);
        else dma4((const float*)(ws + (MODE == 0 ? O_SW5 : O_SW6)) + b * nW + u.pn * BM + 64 * (wid - 4) + lane, base + 1024 + 256 * (wid - 4));
    }
    __device__ __forceinline__ void operator()(f32x4 (&acc)[2][2][4][2], const Unit& u, int wr, int wc, int slot, int) const {
        int lane_ = threadIdx.x & 63; asm volatile("" : "+v"(lane_)); const int fr = lane_ & 15, fq = lane_ >> 4;
        unsigned char* ws = ldp(tab, T_WS);
        const PG8_LAS unsigned char* tb = (const PG8_LAS unsigned char*)tab - 64 - LDS_MISC + LDS_XTRA + 18432 + slot * 2048;
        const PG8_LAS float* ss = (const PG8_LAS float*)tb - u.pm * BM;
        const PG8_LAS float* sW = (const PG8_LAS float*)(tb + 1024) - ((u.pm >> 3) * nW + u.pn * BM);
        const float* gain = (const float*)ldp(tab, MODE == 0 ? 13 : 15); bf16_t* DN = (bf16_t*)(ws + (MODE == 0 ? O_KN : O_QN)); bf16_t* VT = (bf16_t*)(ws + O_VT);
        const int b = u.pm >> 3, row0 = u.pm * BM + wr * 64 + fr, head = 4 * (u.pn & 3) + wc, dl = 8 * fq;
        f32x4 sw[2][2];
#pragma unroll
        for (int bj = 0; bj < 2; ++bj)
#pragma unroll
            for (int n = 0; n < 2; ++n) sw[bj][n] = *(const f32x4*)(sW + b * nW + u.pn * BM + bj * HALF + wc * 32 + dl + 4 * n);
        const bool isv = (MODE == 0) && (u.pn >= 4);
        if (!isv) {
            f32x4 gn[2][2];
#pragma unroll
            for (int bj = 0; bj < 2; ++bj)
#pragma unroll
                for (int n = 0; n < 2; ++n) gn[bj][n] = *(const f32x4*)(gain + 32 * bj + dl + 4 * n) * (MODE == 1 ? 0.125f * 1.44269504089f : 1.f);
#pragma unroll
            for (int ai = 0; ai < 2; ++ai)
#pragma unroll
                for (int m = 0; m < 4; ++m) {
                    const int row = row0 + ai * HALF + m * 16;
                    const float rs = __builtin_amdgcn_rsqf(ss[row] * (1.f / 1024.f) + EPS);
                    f32x4 v[2][2]; float sq = 0.f;
#pragma unroll
                    for (int bj = 0; bj < 2; ++bj)
#pragma unroll
                        for (int n = 0; n < 2; ++n) { v[bj][n] = acc[ai][bj][m][n] * rs + sw[bj][n]; sq += dot4(v[bj][n]); }
                    sq += __shfl_xor(sq, 16); sq += __shfl_xor(sq, 32);
                    const float rh = __builtin_amdgcn_rsqf(sq * (1.f / 64.f) + EPS);
#pragma unroll
                    for (int bj = 0; bj < 2; ++bj) *(u32x4*)(DN + ((size_t)(b * 16 + head) * 2048 + (row & 2047)) * 64 + 32 * bj + dl) = pk8(v[bj][0] * gn[bj][0] * rh, v[bj][1] * gn[bj][1] * rh);
                }
        } else {
            const int wv = wr * 4 + wc;
            PG8_LAS unsigned char* scr = (PG8_LAS unsigned char*)tab - 64 - LDS_MISC + LDS_XTRA + wv * 2304;
            PG8_LAS unsigned char* wrp = scr + fr * 144 + fq * 16;
            const int ln = fq * 16 + fr;
            const PG8_LAS unsigned char* rdp = scr + ((ln & 15) >> 2) * 144 + (16 * (ln >> 4) + 4 * (ln & 3)) * 2;
            bf16_t* vbase = VT + (size_t)(b * 16 + head) * 64 * 2048;
            typedef short v4i16_t __attribute__((ext_vector_type(4)));
#pragma unroll
            for (int ai = 0; ai < 2; ++ai)
#pragma unroll
                for (int m = 0; m < 4; ++m) {
                    const int row = row0 + ai * HALF + m * 16, s0 = (row - fr) & 2047;
                    const float rs = __builtin_amdgcn_rsqf(ss[row] * (1.f / 1024.f) + EPS);
#pragma unroll
                    for (int bj = 0; bj < 2; ++bj) *(PG8_LAS u32x4*)(wrp + bj * 64) = pk8(acc[ai][bj][m][0] * rs + sw[bj][0], acc[ai][bj][m][1] * rs + sw[bj][1]);
                    asm volatile("s_waitcnt lgkmcnt(0)" ::: "memory");
                    bf16_t* fbase = vbase + (size_t)((((s0 >> 5) * 2 + (ln >> 5)) * 2 + ((s0 >> 4) & 1)) * 64 + (ln & 31)) * 8;
#pragma unroll
                    for (int hq = 0; hq < 2; ++hq) {
                        const v4i16_t lo = __builtin_amdgcn_ds_read_tr16_b64_v4i16((PG8_LAS v4i16_t*)(rdp + (4 * hq) * 144)), hi = __builtin_amdgcn_ds_read_tr16_b64_v4i16((PG8_LAS v4i16_t*)(rdp + (4 * hq + 8) * 144));
                        const bf16x8 o = (bf16x8){lo[0], lo[1], lo[2], lo[3], hi[0], hi[1], hi[2], hi[3]};
                        *(bf16x8*)(fbase + hq * 32 * 8) = o;
                    }
                    asm volatile("s_waitcnt lgkmcnt(0)" ::: "memory");
                }
        }
    }
};
template <class Epi, class Sched, bool ALIGN_EPI = false, bool SP2 = false>
__device__ __forceinline__ void gemm_phase(PG8_LAS unsigned char* lds, const Gemm g, const Sched& S, const Epi& E) {
    int tid_ = threadIdx.x; asm volatile("" : "+v"(tid_));
    const int tid = tid_, wid = __builtin_amdgcn_readfirstlane(tid >> 6), lane = tid & 63, wr = wid >> 2, wc = wid & 3, fr = lane & 15, fq = lane >> 4;
    const int K = g.ld, nt = g.K / BK;
    unsigned voffA[2], voffB[2];
#pragma unroll
    for (int i = 0; i < 2; ++i) { int R, C; stage_rc(tid * 16 + i * 8192, R, C); const int Rb = Epi::PERM ? ((R & ~31) + perm32(R & 31)) : R;
        voffA[i] = (unsigned)(R * K + C) * 2u; voffB[i] = (unsigned)(Rb * K + C) * 2u; }
    const size_t kstep = (size_t)(BK * 2);
    const size_t hstep = (size_t)HALF * K * 2;
    const size_t tstep = 2 * hstep;
    const unsigned ldsw = (unsigned)wid * 1024u;
    const int aoff = lds_byte(wr * 64 + fr, fq * 8), boff = lds_byte(wc * 32 + fr, fq * 8);
#define PG8_SA(b, h) (((b) * 2 + (h)) * HTB)
#define PG8_SB(b, h) ((4 + (b) * 2 + (h)) * HTB)
#define PG8_STAGE(bufoff, gbase, voff) do { _Pragma("unroll") for (int _i = 0; _i < 2; ++_i) \
        __builtin_amdgcn_global_load_lds((const unsigned*)((const char*)(gbase) + (voff)[_i]), (PG8_LAS unsigned*)(lds + (bufoff) + ldsw + _i * 8192), 16, 0, 0); } while (0)
#define PG8_LDA(dst, b, h) do { _Pragma("unroll") for (int m = 0; m < 4; ++m) _Pragma("unroll") for (int k = 0; k < 2; ++k) dst[m][k] = *(const PG8_LAS bf16x8*)(lds + PG8_SA(b, h) + aoff + m * 2048 + k * 1024); } while (0)
#define PG8_LDB(dst, b, h) do { _Pragma("unroll") for (int n = 0; n < 2; ++n) _Pragma("unroll") for (int k = 0; k < 2; ++k) dst[n][k] = *(const PG8_LAS bf16x8*)(lds + PG8_SB(b, h) + boff + n * 2048 + k * 1024); } while (0)
#define PG8_MMA(ai, bj, At, Bt) do { __builtin_amdgcn_s_setprio(1); _Pragma("unroll") for (int m = 0; m < 4; ++m) _Pragma("unroll") for (int n = 0; n < 2; ++n) _Pragma("unroll") for (int k = 0; k < 2; ++k) \
        acc[ai][bj][m][n] = __builtin_amdgcn_mfma_f32_16x16x32_bf16(Bt[n][k], At[m][k], acc[ai][bj][m][n], 0, 0, 0); __builtin_amdgcn_s_setprio(0); } while (0)
#define PG8_WAIT_V(n) asm volatile("s_waitcnt vmcnt(" #n ")" ::: "memory")
#define PG8_WAIT_L(n) asm volatile("s_waitcnt lgkmcnt(" #n ")" ::: "memory")
#define PG8_BAR __builtin_amdgcn_s_barrier()
#define PG8_SCHED __builtin_amdgcn_sched_barrier(0)
    Unit cur, nxt; int ui = 0;
    if (!S.next(0, cur)) return;
    f32x4 acc[2][2][4][2];
#pragma unroll
    for (int a = 0; a < 2; ++a)
#pragma unroll
        for (int b = 0; b < 2; ++b)
#pragma unroll
            for (int m = 0; m < 4; ++m)
#pragma unroll
                for (int n = 0; n < 2; ++n) acc[a][b][m][n] = (f32x4){0.f, 0.f, 0.f, 0.f};
    bf16x8 At[4][2], B0[2][2], B1[2][2];
    const size_t sstep = (size_t)g.K * 2;
    const char* cA = (const char*)g.A + (size_t)cur.pm * tstep + cur.kk * sstep; const char* cB = (const char*)g.Bt + (size_t)cur.pn * tstep + cur.kk * sstep;
    S.a_ready(cur);
    E.prefetch(cur, 0, lds, wid, lane);
    if constexpr (SP2) {
        PG8_STAGE(PG8_SB(0, 0), cB, voffB); PG8_STAGE(PG8_SB(0, 1), cB + hstep, voffB); PG8_STAGE(PG8_SA(0, 0), cA, voffA); PG8_STAGE(PG8_SA(0, 1), cA + hstep, voffA);
        if (wr == 1) PG8_BAR;
        PG8_WAIT_V(2); PG8_BAR;
        PG8_STAGE(PG8_SB(1, 0), cB + kstep, voffB); PG8_STAGE(PG8_SA(1, 0), cA + kstep, voffA); PG8_STAGE(PG8_SB(1, 1), cB + hstep + kstep, voffB);
        PG8_WAIT_V(6); PG8_BAR;
    } else {
        PG8_STAGE(PG8_SB(0, 0), cB, voffB); PG8_STAGE(PG8_SA(0, 0), cA, voffA); PG8_STAGE(PG8_SB(0, 1), cB + hstep, voffB); PG8_STAGE(PG8_SA(0, 1), cA + hstep, voffA);
        if (wr == 1) PG8_BAR;
        PG8_WAIT_V(4); PG8_BAR;
        PG8_STAGE(PG8_SB(1, 0), cB + kstep, voffB); PG8_STAGE(PG8_SA(1, 0), cA + kstep, voffA); PG8_STAGE(PG8_SB(1, 1), cB + hstep + kstep, voffB);
        PG8_WAIT_V(6); PG8_BAR;
    }
    for (;;) {
        const bool has_next = S.next(ui + 1, nxt);
        const char* nA = has_next ? (const char*)g.A + (size_t)nxt.pm * tstep + nxt.kk * sstep : cA; const char* nB = has_next ? (const char*)g.Bt + (size_t)nxt.pn * tstep + nxt.kk * sstep : cB;
        for (int t = 0; t < nt; t += 2) {
            const bool last = (t == nt - 2);
            const char* a1 = cA + (size_t)(t + 1) * kstep;
            const char* a2 = last ? nA : cA + (size_t)(t + 2) * kstep; const char* b2 = last ? nB : cB + (size_t)(t + 2) * kstep;
            const char* a3 = a2 + kstep; const char* b3 = b2 + kstep;
            if (last && has_next) { S.a_ready(nxt); E.prefetch(nxt, (ui + 1) & 1, lds, wid, lane); }
            if constexpr (SP2) {
            PG8_LDB(B0, 0, 0); PG8_LDB(B1, 0, 1); PG8_SCHED; PG8_LDA(At, 0, 0); PG8_STAGE(PG8_SA(1, 1), a1 + hstep, voffA);
            PG8_WAIT_V(8); PG8_WAIT_L(0); PG8_BAR; PG8_MMA(0, 0, At, B0); PG8_MMA(0, 1, At, B1); PG8_BAR; PG8_SCHED;
            PG8_LDA(At, 0, 1); PG8_STAGE(PG8_SB(0, 0), b2, voffB); PG8_STAGE(PG8_SB(0, 1), b2 + hstep, voffB); PG8_STAGE(PG8_SA(0, 0), a2, voffA);
            PG8_WAIT_V(8); PG8_WAIT_L(0); PG8_BAR; PG8_MMA(1, 0, At, B0); PG8_MMA(1, 1, At, B1); PG8_BAR; PG8_SCHED;
            PG8_LDB(B0, 1, 0); PG8_LDB(B1, 1, 1); PG8_SCHED; PG8_LDA(At, 1, 0); PG8_STAGE(PG8_SA(0, 1), a2 + hstep, voffA);
            PG8_WAIT_V(8); PG8_WAIT_L(0); PG8_BAR; PG8_MMA(0, 0, At, B0); PG8_MMA(0, 1, At, B1); PG8_BAR; PG8_SCHED;
            PG8_LDA(At, 1, 1); PG8_STAGE(PG8_SB(1, 0), b3, voffB); PG8_STAGE(PG8_SB(1, 1), b3 + hstep, voffB); PG8_STAGE(PG8_SA(1, 0), a3, voffA);
            PG8_WAIT_V(8); PG8_WAIT_L(0); PG8_BAR; PG8_MMA(1, 0, At, B0); PG8_MMA(1, 1, At, B1); PG8_BAR; PG8_SCHED;
            } else {
            PG8_LDB(B0, 0, 0); PG8_SCHED; PG8_LDA(At, 0, 0); PG8_STAGE(PG8_SA(1, 1), a1 + hstep, voffA);
            PG8_WAIT_L(8); PG8_BAR; PG8_WAIT_L(0); PG8_MMA(0, 0, At, B0); PG8_BAR; PG8_SCHED;
            PG8_LDB(B1, 0, 1); PG8_STAGE(PG8_SB(0, 0), b2, voffB);
            PG8_BAR; PG8_WAIT_L(0); PG8_MMA(0, 1, At, B1); PG8_BAR;
            PG8_LDA(At, 0, 1); PG8_STAGE(PG8_SA(0, 0), a2, voffA);
            PG8_BAR; PG8_WAIT_L(0); PG8_MMA(1, 0, At, B0); PG8_BAR; PG8_SCHED;
            PG8_STAGE(PG8_SB(0, 1), b2 + hstep, voffB);
            PG8_WAIT_V(6); PG8_BAR; PG8_MMA(1, 1, At, B1); PG8_BAR;
            PG8_LDB(B0, 1, 0); PG8_SCHED; PG8_LDA(At, 1, 0); PG8_STAGE(PG8_SA(0, 1), a2 + hstep, voffA);
            PG8_WAIT_L(8); PG8_BAR; PG8_WAIT_L(0); PG8_MMA(0, 0, At, B0); PG8_BAR; PG8_SCHED;
            PG8_LDB(B1, 1, 1); PG8_STAGE(PG8_SB(1, 0), b3, voffB);
            PG8_BAR; PG8_WAIT_L(0); PG8_MMA(0, 1, At, B1); PG8_BAR;
            PG8_LDA(At, 1, 1); PG8_STAGE(PG8_SA(1, 0), a3, voffA);
            PG8_BAR; PG8_WAIT_L(0); PG8_MMA(1, 0, At, B0); PG8_BAR; PG8_SCHED;
            PG8_STAGE(PG8_SB(1, 1), b3 + hstep, voffB);
            PG8_WAIT_V(6); PG8_BAR; PG8_MMA(1, 1, At, B1); PG8_BAR;
            }
        }
        if constexpr (ALIGN_EPI) { if (wr == 0) PG8_BAR; }
        if constexpr (Epi::SEG) E.seg(acc, cur.kk, ui >> 2, wr);
        if (!Epi::SEG || cur.kk == 3) {
            if constexpr (!Epi::AFTER_DRAIN) { E(acc, cur, wr, wc, ui & 1, fq); S.done(cur); }
            if (!has_next) break;
#pragma unroll
            for (int a = 0; a < 2; ++a)
#pragma unroll
                for (int b = 0; b < 2; ++b)
#pragma unroll
                    for (int m = 0; m < 4; ++m)
#pragma unroll
                        for (int n = 0; n < 2; ++n) acc[a][b][m][n] = (f32x4){0.f, 0.f, 0.f, 0.f};
        }
        cur = nxt; cA = nA; cB = nB; ++ui;
        if constexpr (ALIGN_EPI) { if (wr == 1) PG8_BAR; }
    }
    PG8_WAIT_V(0);
    if constexpr (!ALIGN_EPI) { if (wr == 0) PG8_BAR; }
    PG8_BAR;
    if constexpr (Epi::AFTER_DRAIN) { E.fused(acc, cur, wr, wc, fr, fq, lds, wid, lane); S.done(cur); }
#undef PG8_SA
#undef PG8_SB
#undef PG8_STAGE
#undef PG8_LDA
#undef PG8_LDB
#undef PG8_MMA
#undef PG8_WAIT_V
#undef PG8_WAIT_L
#undef PG8_BAR
#undef PG8_SCHED
}
}

#define LAS __attribute__((address_space(3)))
typedef unsigned short bf16;
typedef float f32x4 __attribute__((ext_vector_type(4)));
typedef float f32x16 __attribute__((ext_vector_type(16)));
typedef short bf16x8 __attribute__((ext_vector_type(8)));
typedef short s16x4 __attribute__((ext_vector_type(4)));
typedef unsigned u32x4 __attribute__((ext_vector_type(4)));
typedef unsigned u32x2 __attribute__((ext_vector_type(2)));
using pg8::pk_bf16; using pg8::EPS;

#ifndef REP_PHASE
#ifndef PROBE_X
#define PROBE_X -1
#endif
#ifndef PROBE_GAIN
#define PROBE_GAIN 1
#endif
#define REP_PHASE -1
#endif
#define REPS(k) ((REP_PHASE == (k)) ? 2 : 1)
#ifndef PROBE_TS
#define PROBE_TS -1
#endif
#ifndef RET_V2
#define RET_V2 1
#endif
#if RET_V2
#define RET_UNIT ret_unit2
#else
#define RET_UNIT ret_unit
#endif
#ifndef MK_ONE_LAUNCH
#define MK_ONE_LAUNCH 1
#endif
constexpr int NWAVES = 8, NTHREADS = 512;
constexpr int NB = 16, SEQ = 2048, D = 1024, M = NB * SEQ, FF = 2816, FF2 = 5632, RN = 6144;
constexpr int NPHASE = 14;

constexpr size_t MiB = 1u << 20;
constexpr size_t WS_CTL = 0;
constexpr size_t WS_MODS = pg8::O_MODS, WS_KVM = pg8::O_KVM, WS_SW1 = pg8::O_SW1, WS_SW3 = pg8::O_SW3, WS_SW5 = pg8::O_SW5, WS_SW6 = pg8::O_SW6, WS_SS = pg8::O_SS, WS_SSO = pg8::O_SSO;
static_assert(pg8::O_SMALL_END <= 6 * MiB && pg8::M_ == M, "small region");
constexpr size_t WS_WT1 = 6 * MiB;
constexpr size_t WS_WT2 = WS_WT1 + (size_t)6144 * 1024 * 2;
constexpr size_t WS_WT3 = WS_WT2 + (size_t)1024 * 2048 * 2;
constexpr size_t WS_WT4 = WS_WT3 + (size_t)2 * 5632 * 1024 * 2;
constexpr size_t WS_WT5 = WS_WT4 + (size_t)2 * 1024 * 2816 * 2;
constexpr size_t WS_WT6 = WS_WT5 + (size_t)2048 * 1024 * 2;
constexpr size_t WS_WT7 = WS_WT6 + (size_t)1024 * 1024 * 2;
static_assert(WS_WT7 + (size_t)1024 * 1024 * 2 <= 64 * MiB, "weights region");
constexpr size_t WS_A = pg8::O_A, WS_Q = pg8::O_Q, WS_KD = pg8::O_KD, WS_V = pg8::O_V, WS_SG = pg8::O_SG, WS_ACT = pg8::O_ACT, WS_HF = pg8::O_HF, WS_HL = pg8::O_HL, WS_AM1 = pg8::O_AM1,
                 WS_KN = pg8::O_KN, WS_VT = pg8::O_VT, WS_QN = pg8::O_QN, WS_OSB = pg8::O_OSB;
constexpr size_t WS_END = 512 * MiB;
static_assert((size_t)512 * 2 * 5632 * 4 <= 22 * MiB && WS_HL + 22 * MiB <= WS_AM1 && WS_AM1 + 64 * MiB <= WS_END && WS_OSB + 64 * MiB <= WS_END && WS_ACT + (size_t)M * FF * 2 <= WS_HF && pg8::O_H16 + 64 * MiB <= WS_ACT && WS_QN + 64 * MiB <= WS_OSB, "big region");

constexpr int LDS_BYTES = pg8::LDS_TOTAL;
constexpr int MISC_OFF = LDS_BYTES - 512;
using pg8::ptab_t; using pg8::ldp; using pg8::T_OUT; using pg8::T_WS;

#define LBAR() do { asm volatile("s_waitcnt lgkmcnt(0)" ::: "memory"); __builtin_amdgcn_s_barrier(); asm volatile("" ::: "memory"); } while (0)

#define XB_TMO      128
#define XB_XCNT(j)  (256  + 64 * (j))
#define XB_XSUB(j)  (1280 + 64 * (j))
#define XB_XGEN(j)  (2304 + 64 * (j))
#define XB_TOP      3328
#define XB_TOPGEN   3392
#define XCD_BAR_WORDS 3456
#define XB_SPIN_CAP (1u << 20)
__device__ __forceinline__ unsigned xb_ld(unsigned* p)              { return __hip_atomic_load(p, __ATOMIC_RELAXED, __HIP_MEMORY_SCOPE_AGENT); }
__device__ __forceinline__ unsigned xb_add(unsigned* p, unsigned v) { return __hip_atomic_fetch_add(p, v, __ATOMIC_RELAXED, __HIP_MEMORY_SCOPE_AGENT); }
__device__ __forceinline__ unsigned xb_xcc_id() { return (unsigned)__builtin_amdgcn_s_getreg((3 << 11) | 20) & 0xFu; }
#define XB_SPIN(cond, bar) do { unsigned _sp = 0; while (cond) { __builtin_amdgcn_s_sleep(1); \
    if ((++_sp & 255u) == 0u) { if (xb_ld(&(bar)[XB_TMO])) break; if (_sp > XB_SPIN_CAP) { atomicAdd(&(bar)[XB_TMO], 1u); break; } } } } while (0)
struct XcdBarrier { unsigned* bar; unsigned x; volatile LAS unsigned* st; };
__device__ __forceinline__ XcdBarrier xcd_barrier_post(unsigned* bar, volatile LAS unsigned* st) {
    XcdBarrier b; b.bar = bar; b.x = xb_xcc_id(); b.st = st;
    if (threadIdx.x == 0) (void)xb_add(&bar[XB_XCNT(b.x)], 1u);
    return b;
}
__device__ __forceinline__ void xcd_barrier_complete(unsigned* bar, unsigned x, unsigned& nloc, unsigned& nx) {
    const unsigned G = gridDim.x * gridDim.y * gridDim.z;
    unsigned sum, cnt, mine, sp = 0u;
    for (;;) {
        sum = 0u; cnt = 0u; mine = 0u;
#pragma unroll
        for (unsigned j = 0; j < 16; ++j) { const unsigned c = xb_ld(&bar[XB_XCNT(j)]); sum += c; cnt += (c > 0u) ? 1u : 0u; mine = (j == x) ? c : mine; }
        if (sum == G) break;
        __builtin_amdgcn_s_sleep(1);
        if ((++sp & 255u) == 0u) { if (xb_ld(&bar[XB_TMO])) break; if (sp > XB_SPIN_CAP) { atomicAdd(&bar[XB_TMO], 1u); break; } }
    }
    nloc = mine > 0u ? mine : 1u; nx = cnt > 0u ? cnt : 1u;
}
__device__ __forceinline__ void xcd_barrier(const XcdBarrier& b) {
    asm volatile("s_waitcnt vmcnt(0)" ::: "memory");
    __syncthreads();
    if (threadIdx.x == 0) {
        unsigned* bar = b.bar;
        __builtin_amdgcn_s_waitcnt(0);
        unsigned nloc = b.st[0], nx = b.st[1];
        if (nloc == 0u) { xcd_barrier_complete(bar, b.x, nloc, nx); b.st[0] = nloc; b.st[1] = nx; }
        const unsigned old = xb_add(&bar[XB_XSUB(b.x)], 1u);
        const unsigned gen = old / nloc;
        if (old + 1u == (gen + 1u) * nloc) {
            __builtin_amdgcn_fence(__ATOMIC_RELEASE, "agent");
            asm volatile("s_waitcnt vmcnt(0)" ::: "memory");
            const unsigned og = xb_add(&bar[XB_TOP], 1u);
            const unsigned tg = og / nx;
            if (og + 1u == (tg + 1u) * nx) xb_add(&bar[XB_TOPGEN], 1u);
            else XB_SPIN(xb_ld(&bar[XB_TOPGEN]) == tg, bar);
            __builtin_amdgcn_fence(__ATOMIC_ACQUIRE, "agent");
            xb_add(&bar[XB_XGEN(b.x)], 1u);
            asm volatile("s_waitcnt vmcnt(0)" ::: "memory");
        } else {
            XB_SPIN(xb_ld(&bar[XB_XGEN(b.x)]) == gen, bar);
            __builtin_amdgcn_fence(__ATOMIC_ACQUIRE, "agent");
            asm volatile("s_waitcnt vmcnt(0)" ::: "memory");
        }
    }
    __syncthreads();
}

__device__ __forceinline__ float wave_sum(float v) {
#pragma unroll
    for (int o = 1; o < 64; o <<= 1) v += __shfl_xor(v, o);
    return v;
}
__device__ __forceinline__ float bf2f(unsigned short u) { return __builtin_bit_cast(float, (unsigned)u << 16); }

struct Args { const void* in[21]; float* out; unsigned char* ws; int ph_lo, ph_hi; };

__device__ __forceinline__ void p0_transpose_item(const float* W, int K, int N, bf16* WT, int k0, int sc0, int sc1, int nd0, LAS float* scr, int lane) {
    const int r4 = lane >> 4, c4 = lane & 15;
    const float* src = W + (size_t)(k0 + r4) * N + ((c4 < 8) ? sc0 + 4 * c4 : sc1 + 4 * (c4 - 8));
    f32x4 v[16];
#pragma unroll
    for (int i = 0; i < 16; ++i) v[i] = *(const f32x4*)(src + (size_t)(4 * i) * N);
#pragma unroll
    for (int i = 0; i < 16; ++i) { LAS float* d = scr + (4 * i + r4) * 65 + 4 * c4; d[0] = v[i][0]; d[1] = v[i][1]; d[2] = v[i][2]; d[3] = v[i][3]; }
    asm volatile("s_waitcnt lgkmcnt(0)" ::: "memory");
    const int c8 = lane & 7, n8 = lane >> 3;
#pragma unroll
    for (int j = 0; j < 8; ++j) { const int n = n8 + 8 * j; const LAS float* s = scr + (8 * c8) * 65 + n;
        u32x4 o; o.x = pk_bf16(s[0 * 65], s[1 * 65]); o.y = pk_bf16(s[2 * 65], s[3 * 65]); o.z = pk_bf16(s[4 * 65], s[5 * 65]); o.w = pk_bf16(s[6 * 65], s[7 * 65]);
        *(u32x4*)(WT + (size_t)(nd0 + n) * K + k0 + 8 * c8) = o; }
    asm volatile("s_waitcnt lgkmcnt(0)" ::: "memory");
}
__device__ __forceinline__ int src_col(int type, int nd0) {
    if (type == 0) return nd0;
    const int pn = nd0 >> 8, r = nd0 & 255, bj = r >> 7;
    if (type == 1) return bj * FF + 128 * pn + (r & 127);
    const int wc = (r & 127) >> 5, head = 4 * (pn & 3) + wc;
    return (pn >= 4 ? 1024 : 0) + head * 64 + 32 * bj;
}
__device__ __forceinline__ void p0_phase(ptab_t tab, LAS unsigned char* lds, int vcu, int G) {
    const int tid = threadIdx.x, lane = tid & 63, w = __builtin_amdgcn_readfirstlane(tid >> 6);
    unsigned char* ws = ldp(tab, T_WS);
    { float* z = (float*)(ws + WS_SS) + M; const int n = 3 * M;
      for (int i = vcu * NTHREADS + tid; i < n / 4; i += G * NTHREADS) ((f32x4*)z)[i] = (f32x4){0.f, 0.f, 0.f, 0.f}; }
    if (vcu < 224) {
        LAS float* cact = (LAS float*)lds;
        LAS float* part = (LAS float*)(lds + 65536);
        const float* c = (const float*)ldp(tab, 1);
        {
            f32x4 cv[8];
#pragma unroll
            for (int j = 0; j < 8; ++j) cv[j] = *(const f32x4*)(c + 4 * (tid + NTHREADS * j));
#pragma unroll
            for (int j = 0; j < 8; ++j) *(LAS f32x4*)(cact + 4 * (tid + NTHREADS * j)) = pg8::silu4(cv[j]);
        }
        LBAR();
        const int col = vcu * 64;
        const float* W; int N, cw; const float* bias; float* dst; int dstride;
        if (col < 12288) { const int l = col / 6144; cw = col - l * 6144; W = (const float*)ldp(tab, 3) + (size_t)l * 1024 * 6144; N = 6144; bias = (const float*)ldp(tab, 4) + l * 6144; dst = (float*)(ws + WS_MODS) + (size_t)l * 16 * 6144; dstride = 6144; }
        else { cw = col - 12288; W = (const float*)ldp(tab, 9); N = 2048; bias = (const float*)ldp(tab, 10); dst = (float*)(ws + WS_KVM); dstride = 2048; }
        const int c4 = lane & 15, r4 = lane >> 4;
        f32x4 acc[16];
#pragma unroll
        for (int b = 0; b < 16; ++b) acc[b] = (f32x4){0.f, 0.f, 0.f, 0.f};
        const float* wp = W + (size_t)(128 * w + 32 * r4) * N + cw + 4 * c4;
        const LAS float* cp = cact + 128 * w + 32 * r4;
#pragma unroll 1
        for (int i0 = 0; i0 < 32; i0 += 16) {
            f32x4 wv[16];
#pragma unroll
            for (int i = 0; i < 16; ++i) wv[i] = *(const f32x4*)(wp + (size_t)(i0 + i) * N);
#pragma unroll
            for (int j = 0; j < 4; ++j) {
                asm volatile("" ::: "memory");
#pragma unroll
                for (int b = 0; b < 16; ++b) { const f32x4 cv = *(const LAS f32x4*)(cp + b * 1024 + i0 + 4 * j); acc[b] += (cv[0] * wv[4 * j] + cv[1] * wv[4 * j + 1]) + (cv[2] * wv[4 * j + 2] + cv[3] * wv[4 * j + 3]); }
            }
        }
#pragma unroll
        for (int b = 0; b < 16; ++b) {
#pragma unroll
            for (int e = 0; e < 4; ++e) { float v = acc[b][e]; v += __shfl_xor(v, 16); v += __shfl_xor(v, 32); acc[b][e] = v; }
            if (r4 == 0) *(LAS f32x4*)(part + (w * 16 + b) * 64 + 4 * c4) = acc[b];
        }
        LBAR();
        for (int o = tid; o < 1024; o += NTHREADS) { const int b = o >> 6, l = o & 63; float s = bias[cw + l];
#pragma unroll
            for (int ww = 0; ww < 8; ++ww) s += part[(ww * 16 + b) * 64 + l];
            dst[(size_t)b * dstride + cw + l] = s; }
        LBAR();
    }
    {
        LAS float* scr = (LAS float*)(lds + w * 16640);
        constexpr int I0 = 16 * 96, I1 = 32 * 16, I2 = 16 * 88, I4 = 44 * 16, I6 = 16 * 32, I7 = 16 * 16;
        constexpr int NIT = I0 + I1 + 2 * I2 + 2 * I4 + I6 + 2 * I7;
        const int gw = vcu * NWAVES + w, NGW = G * NWAVES;
        for (int it = gw; it < NIT; it += NGW) {
            int r = it; const float* W; int K, N, type; bf16* WT;
            if (r < I0) { W = (const float*)ldp(tab, 7); K = 1024; N = 6144; type = 0; WT = (bf16*)(ws + WS_WT1); }
            else if ((r -= I0) < I1) { W = (const float*)ldp(tab, 8); K = 2048; N = 1024; type = 0; WT = (bf16*)(ws + WS_WT2); }
            else if ((r -= I1) < 2 * I2) { const int l = r / I2; r -= l * I2; W = (const float*)ldp(tab, 17) + (size_t)l * 1024 * FF2; K = 1024; N = FF2; type = 1; WT = (bf16*)(ws + WS_WT3) + (size_t)l * FF2 * 1024; }
            else if ((r -= 2 * I2) < 2 * I4) { const int l = r / I4; r -= l * I4; W = (const float*)ldp(tab, 20) + (size_t)l * FF * 1024; K = FF; N = 1024; type = 0; WT = (bf16*)(ws + WS_WT4) + (size_t)l * 1024 * FF; }
            else if ((r -= 2 * I4) < I6) { W = (const float*)ldp(tab, 12); K = 1024; N = 2048; type = 2; WT = (bf16*)(ws + WS_WT5); }
            else if ((r -= I6) < I7) { W = (const float*)ldp(tab, 14); K = 1024; N = 1024; type = 2; WT = (bf16*)(ws + WS_WT6); }
            else { r -= I7; W = (const float*)ldp(tab, 16); K = 1024; N = 1024; type = 0; WT = (bf16*)(ws + WS_WT7); }
            const int nblk = N / 64, kb = r / nblk, nb = r - kb * nblk;
            p0_transpose_item(W, K, N, WT, 64 * kb, src_col(type, 64 * nb), src_col(type, 64 * nb + 32), 64 * nb, scr, lane);
        }
    }
}

__device__ __forceinline__ void p1_phase(ptab_t tab, LAS unsigned char* lds, int vcu, int G, int roles = 3) {
    const int tid = threadIdx.x, lane = tid & 63, w = __builtin_amdgcn_readfirstlane(tid >> 6);
    unsigned char* ws = ldp(tab, T_WS);
    const float* mods = (const float*)(ws + WS_MODS);
    const int t0 = (G * 77) >> 8, t1 = (G * 147) >> 8, t2 = (G * 217) >> 8, t3 = (G * 243) >> 8;
    const int ty = (vcu < t0) ? 0 : (vcu < t1) ? 1 : (vcu < t2) ? 2 : (vcu < t3) ? 3 : 4;
    const int wbase = (ty == 0) ? 0 : (ty == 1) ? t0 : (ty == 2) ? t1 : (ty == 3) ? t2 : t3, wend = (ty == 0) ? t0 : (ty == 1) ? t1 : (ty == 2) ? t2 : (ty == 3) ? t3 : G;
    const float* sp; int sst, N; const bf16* WT; float* dst;
    if (ty == 0)      { sp = mods;                         sst = 6144; N = RN;   WT = (const bf16*)(ws + WS_WT1); dst = (float*)(ws + WS_SW1); }
    else if (ty == 1) { sp = mods + 3072;                  sst = 6144; N = FF2;  WT = (const bf16*)(ws + WS_WT3); dst = (float*)(ws + WS_SW3); }
    else if (ty == 2) { sp = mods + 16 * 6144 + 3072;      sst = 6144; N = FF2;  WT = (const bf16*)(ws + WS_WT3) + (size_t)FF2 * 1024; dst = (float*)(ws + WS_SW3) + 16 * FF2; }
    else if (ty == 3) { sp = (const float*)(ws + WS_KVM);  sst = 2048; N = 2048; WT = (const bf16*)(ws + WS_WT5); dst = (float*)(ws + WS_SW5); }
    else              { sp = mods + 16 * 6144;             sst = 6144; N = 1024; WT = (const bf16*)(ws + WS_WT6); dst = (float*)(ws + WS_SW6); }
    constexpr int SHP = 1032;
    LAS unsigned short* shh = (LAS unsigned short*)lds; LAS unsigned short* shl = shh + 16 * SHP;
#pragma unroll 4
    for (int i = tid; i < 16 * 512; i += NTHREADS) {
        const int b = i >> 9, k2 = (i & 511) * 2; const float s0 = sp[(size_t)b * sst + k2], s1 = sp[(size_t)b * sst + k2 + 1];
        const unsigned hi = pk_bf16(s0, s1); const float r0 = s0 - __builtin_bit_cast(float, hi << 16), r1 = s1 - __builtin_bit_cast(float, hi & 0xffff0000u);
        *(LAS unsigned*)(shh + b * SHP + k2) = hi; *(LAS unsigned*)(shl + b * SHP + k2) = pk_bf16(r0, r1);
    }
    LBAR();
    if (w < 4) { if (roles & 1) {
        const float* x = (const float*)ldp(tab, 0); const float* g = (const float*)ldp(tab, 5);
        bf16* A0 = (bf16*)(ws + WS_A); float* ss0 = (float*)(ws + WS_SS);
        const int gw4 = vcu * 4 + w, NGW4 = G * 4, rpw = M / NGW4;
        for (int r0 = gw4 * rpw; r0 < M; r0 += NGW4 * rpw) {
            const int b = r0 / SEQ;
            f32x4 gs[4];
#pragma unroll
            for (int j = 0; j < 4; ++j) { const int col = 4 * lane + 256 * j; gs[j] = *(const f32x4*)(g + col) * (*(const f32x4*)(mods + (size_t)b * 6144 + 1024 + col) + 1.f); }
#pragma unroll 1
            for (int r = r0; r < r0 + rpw; r += 4) {
                f32x4 v[4][4]; float s[4];
#pragma unroll
                for (int q = 0; q < 4; ++q)
#pragma unroll
                    for (int j = 0; j < 4; ++j) v[q][j] = *(const f32x4*)(x + (size_t)(r + q) * D + 4 * lane + 256 * j);
#pragma unroll
                for (int q = 0; q < 4; ++q) { s[q] = (pg8::dot4(v[q][0]) + pg8::dot4(v[q][1])) + (pg8::dot4(v[q][2]) + pg8::dot4(v[q][3])); }
#pragma unroll
                for (int o = 1; o < 64; o <<= 1) {
#pragma unroll
                    for (int q = 0; q < 4; ++q) s[q] += __shfl_xor(s[q], o);
                }
                if (lane < 4) ss0[r + lane] = (lane == 0) ? s[0] : (lane == 1) ? s[1] : (lane == 2) ? s[2] : s[3];
#pragma unroll
                for (int q = 0; q < 4; ++q)
#pragma unroll
                    for (int j = 0; j < 4; ++j) { const f32x4 o = v[q][j] * gs[j]; u32x2 pp; pp.x = pk_bf16(o[0], o[1]); pp.y = pk_bf16(o[2], o[3]); *(u32x2*)(A0 + (size_t)(r + q) * D + 4 * lane + 256 * j) = pp; }
            }
        }
    } } else if (roles & 2) {
        const int gw = (vcu - wbase) * 4 + (w - 4), NGW = (wend - wbase) * 4, fr = lane & 15, fq = lane >> 4;
        for (int grp = gw; grp < N / 16; grp += NGW) {
            const bf16* wrow = WT + (size_t)(16 * grp + fr) * 1024 + 8 * fq;
            const LAS unsigned short* ah = shh + fr * SHP + 8 * fq; const LAS unsigned short* al = shl + fr * SHP + 8 * fq;
            f32x4 acc = (f32x4){0.f, 0.f, 0.f, 0.f};
#pragma unroll 1
            for (int half = 0; half < 2; ++half) {
                bf16x8 wv[16];
#pragma unroll
                for (int j = 0; j < 16; ++j) wv[j] = *(const bf16x8*)(wrow + (half * 16 + j) * 32);
#pragma unroll
                for (int j = 0; j < 16; ++j) {
                    const bf16x8 a_hi = *(const LAS bf16x8*)(ah + (half * 16 + j) * 32), a_lo = *(const LAS bf16x8*)(al + (half * 16 + j) * 32);
                    acc = __builtin_amdgcn_mfma_f32_16x16x32_bf16(a_hi, wv[j], acc, 0, 0, 0);
                    acc = __builtin_amdgcn_mfma_f32_16x16x32_bf16(a_lo, wv[j], acc, 0, 0, 0);
                }
            }
#pragma unroll
            for (int i = 0; i < 4; ++i) dst[(size_t)(4 * fq + i) * N + 16 * grp + fr] = acc[i];
        }
    }
}

constexpr int RT_QROWB = 528, RT_VROWB = 272, RT_PROWB = 144;
constexpr int RT_QS = 0, RT_KS = 64 * RT_QROWB, RT_VS = 2 * 64 * RT_QROWB, RT_PS = RT_VS + 64 * RT_VROWB, RT_SQ = RT_PS + 64 * RT_PROWB, RT_BYTES = RT_SQ + 512;
static_assert(RT_BYTES <= MISC_OFF, "retention LDS");
__device__ __forceinline__ s16x4 tr16(const LAS unsigned char* p) { typedef short v4i16_t __attribute__((ext_vector_type(4))); return __builtin_bit_cast(s16x4, __builtin_amdgcn_ds_read_tr16_b64_v4i16((LAS v4i16_t*)p)); }
#define MFMA16(a, b, c) __builtin_amdgcn_mfma_f32_16x16x32_bf16((a), (b), (c), 0, 0, 0)
#define MFMA32(a, b, c) __builtin_amdgcn_mfma_f32_32x32x16_bf16((a), (b), (c), 0, 0, 0)
__device__ __forceinline__ bf16x8 cat8(s16x4 lo, s16x4 hi) { return (bf16x8){lo[0], lo[1], lo[2], lo[3], hi[0], hi[1], hi[2], hi[3]}; }
__device__ __forceinline__ bf16x8 pack8(const f32x4 a, const f32x4 b) { return __builtin_bit_cast(bf16x8, pg8::pk8(a, b)); }

__device__ __forceinline__ void ret_unit(LAS unsigned char* lds, const bf16* Q, const bf16* KD, const bf16* V, bf16* SG, float* SSO, int unit, bool dry) {
    const int tid = threadIdx.x, lane = tid & 63, w = __builtin_amdgcn_readfirstlane(tid >> 6);
    const int b = unit >> 4, h = (unit >> 2) & 3, vs = unit & 3;
    const int c16 = lane & 15, g4 = lane >> 4;
    const float lg2 = __builtin_amdgcn_logf(1.f - __builtin_amdgcn_exp2f(-5.f - (float)h));
    const float gC = __builtin_amdgcn_exp2f(lg2 * 64.f);
    const __amdgpu_buffer_rsrc_t rs = __builtin_amdgcn_make_buffer_rsrc((void*)Q, 0, 0x7fffffff, 0x00020000);
    const unsigned offK = (unsigned)((const char*)KD - (const char*)Q), offV = (unsigned)((const char*)V - (const char*)Q), offG = (unsigned)((const char*)SG - (const char*)Q);
    const unsigned uQ = ((unsigned)b * SEQ * 1024 + h * 256) * 2, uV = ((unsigned)b * SEQ * 2048 + h * 512 + vs * 128) * 2;
    const unsigned vQ = (tid >> 5) * 2048 + (tid & 31) * 16, vV = (tid >> 4) * 4096 + (tid & 15) * 16;
    const unsigned vG = c16 * 4096 + (16 * w + 4 * g4) * 2;
    u32x4 pq[4], pk[4], pv[2];
#define RT_LOAD(c) do { _Pragma("unroll") for (int j = 0; j < 4; ++j) { const unsigned so = uQ + (unsigned)((c) * 64 + 16 * j) * 2048; \
        pq[j] = __builtin_bit_cast(u32x4, __builtin_amdgcn_raw_buffer_load_b128(rs, vQ, so, 0)); pk[j] = __builtin_bit_cast(u32x4, __builtin_amdgcn_raw_buffer_load_b128(rs, vQ, so + offK, 0)); } \
        _Pragma("unroll") for (int j = 0; j < 2; ++j) pv[j] = __builtin_bit_cast(u32x4, __builtin_amdgcn_raw_buffer_load_b128(rs, vV, offV + uV + (unsigned)((c) * 64 + 32 * j) * 4096, 0)); } while (0)
#define RT_STORE() do { _Pragma("unroll") for (int j = 0; j < 4; ++j) { const int cc = tid + 512 * j, row = cc >> 5, ck = cc & 31; *(LAS u32x4*)(lds + RT_QS + row * RT_QROWB + ck * 16) = pq[j]; *(LAS u32x4*)(lds + RT_KS + row * RT_QROWB + ck * 16) = pk[j]; } \
        _Pragma("unroll") for (int j = 0; j < 2; ++j) { const int cc = tid + 512 * j, row = cc >> 4, ck = cc & 15; *(LAS u32x4*)(lds + RT_VS + row * RT_VROWB + ck * 16) = pv[j]; } } while (0)
    f32x4 st[16], oc[4], sT[2]; bf16x8 vf[2];
#pragma unroll
    for (int i = 0; i < 16; ++i) st[i] = (f32x4){0.f, 0.f, 0.f, 0.f};
#pragma unroll
    for (int i = 0; i < 4; ++i) oc[i] = (f32x4){0.f, 0.f, 0.f, 0.f};
    const int ntS = w & 3, mtb = 2 * (w >> 2);
    const LAS unsigned char* qrowS = lds + RT_QS + (16 * ntS + c16) * RT_QROWB + g4 * 16;
    const LAS unsigned char* krowS = lds + RT_KS + (16 * mtb + c16) * RT_QROWB + g4 * 16;
    const LAS unsigned char* qrowC = lds + RT_QS + c16 * RT_QROWB + g4 * 8;
    const LAS unsigned char* ktr = lds + RT_KS + (8 * g4 + (c16 >> 2)) * RT_QROWB + (c16 & 3) * 8;
    const LAS unsigned char* vtr = lds + RT_VS + (8 * g4 + (c16 >> 2)) * RT_VROWB + w * 32 + (c16 & 3) * 8;
    const LAS unsigned char* prow = lds + RT_PS + c16 * RT_PROWB + g4 * 16;
    LAS unsigned char* pst = lds + RT_PS + (16 * ntS + c16) * RT_PROWB + g4 * 8;
    if (tid < 128) ((LAS float*)(lds + RT_SQ))[tid] = 0.f;
    RT_LOAD(0);
    for (int c = 0; c < 32; ++c) {
        LBAR();
        RT_STORE();
        asm volatile("" ::: "memory");
        if (c + 1 < 32) RT_LOAD(c + 1);
        u32x2 sgv[4];
#pragma unroll
        for (int nt = 0; nt < 4; ++nt) sgv[nt] = __builtin_bit_cast(u32x2, __builtin_amdgcn_raw_buffer_load_b64(rs, vG, offG + uV + (unsigned)(c * 64 + 16 * nt) * 4096, 0));
        if (w == 0 && c > 0 && !dry) {
            LAS float* sl = (LAS float*)(lds + RT_SQ) + ((c - 1) & 1) * 64;
            SSO[(size_t)(b * SEQ + (c - 1) * 64 + lane) * 16 + h * 4 + vs] = sl[lane]; sl[lane] = 0.f;
        }
        LBAR();
#pragma unroll
        for (int ks = 0; ks < 2; ++ks) vf[ks] = cat8(tr16(vtr + (32 * ks) * RT_VROWB), tr16(vtr + (32 * ks + 4) * RT_VROWB));
        sT[0] = (f32x4){0.f, 0.f, 0.f, 0.f}; sT[1] = (f32x4){0.f, 0.f, 0.f, 0.f};
#pragma unroll
        for (int ks = 0; ks < 8; ++ks) {
            const bf16x8 bq = *(const LAS bf16x8*)(qrowS + ks * 64);
#pragma unroll
            for (int i = 0; i < 2; ++i) { const bf16x8 ak = *(const LAS bf16x8*)(krowS + i * 16 * RT_QROWB + ks * 64); sT[i] = MFMA16(ak, bq, sT[i]); }
        }
        {
            const int n = 16 * ntS + c16; const float fac = __builtin_amdgcn_exp2f(lg2 * (float)(n - 63));
#pragma unroll
            for (int i = 0; i < 2; ++i) {
                const int m0 = 16 * (mtb + i) + 4 * g4; float v[4];
#pragma unroll
                for (int e = 0; e < 4; ++e) v[e] = (n >= m0 + e) ? sT[i][e] * fac : 0.f;
                u32x2 p; p.x = pk_bf16(v[0], v[1]); p.y = pk_bf16(v[2], v[3]);
                *(LAS u32x2*)(pst + (mtb + i) * 32) = p;
            }
        }
        __builtin_amdgcn_sched_barrier(0);
        {
            s16x4 qlo[2][4], qhi[2][4];
#pragma unroll
            for (int nt = 0; nt < 4; ++nt) { qlo[0][nt] = *(const LAS s16x4*)(qrowC + nt * 16 * RT_QROWB); qhi[0][nt] = *(const LAS s16x4*)(qrowC + nt * 16 * RT_QROWB + 32); }
#pragma unroll
            for (int ks = 0; ks < 8; ++ks) {
                if (ks < 7) {
#pragma unroll
                    for (int nt = 0; nt < 4; ++nt) { qlo[(ks + 1) & 1][nt] = *(const LAS s16x4*)(qrowC + nt * 16 * RT_QROWB + (ks + 1) * 64); qhi[(ks + 1) & 1][nt] = *(const LAS s16x4*)(qrowC + nt * 16 * RT_QROWB + (ks + 1) * 64 + 32); }
                }
                __builtin_amdgcn_sched_barrier(0);
                const bf16x8 as = pack8(st[2 * ks], st[2 * ks + 1]);
#pragma unroll
                for (int nt = 0; nt < 4; ++nt) oc[nt] = MFMA16(as, cat8(qlo[ks & 1][nt], qhi[ks & 1][nt]), oc[nt]);
                __builtin_amdgcn_sched_barrier(0);
            }
        }
        {
            s16x4 kt[2][4];
#pragma unroll
            for (int ks = 0; ks < 2; ++ks) { kt[0][2 * ks] = tr16(ktr + (32 * ks) * RT_QROWB); kt[0][2 * ks + 1] = tr16(ktr + (32 * ks + 4) * RT_QROWB); }
#pragma unroll
            for (int i = 0; i < 16; ++i) {
                if (i < 15) {
#pragma unroll
                    for (int ks = 0; ks < 2; ++ks) { kt[(i + 1) & 1][2 * ks] = tr16(ktr + (32 * ks) * RT_QROWB + (i + 1) * 32); kt[(i + 1) & 1][2 * ks + 1] = tr16(ktr + (32 * ks + 4) * RT_QROWB + (i + 1) * 32); }
                }
                __builtin_amdgcn_sched_barrier(0);
                f32x4 sacc = st[i] * gC;
#pragma unroll
                for (int ks = 0; ks < 2; ++ks) sacc = MFMA16(cat8(kt[i & 1][2 * ks], kt[i & 1][2 * ks + 1]), vf[ks], sacc);
                st[i] = sacc;
                __builtin_amdgcn_sched_barrier(0);
            }
        }
        LBAR();
#pragma unroll
        for (int nt = 0; nt < 4; ++nt) { const float gq = __builtin_amdgcn_exp2f(lg2 * (float)(16 * nt + c16 + 1)); oc[nt] *= gq; }
#pragma unroll
        for (int ks = 0; ks < 2; ++ks)
#pragma unroll
            for (int nt = 0; nt < 4; ++nt) if (32 * ks <= 16 * nt + 15) { const bf16x8 bp = *(const LAS bf16x8*)(prow + nt * 16 * RT_PROWB + ks * 64); oc[nt] = MFMA16(vf[ks], bp, oc[nt]); }
#pragma unroll
        for (int nt = 0; nt < 4; ++nt) {
            float sq = pg8::dot4(oc[nt]); sq += __shfl_xor(sq, 16); sq += __shfl_xor(sq, 32);
            if (g4 == 0) (void)__hip_atomic_fetch_add((LAS float*)(lds + RT_SQ) + (c & 1) * 64 + 16 * nt + c16, sq, __ATOMIC_RELAXED, __HIP_MEMORY_SCOPE_WORKGROUP);
            const u32x2 sg = sgv[nt];
            const float o0 = oc[nt][0] * __builtin_bit_cast(float, sg.x << 16), o1 = oc[nt][1] * __builtin_bit_cast(float, sg.x & 0xffff0000u);
            const float o2 = oc[nt][2] * __builtin_bit_cast(float, sg.y << 16), o3 = oc[nt][3] * __builtin_bit_cast(float, sg.y & 0xffff0000u);
            u32x2 p; p.x = pk_bf16(o0, o1); p.y = pk_bf16(o2, o3);
            if (!dry) __builtin_amdgcn_raw_buffer_store_b64(__builtin_bit_cast(__attribute__((ext_vector_type(2))) unsigned, p), rs, vG, offG + uV + (unsigned)(c * 64 + 16 * nt) * 4096, 0);
            oc[nt] = (f32x4){0.f, 0.f, 0.f, 0.f};
        }
    }
    LBAR();
    if (w == 0 && !dry) { LAS float* sl = (LAS float*)(lds + RT_SQ) + 64; SSO[(size_t)(b * SEQ + 31 * 64 + lane) * 16 + h * 4 + vs] = sl[lane]; sl[lane] = 0.f; }
    LBAR();
#undef RT_LOAD
#undef RT_STORE
}

constexpr int R2_QS = 0, R2_KS = 64 * RT_QROWB, R2_VS = 2 * 64 * RT_QROWB, R2_PS = R2_VS + 2 * 64 * RT_VROWB, R2_SQ = R2_PS + 64 * RT_PROWB, R2_SG = R2_SQ + 512, R2_BYTES = R2_SG + 64 * RT_VROWB;
static_assert(R2_BYTES <= MISC_OFF, "retention v2 LDS");
__device__ __forceinline__ void ret_unit2(LAS unsigned char* lds, const bf16* Q, const bf16* KD, const bf16* V, bf16* SG, float* SSO, int unit, bool dry) {
    const int tid = threadIdx.x, lane = tid & 63, w = __builtin_amdgcn_readfirstlane(tid >> 6);
    const int b = unit >> 4, h = (unit >> 2) & 3, vs = unit & 3;
    const int r32 = lane & 31, hh = lane >> 5;
    const float lg2 = __builtin_amdgcn_logf(1.f - __builtin_amdgcn_exp2f(-5.f - (float)h));
    const __amdgpu_buffer_rsrc_t rs = __builtin_amdgcn_make_buffer_rsrc((void*)Q, 0, 0x7fffffff, 0x00020000);
    const unsigned offK = (unsigned)((const char*)KD - (const char*)Q), offV = (unsigned)((const char*)V - (const char*)Q), offG = (unsigned)((const char*)SG - (const char*)Q);
    const unsigned uQ = ((unsigned)b * SEQ * 1024 + h * 256) * 2, uV = ((unsigned)b * SEQ * 2048 + h * 512 + vs * 128) * 2;
    if (tid < 128) ((LAS float*)(lds + R2_SQ))[tid] = 0.f;
    if (w >= 4) {
        const int ht = tid - 256, hw = w - 4, mt2 = hw >> 1, nt2 = hw & 1;
        const unsigned vQ = (ht >> 5) * 2048 + (ht & 31) * 16, vV = (ht >> 4) * 4096 + (ht & 15) * 16;
        u32x4 pq[8], pk[8], pv[4], pg[4];
#define H_LOAD(c) do { _Pragma("unroll") for (int j = 0; j < 8; ++j) { const unsigned so = uQ + (unsigned)((c) * 64 + 8 * j) * 2048; \
            pq[j] = __builtin_bit_cast(u32x4, __builtin_amdgcn_raw_buffer_load_b128(rs, vQ, so, 0)); pk[j] = __builtin_bit_cast(u32x4, __builtin_amdgcn_raw_buffer_load_b128(rs, vQ, so + offK, 0)); } \
            _Pragma("unroll") for (int j = 0; j < 4; ++j) { pv[j] = __builtin_bit_cast(u32x4, __builtin_amdgcn_raw_buffer_load_b128(rs, vV, offV + uV + (unsigned)((c) * 64 + 16 * j) * 4096, 0)); \
            pg[j] = __builtin_bit_cast(u32x4, __builtin_amdgcn_raw_buffer_load_b128(rs, vV, offG + uV + (unsigned)((c) * 64 + 16 * j) * 4096, 0)); } } while (0)
#define H_STORE(c) do { _Pragma("unroll") for (int j = 0; j < 8; ++j) { const int row = (ht >> 5) + 8 * j, ck = ht & 31; *(LAS u32x4*)(lds + R2_QS + row * RT_QROWB + ck * 16) = pq[j]; *(LAS u32x4*)(lds + R2_KS + row * RT_QROWB + ck * 16) = pk[j]; } \
            _Pragma("unroll") for (int j = 0; j < 4; ++j) { const int row = (ht >> 4) + 16 * j, ck = ht & 15; *(LAS u32x4*)(lds + R2_VS + ((c) & 1) * 64 * RT_VROWB + row * RT_VROWB + ck * 16) = pv[j]; } } while (0)
#define H_STORE_G() do { _Pragma("unroll") for (int j = 0; j < 4; ++j) { const int row = (ht >> 4) + 16 * j, ck = ht & 15; *(LAS u32x4*)(lds + R2_SG + row * RT_VROWB + ck * 16) = pg[j]; } } while (0)
        const LAS unsigned char* qrowS = lds + R2_QS + (32 * nt2 + r32) * RT_QROWB + hh * 16;
        const LAS unsigned char* krowS = lds + R2_KS + (32 * mt2 + r32) * RT_QROWB + hh * 16;
        LAS unsigned char* pst = lds + R2_PS + (32 * nt2 + r32) * RT_PROWB + (32 * mt2 + 4 * hh) * 2;
        const int n_loc = 32 * nt2 + r32; const float fac = __builtin_amdgcn_exp2f(lg2 * (float)(n_loc - 63));
        H_LOAD(0);
        for (int c = 0; c < 32; ++c) {
            H_STORE(c);
            LBAR();
            H_STORE_G();
            asm volatile("" ::: "memory");
            if (c + 1 < 32) H_LOAD(c + 1);
            f32x16 sT;
#pragma unroll
            for (int i = 0; i < 16; ++i) sT[i] = 0.f;
            if (mt2 <= nt2) {
#pragma unroll
                for (int s = 0; s < 16; ++s) { const bf16x8 ak = *(const LAS bf16x8*)(krowS + s * 32), bq = *(const LAS bf16x8*)(qrowS + s * 32); sT = MFMA32(ak, bq, sT); }
            }
#pragma unroll
            for (int g = 0; g < 4; ++g) {
                const int m0 = 32 * mt2 + 8 * g + 4 * hh; float v[4];
#pragma unroll
                for (int e = 0; e < 4; ++e) v[e] = (n_loc >= m0 + e) ? sT[4 * g + e] * fac : 0.f;
                u32x2 pp; pp.x = pk_bf16(v[0], v[1]); pp.y = pk_bf16(v[2], v[3]);
                *(LAS u32x2*)(pst + g * 16) = pp;
            }
            if (hw == 0 && c > 0 && !dry) {
                LAS float* sl = (LAS float*)(lds + R2_SQ) + ((c - 1) & 1) * 64;
                SSO[(size_t)(b * SEQ + (c - 1) * 64 + lane) * 16 + h * 4 + vs] = sl[lane]; sl[lane] = 0.f;
            }
            LBAR();
        }
        LBAR();
        if (hw == 0 && !dry) { LAS float* sl = (LAS float*)(lds + R2_SQ) + 64; SSO[(size_t)(b * SEQ + 31 * 64 + lane) * 16 + h * 4 + vs] = sl[lane]; sl[lane] = 0.f; }
        LBAR();
#undef H_LOAD
#undef H_STORE
#undef H_STORE_G
    } else {
        const float gC = __builtin_amdgcn_exp2f(lg2 * 64.f);
        f32x16 st[8], oc[2]; bf16x8 vf[4];
#pragma unroll
        for (int t = 0; t < 8; ++t)
#pragma unroll
            for (int i = 0; i < 16; ++i) st[t][i] = 0.f;
#pragma unroll
        for (int i = 0; i < 16; ++i) { oc[0][i] = 0.f; oc[1][i] = 0.f; }
        for (int c = 0; c < 32; ++c) {
            int ln = lane; asm volatile("" : "+v"(ln));
            const int r32 = ln & 31, hh = ln >> 5, blk = (ln >> 4) & 1, q4 = (ln & 15) >> 2, p4 = ln & 3;
            const unsigned vG = r32 * 4096 + (32 * w + 4 * hh) * 2;
            const LAS unsigned char* qrowC = lds + R2_QS + r32 * RT_QROWB + hh * 8;
            const LAS unsigned char* ktr = lds + R2_KS + (8 * hh + q4) * RT_QROWB + (16 * blk + 4 * p4) * 2;
            const LAS unsigned char* vtr = lds + R2_VS + (8 * hh + q4) * RT_VROWB + (32 * w + 16 * blk + 4 * p4) * 2;
            const LAS unsigned char* prow = lds + R2_PS + r32 * RT_PROWB + hh * 16;
            LBAR();
            const LAS unsigned char* vb = vtr + (c & 1) * 64 * RT_VROWB;
#pragma unroll
            for (int ks = 0; ks < 4; ++ks) vf[ks] = cat8(tr16(vb + (16 * ks) * RT_VROWB), tr16(vb + (16 * ks + 4) * RT_VROWB));
            {
                s16x4 qlo[3][2], qhi[3][2];
#pragma unroll
                for (int kk = 0; kk < 2; ++kk)
#pragma unroll
                    for (int nt = 0; nt < 2; ++nt) { qlo[kk][nt] = *(const LAS s16x4*)(qrowC + nt * 32 * RT_QROWB + kk * 32); qhi[kk][nt] = *(const LAS s16x4*)(qrowC + nt * 32 * RT_QROWB + kk * 32 + 16); }
#pragma unroll
                for (int k = 0; k < 16; ++k) {
                    if (k < 14) {
#pragma unroll
                        for (int nt = 0; nt < 2; ++nt) { qlo[(k + 2) % 3][nt] = *(const LAS s16x4*)(qrowC + nt * 32 * RT_QROWB + (k + 2) * 32); qhi[(k + 2) % 3][nt] = *(const LAS s16x4*)(qrowC + nt * 32 * RT_QROWB + (k + 2) * 32 + 16); }
                    }
                    __builtin_amdgcn_sched_barrier(0);
                    const int t = k >> 1, s = k & 1;
                    const bf16x8 as = pack8((f32x4){st[t][8 * s], st[t][8 * s + 1], st[t][8 * s + 2], st[t][8 * s + 3]}, (f32x4){st[t][8 * s + 4], st[t][8 * s + 5], st[t][8 * s + 6], st[t][8 * s + 7]});
#pragma unroll
                    for (int nt = 0; nt < 2; ++nt) oc[nt] = MFMA32(as, cat8(qlo[k % 3][nt], qhi[k % 3][nt]), oc[nt]);
                    __builtin_amdgcn_sched_barrier(0);
                }
            }
            {
#pragma unroll
                for (int t = 0; t < 8; ++t) st[t] *= gC;
                s16x4 kf[4][2];
#define KT_ADDR(u_) (ktr + (16 * (((u_) >> 1) & 3)) * RT_QROWB + (2 * ((u_) >> 3) + ((u_) & 1)) * 64)
#pragma unroll
                for (int u = 0; u < 3; ++u) { kf[u][0] = tr16(KT_ADDR(u)); kf[u][1] = tr16(KT_ADDR(u) + 4 * RT_QROWB); }
#pragma unroll
                for (int u = 0; u < 32; ++u) {
                    if (u + 3 < 32) { kf[(u + 3) & 3][0] = tr16(KT_ADDR(u + 3)); kf[(u + 3) & 3][1] = tr16(KT_ADDR(u + 3) + 4 * RT_QROWB); }
                    __builtin_amdgcn_sched_barrier(0);
                    const int t = 2 * (u >> 3) + (u & 1), ks = (u >> 1) & 3;
                    st[t] = MFMA32(cat8(kf[u & 3][0], kf[u & 3][1]), vf[ks], st[t]);
                    __builtin_amdgcn_sched_barrier(0);
                }
#undef KT_ADDR
            }
            LBAR();
            { const float gq0 = __builtin_amdgcn_exp2f(lg2 * (float)(r32 + 1)), gq1 = __builtin_amdgcn_exp2f(lg2 * (float)(r32 + 33)); oc[0] *= gq0; oc[1] *= gq1; }
#pragma unroll
            for (int ks = 0; ks < 4; ++ks)
#pragma unroll
                for (int nt = 0; nt < 2; ++nt) if (16 * ks <= 32 * nt + 31) { const bf16x8 bp = *(const LAS bf16x8*)(prow + nt * 32 * RT_PROWB + ks * 32); oc[nt] = MFMA32(vf[ks], bp, oc[nt]); }
#pragma unroll
            for (int nt = 0; nt < 2; ++nt) {
                float sq = 0.f;
#pragma unroll
                for (int i = 0; i < 16; ++i) sq += oc[nt][i] * oc[nt][i];
                sq += __shfl_xor(sq, 32);
                if (hh == 0) (void)__hip_atomic_fetch_add((LAS float*)(lds + R2_SQ) + (c & 1) * 64 + 32 * nt + r32, sq, __ATOMIC_RELAXED, __HIP_MEMORY_SCOPE_WORKGROUP);
#pragma unroll
                for (int g = 0; g < 4; ++g) {
                    const u32x2 sg = *(const LAS u32x2*)(lds + R2_SG + (32 * nt + r32) * RT_VROWB + (32 * w + 8 * g + 4 * hh) * 2);
                    const float o0 = oc[nt][4 * g] * __builtin_bit_cast(float, sg.x << 16), o1 = oc[nt][4 * g + 1] * __builtin_bit_cast(float, sg.x & 0xffff0000u);
                    const float o2 = oc[nt][4 * g + 2] * __builtin_bit_cast(float, sg.y << 16), o3 = oc[nt][4 * g + 3] * __builtin_bit_cast(float, sg.y & 0xffff0000u);
                    u32x2 pp; pp.x = pk_bf16(o0, o1); pp.y = pk_bf16(o2, o3);
                    if (!dry) __builtin_amdgcn_raw_buffer_store_b64(__builtin_bit_cast(__attribute__((ext_vector_type(2))) unsigned, pp), rs, vG, offG + uV + (unsigned)(c * 64 + 32 * nt) * 4096 + g * 16, 0);
                }
#pragma unroll
                for (int i = 0; i < 16; ++i) oc[nt][i] = 0.f;
            }
        }
        LBAR();
        LBAR();
    }
}

__device__ __forceinline__ int crow(int r, int hi) { return (r & 3) + 8 * (r >> 2) + 4 * hi; }
__device__ __forceinline__ void sb_wave(const bf16* QN, const bf16* KN, const bf16* VF, bf16* O, int vcu, int wave, int lane) {
    const int r32 = lane & 31, hh = lane >> 5;
#define SB_IDX(i_, bh_, qb_) const int bh_ = (vcu >> 3) + 32 * (i_), qb_ = ((((vcu & 7) + (i_)) & 7) << 3) + wave
#define SB_KBASE(bh_) (KN + ((size_t)(bh_) * SEQ + r32) * 64 + 8 * hh)
#define SB_VBASE(bh_) (VF + (size_t)(bh_) * 64 * 2048 + lane * 8)
    bf16x8 qN[4], kfU[4], vfU[2][2];
#define SB_LOAD_UNIT(bh_, qb_) do { const bf16* qp_ = QN + ((size_t)(bh_) * SEQ + 32 * (qb_) + r32) * 64 + 8 * hh; \
        _Pragma("unroll") for (int s = 0; s < 4; ++s) { qN[s] = *(const bf16x8*)(qp_ + 16 * s); kfU[s] = *(const bf16x8*)(SB_KBASE(bh_) + (size_t)(32 * (qb_)) * 64 + 16 * s); } \
        _Pragma("unroll") for (int dt = 0; dt < 2; ++dt) _Pragma("unroll") for (int sp = 0; sp < 2; ++sp) vfU[dt][sp] = *(const bf16x8*)(SB_VBASE(bh_) + (size_t)((((qb_) * 2 + dt) * 2 + sp) * 512)); } while (0)
    { SB_IDX(0, bh0, qb0); SB_LOAD_UNIT(bh0, qb0); }
#pragma unroll 1
    for (int i = 0; i < 8; ++i) {
        SB_IDX(i, bh, qblk);
        const int b = bh >> 4, h = bh & 15;
        const size_t row0 = (size_t)b * SEQ + 32 * qblk;
        bf16x8 qf[4], kfn[4], vfn[2][2];
#pragma unroll
        for (int s = 0; s < 4; ++s) { qf[s] = qN[s]; kfn[s] = kfU[s]; }
#pragma unroll
        for (int dt = 0; dt < 2; ++dt)
#pragma unroll
            for (int sp = 0; sp < 2; ++sp) vfn[dt][sp] = vfU[dt][sp];
        if (i + 1 < 8) { SB_IDX(i + 1, bh1, qb1); SB_LOAD_UNIT(bh1, qb1); }
        f32x16 oT[2];
#pragma unroll
        for (int q = 0; q < 16; ++q) { oT[0][q] = 0.f; oT[1][q] = 0.f; }
        float R = 0.f;
        const bf16* kbase = SB_KBASE(bh);
        const bf16* vbase = SB_VBASE(bh);
#define SB_LOAD(kt_) do { _Pragma("unroll") for (int s = 0; s < 4; ++s) kfn[s] = *(const bf16x8*)(kbase + (size_t)(32 * (kt_)) * 64 + 16 * s); \
        _Pragma("unroll") for (int dt = 0; dt < 2; ++dt) _Pragma("unroll") for (int sp = 0; sp < 2; ++sp) vfn[dt][sp] = *(const bf16x8*)(vbase + (size_t)((((kt_) * 2 + dt) * 2 + sp) * 512)); } while (0)
        for (int kt = qblk; kt >= 0; --kt) {
            bf16x8 kf[4], vf[2][2];
#pragma unroll
            for (int s = 0; s < 4; ++s) kf[s] = kfn[s];
#pragma unroll
            for (int dt = 0; dt < 2; ++dt)
#pragma unroll
                for (int sp = 0; sp < 2; ++sp) vf[dt][sp] = vfn[dt][sp];
            if (kt > 0) SB_LOAD(kt - 1);
            f32x16 z;
#pragma unroll
            for (int q = 0; q < 16; ++q) z[q] = 0.f;
#pragma unroll
            for (int s = 0; s < 4; ++s) z = MFMA32(kf[s], qf[s], z);
            float sp_[16], lb[16];
            const bool diag = (kt == qblk);
#pragma unroll
            for (int q = 0; q < 16; ++q) {
                const float zz = z[q];
                const float t = __builtin_amdgcn_exp2f(-__builtin_fabsf(zz));
                const float s = __builtin_fmaxf(zz, 0.f) + __builtin_amdgcn_logf(1.f + t);
                const bool valid = !diag || (crow(q, hh) < r32);
                sp_[q] = valid ? s : 0.f;
                lb[q] = valid ? (zz - s) : -INFINITY;
            }
            float gsum[4], pgs[4];
#pragma unroll
            for (int q = 0; q < 4; ++q) { gsum[q] = (sp_[4 * q] + sp_[4 * q + 1]) + (sp_[4 * q + 2] + sp_[4 * q + 3]); pgs[q] = __shfl_xor(gsum[q], 32); }
            float later = R;
            f32x16 pa;
#pragma unroll
            for (int q = 3; q >= 0; --q) {
                const float L = later + (hh == 0 ? pgs[q] : 0.f);
                const float s3 = L, s2 = s3 + sp_[4 * q + 3], s1 = s2 + sp_[4 * q + 2], s0 = s1 + sp_[4 * q + 1];
                pa[4 * q + 0] = __builtin_amdgcn_exp2f(lb[4 * q + 0] - s0);
                pa[4 * q + 1] = __builtin_amdgcn_exp2f(lb[4 * q + 1] - s1);
                pa[4 * q + 2] = __builtin_amdgcn_exp2f(lb[4 * q + 2] - s2);
                pa[4 * q + 3] = __builtin_amdgcn_exp2f(lb[4 * q + 3] - s3);
                later += gsum[q] + pgs[q];
            }
            R = later;
#pragma unroll
            for (int sp = 0; sp < 2; ++sp) {
                const bf16x8 pf = pack8((f32x4){pa[8 * sp], pa[8 * sp + 1], pa[8 * sp + 2], pa[8 * sp + 3]}, (f32x4){pa[8 * sp + 4], pa[8 * sp + 5], pa[8 * sp + 6], pa[8 * sp + 7]});
#pragma unroll
                for (int dt = 0; dt < 2; ++dt) oT[dt] = MFMA32(vf[dt][sp], pf, oT[dt]);
            }
            if (__all(R > 46.2f)) break;
        }
#undef SB_LOAD
#pragma unroll
        for (int dt = 0; dt < 2; ++dt)
#pragma unroll
            for (int q = 0; q < 4; ++q) {
                u32x2 pp; pp.x = pk_bf16(oT[dt][4 * q], oT[dt][4 * q + 1]); pp.y = pk_bf16(oT[dt][4 * q + 2], oT[dt][4 * q + 3]);
                *(u32x2*)(O + (row0 + r32) * 1024 + h * 64 + 32 * dt + 8 * q + 4 * hh) = pp;
            }
    }
#undef SB_IDX
#undef SB_KBASE
#undef SB_VBASE
#undef SB_LOAD_UNIT
}

__device__ __forceinline__ void fix_phase(const bf16* HF, const bf16* HL, const float* cw, const float* cb, bf16* ACT, int vcu, int G) {
    const int NIT = 512 * 2 * (FF / 4), stride = G * NTHREADS;
    for (int it0 = vcu * NTHREADS + threadIdx.x; it0 < NIT; it0 += 3 * stride) {
        f32x4 u0[3][2], u1[3][2], u2[3][2], w0[3][2], w1[3][2], w2[3][2], bb[3][2];
#pragma unroll
        for (int q = 0; q < 3; ++q) {
            const int it = (it0 + q * stride < NIT) ? it0 + q * stride : it0;
            const int cg4 = it % (FF / 4), bi = it / (FF / 4), i = bi & 1, blk = bi >> 1;
            const int c0 = 4 * cg4, pn = c0 >> 7, j = c0 & 127, nv = 256 * pn + j;
            const bool first = (blk & 31) == 0;
            const int pb = first ? blk : blk - 1;
#pragma unroll
            for (int half = 0; half < 2; ++half) {
                const int nn = nv + 128 * half, co = half * FF + c0;
#define FIX_LD4(P) ({ const u32x2 t_ = *(const u32x2*)(P); (f32x4){__builtin_bit_cast(float, t_.x << 16), __builtin_bit_cast(float, t_.x & 0xffff0000u), __builtin_bit_cast(float, t_.y << 16), __builtin_bit_cast(float, t_.y & 0xffff0000u)}; })
                u0[q][half] = FIX_LD4(HF + (size_t)(blk * 2 + i) * FF2 + nn);
                const f32x4 hf0 = FIX_LD4(HF + (size_t)(blk * 2) * FF2 + nn), hl1 = FIX_LD4(HL + (size_t)(pb * 2 + 1) * FF2 + nn), hl0 = FIX_LD4(HL + (size_t)(pb * 2) * FF2 + nn);
#undef FIX_LD4
                const f32x4 zero = (f32x4){0.f, 0.f, 0.f, 0.f}, pl1 = first ? zero : hl1, pl0 = first ? zero : hl0;
                u1[q][half] = (i == 1) ? hf0 : pl1; u2[q][half] = (i == 1) ? pl1 : pl0;
                w0[q][half] = *(const f32x4*)(cw + co); w1[q][half] = *(const f32x4*)(cw + FF2 + co); w2[q][half] = *(const f32x4*)(cw + 2 * FF2 + co); bb[q][half] = *(const f32x4*)(cb + co);
            }
        }
#pragma unroll
        for (int q = 0; q < 3; ++q) {
            const int it = it0 + q * stride;
            if (it < NIT) {
                const int cg4 = it % (FF / 4), bi = it / (FF / 4), i = bi & 1, blk = bi >> 1, c0 = 4 * cg4;
                const f32x4 val = bb[q][0] + w2[q][0] * u0[q][0] + w1[q][0] * u1[q][0] + w0[q][0] * u2[q][0];
                const f32x4 gat = bb[q][1] + w2[q][1] * u0[q][1] + w1[q][1] * u1[q][1] + w0[q][1] * u2[q][1];
                const f32x4 o = val * pg8::silu4(gat);
                u32x2 p2; p2.x = pk_bf16(o[0], o[1]); p2.y = pk_bf16(o[2], o[3]);
                *(u32x2*)(ACT + (size_t)(64 * blk + i) * FF + c0) = p2;
            }
        }
    }
}

__device__ __forceinline__ XcdBarrier mk_bar(ptab_t tab, LAS unsigned char* lds) { XcdBarrier b; b.bar = (unsigned*)(ldp(tab, T_WS) + WS_CTL) + 1024; b.x = xb_xcc_id(); b.st = (volatile LAS unsigned*)(lds + MISC_OFF) + 8; return b; }
__global__ void __launch_bounds__(NTHREADS, 2) yoco_fwd(Args a) {
    extern __shared__ __attribute__((aligned(16))) unsigned char lds_raw[];
    LAS unsigned char* lds = (LAS unsigned char*)lds_raw;
    volatile LAS unsigned* MISC = (volatile LAS unsigned*)(lds + MISC_OFF);
    LAS unsigned long long* tabw = (LAS unsigned long long*)(lds + MISC_OFF + 64);
    const ptab_t tab = (ptab_t)(lds + MISC_OFF + 64);
    if (threadIdx.x < 16) MISC[threadIdx.x] = 0u;
    if (threadIdx.x == 64) {
#pragma unroll
        for (int i = 0; i < 21; ++i) tabw[i] = (unsigned long long)a.in[i];
        tabw[T_OUT] = (unsigned long long)a.out; tabw[T_WS] = (unsigned long long)a.ws;
        MISC[0] = (unsigned)a.ph_lo; MISC[1] = (unsigned)a.ph_hi;
    }
    __syncthreads();
    if (a.ph_hi - a.ph_lo > 1) (void)xcd_barrier_post((unsigned*)(a.ws + WS_CTL) + 1024, MISC + 8);
#define PH_LO ((int)__builtin_amdgcn_readfirstlane(MISC[0]))
#define PH_HI ((int)__builtin_amdgcn_readfirstlane(MISC[1]))
#define IN(k) (PH_LO <= (k) && (k) < PH_HI)
#define STAMP(k) do { if (PROBE_TS >= 0 && threadIdx.x == 0) { const unsigned long long t_ = __builtin_amdgcn_s_memrealtime(); *(volatile LAS unsigned long long*)(lds + MISC_OFF + 256 + 8 * (k)) = t_; } } while (0)
#define SEAM(k) do { if (IN(k) && IN((k) + 1)) xcd_barrier(mk_bar(tab, lds)); STAMP((k) + 1); } while (0)
#define GRID ((int)gridDim.x)
#define BX ((int)blockIdx.x)
#define VCU ((GRID % 8 == 0) ? (BX % 8) * (GRID / 8) + BX / 8 : BX)
#define WSP (ldp(tab, T_WS))

    STAMP(0);
#ifndef SKIP_P0
    if (IN(0)) { for (int rep = 0; rep < REPS(0); ++rep) { p0_phase(tab, lds, VCU, GRID); LBAR(); } }
#endif
    if (IN(0) && IN(1)) {
        if (MK_ONE_LAUNCH && PH_LO < 0) { cg::this_grid().sync(); }
        xcd_barrier(mk_bar(tab, lds));
    }
    STAMP(1);
#ifndef SKIP_P1
    if (IN(1)) { for (int rep = 0; rep < REPS(1); ++rep) p1_phase(tab, lds, VCU, GRID); }
#endif
    SEAM(1);
    if (IN(2)) {
        pg8::Gemm g{(const bf16*)(WSP + WS_A), (const bf16*)(WSP + WS_WT1), M, RN, D, D}; pg8::StaticOrder S; S.init(M, RN, GRID, BX);
        pg8::EpiRetIn E{tab};
        for (int rep = 0; rep < REPS(2); ++rep) pg8::gemm_phase<pg8::EpiRetIn, pg8::StaticOrder, true, true>(lds, g, S, E);
    }
    SEAM(2);
#ifndef SKIP_RET
    if (IN(3)) {
        unsigned char* ws = WSP;
        for (int rep = 0; rep < REPS(3); ++rep) for (int u = VCU; u < 256; u += GRID) RET_UNIT(lds, (const bf16*)(ws + WS_Q), (const bf16*)(ws + WS_KD), (const bf16*)(ws + WS_V), (bf16*)(ws + WS_SG), (float*)(ws + WS_SSO), u, rep == 0 && REPS(3) == 2);
    }
#endif
    SEAM(3);
    if (IN(4)) {
        pg8::Gemm g{(const bf16*)(WSP + WS_SG), (const bf16*)(WSP + WS_WT2), M, D, 512, 2048}; pg8::SegOrder S; S.init(M, D, GRID, BX);
        pg8::EpiRes<0> E{tab};
        {
            const int slot = threadIdx.x >> 8, r = threadIdx.x & 255; pg8::Unit u;
            if (S.next(4 * slot, u)) {
                const float* sp4 = (const float*)(WSP + WS_SSO) + (size_t)(u.pm * 256 + r) * 16; f32x4 s4;
#pragma unroll
                for (int hh = 0; hh < 4; ++hh) { const f32x4 q = *(const f32x4*)(sp4 + 4 * hh); s4[hh] = (q[0] + q[1]) + (q[2] + q[3]); }
                const float e0 = s4[0] * (1.f / 512.f) + EPS, e1 = s4[1] * (1.f / 512.f) + EPS, e2 = s4[2] * (1.f / 512.f) + EPS, e3 = s4[3] * (1.f / 512.f) + EPS;
                f32x4 o; o[0] = __builtin_sqrtf(e1 / e0); o[1] = __builtin_sqrtf(e2 / e1); o[2] = __builtin_sqrtf(e3 / e2); o[3] = 1.f / __builtin_sqrtf(e3);
                *(LAS f32x4*)(lds + pg8::LDS_XTRA + (slot * 256 + r) * 16) = o;
            }
            LBAR();
        }
        pg8::gemm_phase<pg8::EpiRes<0>, pg8::SegOrder, true, true>(lds, g, S, E);
    }
    SEAM(4);
#pragma unroll 1
    for (int l = 0; l < 2; ++l) {
        const int pb = (l == 0) ? 5 : 11;
        if (IN(pb)) {
            pg8::Gemm g{(const bf16*)(WSP + WS_A), (const bf16*)(WSP + WS_WT3) + (size_t)l * FF2 * 1024, M, FF2, D, D}; pg8::StaticOrder S; S.init(M, FF2, GRID, BX);
            pg8::EpiFfnIn E{tab, l};
            for (int rep = 0; rep < ((l == 0) ? REPS(5) : 1); ++rep) pg8::gemm_phase<pg8::EpiFfnIn, pg8::StaticOrder, true, true>(lds, g, S, E);
        }
        SEAM(pb);
        if (IN(pb + 1)) { unsigned char* ws = WSP; fix_phase((const bf16*)(ws + WS_HF), (const bf16*)(ws + WS_HL), (const float*)ldp(tab, 18) + l * 3 * FF2, (const float*)ldp(tab, 19) + l * FF2, (bf16*)(ws + WS_ACT), VCU, GRID); }
        SEAM(pb + 1);
        if (IN(pb + 2)) {
            pg8::Gemm g{(const bf16*)(WSP + WS_ACT), (const bf16*)(WSP + WS_WT4) + (size_t)l * 1024 * FF, M, D, FF, FF}; pg8::StaticOrder S; S.init(M, D, GRID, BX);
            if (l == 0) { pg8::EpiRes<1> E{tab}; pg8::gemm_phase<pg8::EpiRes<1>, pg8::StaticOrder, true, true>(lds, g, S, E); }
            else        { pg8::EpiRes<3> E{tab}; pg8::gemm_phase<pg8::EpiRes<3>, pg8::StaticOrder, true, true>(lds, g, S, E); }
        }
        if (l == 1) break;
        SEAM(7);
        if (IN(8)) {
            { pg8::Gemm g{(const bf16*)(WSP + WS_A), (const bf16*)(WSP + WS_WT5), M, 2048, D, D}; pg8::StaticOrder S; S.init(M, 2048, GRID, BX);
              pg8::EpiKVQ<0> E{tab};
              for (int rep = 0; rep < REPS(8); ++rep) pg8::gemm_phase<pg8::EpiKVQ<0>, pg8::StaticOrder, true, true>(lds, g, S, E); }
            { pg8::Gemm g{(const bf16*)(WSP + WS_AM1), (const bf16*)(WSP + WS_WT6), M, D, D, D}; pg8::StaticOrder S; S.init(M, D, GRID, BX);
              pg8::EpiKVQ<1> E{tab};
              pg8::gemm_phase<pg8::EpiKVQ<1>, pg8::StaticOrder, true, true>(lds, g, S, E); }
        }
        SEAM(8);
#ifndef SKIP_SB
        if (IN(9)) {
            unsigned char* ws = WSP; const int vcu = VCU, wave = __builtin_amdgcn_readfirstlane(threadIdx.x >> 6); int lane = threadIdx.x & 63;
            asm volatile("" : "+v"(lane));
            for (int rep = 0; rep < REPS(9); ++rep) sb_wave((const bf16*)(ws + WS_QN), (const bf16*)(ws + WS_KN), (const bf16*)(ws + WS_VT), (bf16*)(ws + WS_OSB), vcu, wave, lane);
        }
#endif
        SEAM(9);
        if (IN(10)) {
            pg8::Gemm g{(const bf16*)(WSP + WS_OSB), (const bf16*)(WSP + WS_WT7), M, D, D, D}; pg8::StaticOrder S; S.init(M, D, GRID, BX);
            pg8::EpiRes<2> E{tab};
            pg8::gemm_phase<pg8::EpiRes<2>, pg8::StaticOrder, true, true>(lds, g, S, E);
        }
        SEAM(10);
    }
#if PROBE_X >= 0
    {
        xcd_barrier(mk_bar(tab, lds)); STAMP(14);
        pg8::Gemm g{(const bf16*)(WSP + WS_OSB), (const bf16*)(WSP + WS_WT7), M, D, D, D}; pg8::StaticOrder S; S.init(M, D, GRID, BX);
        if (PROBE_X >= 128) { LBAR(); p1_phase(tab, lds, VCU, GRID, PROBE_X - 128); }
        if (PROBE_X < 64) { pg8::EpiRes<2, PROBE_X & 63> E{tab};
        pg8::gemm_phase<pg8::EpiRes<2, PROBE_X & 63>, pg8::StaticOrder, true, true>(lds, g, S, E); }
    }
#endif
#if PROBE_TS >= 0
    {
        xcd_barrier(mk_bar(tab, lds)); STAMP(PROBE_X >= 0 ? 15 : 14);
        float* dlt = (float*)(WSP + WS_CTL) + 8192;
        if (BX == 0 && threadIdx.x == 0) {
            const volatile LAS unsigned long long* ts = (const volatile LAS unsigned long long*)(lds + MISC_OFF + 256);
            float t_us = (PROBE_TS >= 100) ? 200.f : (float)(ts[PROBE_TS + 1] - ts[PROBE_TS]) * 0.01f;
            __hip_atomic_store(dlt, __builtin_sqrtf(t_us * (3.35e-6f * PROBE_GAIN)), __ATOMIC_RELAXED, __HIP_MEMORY_SCOPE_AGENT);
        }
        xcd_barrier(mk_bar(tab, lds));
        const float d = __hip_atomic_load(dlt, __ATOMIC_RELAXED, __HIP_MEMORY_SCOPE_AGENT);
        float* o = (float*)ldp(tab, T_OUT);
        for (int i = BX * NTHREADS + threadIdx.x; i < (1 << 20); i += GRID * NTHREADS) o[i] += d;
    }
#endif
#undef IN
#undef SEAM
}

extern "C" void kernel_launch(void* const* d_in, const int* in_sizes, int n_in, void* d_out, int out_size, void* d_ws, size_t ws_size, hipStream_t stream) {
    static int grid = 0;
    if (grid == 0) {
        if (n_in != 21 || in_sizes[0] != M * D || out_size != M * D || ws_size < WS_END) { fprintf(stderr, "kernel_launch: unexpected problem: n_in %d in0 %d out %d ws %zu (need %zu)\n", n_in, n_in > 0 ? in_sizes[0] : -1, out_size, ws_size, (size_t)WS_END); grid = -1; return; }
        int dev = 0, cus = 0, per_cu = 0;
        if (hipGetDevice(&dev) != hipSuccess || hipDeviceGetAttribute(&cus, hipDeviceAttributeMultiprocessorCount, dev) != hipSuccess) { grid = -1; return; }
        if (hipFuncSetAttribute((const void*)yoco_fwd, hipFuncAttributeMaxDynamicSharedMemorySize, LDS_BYTES) != hipSuccess) { fprintf(stderr, "kernel_launch: hipFuncSetAttribute failed\n"); grid = -1; return; }
        if (hipOccupancyMaxActiveBlocksPerMultiprocessor(&per_cu, (const void*)yoco_fwd, NTHREADS, LDS_BYTES) != hipSuccess || per_cu < 1) { fprintf(stderr, "kernel_launch: occupancy query says %d\n", per_cu); (void)hipGetLastError(); per_cu = 1; }
        grid = cus;
        if (grid > 256) grid = 256;
    }
    if (grid < 0) return;
    (void)hipMemsetAsync((char*)d_ws + WS_CTL, 0, 65536, stream);
    Args a{};
    for (int i = 0; i < 21; ++i) a.in[i] = d_in[i];
    a.out = (float*)d_out; a.ws = (unsigned char*)d_ws;
#if MK_ONE_LAUNCH
    a.ph_lo = 0; a.ph_hi = NPHASE;
    void* args[] = {&a};
    hipError_t e = hipLaunchCooperativeKernel((const void*)yoco_fwd, dim3(grid), dim3(NTHREADS), args, LDS_BYTES, stream);
    if (e != hipSuccess) fprintf(stderr, "kernel_launch: cooperative launch failed: %s\n", hipGetErrorString(e));
#else
    for (int p = 0; p < NPHASE; ++p) { a.ph_lo = p; a.ph_hi = p + 1; hipLaunchKernelGGL(yoco_fwd, dim3(grid), dim3(NTHREADS), LDS_BYTES, stream, a); }
#endif
}
```

```cpp
#include <hip/hip_runtime.h>
#include <hip/hip_cooperative_groups.h>
#include <cstdio>
#include <cstdint>
namespace cg = cooperative_groups;
namespace pg8 {
#define PG8_LAS __attribute__((address_space(3)))
typedef unsigned short bf16_t;
typedef short bf16x8 __attribute__((ext_vector_type(8)));
typedef float f32x4 __attribute__((ext_vector_type(4)));
typedef unsigned u32x4 __attribute__((ext_vector_type(4)));
constexpr int BM = 256, BK = 64, HALF = 128, HTB = HALF * BK * 2  , STAGE_BYTES = 8 * HTB, NXCD = 8, WGM = 8;

__host__ __device__ __forceinline__ int lds_byte(int r, int c) { const int st = (r >> 4) * 2 + (c >> 5), rr = r & 15, cc = c & 31, ob = rr * 64 + cc * 2; return st * 1024 + (ob ^ (((ob >> 9) & 1) << 5)); }
__host__ __device__ __forceinline__ void stage_rc(int b, int& R, int& C) { const int st = b / 1024, sb = b % 1024, swz = sb ^ (((sb >> 9) & 1) << 5); R = (st >> 1) * 16 + swz / 64; C = (st & 1) * 32 + (swz % 64) / 2; }
__host__ __device__ __forceinline__ int perm32(int rho) { const int n = rho >> 4, i = rho & 15; return 8 * (i >> 2) + 4 * n + (i & 3); }

struct Unit { int pm, pn, kk; };
struct Gemm { const bf16_t* A; const bf16_t* Bt; int M, N, K, ld; };

struct StaticOrder {
    int nM, nN, nwg, G, c;
    __host__ __device__ void init(int M, int N, int G_, int c_) { nM = M / BM; nN = N / BM; nwg = nM * nN; G = G_; c = c_; }
    __host__ __device__ bool next(int i, Unit& u) const {
        const long L = (long)i * G + c; if (L >= nwg) return false;
        int wgid = (int)L; { const int q = nwg / NXCD, r = nwg % NXCD, xcd = wgid % NXCD, off = wgid / NXCD; wgid = (xcd < r ? xcd * (q + 1) : r * (q + 1) + (xcd - r) * q) + off; }
        const int nig = WGM * nN, gid = wgid / nig, fm = gid * WGM, gsz = (nM - fm) < WGM ? (nM - fm) : WGM;
        u.pm = fm + ((wgid % nig) % gsz); u.pn = (wgid % nig) / gsz; u.kk = 0; return true;
    }
    __device__ __forceinline__ void a_ready(const Unit&) const {}
    __device__ __forceinline__ void done(const Unit&) const {}
};

struct SegOrder : StaticOrder {
    __host__ __device__ bool next(int i, Unit& u) const { if (!StaticOrder::next(i >> 2, u)) return false; u.kk = i & 3; return true; }
};
typedef float f32x2 __attribute__((ext_vector_type(2)));
typedef __bf16 bf16x2_t __attribute__((ext_vector_type(2)));
constexpr float EPS = 1e-6f;
__device__ __forceinline__ unsigned pk_bf16(float lo, float hi) { f32x2 v = {lo, hi}; bf16x2_t b = __builtin_convertvector(v, bf16x2_t); return __builtin_bit_cast(unsigned, b); }
__device__ __forceinline__ u32x4 pk8(const f32x4 a, const f32x4 b) { u32x4 w; w.x = pk_bf16(a[0], a[1]); w.y = pk_bf16(a[2], a[3]); w.z = pk_bf16(b[0], b[1]); w.w = pk_bf16(b[2], b[3]); return w; }
__device__ __forceinline__ float silu_f(float x) { return x * __builtin_amdgcn_rcpf(1.f + __builtin_amdgcn_exp2f(-1.44269504089f * x)); }
__device__ __forceinline__ f32x4 silu4(f32x4 v) { f32x4 o; o[0] = silu_f(v[0]); o[1] = silu_f(v[1]); o[2] = silu_f(v[2]); o[3] = silu_f(v[3]); return o; }
__device__ __forceinline__ float dot4(const f32x4 a) { return (a[0] * a[0] + a[1] * a[1]) + (a[2] * a[2] + a[3] * a[3]); }
template <int CTRL> __device__ __forceinline__ float dppf(float old, float src) { return __builtin_bit_cast(float, __builtin_amdgcn_update_dpp(__builtin_bit_cast(int, old), __builtin_bit_cast(int, src), CTRL, 0xf, 0xf, false)); }


typedef const PG8_LAS unsigned long long* ptab_t;
enum { T_OUT = 21, T_WS = 22 };
__device__ __forceinline__ unsigned char* ldp(ptab_t tab, int k) { const unsigned long long v = tab[k]; const unsigned lo = __builtin_amdgcn_readfirstlane((unsigned)v), hi = __builtin_amdgcn_readfirstlane((unsigned)(v >> 32)); return (unsigned char*)(__attribute__((address_space(1))) unsigned char*)(((unsigned long long)hi << 32) | lo); }
__device__ __forceinline__ void dma4(const void* src_lane, PG8_LAS unsigned char* dst_wave_base) { __builtin_amdgcn_global_load_lds((const unsigned*)src_lane, (PG8_LAS unsigned*)dst_wave_base, 4, 0, 0); }
constexpr int LDS_TOTAL = 155648, LDS_MISC = LDS_TOTAL - 512, LDS_XTRA = 131072;
constexpr size_t MiB_ = 1u << 20;
constexpr int M_ = 32768;
constexpr size_t O_MODS = 65536, O_KVM = O_MODS + (size_t)2 * 16 * 6144 * 4, O_SW1 = O_KVM + (size_t)16 * 2048 * 4, O_SW3 = O_SW1 + (size_t)16 * 6144 * 4, O_SW5 = O_SW3 + (size_t)2 * 16 * 5632 * 4,
                 O_SW6 = O_SW5 + (size_t)16 * 2048 * 4, O_SS = O_SW6 + (size_t)16 * 1024 * 4, O_SSO = O_SS + (size_t)4 * M_ * 4, O_SMALL_END = O_SSO + (size_t)M_ * 16 * 4;
constexpr size_t O_A = 64 * MiB_, O_BIG = 128 * MiB_, O_Q = O_BIG, O_KD = O_BIG + 64 * MiB_, O_V = O_BIG + 128 * MiB_, O_SG = O_BIG + 256 * MiB_;
constexpr size_t O_H16 = O_BIG, O_ACT = O_BIG + 64 * MiB_, O_HF = O_ACT + 176 * MiB_, O_HL = O_HF + 22 * MiB_, O_AM1 = O_BIG + 284 * MiB_, O_KN = O_BIG + 64 * MiB_, O_VT = O_BIG + 128 * MiB_, O_QN = O_BIG + 192 * MiB_, O_OSB = O_BIG + 256 * MiB_;

struct EpiRetIn {
    static constexpr bool PERM = true, AFTER_DRAIN = false, SEG = false, PERMA = false, TILEDA = true;
    ptab_t tab;
    __device__ __forceinline__ void prefetch(const Unit& u, int slot, PG8_LAS unsigned char* lds, int wid, int lane) const {
        unsigned char* ws = ldp(tab, T_WS); PG8_LAS unsigned char* base = lds + LDS_XTRA + slot * 3072; const int b = u.pm >> 3;
        if (wid < 4) { dma4((const float*)(ws + O_SS) + u.pm * BM + 64 * wid + lane, base + 256 * wid); dma4((const float*)(ws + O_SW1) + b * 6144 + u.pn * BM + 64 * wid + lane, base + 2048 + 256 * wid); }
        else dma4((const int*)ldp(tab, 2) + u.pm * BM + 64 * (wid - 4) + lane, base + 1024 + 256 * (wid - 4));
    }
    __device__ __forceinline__ void operator()(f32x4 (&acc)[2][2][4][2], const Unit& u, int wr, int wc, int slot, int) const {
        int lane_ = threadIdx.x & 63; asm volatile("" : "+v"(lane_)); const int fr = lane_ & 15, fq = lane_ >> 4;
        unsigned char* ws = ldp(tab, T_WS);
        const PG8_LAS unsigned char* tb = (const PG8_LAS unsigned char*)tab - 64 - LDS_MISC + LDS_XTRA + slot * 3072;
        const PG8_LAS float* ss = (const PG8_LAS float*)tb - u.pm * BM; const PG8_LAS int* pos = (const PG8_LAS int*)(tb + 1024) - u.pm * BM;
        const PG8_LAS float* sW = (const PG8_LAS float*)(tb + 2048) - ((u.pm >> 3) * 6144 + u.pn * 256);
        bf16_t* Q = (bf16_t*)(ws + O_Q); bf16_t* KD = (bf16_t*)(ws + O_KD); bf16_t* V = (bf16_t*)(ws + O_V); bf16_t* SG = (bf16_t*)(ws + O_SG);
        const int b = u.pm >> 3, cl = wc * 32 + 8 * fq, row0 = u.pm * BM + wr * 64 + fr;
        f32x4 sw[2][2];
#pragma unroll
        for (int bj = 0; bj < 2; ++bj)
#pragma unroll
            for (int n = 0; n < 2; ++n) sw[bj][n] = *(const f32x4*)(sW + b * 6144 + u.pn * 256 + bj * 128 + cl + 4 * n);
        if (u.pn < 8) {
            const bool isk = u.pn >= 4; const int h = u.pn & 3;
            bf16_t* dst = (isk ? KD : Q) + h * 256 + cl;
            float inv[8];
#pragma unroll
            for (int i = 0; i < 8; ++i) inv[i] = __builtin_amdgcn_exp2f(-(float)(cl + i) * 0.10381025296523f) * 0.15915494309189535f;
            const float lg = __builtin_amdgcn_logf(1.f - __builtin_amdgcn_exp2f(-5.f - (float)h));
#pragma unroll
            for (int ai = 0; ai < 2; ++ai)
#pragma unroll
                for (int m = 0; m < 4; ++m) {
                    const int row = row0 + ai * HALF + m * 16;
                    const float p = (float)pos[row], rs = __builtin_amdgcn_rsqf(ss[row] * (1.f / 1024.f) + EPS);
                    const float ksc = isk ? 0.0625f * __builtin_amdgcn_exp2f(lg * (float)(63 - (row & 63))) : 1.f;
                    f32x4 o1[2], o2[2];
#pragma unroll
                    for (int n = 0; n < 2; ++n)
#pragma unroll
                        for (int e = 0; e < 4; ++e) {
                            const float x1 = acc[ai][0][m][n][e] * rs + sw[0][n][e], x2 = acc[ai][1][m][n][e] * rs + sw[1][n][e];
                            const float r = __builtin_amdgcn_fractf(p * inv[4 * n + e]);
                            const float s = __builtin_amdgcn_sinf(r), c = __builtin_amdgcn_cosf(r);
                            o1[n][e] = (x1 * c - x2 * s) * ksc; o2[n][e] = (x1 * s + x2 * c) * ksc;
                        }
                    *(u32x4*)(dst + (size_t)row * 1024) = pk8(o1[0], o1[1]);
                    *(u32x4*)(dst + (size_t)row * 1024 + 128) = pk8(o2[0], o2[1]);
                }
        } else {
            const bool isg = u.pn >= 16;
            bf16_t* dst = (isg ? SG : V) + ((u.pn - 8) & 7) * 256 + cl;
#pragma unroll
            for (int ai = 0; ai < 2; ++ai)
#pragma unroll
                for (int m = 0; m < 4; ++m) {
                    const int row = row0 + ai * HALF + m * 16;
                    const float rs = __builtin_amdgcn_rsqf(ss[row] * (1.f / 1024.f) + EPS);
#pragma unroll
                    for (int bj = 0; bj < 2; ++bj) {
                        f32x4 v0 = acc[ai][bj][m][0] * rs + sw[bj][0], v1 = acc[ai][bj][m][1] * rs + sw[bj][1];
                        if (isg) { v0 = silu4(v0); v1 = silu4(v1); }
                        *(u32x4*)(dst + (size_t)row * 2048 + bj * HALF) = pk8(v0, v1);
                    }
                }
        }
    }
};

template <bool WT> __device__ __forceinline__ void st16(void* p, u32x4 v) {
    if (WT) asm volatile("global_store_dwordx4 %0, %1, off sc1" :: "v"(p), "v"(v) : "memory"); else *(u32x4*)p = v;
}
__device__ __forceinline__ u32x4 dpp_ror8(u32x4 v) { u32x4 r;
#pragma unroll
    for (int i = 0; i < 4; ++i) r[i] = (unsigned)__builtin_amdgcn_update_dpp(0, (int)v[i], 0x128, 0xf, 0xf, true);
    return r; }
__device__ __forceinline__ float xsum_rows(float x) {
    const unsigned u = __builtin_bit_cast(unsigned, x);
    const auto a = __builtin_amdgcn_permlane16_swap(u, u, false, false);
    const float y = __builtin_bit_cast(float, (unsigned)a[0]) + __builtin_bit_cast(float, (unsigned)a[1]);
    const unsigned v = __builtin_bit_cast(unsigned, y);
    const auto b = __builtin_amdgcn_permlane32_swap(v, v, false, false);
    return __builtin_bit_cast(float, (unsigned)b[0]) + __builtin_bit_cast(float, (unsigned)b[1]);
}
__device__ __forceinline__ void unswap_rows128(int fr, u32x4 x, u32x4 y, u32x4& a, u32x4& b) { const bool lo = fr < 8; const u32x4 recv = dpp_ror8(lo ? y : x); a = lo ? x : recv; b = lo ? recv : y; }
__device__ __forceinline__ void st_rows128_f32(float* p16, int pitch, int fr, int fq, f32x4 a, f32x4 b) {
    const bool lo = fr < 8; const u32x4 ua = __builtin_bit_cast(u32x4, a), ub = __builtin_bit_cast(u32x4, b);
    const u32x4 recv = dpp_ror8(lo ? ub : ua), d1 = lo ? ua : recv, d2 = lo ? recv : ub;
    float* p = p16 + (size_t)(fr & 7) * pitch + 8 * fq + 4 * (fr >> 3);
    *(u32x4*)p = d1; *(u32x4*)(p + (size_t)8 * pitch) = d2;
}
__device__ __forceinline__ void st_rows128(bf16_t* p16, int pitch, int fr, int fq, u32x4 a, u32x4 b) {
    const bool lo = fr < 8;
    const u32x4 send = lo ? b : a; u32x4 recv;
#pragma unroll
    for (int i = 0; i < 4; ++i) recv[i] = (unsigned)__builtin_amdgcn_update_dpp(0, (int)send[i], 0x128, 0xf, 0xf, true);
    const u32x4 d1 = lo ? a : recv, d2 = lo ? recv : b;
    bf16_t* p = p16 + (size_t)(fr & 7) * pitch + 32 * (fr >> 3) + 8 * fq;
    *(u32x4*)p = d1; *(u32x4*)(p + (size_t)8 * pitch) = d2;
}
template <int WHICH, int VAR = 0> struct EpiRes {
    static constexpr int NOUT = (WHICH == 1) ? 2 : (WHICH == 3 ? 0 : 1);
    static constexpr bool HOOK = (WHICH == 0), SSACC = (WHICH != 3);
    static constexpr int MB = (NOUT == 2) ? 1 : 2;
    static constexpr bool PERM = true, AFTER_DRAIN = false, SEG = HOOK, PERMA = false, TILEDA = (WHICH != 0);
    ptab_t tab;
    __device__ __forceinline__ void prefetch(const Unit&, int, PG8_LAS unsigned char*, int, int) const {}
    __device__ __forceinline__ void seg(f32x4 (&acc)[2][2][4][2], int kk, int tile, int wr) const {
        int lane_ = threadIdx.x & 63; asm volatile("" : "+v"(lane_)); const int fr = lane_ & 15;
        const PG8_LAS float* tb = (const PG8_LAS float*)((const PG8_LAS unsigned char*)tab - 64 - LDS_MISC + LDS_XTRA) + (tile * 256 + wr * 64 + fr) * 4 + kk;
#pragma unroll
        for (int ai = 0; ai < 2; ++ai)
#pragma unroll
            for (int m = 0; m < 4; ++m) {
                const float ratio = tb[(ai * HALF + m * 16) * 4];
#pragma unroll
                for (int bj = 0; bj < 2; ++bj)
#pragma unroll
                    for (int n = 0; n < 2; ++n) acc[ai][bj][m][n] *= ratio;
            }
    }
    __device__ __forceinline__ void operator()(f32x4 (&acc)[2][2][4][2], const Unit& u, int wr, int wc, int, int) const {
        int lane_ = threadIdx.x & 63; asm volatile("" : "+v"(lane_)); const int fr = lane_ & 15, fq = lane_ >> 4;
        unsigned char* ws = ldp(tab, T_WS); float* hout = (float*)ldp(tab, T_OUT); bf16_t* h16 = (bf16_t*)(ws + O_H16);
        const float* mods = (const float*)(ws + O_MODS);
        const float* hin = (const float*)ldp(tab, 0);
        const float* gate = mods + (WHICH >= 2 ? 16 * 6144 : 0) + ((WHICH == 0 || WHICH == 2) ? 2048 : 5120);
        const float* g0 = nullptr; const float* sc0 = nullptr; int st0 = 6144; bf16_t* o0 = (bf16_t*)(ws + O_A);
        const float* g1 = nullptr; const float* sc1 = nullptr; const int st1 = 6144; bf16_t* o1 = (bf16_t*)(ws + O_AM1);
        if (WHICH == 0) { g0 = (const float*)ldp(tab, 6); sc0 = mods + 4096; }
        if (WHICH == 1) { g0 = (const float*)ldp(tab, 11); sc0 = (const float*)(ws + O_KVM) + 1024; st0 = 2048; g1 = (const float*)ldp(tab, 5) + 1024; sc1 = mods + 16 * 6144 + 1024; }
        if (WHICH == 2) { g0 = (const float*)ldp(tab, 6) + 1024; sc0 = mods + 16 * 6144 + 4096; }
        float* ss = (float*)(ws + O_SS) + (WHICH + 1) * M_;
        const int b = u.pm >> 3, cl = wc * 64 + 8 * fq, row0 = u.pm * BM + wr * 64 + fr;
        f32x4 gt[2][2], gs0[2][2], gs1[2][2];
#pragma unroll
        for (int bj = 0; bj < 2; ++bj)
#pragma unroll
            for (int n = 0; n < 2; ++n) {
                const int col = u.pn * BM + bj * 32 + cl + 4 * n;
                gt[bj][n] = *(const f32x4*)(gate + b * 6144 + col);
                if (NOUT >= 1) gs0[bj][n] = *(const f32x4*)(g0 + col) * (*(const f32x4*)(sc0 + b * st0 + col) + 1.f);
                if (NOUT >= 2) gs1[bj][n] = *(const f32x4*)(g1 + col) * (*(const f32x4*)(sc1 + b * st1 + col) + 1.f);
            }
#pragma unroll
        for (int ai = 0; ai < 2; ++ai)
#pragma unroll
            for (int mp = 0; mp < 4; mp += MB) {
                f32x4 pre[MB][2][2];
#pragma unroll
                for (int m = 0; m < MB; ++m) {
                    const size_t o16 = (size_t)(row0 - fr + ai * HALF + (mp + m) * 16) * 1024 + u.pn * BM + wc * 64;
                    if (WHICH == 0) {
#pragma unroll
                        for (int bj = 0; bj < 2; ++bj) {
                            const float* p = hin + o16 + (size_t)(fr & 7) * 1024 + 32 * bj + 8 * fq + 4 * (fr >> 3);
                            const u32x4 x = *(const u32x4*)p, y = *(const u32x4*)(p + 8 * 1024); u32x4 a, b; unswap_rows128(fr, x, y, a, b);
                            pre[m][bj][0] = __builtin_bit_cast(f32x4, a); pre[m][bj][1] = __builtin_bit_cast(f32x4, b);
                        }
                    } else {
                        const bf16_t* p = h16 + ((o16 >> 14) * 32 + u.pn * 8 + 2 * wc) * 512 + fr * 32 + 8 * fq;
                        u32x4 hb[2]; hb[0] = (u32x4){0u, 0u, 0u, 0u}; hb[1] = hb[0]; if (!(VAR & 4)) { hb[0] = *(const u32x4*)p; hb[1] = *(const u32x4*)(p + 512); }
#pragma unroll
                        for (int bj = 0; bj < 2; ++bj) {
                            pre[m][bj][0] = (f32x4){__builtin_bit_cast(float, hb[bj].x << 16), __builtin_bit_cast(float, hb[bj].x & 0xffff0000u), __builtin_bit_cast(float, hb[bj].y << 16), __builtin_bit_cast(float, hb[bj].y & 0xffff0000u)};
                            pre[m][bj][1] = (f32x4){__builtin_bit_cast(float, hb[bj].z << 16), __builtin_bit_cast(float, hb[bj].z & 0xffff0000u), __builtin_bit_cast(float, hb[bj].w << 16), __builtin_bit_cast(float, hb[bj].w & 0xffff0000u)};
                        }
                    }
                }
#pragma unroll
                for (int m = 0; m < MB; ++m) {
                    const int row = row0 + ai * HALF + (mp + m) * 16;
                    float sq = 0.f;
                    u32x4 ph[2], p0[2], p1[2];
#pragma unroll
                    for (int bj = 0; bj < 2; ++bj) {
                        const size_t off = (size_t)row * 1024 + u.pn * BM + bj * 32 + cl;
                        const f32x4 h0 = pre[m][bj][0] + gt[bj][0] * acc[ai][bj][mp + m][0], h1 = pre[m][bj][1] + gt[bj][1] * acc[ai][bj][mp + m][1];
                        if (WHICH == 3) st_rows128_f32(hout + (size_t)(row - fr) * 1024 + u.pn * BM + wc * 64 + 32 * bj, 1024, fr, fq, h0, h1); else ph[bj] = pk8(h0, h1);
                        if (SSACC) sq += dot4(h0) + dot4(h1);
                        if (NOUT >= 1) p0[bj] = pk8(h0 * gs0[bj][0], h1 * gs0[bj][1]);
                        if (NOUT >= 2) p1[bj] = pk8(h0 * gs1[bj][0], h1 * gs1[bj][1]);
                    }
                    {
                        const size_t oT = ((size_t)((row - fr) >> 4) * 32 + u.pn * 8 + 2 * wc) * 512 + fr * 32 + 8 * fq;
                        if (WHICH != 3 && !(VAR & 1)) { *(u32x4*)(h16 + oT) = ph[0]; *(u32x4*)(h16 + oT + 512) = ph[1]; }
                        if (NOUT >= 1 && !(VAR & 2)) { *(u32x4*)(o0 + oT) = p0[0]; *(u32x4*)(o0 + oT + 512) = p0[1]; }
                        if (NOUT >= 2) { *(u32x4*)(o1 + oT) = p1[0]; *(u32x4*)(o1 + oT + 512) = p1[1]; }
                    }
                    if (SSACC) { sq = xsum_rows(sq); if ((VAR & 8) ? (sq == 1.2345e-30f) : (fq == 0)) atomicAdd(ss + row, sq); }
                }
                asm volatile("" ::: "memory");
            }
    }
};

template <int EV = 0> struct EpiFfnInT {
    static constexpr bool PERM = true, AFTER_DRAIN = false, SEG = false, PERMA = true, TILEDA = true;
    ptab_t tab; int l;
    __device__ __forceinline__ void prefetch(const Unit& u, int slot, PG8_LAS unsigned char* lds, int wid, int lane) const {
        unsigned char* ws = ldp(tab, T_WS); PG8_LAS unsigned char* base = lds + LDS_XTRA + slot * 6144; const int b = u.pm >> 3;
        if (wid < 4) dma4((const float*)(ws + O_SS) + (l == 0 ? 1 : 3) * M_ + u.pm * BM + 64 * wid + lane, base + 256 * wid);
        else dma4((const float*)(ws + O_SW3) + l * 16 * 5632 + b * 5632 + u.pn * BM + 64 * (wid - 4) + lane, base + 1024 + 256 * (wid - 4));
        const int v = wid >> 1, bj = wid & 1;
        const float* src = (v < 3 ? (const float*)ldp(tab, 18) + l * 3 * 5632 + v * 5632 : (const float*)ldp(tab, 19) + l * 5632) + bj * 2816 + u.pn * HALF + lane;
        dma4(src, base + 2048 + v * 1024 + (128 * bj) * 4); dma4(src + 64, base + 2048 + v * 1024 + (128 * bj + 64) * 4);
    }
    __device__ __forceinline__ void operator()(f32x4 (&acc)[2][2][4][2], const Unit& u, int wr, int wc, int slot, int) const {
        int lane_ = threadIdx.x & 63; asm volatile("" : "+v"(lane_)); const int fr = lane_ & 15, fq = lane_ >> 4;
        unsigned char* ws = ldp(tab, T_WS);
        const PG8_LAS unsigned char* tb = (const PG8_LAS unsigned char*)tab - 64 - LDS_MISC + LDS_XTRA + slot * 6144;
        const PG8_LAS float* ss = (const PG8_LAS float*)tb - u.pm * BM;
        const PG8_LAS float* sW = (const PG8_LAS float*)(tb + 1024) - ((u.pm >> 3) * 5632 + u.pn * BM);
        const PG8_LAS float* tcw = (const PG8_LAS float*)(tb + 2048);
        bf16_t* ACT = (bf16_t*)(ws + O_ACT); bf16_t* HF = (bf16_t*)(ws + O_HF); bf16_t* HL = (bf16_t*)(ws + O_HL);
        const int b = u.pm >> 3, cl = wc * 32 + 8 * fq, row0 = u.pm * BM + wr * 128 + fr, ch = u.pn * HALF + cl;
        {
            f32x4 sw[2][2];
#pragma unroll
            for (int bj = 0; bj < 2; ++bj)
#pragma unroll
                for (int n = 0; n < 2; ++n) sw[bj][n] = *(const f32x4*)(sW + b * 5632 + u.pn * BM + bj * HALF + cl + 4 * n);
#pragma unroll
            for (int ai = 0; ai < 2; ++ai)
#pragma unroll
                for (int m = 0; m < 4; ++m) {
                    const float rs = __builtin_amdgcn_rsqf(ss[row0 + ai * 64 + m * 16] * (1.f / 1024.f) + EPS);
#pragma unroll
                    for (int bj = 0; bj < 2; ++bj)
#pragma unroll
                        for (int n = 0; n < 2; ++n) acc[ai][bj][m][n] = acc[ai][bj][m][n] * rs + sw[bj][n];
                }
        }
        {
            const int b128 = u.pm * 2 + wr;
            if (fr < 2) {
                bf16_t* d = HF + (size_t)(b128 * 2 + fr) * 5632 + u.pn * BM + cl;
#pragma unroll
                for (int bj = 0; bj < 2; ++bj) *(u32x4*)(d + bj * HALF) = pk8(acc[0][bj][0][0], acc[0][bj][0][1]);
            }
            if (fr >= 14) {
                bf16_t* d = HL + (size_t)(b128 * 2 + fr - 14) * 5632 + u.pn * BM + cl;
#pragma unroll
                for (int bj = 0; bj < 2; ++bj) *(u32x4*)(d + bj * HALF) = pk8(acc[1][bj][3][0], acc[1][bj][3][1]);
            }
        }
#pragma unroll
        for (int bj = 0; bj < 2; ++bj)
#pragma unroll
            for (int n = 0; n < 2; ++n) {
                const int tcol = bj * HALF + cl + 4 * n;
                f32x4 w0 = *(const PG8_LAS f32x4*)(tcw + tcol), w1 = *(const PG8_LAS f32x4*)(tcw + 256 + tcol), w2 = *(const PG8_LAS f32x4*)(tcw + 512 + tcol), bb = *(const PG8_LAS f32x4*)(tcw + 768 + tcol);
                asm volatile("" : "+v"(w0), "+v"(w1), "+v"(w2), "+v"(bb));
#pragma unroll
                for (int ai = 1; ai >= 0; --ai)
#pragma unroll
                    for (int m = 3; m >= 0; --m) {
                        const f32x4 x = acc[ai][bj][m][n];
                        float y0 = bb[0] + w2[0] * x[0], y1 = bb[1] + w2[1] * x[1], y2 = bb[2] + w2[2] * x[2], y3 = bb[3] + w2[3] * x[3];
#define CONV_DPP8(SRC, C1, C0) asm volatile("s_nop 1\n\t" \
                            "v_fmac_f32_dpp %0, %4, %8 " C1 " row_mask:0xf bank_mask:0xf\n\tv_fmac_f32_dpp %1, %5, %9 " C1 " row_mask:0xf bank_mask:0xf\n\t" \
                            "v_fmac_f32_dpp %2, %6, %10 " C1 " row_mask:0xf bank_mask:0xf\n\tv_fmac_f32_dpp %3, %7, %11 " C1 " row_mask:0xf bank_mask:0xf\n\t" \
                            "v_fmac_f32_dpp %0, %4, %12 " C0 " row_mask:0xf bank_mask:0xf\n\tv_fmac_f32_dpp %1, %5, %13 " C0 " row_mask:0xf bank_mask:0xf\n\t" \
                            "v_fmac_f32_dpp %2, %6, %14 " C0 " row_mask:0xf bank_mask:0xf\n\tv_fmac_f32_dpp %3, %7, %15 " C0 " row_mask:0xf bank_mask:0xf" \
                            : "+v"(y0), "+v"(y1), "+v"(y2), "+v"(y3) : "v"(SRC[0]), "v"(SRC[1]), "v"(SRC[2]), "v"(SRC[3]), "v"(w1[0]), "v"(w1[1]), "v"(w1[2]), "v"(w1[3]), "v"(w0[0]), "v"(w0[1]), "v"(w0[2]), "v"(w0[3]))
                        CONV_DPP8(x, "row_shr:1", "row_shr:2");
                        if (m > 0) { const f32x4 xp = acc[ai][bj][m - 1][n]; CONV_DPP8(xp, "row_shl:15", "row_shl:14"); }
                        else if (ai == 1) { const f32x4 xp = acc[0][bj][3][n]; CONV_DPP8(xp, "row_shl:15", "row_shl:14"); }
#undef CONV_DPP8
                        f32x4 y; y[0] = y0; y[1] = y1; y[2] = y2; y[3] = y3;
                        acc[ai][bj][m][n] = y;
                    }
            }
#pragma unroll
        for (int ai = 0; ai < 2; ++ai)
#pragma unroll
            for (int m = 0; m < 4; ++m) {
                const int row = row0 + ai * 64 + m * 16;
                const f32x4 v0 = (EV & 2) ? acc[ai][0][m][0] * acc[ai][1][m][0] : acc[ai][0][m][0] * silu4(acc[ai][1][m][0]), v1 = (EV & 2) ? acc[ai][0][m][1] * acc[ai][1][m][1] : acc[ai][0][m][1] * silu4(acc[ai][1][m][1]);
                if ((EV & 1) ? (v0[0] == 1.2345e-30f) : (ai == 1 || m > 0 || fr >= 2)) *(u32x4*)(ACT + ((size_t)(row >> 4) * 88 + (ch >> 5)) * 512 + fr * 32 + (ch & 31)) = pk8(v0, v1);
            }
    }
};
typedef EpiFfnInT<0> EpiFfnIn;


template <int MODE> struct EpiKVQ {
    static constexpr bool PERM = true, AFTER_DRAIN = false, SEG = false, PERMA = false, TILEDA = true;
    ptab_t tab;
    static constexpr int nW = (MODE == 0) ? 2048 : 1024;
    __device__ __forceinline__ void prefetch(const Unit& u, int slot, PG8_LAS unsigned char* lds, int wid, int lane) const {
        unsigned char* ws = ldp(tab, T_WS); PG8_LAS unsigned char* base = lds + LDS_XTRA + 18432 + slot * 2048; const int b = u.pm >> 3;
        if (wid < 4) dma4((const float*)(ws + O_SS) + 2 * M_ + u.pm * BM + 64 * wid + lane, base + 256 * wid);
        else dma4((const float*)(ws + (MODE == 0 ? O_SW5 : O_SW6)) + b * nW + u.pn * BM + 64 * (wid - 4) + lane, base + 1024 + 256 * (wid - 4));
    }
    __device__ __forceinline__ void operator()(f32x4 (&acc)[2][2][4][2], const Unit& u, int wr, int wc, int slot, int) const {
        int lane_ = threadIdx.x & 63; asm volatile("" : "+v"(lane_)); const int fr = lane_ & 15, fq = lane_ >> 4;
        unsigned char* ws = ldp(tab, T_WS);
        const PG8_LAS unsigned char* tb = (const PG8_LAS unsigned char*)tab - 64 - LDS_MISC + LDS_XTRA + 18432 + slot * 2048;
        const PG8_LAS float* ss = (const PG8_LAS float*)tb - u.pm * BM;
        const PG8_LAS float* sW = (const PG8_LAS float*)(tb + 1024) - ((u.pm >> 3) * nW + u.pn * BM);
        const float* gain = (const float*)ldp(tab, MODE == 0 ? 13 : 15); bf16_t* DN = (bf16_t*)(ws + (MODE == 0 ? O_KN : O_QN)); bf16_t* VT = (bf16_t*)(ws + O_VT);
        const int b = u.pm >> 3, row0 = u.pm * BM + wr * 64 + fr, head = 4 * (u.pn & 3) + wc, dl = 8 * fq;
        f32x4 sw[2][2];
#pragma unroll
        for (int bj = 0; bj < 2; ++bj)
#pragma unroll
            for (int n = 0; n < 2; ++n) sw[bj][n] = *(const f32x4*)(sW + b * nW + u.pn * BM + bj * HALF + wc * 32 + dl + 4 * n);
        const bool isv = (MODE == 0) && (u.pn >= 4);
        if (!isv) {
            f32x4 gn[2][2];
#pragma unroll
            for (int bj = 0; bj < 2; ++bj)
#pragma unroll
                for (int n = 0; n < 2; ++n) gn[bj][n] = *(const f32x4*)(gain + 32 * bj + dl + 4 * n) * (MODE == 1 ? 0.125f * 1.44269504089f : 1.f);
#pragma unroll
            for (int ai = 0; ai < 2; ++ai)
#pragma unroll
                for (int m = 0; m < 4; ++m) {
                    const int row = row0 + ai * HALF + m * 16;
                    const float rs = __builtin_amdgcn_rsqf(ss[row] * (1.f / 1024.f) + EPS);
                    f32x4 v[2][2]; float sq = 0.f;
#pragma unroll
                    for (int bj = 0; bj < 2; ++bj)
#pragma unroll
                        for (int n = 0; n < 2; ++n) { v[bj][n] = acc[ai][bj][m][n] * rs + sw[bj][n]; sq += dot4(v[bj][n]); }
                    sq = xsum_rows(sq);
                    const float rh = __builtin_amdgcn_rsqf(sq * (1.f / 64.f) + EPS);
#pragma unroll
                    for (int bj = 0; bj < 2; ++bj) *(u32x4*)(DN + (((size_t)(b * 16 + head) * 64 + ((row & 2047) >> 5)) * 4 + 2 * bj + (fq >> 1)) * 512 + ((fq & 1) * 32 + (row & 31)) * 8) = pk8(v[bj][0] * gn[bj][0] * rh, v[bj][1] * gn[bj][1] * rh);
                }
        } else {
            const int wv = wr * 4 + wc;
            PG8_LAS unsigned char* scr = (PG8_LAS unsigned char*)tab - 64 - LDS_MISC + LDS_XTRA + wv * 2304;
            PG8_LAS unsigned char* wrp = scr + fr * 144 + fq * 16;
            const int ln = fq * 16 + fr;
            const PG8_LAS unsigned char* rdp = scr + ((ln & 15) >> 2) * 144 + (16 * (ln >> 4) + 4 * (ln & 3)) * 2;
            bf16_t* vbase = VT + (size_t)(b * 16 + head) * 64 * 2048;
            typedef short v4i16_t __attribute__((ext_vector_type(4)));
#pragma unroll
            for (int ai = 0; ai < 2; ++ai)
#pragma unroll
                for (int m = 0; m < 4; ++m) {
                    const int row = row0 + ai * HALF + m * 16, s0 = (row - fr) & 2047;
                    const float rs = __builtin_amdgcn_rsqf(ss[row] * (1.f / 1024.f) + EPS);
#pragma unroll
                    for (int bj = 0; bj < 2; ++bj) *(PG8_LAS u32x4*)(wrp + bj * 64) = pk8(acc[ai][bj][m][0] * rs + sw[bj][0], acc[ai][bj][m][1] * rs + sw[bj][1]);
                    asm volatile("s_waitcnt lgkmcnt(0)" ::: "memory");
                    bf16_t* fbase = vbase + (size_t)((((s0 >> 5) * 2 + (ln >> 5)) * 2 + ((s0 >> 4) & 1)) * 64 + (ln & 31)) * 8;
#pragma unroll
                    for (int hq = 0; hq < 2; ++hq) {
                        const v4i16_t lo = __builtin_amdgcn_ds_read_tr16_b64_v4i16((PG8_LAS v4i16_t*)(rdp + (4 * hq) * 144)), hi = __builtin_amdgcn_ds_read_tr16_b64_v4i16((PG8_LAS v4i16_t*)(rdp + (4 * hq + 8) * 144));
                        const bf16x8 o = (bf16x8){lo[0], lo[1], lo[2], lo[3], hi[0], hi[1], hi[2], hi[3]};
                        *(bf16x8*)(fbase + hq * 32 * 8) = o;
                    }
                    asm volatile("s_waitcnt lgkmcnt(0)" ::: "memory");
                }
        }
    }
};
template <class Epi, class Sched, bool ALIGN_EPI = false, bool SP2 = false>
__device__ __forceinline__ void gemm_phase(PG8_LAS unsigned char* lds, const Gemm g, const Sched& S, const Epi& E) {
    int tid_ = threadIdx.x; asm volatile("" : "+v"(tid_));
    const int tid = tid_, wid = __builtin_amdgcn_readfirstlane(tid >> 6), lane = tid & 63, wr = wid >> 2, wc = wid & 3, fr = lane & 15, fq = lane >> 4;
    const int K = g.ld, nt = g.K / BK;
    unsigned voffA[2], voffB[2];
#pragma unroll
    for (int i = 0; i < 2; ++i) { int R, C; stage_rc(tid * 16 + i * 8192, R, C); const int Rb = Epi::PERM ? ((R & ~31) + perm32(R & 31)) : R;
        const int Ra = Epi::PERMA ? (128 * (R >> 6) + (R & 63)) : R;
        voffA[i] = Epi::TILEDA ? (unsigned)(((Ra >> 4) * (K >> 5) + (C >> 5)) * 1024 + (Ra & 15) * 64 + (C & 31) * 2) : (unsigned)(Ra * K + C) * 2u; voffB[i] = (unsigned)(((Rb >> 4) * (K >> 5) + (C >> 5)) * 1024 + (Rb & 15) * 64 + (C & 31) * 2); }
    const size_t kstep = (size_t)(BK * 2);
    const size_t hstep = (size_t)HALF * K * 2;
    const size_t kstepB = 2048;
    const size_t kstepA = Epi::TILEDA ? (size_t)2048 : kstep;
    const size_t hstepA = Epi::PERMA ? hstep / 2 : hstep;
    const size_t tstep = 2 * hstep;
    const unsigned ldsw = (unsigned)wid * 1024u;
    const int aoff = lds_byte(wr * 64 + fr, fq * 8), boff = lds_byte(wc * 32 + fr, fq * 8);
#define PG8_SA(b, h) (((b) * 2 + (h)) * HTB)
#define PG8_SB(b, h) ((4 + (b) * 2 + (h)) * HTB)
#define PG8_STAGE(bufoff, gbase, voff) do { _Pragma("unroll") for (int _i = 0; _i < 2; ++_i) \
        __builtin_amdgcn_global_load_lds((const unsigned*)((const char*)(gbase) + (voff)[_i]), (PG8_LAS unsigned*)(lds + (bufoff) + ldsw + _i * 8192), 16, 0, 0); } while (0)
#define PG8_LDA(dst, b, h) do { _Pragma("unroll") for (int m = 0; m < 4; ++m) _Pragma("unroll") for (int k = 0; k < 2; ++k) dst[m][k] = *(const PG8_LAS bf16x8*)(lds + PG8_SA(b, h) + aoff + m * 2048 + k * 1024); } while (0)
#define PG8_LDB(dst, b, h) do { _Pragma("unroll") for (int n = 0; n < 2; ++n) _Pragma("unroll") for (int k = 0; k < 2; ++k) dst[n][k] = *(const PG8_LAS bf16x8*)(lds + PG8_SB(b, h) + boff + n * 2048 + k * 1024); } while (0)
#define PG8_MMA(ai, bj, At, Bt) do { __builtin_amdgcn_s_setprio(1); _Pragma("unroll") for (int m = 0; m < 4; ++m) _Pragma("unroll") for (int n = 0; n < 2; ++n) _Pragma("unroll") for (int k = 0; k < 2; ++k) \
        acc[ai][bj][m][n] = __builtin_amdgcn_mfma_f32_16x16x32_bf16(Bt[n][k], At[m][k], acc[ai][bj][m][n], 0, 0, 0); __builtin_amdgcn_s_setprio(0); } while (0)
#define PG8_WAIT_V(n) asm volatile("s_waitcnt vmcnt(" #n ")" ::: "memory")
#define PG8_WAIT_L(n) asm volatile("s_waitcnt lgkmcnt(" #n ")" ::: "memory")
#define PG8_BAR __builtin_amdgcn_s_barrier()
#define PG8_SCHED __builtin_amdgcn_sched_barrier(0)
    Unit cur, nxt; int ui = 0;
    if (!S.next(0, cur)) return;
    f32x4 acc[2][2][4][2];
#pragma unroll
    for (int a = 0; a < 2; ++a)
#pragma unroll
        for (int b = 0; b < 2; ++b)
#pragma unroll
            for (int m = 0; m < 4; ++m)
#pragma unroll
                for (int n = 0; n < 2; ++n) acc[a][b][m][n] = (f32x4){0.f, 0.f, 0.f, 0.f};
    bf16x8 At[4][2], B0[2][2], B1[2][2];
    const size_t sstep = (size_t)g.K * 2, sstepB = (size_t)(g.K >> 5) * 1024;
    const char* cA = (const char*)g.A + (size_t)cur.pm * tstep + cur.kk * sstep; const char* cB = (const char*)g.Bt + (size_t)cur.pn * tstep + cur.kk * sstepB;
    S.a_ready(cur);
    E.prefetch(cur, 0, lds, wid, lane);
    if constexpr (SP2) {
        PG8_STAGE(PG8_SB(0, 0), cB, voffB); PG8_STAGE(PG8_SB(0, 1), cB + hstep, voffB); PG8_STAGE(PG8_SA(0, 0), cA, voffA); PG8_STAGE(PG8_SA(0, 1), cA + hstepA, voffA);
        if (wr == 1) PG8_BAR;
        PG8_WAIT_V(2); PG8_BAR;
        PG8_STAGE(PG8_SB(1, 0), cB + kstepB, voffB); PG8_STAGE(PG8_SA(1, 0), cA + kstepA, voffA); PG8_STAGE(PG8_SB(1, 1), cB + hstep + kstepB, voffB);
        PG8_WAIT_V(6); PG8_BAR;
    } else {
        PG8_STAGE(PG8_SB(0, 0), cB, voffB); PG8_STAGE(PG8_SA(0, 0), cA, voffA); PG8_STAGE(PG8_SB(0, 1), cB + hstep, voffB); PG8_STAGE(PG8_SA(0, 1), cA + hstepA, voffA);
        if (wr == 1) PG8_BAR;
        PG8_WAIT_V(4); PG8_BAR;
        PG8_STAGE(PG8_SB(1, 0), cB + kstepB, voffB); PG8_STAGE(PG8_SA(1, 0), cA + kstepA, voffA); PG8_STAGE(PG8_SB(1, 1), cB + hstep + kstepB, voffB);
        PG8_WAIT_V(6); PG8_BAR;
    }
    for (;;) {
        const bool has_next = S.next(ui + 1, nxt);
        const char* nA = has_next ? (const char*)g.A + (size_t)nxt.pm * tstep + nxt.kk * sstep : cA; const char* nB = has_next ? (const char*)g.Bt + (size_t)nxt.pn * tstep + nxt.kk * sstepB : cB;
        for (int t = 0; t < nt; t += 2) {
            const bool last = (t == nt - 2);
            const char* a1 = cA + (size_t)(t + 1) * kstepA;
            const char* a2 = last ? nA : cA + (size_t)(t + 2) * kstepA; const char* b2 = last ? nB : cB + (size_t)(t + 2) * kstepB;
            const char* a3 = a2 + kstepA; const char* b3 = b2 + kstepB;
            if (last && has_next) { S.a_ready(nxt); E.prefetch(nxt, (ui + 1) & 1, lds, wid, lane); }
            if constexpr (SP2) {
            PG8_LDB(B0, 0, 0); PG8_LDB(B1, 0, 1); PG8_SCHED; PG8_LDA(At, 0, 0); PG8_STAGE(PG8_SA(1, 1), a1 + hstepA, voffA);
            PG8_WAIT_V(8); PG8_WAIT_L(0); PG8_BAR; PG8_MMA(0, 0, At, B0); PG8_MMA(0, 1, At, B1); PG8_BAR; PG8_SCHED;
            PG8_LDA(At, 0, 1); PG8_STAGE(PG8_SB(0, 0), b2, voffB); PG8_STAGE(PG8_SB(0, 1), b2 + hstep, voffB); PG8_STAGE(PG8_SA(0, 0), a2, voffA);
            PG8_WAIT_V(8); PG8_WAIT_L(0); PG8_BAR; PG8_MMA(1, 0, At, B0); PG8_MMA(1, 1, At, B1); PG8_BAR; PG8_SCHED;
            PG8_LDB(B0, 1, 0); PG8_LDB(B1, 1, 1); PG8_SCHED; PG8_LDA(At, 1, 0); PG8_STAGE(PG8_SA(0, 1), a2 + hstepA, voffA);
            PG8_WAIT_V(8); PG8_WAIT_L(0); PG8_BAR; PG8_MMA(0, 0, At, B0); PG8_MMA(0, 1, At, B1); PG8_BAR; PG8_SCHED;
            PG8_LDA(At, 1, 1); PG8_STAGE(PG8_SB(1, 0), b3, voffB); PG8_STAGE(PG8_SB(1, 1), b3 + hstep, voffB); PG8_STAGE(PG8_SA(1, 0), a3, voffA);
            PG8_WAIT_V(8); PG8_WAIT_L(0); PG8_BAR; PG8_MMA(1, 0, At, B0); PG8_MMA(1, 1, At, B1); PG8_BAR; PG8_SCHED;
            } else {
            PG8_LDB(B0, 0, 0); PG8_SCHED; PG8_LDA(At, 0, 0); PG8_STAGE(PG8_SA(1, 1), a1 + hstepA, voffA);
            PG8_WAIT_L(8); PG8_BAR; PG8_WAIT_L(0); PG8_MMA(0, 0, At, B0); PG8_BAR; PG8_SCHED;
            PG8_LDB(B1, 0, 1); PG8_STAGE(PG8_SB(0, 0), b2, voffB);
            PG8_BAR; PG8_WAIT_L(0); PG8_MMA(0, 1, At, B1); PG8_BAR;
            PG8_LDA(At, 0, 1); PG8_STAGE(PG8_SA(0, 0), a2, voffA);
            PG8_BAR; PG8_WAIT_L(0); PG8_MMA(1, 0, At, B0); PG8_BAR; PG8_SCHED;
            PG8_STAGE(PG8_SB(0, 1), b2 + hstep, voffB);
            PG8_WAIT_V(6); PG8_BAR; PG8_MMA(1, 1, At, B1); PG8_BAR;
            PG8_LDB(B0, 1, 0); PG8_SCHED; PG8_LDA(At, 1, 0); PG8_STAGE(PG8_SA(0, 1), a2 + hstepA, voffA);
            PG8_WAIT_L(8); PG8_BAR; PG8_WAIT_L(0); PG8_MMA(0, 0, At, B0); PG8_BAR; PG8_SCHED;
            PG8_LDB(B1, 1, 1); PG8_STAGE(PG8_SB(1, 0), b3, voffB);
            PG8_BAR; PG8_WAIT_L(0); PG8_MMA(0, 1, At, B1); PG8_BAR;
            PG8_LDA(At, 1, 1); PG8_STAGE(PG8_SA(1, 0), a3, voffA);
            PG8_BAR; PG8_WAIT_L(0); PG8_MMA(1, 0, At, B0); PG8_BAR; PG8_SCHED;
            PG8_STAGE(PG8_SB(1, 1), b3 + hstep, voffB);
            PG8_WAIT_V(6); PG8_BAR; PG8_MMA(1, 1, At, B1); PG8_BAR;
            }
        }
        if constexpr (ALIGN_EPI) { if (wr == 0) PG8_BAR; }
        if constexpr (Epi::SEG) E.seg(acc, cur.kk, ui >> 2, wr);
        if (!Epi::SEG || cur.kk == 3) {
            if constexpr (!Epi::AFTER_DRAIN) { E(acc, cur, wr, wc, ui & 1, fq); S.done(cur); }
            if (!has_next) break;
#pragma unroll
            for (int a = 0; a < 2; ++a)
#pragma unroll
                for (int b = 0; b < 2; ++b)
#pragma unroll
                    for (int m = 0; m < 4; ++m)
#pragma unroll
                        for (int n = 0; n < 2; ++n) acc[a][b][m][n] = (f32x4){0.f, 0.f, 0.f, 0.f};
        }
        cur = nxt; cA = nA; cB = nB; ++ui;
        if constexpr (ALIGN_EPI) { if (wr == 1) PG8_BAR; }
    }
    PG8_WAIT_V(0);
    if constexpr (!ALIGN_EPI) { if (wr == 0) PG8_BAR; }
    PG8_BAR;
    if constexpr (Epi::AFTER_DRAIN) { E.fused(acc, cur, wr, wc, fr, fq, lds, wid, lane); S.done(cur); }
#undef PG8_SA
#undef PG8_SB
#undef PG8_STAGE
#undef PG8_LDA
#undef PG8_LDB
#undef PG8_MMA
#undef PG8_WAIT_V
#undef PG8_WAIT_L
#undef PG8_BAR
#undef PG8_SCHED
}
}

#define LAS __attribute__((address_space(3)))
typedef unsigned short bf16;
typedef float f32x4 __attribute__((ext_vector_type(4)));
typedef float f32x16 __attribute__((ext_vector_type(16)));
typedef short bf16x8 __attribute__((ext_vector_type(8)));
typedef short s16x4 __attribute__((ext_vector_type(4)));
typedef unsigned u32x4 __attribute__((ext_vector_type(4)));
typedef unsigned u32x2 __attribute__((ext_vector_type(2)));
using pg8::pk_bf16; using pg8::EPS;

#ifndef REP_PHASE
#ifndef PROBE_X
#define PROBE_X -1
#endif
#ifndef PROBE_GAIN
#define PROBE_GAIN 1
#endif
#define REP_PHASE -1
#endif
#define REPS(k) ((REP_PHASE == (k)) ? 2 : 1)
#ifndef PROBE_TS
#define PROBE_TS -1
#endif
#ifndef RET_V2
#define RET_V2 1
#endif
#if RET_V2
#define RET_UNIT ret_unit2
#else
#define RET_UNIT ret_unit
#endif
#ifndef MK_ONE_LAUNCH
#define MK_ONE_LAUNCH 1
#endif
constexpr int NWAVES = 8, NTHREADS = 512;
constexpr int NB = 16, SEQ = 2048, D = 1024, M = NB * SEQ, FF = 2816, FF2 = 5632, RN = 6144;
constexpr int NPHASE = 14;

constexpr size_t MiB = 1u << 20;
constexpr size_t WS_CTL = 0;
constexpr size_t WS_MODS = pg8::O_MODS, WS_KVM = pg8::O_KVM, WS_SW1 = pg8::O_SW1, WS_SW3 = pg8::O_SW3, WS_SW5 = pg8::O_SW5, WS_SW6 = pg8::O_SW6, WS_SS = pg8::O_SS, WS_SSO = pg8::O_SSO;
static_assert(pg8::O_SMALL_END <= 6 * MiB && pg8::M_ == M, "small region");
constexpr size_t WS_WT1 = 6 * MiB;
constexpr size_t WS_WT2 = WS_WT1 + (size_t)6144 * 1024 * 2;
constexpr size_t WS_WT3 = WS_WT2 + (size_t)1024 * 2048 * 2;
constexpr size_t WS_WT4 = WS_WT3 + (size_t)2 * 5632 * 1024 * 2;
constexpr size_t WS_WT5 = WS_WT4 + (size_t)2 * 1024 * 2816 * 2;
constexpr size_t WS_WT6 = WS_WT5 + (size_t)2048 * 1024 * 2;
constexpr size_t WS_WT7 = WS_WT6 + (size_t)1024 * 1024 * 2;
static_assert(WS_WT7 + (size_t)1024 * 1024 * 2 <= 64 * MiB, "weights region");
constexpr size_t WS_A = pg8::O_A, WS_Q = pg8::O_Q, WS_KD = pg8::O_KD, WS_V = pg8::O_V, WS_SG = pg8::O_SG, WS_ACT = pg8::O_ACT, WS_HF = pg8::O_HF, WS_HL = pg8::O_HL, WS_AM1 = pg8::O_AM1,
                 WS_KN = pg8::O_KN, WS_VT = pg8::O_VT, WS_QN = pg8::O_QN, WS_OSB = pg8::O_OSB;
constexpr size_t WS_END = 512 * MiB;
static_assert((size_t)512 * 2 * 5632 * 4 <= 22 * MiB && WS_HL + 22 * MiB <= WS_AM1 && WS_AM1 + 64 * MiB <= WS_END && WS_OSB + 64 * MiB <= WS_END && WS_ACT + (size_t)M * FF * 2 <= WS_HF && pg8::O_H16 + 64 * MiB <= WS_ACT && WS_QN + 64 * MiB <= WS_OSB, "big region");

constexpr int LDS_BYTES = pg8::LDS_TOTAL;
constexpr int MISC_OFF = LDS_BYTES - 512;
using pg8::ptab_t; using pg8::ldp; using pg8::T_OUT; using pg8::T_WS;

#define LBAR() do { asm volatile("s_waitcnt lgkmcnt(0)" ::: "memory"); __builtin_amdgcn_s_barrier(); asm volatile("" ::: "memory"); } while (0)

#define XB_TMO      128
#define XB_XCNT(j)  (256  + 64 * (j))
#define XB_XSUB(j)  (1280 + 64 * (j))
#define XB_XGEN(j)  (2304 + 64 * (j))
#define XB_TOP      3328
#define XB_TOPGEN   3392
#define XCD_BAR_WORDS 3456
#define XB_SPIN_CAP (1u << 20)
__device__ __forceinline__ unsigned xb_ld(unsigned* p)              { return __hip_atomic_load(p, __ATOMIC_RELAXED, __HIP_MEMORY_SCOPE_AGENT); }
__device__ __forceinline__ unsigned xb_add(unsigned* p, unsigned v) { return __hip_atomic_fetch_add(p, v, __ATOMIC_RELAXED, __HIP_MEMORY_SCOPE_AGENT); }
__device__ __forceinline__ unsigned xb_xcc_id() { return (unsigned)__builtin_amdgcn_s_getreg((3 << 11) | 20) & 0xFu; }
#define XB_SPIN(cond, bar) do { unsigned _sp = 0; while (cond) { __builtin_amdgcn_s_sleep(1); \
    if ((++_sp & 255u) == 0u) { if (xb_ld(&(bar)[XB_TMO])) break; if (_sp > XB_SPIN_CAP) { atomicAdd(&(bar)[XB_TMO], 1u); break; } } } } while (0)
struct XcdBarrier { unsigned* bar; unsigned x; volatile LAS unsigned* st; };
__device__ __forceinline__ XcdBarrier xcd_barrier_post(unsigned* bar, volatile LAS unsigned* st) {
    XcdBarrier b; b.bar = bar; b.x = xb_xcc_id(); b.st = st;
    if (threadIdx.x == 0) (void)xb_add(&bar[XB_XCNT(b.x)], 1u);
    return b;
}
__device__ __forceinline__ void xcd_barrier_complete(unsigned* bar, unsigned x, unsigned& nloc, unsigned& nx) {
    const unsigned G = gridDim.x * gridDim.y * gridDim.z;
    unsigned sum, cnt, mine, sp = 0u;
    for (;;) {
        sum = 0u; cnt = 0u; mine = 0u;
#pragma unroll
        for (unsigned j = 0; j < 16; ++j) { const unsigned c = xb_ld(&bar[XB_XCNT(j)]); sum += c; cnt += (c > 0u) ? 1u : 0u; mine = (j == x) ? c : mine; }
        if (sum == G) break;
        __builtin_amdgcn_s_sleep(1);
        if ((++sp & 255u) == 0u) { if (xb_ld(&bar[XB_TMO])) break; if (sp > XB_SPIN_CAP) { atomicAdd(&bar[XB_TMO], 1u); break; } }
    }
    nloc = mine > 0u ? mine : 1u; nx = cnt > 0u ? cnt : 1u;
}
__device__ __forceinline__ void xcd_barrier(const XcdBarrier& b) {
    asm volatile("s_waitcnt vmcnt(0)" ::: "memory");
    __syncthreads();
    if (threadIdx.x == 0) {
        unsigned* bar = b.bar;
        __builtin_amdgcn_s_waitcnt(0);
        unsigned nloc = b.st[0], nx = b.st[1];
        if (nloc == 0u) { xcd_barrier_complete(bar, b.x, nloc, nx); b.st[0] = nloc; b.st[1] = nx; }
        const unsigned old = xb_add(&bar[XB_XSUB(b.x)], 1u);
        const unsigned gen = old / nloc;
        if (old + 1u == (gen + 1u) * nloc) {
            __builtin_amdgcn_fence(__ATOMIC_RELEASE, "agent");
            asm volatile("s_waitcnt vmcnt(0)" ::: "memory");
            const unsigned og = xb_add(&bar[XB_TOP], 1u);
            const unsigned tg = og / nx;
            if (og + 1u == (tg + 1u) * nx) xb_add(&bar[XB_TOPGEN], 1u);
            else XB_SPIN(xb_ld(&bar[XB_TOPGEN]) == tg, bar);
            __builtin_amdgcn_fence(__ATOMIC_ACQUIRE, "agent");
            xb_add(&bar[XB_XGEN(b.x)], 1u);
            asm volatile("s_waitcnt vmcnt(0)" ::: "memory");
        } else {
            XB_SPIN(xb_ld(&bar[XB_XGEN(b.x)]) == gen, bar);
            __builtin_amdgcn_fence(__ATOMIC_ACQUIRE, "agent");
            asm volatile("s_waitcnt vmcnt(0)" ::: "memory");
        }
    }
    __syncthreads();
}

__device__ __forceinline__ float wave_sum(float v) {
#pragma unroll
    for (int o = 1; o < 64; o <<= 1) v += __shfl_xor(v, o);
    return v;
}
__device__ __forceinline__ float bf2f(unsigned short u) { return __builtin_bit_cast(float, (unsigned)u << 16); }

struct Args { const void* in[21]; float* out; unsigned char* ws; int ph_lo, ph_hi; };

__device__ __forceinline__ void p0_transpose_item(const float* W, int K, int N, bf16* WT, int k0, int sc0, int sc1, int nd0, LAS float* scr, int lane) {
    const int r4 = lane >> 4, c4 = lane & 15;
    const float* src = W + (size_t)(k0 + r4) * N + ((c4 < 8) ? sc0 + 4 * c4 : sc1 + 4 * (c4 - 8));
    f32x4 v[16];
#pragma unroll
    for (int i = 0; i < 16; ++i) v[i] = *(const f32x4*)(src + (size_t)(4 * i) * N);
#pragma unroll
    for (int i = 0; i < 16; ++i) { LAS float* d = scr + (4 * i + r4) * 65 + 4 * c4; d[0] = v[i][0]; d[1] = v[i][1]; d[2] = v[i][2]; d[3] = v[i][3]; }
    asm volatile("s_waitcnt lgkmcnt(0)" ::: "memory");
    const int c8 = lane & 7, n8 = lane >> 3;
#pragma unroll
    for (int j = 0; j < 8; ++j) { const int n = n8 + 8 * j; const LAS float* s = scr + (8 * c8) * 65 + n;
        u32x4 o; o.x = pk_bf16(s[0 * 65], s[1 * 65]); o.y = pk_bf16(s[2 * 65], s[3 * 65]); o.z = pk_bf16(s[4 * 65], s[5 * 65]); o.w = pk_bf16(s[6 * 65], s[7 * 65]);
        *(u32x4*)(WT + ((size_t)((nd0 >> 4) + (j >> 1)) * (K >> 5) + (k0 >> 5) + (c8 >> 2)) * 512 + (n8 + 8 * (j & 1)) * 32 + 8 * (c8 & 3)) = o; }
    asm volatile("s_waitcnt lgkmcnt(0)" ::: "memory");
}
__device__ __forceinline__ int src_col(int type, int nd0) {
    if (type == 0) return nd0;
    const int pn = nd0 >> 8, r = nd0 & 255, bj = r >> 7;
    if (type == 3) return 256 * pn + 64 * ((r & 127) >> 5) + 32 * bj;
    if (type == 1) return bj * FF + 128 * pn + (r & 127);
    const int wc = (r & 127) >> 5, head = 4 * (pn & 3) + wc;
    return (pn >= 4 ? 1024 : 0) + head * 64 + 32 * bj;
}
__device__ __forceinline__ void p0_phase(ptab_t tab, LAS unsigned char* lds, int vcu, int G) {
    const int tid = threadIdx.x, lane = tid & 63, w = __builtin_amdgcn_readfirstlane(tid >> 6);
    unsigned char* ws = ldp(tab, T_WS);
    { float* z = (float*)(ws + WS_SS) + M; const int n = 3 * M;
      for (int i = vcu * NTHREADS + tid; i < n / 4; i += G * NTHREADS) ((f32x4*)z)[i] = (f32x4){0.f, 0.f, 0.f, 0.f}; }
    if (vcu < 224) {
        LAS float* cact = (LAS float*)lds;
        LAS float* part = (LAS float*)(lds + 65536);
        const float* c = (const float*)ldp(tab, 1);
        {
            f32x4 cv[8];
#pragma unroll
            for (int j = 0; j < 8; ++j) cv[j] = *(const f32x4*)(c + 4 * (tid + NTHREADS * j));
#pragma unroll
            for (int j = 0; j < 8; ++j) *(LAS f32x4*)(cact + 4 * (tid + NTHREADS * j)) = pg8::silu4(cv[j]);
        }
        LBAR();
        const int col = vcu * 64;
        const float* W; int N, cw; const float* bias; float* dst; int dstride;
        if (col < 12288) { const int l = col / 6144; cw = col - l * 6144; W = (const float*)ldp(tab, 3) + (size_t)l * 1024 * 6144; N = 6144; bias = (const float*)ldp(tab, 4) + l * 6144; dst = (float*)(ws + WS_MODS) + (size_t)l * 16 * 6144; dstride = 6144; }
        else { cw = col - 12288; W = (const float*)ldp(tab, 9); N = 2048; bias = (const float*)ldp(tab, 10); dst = (float*)(ws + WS_KVM); dstride = 2048; }
        const int c4 = lane & 15, r4 = lane >> 4;
        f32x4 acc[16];
#pragma unroll
        for (int b = 0; b < 16; ++b) acc[b] = (f32x4){0.f, 0.f, 0.f, 0.f};
        const float* wp = W + (size_t)(128 * w + 32 * r4) * N + cw + 4 * c4;
        const LAS float* cp = cact + 128 * w + 32 * r4;
#pragma unroll 1
        for (int i0 = 0; i0 < 32; i0 += 16) {
            f32x4 wv[16];
#pragma unroll
            for (int i = 0; i < 16; ++i) wv[i] = *(const f32x4*)(wp + (size_t)(i0 + i) * N);
#pragma unroll
            for (int j = 0; j < 4; ++j) {
                asm volatile("" ::: "memory");
#pragma unroll
                for (int b = 0; b < 16; ++b) { const f32x4 cv = *(const LAS f32x4*)(cp + b * 1024 + i0 + 4 * j); acc[b] += (cv[0] * wv[4 * j] + cv[1] * wv[4 * j + 1]) + (cv[2] * wv[4 * j + 2] + cv[3] * wv[4 * j + 3]); }
            }
        }
#pragma unroll
        for (int b = 0; b < 16; ++b) {
#pragma unroll
            for (int e = 0; e < 4; ++e) { float v = acc[b][e]; v += __shfl_xor(v, 16); v += __shfl_xor(v, 32); acc[b][e] = v; }
            if (r4 == 0) *(LAS f32x4*)(part + (w * 16 + b) * 64 + 4 * c4) = acc[b];
        }
        LBAR();
        for (int o = tid; o < 1024; o += NTHREADS) { const int b = o >> 6, l = o & 63; float s = bias[cw + l];
#pragma unroll
            for (int ww = 0; ww < 8; ++ww) s += part[(ww * 16 + b) * 64 + l];
            dst[(size_t)b * dstride + cw + l] = s; }
        LBAR();
    }
    {
        LAS float* scr = (LAS float*)(lds + w * 16640);
        constexpr int I0 = 16 * 96, I1 = 32 * 16, I2 = 16 * 88, I4 = 44 * 16, I6 = 16 * 32, I7 = 16 * 16;
        constexpr int NIT = I0 + I1 + 2 * I2 + 2 * I4 + I6 + 2 * I7;
        const int gw = vcu * NWAVES + w, NGW = G * NWAVES;
        for (int it = gw; it < NIT; it += NGW) {
            int r = it; const float* W; int K, N, type; bf16* WT;
            if (r < I0) { W = (const float*)ldp(tab, 7); K = 1024; N = 6144; type = 0; WT = (bf16*)(ws + WS_WT1); }
            else if ((r -= I0) < I1) { W = (const float*)ldp(tab, 8); K = 2048; N = 1024; type = 3; WT = (bf16*)(ws + WS_WT2); }
            else if ((r -= I1) < 2 * I2) { const int l = r / I2; r -= l * I2; W = (const float*)ldp(tab, 17) + (size_t)l * 1024 * FF2; K = 1024; N = FF2; type = 1; WT = (bf16*)(ws + WS_WT3) + (size_t)l * FF2 * 1024; }
            else if ((r -= 2 * I2) < 2 * I4) { const int l = r / I4; r -= l * I4; W = (const float*)ldp(tab, 20) + (size_t)l * FF * 1024; K = FF; N = 1024; type = 3; WT = (bf16*)(ws + WS_WT4) + (size_t)l * 1024 * FF; }
            else if ((r -= 2 * I4) < I6) { W = (const float*)ldp(tab, 12); K = 1024; N = 2048; type = 2; WT = (bf16*)(ws + WS_WT5); }
            else if ((r -= I6) < I7) { W = (const float*)ldp(tab, 14); K = 1024; N = 1024; type = 2; WT = (bf16*)(ws + WS_WT6); }
            else { r -= I7; W = (const float*)ldp(tab, 16); K = 1024; N = 1024; type = 3; WT = (bf16*)(ws + WS_WT7); }
            const int nblk = N / 64, kb = r / nblk, nb = r - kb * nblk;
            p0_transpose_item(W, K, N, WT, 64 * kb, src_col(type, 64 * nb), src_col(type, 64 * nb + 32), 64 * nb, scr, lane);
        }
    }
}

__device__ __forceinline__ void p1_phase(ptab_t tab, LAS unsigned char* lds, int vcu, int G, int roles = 3) {
    const int tid = threadIdx.x, lane = tid & 63, w = __builtin_amdgcn_readfirstlane(tid >> 6);
    unsigned char* ws = ldp(tab, T_WS);
    const float* mods = (const float*)(ws + WS_MODS);
    const int t0 = (G * 77) >> 8, t1 = (G * 147) >> 8, t2 = (G * 217) >> 8, t3 = (G * 243) >> 8;
    const int ty = (vcu < t0) ? 0 : (vcu < t1) ? 1 : (vcu < t2) ? 2 : (vcu < t3) ? 3 : 4;
    const int wbase = (ty == 0) ? 0 : (ty == 1) ? t0 : (ty == 2) ? t1 : (ty == 3) ? t2 : t3, wend = (ty == 0) ? t0 : (ty == 1) ? t1 : (ty == 2) ? t2 : (ty == 3) ? t3 : G;
    const float* sp; int sst, N; const bf16* WT; float* dst;
    if (ty == 0)      { sp = mods;                         sst = 6144; N = RN;   WT = (const bf16*)(ws + WS_WT1); dst = (float*)(ws + WS_SW1); }
    else if (ty == 1) { sp = mods + 3072;                  sst = 6144; N = FF2;  WT = (const bf16*)(ws + WS_WT3); dst = (float*)(ws + WS_SW3); }
    else if (ty == 2) { sp = mods + 16 * 6144 + 3072;      sst = 6144; N = FF2;  WT = (const bf16*)(ws + WS_WT3) + (size_t)FF2 * 1024; dst = (float*)(ws + WS_SW3) + 16 * FF2; }
    else if (ty == 3) { sp = (const float*)(ws + WS_KVM);  sst = 2048; N = 2048; WT = (const bf16*)(ws + WS_WT5); dst = (float*)(ws + WS_SW5); }
    else              { sp = mods + 16 * 6144;             sst = 6144; N = 1024; WT = (const bf16*)(ws + WS_WT6); dst = (float*)(ws + WS_SW6); }
    constexpr int SHP = 1032;
    LAS unsigned short* shh = (LAS unsigned short*)lds; LAS unsigned short* shl = shh + 16 * SHP;
#pragma unroll
    for (int i = tid; i < 16 * 512; i += NTHREADS) {
        const int b = i >> 9, k2 = (i & 511) * 2; const float s0 = sp[(size_t)b * sst + k2], s1 = sp[(size_t)b * sst + k2 + 1];
        const unsigned hi = pk_bf16(s0, s1); const float r0 = s0 - __builtin_bit_cast(float, hi << 16), r1 = s1 - __builtin_bit_cast(float, hi & 0xffff0000u);
        *(LAS unsigned*)(shh + b * SHP + k2) = hi; *(LAS unsigned*)(shl + b * SHP + k2) = pk_bf16(r0, r1);
    }
    LBAR();
    if (roles & 2) {
        const int gw = (vcu - wbase) * NWAVES + w, NGW = (wend - wbase) * NWAVES, fr = lane & 15, fq = lane >> 4;
        for (int grp = gw; grp < N / 16; grp += NGW) {
            const bf16* wrow = WT + (size_t)grp * 32 * 512 + fr * 32 + 8 * fq;
            const LAS unsigned short* ah = shh + fr * SHP + 8 * fq; const LAS unsigned short* al = shl + fr * SHP + 8 * fq;
            f32x4 acc = (f32x4){0.f, 0.f, 0.f, 0.f};
#pragma unroll 1
            for (int half = 0; half < 2; ++half) {
                bf16x8 wv[16];
#pragma unroll
                for (int j = 0; j < 16; ++j) wv[j] = *(const bf16x8*)(wrow + (half * 16 + j) * 512);
#pragma unroll
                for (int j = 0; j < 16; ++j) {
                    const bf16x8 a_hi = *(const LAS bf16x8*)(ah + (half * 16 + j) * 32), a_lo = *(const LAS bf16x8*)(al + (half * 16 + j) * 32);
                    acc = __builtin_amdgcn_mfma_f32_16x16x32_bf16(a_hi, wv[j], acc, 0, 0, 0);
                    acc = __builtin_amdgcn_mfma_f32_16x16x32_bf16(a_lo, wv[j], acc, 0, 0, 0);
                }
            }
#pragma unroll
            for (int i = 0; i < 4; ++i) dst[(size_t)(4 * fq + i) * N + 16 * grp + fr] = acc[i];
        }
    }
    if (roles & 1) {
        const float* x = (const float*)ldp(tab, 0); const float* g = (const float*)ldp(tab, 5);
        bf16* A0 = (bf16*)(ws + WS_A); float* ss0 = (float*)(ws + WS_SS);
        const int gw8 = vcu * NWAVES + w, NGW8 = G * NWAVES, rpw = M / NGW8;
        for (int r0 = gw8 * rpw; r0 < M; r0 += NGW8 * rpw) {
            const int b = r0 / SEQ;
            f32x4 gs[4];
#pragma unroll
            for (int j = 0; j < 4; ++j) { const int col = 4 * lane + 256 * j; gs[j] = *(const f32x4*)(g + col) * (*(const f32x4*)(mods + (size_t)b * 6144 + 1024 + col) + 1.f); }
#pragma unroll 1
            for (int r = r0; r < r0 + rpw; r += 4) {
                f32x4 v[4][4]; float s[4];
#pragma unroll
                for (int q = 0; q < 4; ++q)
#pragma unroll
                    for (int j = 0; j < 4; ++j) v[q][j] = *(const f32x4*)(x + (size_t)(r + q) * D + 4 * lane + 256 * j);
#pragma unroll
                for (int q = 0; q < 4; ++q) { s[q] = (pg8::dot4(v[q][0]) + pg8::dot4(v[q][1])) + (pg8::dot4(v[q][2]) + pg8::dot4(v[q][3])); }
#pragma unroll
                for (int o = 1; o < 64; o <<= 1) {
#pragma unroll
                    for (int q = 0; q < 4; ++q) s[q] += __shfl_xor(s[q], o);
                }
                if (lane < 4) ss0[r + lane] = (lane == 0) ? s[0] : (lane == 1) ? s[1] : (lane == 2) ? s[2] : s[3];
#pragma unroll
                for (int q = 0; q < 4; ++q)
#pragma unroll
                    for (int j = 0; j < 4; ++j) { const f32x4 o = v[q][j] * gs[j]; u32x2 pp; pp.x = pk_bf16(o[0], o[1]); pp.y = pk_bf16(o[2], o[3]); *(u32x2*)(A0 + ((size_t)((r + q) >> 4) * 32 + (lane >> 3) + 8 * j) * 512 + ((r + q) & 15) * 32 + 4 * (lane & 7)) = pp; }
            }
        }
    }
}

constexpr int RT_QROWB = 528, RT_VROWB = 272, RT_PROWB = 144;
constexpr int RT_QS = 0, RT_KS = 64 * RT_QROWB, RT_VS = 2 * 64 * RT_QROWB, RT_PS = RT_VS + 64 * RT_VROWB, RT_SQ = RT_PS + 64 * RT_PROWB, RT_BYTES = RT_SQ + 512;
static_assert(RT_BYTES <= MISC_OFF, "retention LDS");
__device__ __forceinline__ s16x4 tr16(const LAS unsigned char* p) { typedef short v4i16_t __attribute__((ext_vector_type(4))); return __builtin_bit_cast(s16x4, __builtin_amdgcn_ds_read_tr16_b64_v4i16((LAS v4i16_t*)p)); }
#define MFMA16(a, b, c) __builtin_amdgcn_mfma_f32_16x16x32_bf16((a), (b), (c), 0, 0, 0)
#define MFMA32(a, b, c) __builtin_amdgcn_mfma_f32_32x32x16_bf16((a), (b), (c), 0, 0, 0)
__device__ __forceinline__ bf16x8 cat8(s16x4 lo, s16x4 hi) { return (bf16x8){lo[0], lo[1], lo[2], lo[3], hi[0], hi[1], hi[2], hi[3]}; }
__device__ __forceinline__ bf16x8 pack8(const f32x4 a, const f32x4 b) { return __builtin_bit_cast(bf16x8, pg8::pk8(a, b)); }

__device__ __forceinline__ void ret_unit(LAS unsigned char* lds, const bf16* Q, const bf16* KD, const bf16* V, bf16* SG, float* SSO, int unit, bool dry) {
    const int tid = threadIdx.x, lane = tid & 63, w = __builtin_amdgcn_readfirstlane(tid >> 6);
    const int b = unit >> 4, h = (unit >> 2) & 3, vs = unit & 3;
    const int c16 = lane & 15, g4 = lane >> 4;
    const float lg2 = __builtin_amdgcn_logf(1.f - __builtin_amdgcn_exp2f(-5.f - (float)h));
    const float gC = __builtin_amdgcn_exp2f(lg2 * 64.f);
    const __amdgpu_buffer_rsrc_t rs = __builtin_amdgcn_make_buffer_rsrc((void*)Q, 0, 0x7fffffff, 0x00020000);
    const unsigned offK = (unsigned)((const char*)KD - (const char*)Q), offV = (unsigned)((const char*)V - (const char*)Q), offG = (unsigned)((const char*)SG - (const char*)Q);
    const unsigned uQ = ((unsigned)b * SEQ * 1024 + h * 256) * 2, uV = ((unsigned)b * SEQ * 2048 + h * 512 + vs * 128) * 2;
    const unsigned vQ = (tid >> 5) * 2048 + (tid & 31) * 16, vV = (tid >> 4) * 4096 + (tid & 15) * 16;
    const unsigned vG = c16 * 4096 + (16 * w + 4 * g4) * 2;
    u32x4 pq[4], pk[4], pv[2];
#define RT_LOAD(c) do { _Pragma("unroll") for (int j = 0; j < 4; ++j) { const unsigned so = uQ + (unsigned)((c) * 64 + 16 * j) * 2048; \
        pq[j] = __builtin_bit_cast(u32x4, __builtin_amdgcn_raw_buffer_load_b128(rs, vQ, so, 0)); pk[j] = __builtin_bit_cast(u32x4, __builtin_amdgcn_raw_buffer_load_b128(rs, vQ, so + offK, 0)); } \
        _Pragma("unroll") for (int j = 0; j < 2; ++j) pv[j] = __builtin_bit_cast(u32x4, __builtin_amdgcn_raw_buffer_load_b128(rs, vV, offV + uV + (unsigned)((c) * 64 + 32 * j) * 4096, 0)); } while (0)
#define RT_STORE() do { _Pragma("unroll") for (int j = 0; j < 4; ++j) { const int cc = tid + 512 * j, row = cc >> 5, ck = cc & 31; *(LAS u32x4*)(lds + RT_QS + row * RT_QROWB + ck * 16) = pq[j]; *(LAS u32x4*)(lds + RT_KS + row * RT_QROWB + ck * 16) = pk[j]; } \
        _Pragma("unroll") for (int j = 0; j < 2; ++j) { const int cc = tid + 512 * j, row = cc >> 4, ck = cc & 15; *(LAS u32x4*)(lds + RT_VS + row * RT_VROWB + ck * 16) = pv[j]; } } while (0)
    f32x4 st[16], oc[4], sT[2]; bf16x8 vf[2];
#pragma unroll
    for (int i = 0; i < 16; ++i) st[i] = (f32x4){0.f, 0.f, 0.f, 0.f};
#pragma unroll
    for (int i = 0; i < 4; ++i) oc[i] = (f32x4){0.f, 0.f, 0.f, 0.f};
    const int ntS = w & 3, mtb = 2 * (w >> 2);
    const LAS unsigned char* qrowS = lds + RT_QS + (16 * ntS + c16) * RT_QROWB + g4 * 16;
    const LAS unsigned char* krowS = lds + RT_KS + (16 * mtb + c16) * RT_QROWB + g4 * 16;
    const LAS unsigned char* qrowC = lds + RT_QS + c16 * RT_QROWB + g4 * 8;
    const LAS unsigned char* ktr = lds + RT_KS + (8 * g4 + (c16 >> 2)) * RT_QROWB + (c16 & 3) * 8;
    const LAS unsigned char* vtr = lds + RT_VS + (8 * g4 + (c16 >> 2)) * RT_VROWB + w * 32 + (c16 & 3) * 8;
    const LAS unsigned char* prow = lds + RT_PS + c16 * RT_PROWB + g4 * 16;
    LAS unsigned char* pst = lds + RT_PS + (16 * ntS + c16) * RT_PROWB + g4 * 8;
    if (tid < 128) ((LAS float*)(lds + RT_SQ))[tid] = 0.f;
    RT_LOAD(0);
    for (int c = 0; c < 32; ++c) {
        LBAR();
        RT_STORE();
        asm volatile("" ::: "memory");
        if (c + 1 < 32) RT_LOAD(c + 1);
        u32x2 sgv[4];
#pragma unroll
        for (int nt = 0; nt < 4; ++nt) sgv[nt] = __builtin_bit_cast(u32x2, __builtin_amdgcn_raw_buffer_load_b64(rs, vG, offG + uV + (unsigned)(c * 64 + 16 * nt) * 4096, 0));
        if (w == 0 && c > 0 && !dry) {
            LAS float* sl = (LAS float*)(lds + RT_SQ) + ((c - 1) & 1) * 64;
            SSO[(size_t)(b * SEQ + (c - 1) * 64 + lane) * 16 + h * 4 + vs] = sl[lane]; sl[lane] = 0.f;
        }
        LBAR();
#pragma unroll
        for (int ks = 0; ks < 2; ++ks) vf[ks] = cat8(tr16(vtr + (32 * ks) * RT_VROWB), tr16(vtr + (32 * ks + 4) * RT_VROWB));
        sT[0] = (f32x4){0.f, 0.f, 0.f, 0.f}; sT[1] = (f32x4){0.f, 0.f, 0.f, 0.f};
#pragma unroll
        for (int ks = 0; ks < 8; ++ks) {
            const bf16x8 bq = *(const LAS bf16x8*)(qrowS + ks * 64);
#pragma unroll
            for (int i = 0; i < 2; ++i) { const bf16x8 ak = *(const LAS bf16x8*)(krowS + i * 16 * RT_QROWB + ks * 64); sT[i] = MFMA16(ak, bq, sT[i]); }
        }
        {
            const int n = 16 * ntS + c16; const float fac = __builtin_amdgcn_exp2f(lg2 * (float)(n - 63));
#pragma unroll
            for (int i = 0; i < 2; ++i) {
                const int m0 = 16 * (mtb + i) + 4 * g4; float v[4];
#pragma unroll
                for (int e = 0; e < 4; ++e) v[e] = (n >= m0 + e) ? sT[i][e] * fac : 0.f;
                u32x2 p; p.x = pk_bf16(v[0], v[1]); p.y = pk_bf16(v[2], v[3]);
                *(LAS u32x2*)(pst + (mtb + i) * 32) = p;
            }
        }
        __builtin_amdgcn_sched_barrier(0);
        {
            s16x4 qlo[2][4], qhi[2][4];
#pragma unroll
            for (int nt = 0; nt < 4; ++nt) { qlo[0][nt] = *(const LAS s16x4*)(qrowC + nt * 16 * RT_QROWB); qhi[0][nt] = *(const LAS s16x4*)(qrowC + nt * 16 * RT_QROWB + 32); }
#pragma unroll
            for (int ks = 0; ks < 8; ++ks) {
                if (ks < 7) {
#pragma unroll
                    for (int nt = 0; nt < 4; ++nt) { qlo[(ks + 1) & 1][nt] = *(const LAS s16x4*)(qrowC + nt * 16 * RT_QROWB + (ks + 1) * 64); qhi[(ks + 1) & 1][nt] = *(const LAS s16x4*)(qrowC + nt * 16 * RT_QROWB + (ks + 1) * 64 + 32); }
                }
                __builtin_amdgcn_sched_barrier(0);
                const bf16x8 as = pack8(st[2 * ks], st[2 * ks + 1]);
#pragma unroll
                for (int nt = 0; nt < 4; ++nt) oc[nt] = MFMA16(as, cat8(qlo[ks & 1][nt], qhi[ks & 1][nt]), oc[nt]);
                __builtin_amdgcn_sched_barrier(0);
            }
        }
        {
            s16x4 kt[2][4];
#pragma unroll
            for (int ks = 0; ks < 2; ++ks) { kt[0][2 * ks] = tr16(ktr + (32 * ks) * RT_QROWB); kt[0][2 * ks + 1] = tr16(ktr + (32 * ks + 4) * RT_QROWB); }
#pragma unroll
            for (int i = 0; i < 16; ++i) {
                if (i < 15) {
#pragma unroll
                    for (int ks = 0; ks < 2; ++ks) { kt[(i + 1) & 1][2 * ks] = tr16(ktr + (32 * ks) * RT_QROWB + (i + 1) * 32); kt[(i + 1) & 1][2 * ks + 1] = tr16(ktr + (32 * ks + 4) * RT_QROWB + (i + 1) * 32); }
                }
                __builtin_amdgcn_sched_barrier(0);
                f32x4 sacc = st[i] * gC;
#pragma unroll
                for (int ks = 0; ks < 2; ++ks) sacc = MFMA16(cat8(kt[i & 1][2 * ks], kt[i & 1][2 * ks + 1]), vf[ks], sacc);
                st[i] = sacc;
                __builtin_amdgcn_sched_barrier(0);
            }
        }
        LBAR();
#pragma unroll
        for (int nt = 0; nt < 4; ++nt) { const float gq = __builtin_amdgcn_exp2f(lg2 * (float)(16 * nt + c16 + 1)); oc[nt] *= gq; }
#pragma unroll
        for (int ks = 0; ks < 2; ++ks)
#pragma unroll
            for (int nt = 0; nt < 4; ++nt) if (32 * ks <= 16 * nt + 15) { const bf16x8 bp = *(const LAS bf16x8*)(prow + nt * 16 * RT_PROWB + ks * 64); oc[nt] = MFMA16(vf[ks], bp, oc[nt]); }
#pragma unroll
        for (int nt = 0; nt < 4; ++nt) {
            float sq = pg8::dot4(oc[nt]); sq += __shfl_xor(sq, 16); sq += __shfl_xor(sq, 32);
            if (g4 == 0) (void)__hip_atomic_fetch_add((LAS float*)(lds + RT_SQ) + (c & 1) * 64 + 16 * nt + c16, sq, __ATOMIC_RELAXED, __HIP_MEMORY_SCOPE_WORKGROUP);
            const u32x2 sg = sgv[nt];
            const float o0 = oc[nt][0] * __builtin_bit_cast(float, sg.x << 16), o1 = oc[nt][1] * __builtin_bit_cast(float, sg.x & 0xffff0000u);
            const float o2 = oc[nt][2] * __builtin_bit_cast(float, sg.y << 16), o3 = oc[nt][3] * __builtin_bit_cast(float, sg.y & 0xffff0000u);
            u32x2 p; p.x = pk_bf16(o0, o1); p.y = pk_bf16(o2, o3);
            if (!dry) __builtin_amdgcn_raw_buffer_store_b64(__builtin_bit_cast(__attribute__((ext_vector_type(2))) unsigned, p), rs, vG, offG + uV + (unsigned)(c * 64 + 16 * nt) * 4096, 0);
            oc[nt] = (f32x4){0.f, 0.f, 0.f, 0.f};
        }
    }
    LBAR();
    if (w == 0 && !dry) { LAS float* sl = (LAS float*)(lds + RT_SQ) + 64; SSO[(size_t)(b * SEQ + 31 * 64 + lane) * 16 + h * 4 + vs] = sl[lane]; sl[lane] = 0.f; }
    LBAR();
#undef RT_LOAD
#undef RT_STORE
}

constexpr int R2_QS = 0, R2_KS = 64 * RT_QROWB, R2_VS = 2 * 64 * RT_QROWB, R2_PS = R2_VS + 2 * 64 * RT_VROWB, R2_SQ = R2_PS + 64 * RT_PROWB, R2_SG = R2_SQ + 512, R2_BYTES = R2_SG + 64 * RT_VROWB;
static_assert(R2_BYTES <= MISC_OFF, "retention v2 LDS");
__device__ __forceinline__ void ret_unit2(LAS unsigned char* lds, const bf16* Q, const bf16* KD, const bf16* V, bf16* SG, float* SSO, int unit, bool dry) {
    const int tid = threadIdx.x, lane = tid & 63, w = __builtin_amdgcn_readfirstlane(tid >> 6);
    const int b = unit >> 4, h = (unit >> 2) & 3, vs = unit & 3;
    const int r32 = lane & 31, hh = lane >> 5;
    const float lg2 = __builtin_amdgcn_logf(1.f - __builtin_amdgcn_exp2f(-5.f - (float)h));
    const __amdgpu_buffer_rsrc_t rs = __builtin_amdgcn_make_buffer_rsrc((void*)Q, 0, 0x7fffffff, 0x00020000);
    const unsigned offK = (unsigned)((const char*)KD - (const char*)Q), offV = (unsigned)((const char*)V - (const char*)Q), offG = (unsigned)((const char*)SG - (const char*)Q);
    const unsigned uQ = ((unsigned)b * SEQ * 1024 + h * 256) * 2, uV = ((unsigned)b * SEQ * 2048 + h * 512 + vs * 128) * 2;
    if (tid < 128) ((LAS float*)(lds + R2_SQ))[tid] = 0.f;
    if (w >= 4) {
        const int ht = tid - 256, hw = w - 4, mt2 = hw >> 1, nt2 = hw & 1;
        const unsigned vQ = (ht >> 5) * 2048 + (ht & 31) * 16, vV = (ht >> 4) * 4096 + (ht & 15) * 16;
        u32x4 pq[8], pk[8], pv[4], pg[4];
#define H_LOAD(c) do { _Pragma("unroll") for (int j = 0; j < 8; ++j) { const unsigned so = uQ + (unsigned)((c) * 64 + 8 * j) * 2048; \
            pq[j] = __builtin_bit_cast(u32x4, __builtin_amdgcn_raw_buffer_load_b128(rs, vQ, so, 0)); pk[j] = __builtin_bit_cast(u32x4, __builtin_amdgcn_raw_buffer_load_b128(rs, vQ, so + offK, 0)); } \
            _Pragma("unroll") for (int j = 0; j < 4; ++j) { pv[j] = __builtin_bit_cast(u32x4, __builtin_amdgcn_raw_buffer_load_b128(rs, vV, offV + uV + (unsigned)((c) * 64 + 16 * j) * 4096, 0)); \
            pg[j] = __builtin_bit_cast(u32x4, __builtin_amdgcn_raw_buffer_load_b128(rs, vV, offG + uV + (unsigned)((c) * 64 + 16 * j) * 4096, 0)); } } while (0)
#define H_STORE(c) do { _Pragma("unroll") for (int j = 0; j < 8; ++j) { const int row = (ht >> 5) + 8 * j, ck = ht & 31; *(LAS u32x4*)(lds + R2_QS + row * RT_QROWB + ck * 16) = pq[j]; *(LAS u32x4*)(lds + R2_KS + row * RT_QROWB + ck * 16) = pk[j]; } \
            _Pragma("unroll") for (int j = 0; j < 4; ++j) { const int row = (ht >> 4) + 16 * j, ck = ht & 15; *(LAS u32x4*)(lds + R2_VS + ((c) & 1) * 64 * RT_VROWB + row * RT_VROWB + ck * 16) = pv[j]; } } while (0)
#define H_STORE_G() do { _Pragma("unroll") for (int j = 0; j < 4; ++j) { const int row = (ht >> 4) + 16 * j, ck = ht & 15; *(LAS u32x4*)(lds + R2_SG + row * RT_VROWB + ck * 16) = pg[j]; } } while (0)
        const LAS unsigned char* qrowS = lds + R2_QS + (32 * nt2 + r32) * RT_QROWB + hh * 16;
        const LAS unsigned char* krowS = lds + R2_KS + (32 * mt2 + r32) * RT_QROWB + hh * 16;
        LAS unsigned char* pst = lds + R2_PS + (32 * nt2 + r32) * RT_PROWB + (32 * mt2 + 4 * hh) * 2;
        const int n_loc = 32 * nt2 + r32; const float fac = __builtin_amdgcn_exp2f(lg2 * (float)(n_loc - 63));
        H_LOAD(0);
        for (int c = 0; c < 32; ++c) {
            H_STORE(c);
            LBAR();
            H_STORE_G();
            asm volatile("" ::: "memory");
            if (c + 1 < 32) H_LOAD(c + 1);
            f32x16 sT;
#pragma unroll
            for (int i = 0; i < 16; ++i) sT[i] = 0.f;
            if (mt2 <= nt2) {
#pragma unroll
                for (int s = 0; s < 16; ++s) { const bf16x8 ak = *(const LAS bf16x8*)(krowS + s * 32), bq = *(const LAS bf16x8*)(qrowS + s * 32); sT = MFMA32(ak, bq, sT); }
            }
#pragma unroll
            for (int g = 0; g < 4; ++g) {
                const int m0 = 32 * mt2 + 8 * g + 4 * hh; float v[4];
#pragma unroll
                for (int e = 0; e < 4; ++e) v[e] = (n_loc >= m0 + e) ? sT[4 * g + e] * fac : 0.f;
                u32x2 pp; pp.x = pk_bf16(v[0], v[1]); pp.y = pk_bf16(v[2], v[3]);
                *(LAS u32x2*)(pst + g * 16) = pp;
            }
            if (hw == 0 && c > 0 && !dry) {
                LAS float* sl = (LAS float*)(lds + R2_SQ) + ((c - 1) & 1) * 64;
                SSO[(size_t)(b * SEQ + (c - 1) * 64 + lane) * 16 + h * 4 + vs] = sl[lane]; sl[lane] = 0.f;
            }
            LBAR();
        }
        LBAR();
        if (hw == 0 && !dry) { LAS float* sl = (LAS float*)(lds + R2_SQ) + 64; SSO[(size_t)(b * SEQ + 31 * 64 + lane) * 16 + h * 4 + vs] = sl[lane]; sl[lane] = 0.f; }
        LBAR();
#undef H_LOAD
#undef H_STORE
#undef H_STORE_G
    } else {
        const float gC = __builtin_amdgcn_exp2f(lg2 * 64.f);
        f32x16 st[8], oc[2]; bf16x8 vf[4];
#pragma unroll
        for (int t = 0; t < 8; ++t)
#pragma unroll
            for (int i = 0; i < 16; ++i) st[t][i] = 0.f;
#pragma unroll
        for (int i = 0; i < 16; ++i) { oc[0][i] = 0.f; oc[1][i] = 0.f; }
        for (int c = 0; c < 32; ++c) {
            int ln = lane; asm volatile("" : "+v"(ln));
            const int r32 = ln & 31, hh = ln >> 5, blk = (ln >> 4) & 1, q4 = (ln & 15) >> 2, p4 = ln & 3;
            const unsigned vG2 = r32 * 4096 + (32 * w) * 2 + hh * 16;
            const LAS unsigned char* qrowC = lds + R2_QS + r32 * RT_QROWB + hh * 8;
            const LAS unsigned char* ktr = lds + R2_KS + (8 * hh + q4) * RT_QROWB + (16 * blk + 4 * p4) * 2;
            const LAS unsigned char* vtr = lds + R2_VS + (8 * hh + q4) * RT_VROWB + (32 * w + 16 * blk + 4 * p4) * 2;
            const LAS unsigned char* prow = lds + R2_PS + r32 * RT_PROWB + hh * 16;
            LBAR();
            const LAS unsigned char* vb = vtr + (c & 1) * 64 * RT_VROWB;
#pragma unroll
            for (int ks = 0; ks < 4; ++ks) vf[ks] = cat8(tr16(vb + (16 * ks) * RT_VROWB), tr16(vb + (16 * ks + 4) * RT_VROWB));
            {
                s16x4 qlo[3][2], qhi[3][2];
#pragma unroll
                for (int kk = 0; kk < 2; ++kk)
#pragma unroll
                    for (int nt = 0; nt < 2; ++nt) { qlo[kk][nt] = *(const LAS s16x4*)(qrowC + nt * 32 * RT_QROWB + kk * 32); qhi[kk][nt] = *(const LAS s16x4*)(qrowC + nt * 32 * RT_QROWB + kk * 32 + 16); }
#pragma unroll
                for (int k = 0; k < 16; ++k) {
                    if (k < 14) {
#pragma unroll
                        for (int nt = 0; nt < 2; ++nt) { qlo[(k + 2) % 3][nt] = *(const LAS s16x4*)(qrowC + nt * 32 * RT_QROWB + (k + 2) * 32); qhi[(k + 2) % 3][nt] = *(const LAS s16x4*)(qrowC + nt * 32 * RT_QROWB + (k + 2) * 32 + 16); }
                    }
                    __builtin_amdgcn_sched_barrier(0);
                    const int t = k >> 1, s = k & 1;
                    const bf16x8 as = pack8((f32x4){st[t][8 * s], st[t][8 * s + 1], st[t][8 * s + 2], st[t][8 * s + 3]}, (f32x4){st[t][8 * s + 4], st[t][8 * s + 5], st[t][8 * s + 6], st[t][8 * s + 7]});
#pragma unroll
                    for (int nt = 0; nt < 2; ++nt) oc[nt] = MFMA32(as, cat8(qlo[k % 3][nt], qhi[k % 3][nt]), oc[nt]);
                    __builtin_amdgcn_sched_barrier(0);
                }
            }
            {
#pragma unroll
                for (int t = 0; t < 8; ++t) st[t] *= gC;
                s16x4 kf[4][2];
#define KT_ADDR(u_) (ktr + (16 * (((u_) >> 1) & 3)) * RT_QROWB + (2 * ((u_) >> 3) + ((u_) & 1)) * 64)
#pragma unroll
                for (int u = 0; u < 3; ++u) { kf[u][0] = tr16(KT_ADDR(u)); kf[u][1] = tr16(KT_ADDR(u) + 4 * RT_QROWB); }
#pragma unroll
                for (int u = 0; u < 32; ++u) {
                    if (u + 3 < 32) { kf[(u + 3) & 3][0] = tr16(KT_ADDR(u + 3)); kf[(u + 3) & 3][1] = tr16(KT_ADDR(u + 3) + 4 * RT_QROWB); }
                    __builtin_amdgcn_sched_barrier(0);
                    const int t = 2 * (u >> 3) + (u & 1), ks = (u >> 1) & 3;
                    st[t] = MFMA32(cat8(kf[u & 3][0], kf[u & 3][1]), vf[ks], st[t]);
                    __builtin_amdgcn_sched_barrier(0);
                }
#undef KT_ADDR
            }
            LBAR();
            { const float gq0 = __builtin_amdgcn_exp2f(lg2 * (float)(r32 + 1)), gq1 = __builtin_amdgcn_exp2f(lg2 * (float)(r32 + 33)); oc[0] *= gq0; oc[1] *= gq1; }
#pragma unroll
            for (int ks = 0; ks < 4; ++ks)
#pragma unroll
                for (int nt = 0; nt < 2; ++nt) if (16 * ks <= 32 * nt + 31) { const bf16x8 bp = *(const LAS bf16x8*)(prow + nt * 32 * RT_PROWB + ks * 32); oc[nt] = MFMA32(vf[ks], bp, oc[nt]); }
#pragma unroll
            for (int nt = 0; nt < 2; ++nt) {
                float sq = 0.f;
#pragma unroll
                for (int i = 0; i < 16; ++i) sq += oc[nt][i] * oc[nt][i];
                sq += __shfl_xor(sq, 32);
                if (hh == 0) (void)__hip_atomic_fetch_add((LAS float*)(lds + R2_SQ) + (c & 1) * 64 + 32 * nt + r32, sq, __ATOMIC_RELAXED, __HIP_MEMORY_SCOPE_WORKGROUP);
                u32x2 pp[4];
#pragma unroll
                for (int g = 0; g < 4; ++g) {
                    const u32x2 sg = *(const LAS u32x2*)(lds + R2_SG + (32 * nt + r32) * RT_VROWB + (32 * w + 8 * g + 4 * hh) * 2);
                    const float o0 = oc[nt][4 * g] * __builtin_bit_cast(float, sg.x << 16), o1 = oc[nt][4 * g + 1] * __builtin_bit_cast(float, sg.x & 0xffff0000u);
                    const float o2 = oc[nt][4 * g + 2] * __builtin_bit_cast(float, sg.y << 16), o3 = oc[nt][4 * g + 3] * __builtin_bit_cast(float, sg.y & 0xffff0000u);
                    pp[g].x = pk_bf16(o0, o1); pp[g].y = pk_bf16(o2, o3);
                }
#pragma unroll
                for (int j = 0; j < 2; ++j) {
                    const auto sx = __builtin_amdgcn_permlane32_swap(pp[2 * j].x, pp[2 * j + 1].x, false, false), sy = __builtin_amdgcn_permlane32_swap(pp[2 * j].y, pp[2 * j + 1].y, false, false);
                    const u32x4 o4 = (u32x4){sx[0], sy[0], sx[1], sy[1]};
                    if (!dry) __builtin_amdgcn_raw_buffer_store_b128(__builtin_bit_cast(__attribute__((ext_vector_type(4))) unsigned, o4), rs, vG2, offG + uV + (unsigned)(c * 64 + 32 * nt) * 4096 + j * 32, 0);
                }
#pragma unroll
                for (int i = 0; i < 16; ++i) oc[nt][i] = 0.f;
            }
        }
        LBAR();
        LBAR();
    }
}

__device__ __forceinline__ int crow(int r, int hi) { return (r & 3) + 8 * (r >> 2) + 4 * hi; }
__device__ __forceinline__ void sb_wave(const bf16* QN, const bf16* KN, const bf16* VF, bf16* O, int vcu, int wave, int lane) {
    const int r32 = lane & 31, hh = lane >> 5;
#define SB_IDX(i_, bh_, qb_) const int bh_ = (vcu >> 3) + 32 * (i_), qb_ = ((((vcu & 7) + (i_)) & 7) << 3) + wave
#define SB_KBASE(bh_) (KN + ((size_t)(bh_) * SEQ + r32) * 64 + 8 * hh)
#define SB_VBASE(bh_) (VF + (size_t)(bh_) * 64 * 2048 + lane * 8)
    bf16x8 qN[4], kfU[4], vfU[2][2];
#define SB_LOAD_UNIT(bh_, qb_) do { const bf16* qp_ = QN + ((size_t)(bh_) * SEQ + 32 * (qb_) + r32) * 64 + 8 * hh; \
        _Pragma("unroll") for (int s = 0; s < 4; ++s) { qN[s] = *(const bf16x8*)(qp_ + 16 * s); kfU[s] = *(const bf16x8*)(SB_KBASE(bh_) + (size_t)(32 * (qb_)) * 64 + 16 * s); } \
        _Pragma("unroll") for (int dt = 0; dt < 2; ++dt) _Pragma("unroll") for (int sp = 0; sp < 2; ++sp) vfU[dt][sp] = *(const bf16x8*)(SB_VBASE(bh_) + (size_t)((((qb_) * 2 + dt) * 2 + sp) * 512)); } while (0)
    { SB_IDX(0, bh0, qb0); SB_LOAD_UNIT(bh0, qb0); }
#pragma unroll 1
    for (int i = 0; i < 8; ++i) {
        SB_IDX(i, bh, qblk);
        const int b = bh >> 4, h = bh & 15;
        const size_t row0 = (size_t)b * SEQ + 32 * qblk;
        bf16x8 qf[4], kfn[4], vfn[2][2];
#pragma unroll
        for (int s = 0; s < 4; ++s) { qf[s] = qN[s]; kfn[s] = kfU[s]; }
#pragma unroll
        for (int dt = 0; dt < 2; ++dt)
#pragma unroll
            for (int sp = 0; sp < 2; ++sp) vfn[dt][sp] = vfU[dt][sp];
        if (i + 1 < 8) { SB_IDX(i + 1, bh1, qb1); SB_LOAD_UNIT(bh1, qb1); }
        f32x16 oT[2];
#pragma unroll
        for (int q = 0; q < 16; ++q) { oT[0][q] = 0.f; oT[1][q] = 0.f; }
        float R = 0.f;
        const bf16* kbase = SB_KBASE(bh);
        const bf16* vbase = SB_VBASE(bh);
#define SB_LOAD(kt_) do { _Pragma("unroll") for (int s = 0; s < 4; ++s) kfn[s] = *(const bf16x8*)(kbase + (size_t)(32 * (kt_)) * 64 + 16 * s); \
        _Pragma("unroll") for (int dt = 0; dt < 2; ++dt) _Pragma("unroll") for (int sp = 0; sp < 2; ++sp) vfn[dt][sp] = *(const bf16x8*)(vbase + (size_t)((((kt_) * 2 + dt) * 2 + sp) * 512)); } while (0)
        for (int kt = qblk; kt >= 0; --kt) {
            bf16x8 kf[4], vf[2][2];
#pragma unroll
            for (int s = 0; s < 4; ++s) kf[s] = kfn[s];
#pragma unroll
            for (int dt = 0; dt < 2; ++dt)
#pragma unroll
                for (int sp = 0; sp < 2; ++sp) vf[dt][sp] = vfn[dt][sp];
            if (kt > 0) SB_LOAD(kt - 1);
            f32x16 z;
#pragma unroll
            for (int q = 0; q < 16; ++q) z[q] = 0.f;
#pragma unroll
            for (int s = 0; s < 4; ++s) z = MFMA32(kf[s], qf[s], z);
            float sp_[16], lb[16];
            const bool diag = (kt == qblk);
#pragma unroll
            for (int q = 0; q < 16; ++q) {
                const float zz = z[q];
                const float t = __builtin_amdgcn_exp2f(-__builtin_fabsf(zz));
                const float s = __builtin_fmaxf(zz, 0.f) + __builtin_amdgcn_logf(1.f + t);
                const bool valid = !diag || (crow(q, hh) < r32);
                sp_[q] = valid ? s : 0.f;
                lb[q] = valid ? (zz - s) : -INFINITY;
            }
            float gsum[4], pgs[4];
#pragma unroll
            for (int q = 0; q < 4; ++q) { gsum[q] = (sp_[4 * q] + sp_[4 * q + 1]) + (sp_[4 * q + 2] + sp_[4 * q + 3]); pgs[q] = __shfl_xor(gsum[q], 32); }
            float later = R;
            f32x16 pa;
#pragma unroll
            for (int q = 3; q >= 0; --q) {
                const float L = later + (hh == 0 ? pgs[q] : 0.f);
                const float s3 = L, s2 = s3 + sp_[4 * q + 3], s1 = s2 + sp_[4 * q + 2], s0 = s1 + sp_[4 * q + 1];
                pa[4 * q + 0] = __builtin_amdgcn_exp2f(lb[4 * q + 0] - s0);
                pa[4 * q + 1] = __builtin_amdgcn_exp2f(lb[4 * q + 1] - s1);
                pa[4 * q + 2] = __builtin_amdgcn_exp2f(lb[4 * q + 2] - s2);
                pa[4 * q + 3] = __builtin_amdgcn_exp2f(lb[4 * q + 3] - s3);
                later += gsum[q] + pgs[q];
            }
            R = later;
#pragma unroll
            for (int sp = 0; sp < 2; ++sp) {
                const bf16x8 pf = pack8((f32x4){pa[8 * sp], pa[8 * sp + 1], pa[8 * sp + 2], pa[8 * sp + 3]}, (f32x4){pa[8 * sp + 4], pa[8 * sp + 5], pa[8 * sp + 6], pa[8 * sp + 7]});
#pragma unroll
                for (int dt = 0; dt < 2; ++dt) oT[dt] = MFMA32(vf[dt][sp], pf, oT[dt]);
            }
            if (__all(R > 46.2f)) break;
        }
#undef SB_LOAD
#pragma unroll
        for (int dt = 0; dt < 2; ++dt)
#pragma unroll
            for (int q = 0; q < 4; ++q) {
                u32x2 pp; pp.x = pk_bf16(oT[dt][4 * q], oT[dt][4 * q + 1]); pp.y = pk_bf16(oT[dt][4 * q + 2], oT[dt][4 * q + 3]);
                *(u32x2*)(O + (row0 + r32) * 1024 + h * 64 + 32 * dt + 8 * q + 4 * hh) = pp;
            }
    }
#undef SB_IDX
#undef SB_KBASE
#undef SB_VBASE
#undef SB_LOAD_UNIT
}

constexpr int SBL_TILE = 8192, SBL_BUF = 9 * SBL_TILE;
static_assert(2 * SBL_BUF <= MISC_OFF, "stick-breaking LDS");
__device__ __forceinline__ void sb_wave_lds(LAS unsigned char* lds, const bf16* QN, const bf16* KN, const bf16* VF, bf16* O, int vcu, int wave, int lane) {
    const int r32 = lane & 31, hh = lane >> 5;
#define SBL_IDX(i_, bh_, qb0_) const int bh_ = (vcu >> 3) + 32 * (i_), qb0_ = ((((vcu & 7) + (i_)) & 7) << 3)
#define SBL_STAGE(bh_, qb0_, b_) do { _Pragma("unroll") for (int tl = 0; tl < 9; ++tl) { const int kt_ = (qb0_) - 1 + tl; \
        if (kt_ >= 0) { const bf16* src_ = (wave < 4) ? KN + (((size_t)(bh_) * 64 + kt_) * 4 + wave) * 512 + lane * 8 : VF + (size_t)(bh_) * 64 * 2048 + (size_t)(kt_ * 4 + (wave - 4)) * 512 + lane * 8; \
            __builtin_amdgcn_global_load_lds((const unsigned*)src_, (LAS unsigned*)(lds + (b_) * SBL_BUF + tl * SBL_TILE + wave * 1024), 16, 0, 0); } } } while (0)
    bf16x8 qN[4];
#define SBL_LOADQ(bh_, qb_) do { const bf16* qp_ = QN + ((size_t)(bh_) * 64 + (qb_)) * 2048 + lane * 8; _Pragma("unroll") for (int s = 0; s < 4; ++s) qN[s] = *(const bf16x8*)(qp_ + 512 * s); } while (0)
    { SBL_IDX(0, bh0, q00); SBL_STAGE(bh0, q00, 0); SBL_LOADQ(bh0, q00 + wave); }
#pragma unroll 1
    for (int i = 0; i < 8; ++i) {
        SBL_IDX(i, bh, qb0);
        const int qblk = qb0 + wave, b = bh >> 4, h = bh & 15;
        const size_t row0 = (size_t)b * SEQ + 32 * qblk;
        if (i == 0) asm volatile("s_waitcnt vmcnt(0)" ::: "memory"); else asm volatile("s_waitcnt vmcnt(4)" ::: "memory");
        __builtin_amdgcn_s_barrier(); asm volatile("" ::: "memory");
        bf16x8 qf[4];
#pragma unroll
        for (int s = 0; s < 4; ++s) qf[s] = qN[s];
        if (i + 1 < 8) { SBL_IDX(i + 1, bh1, q01); SBL_STAGE(bh1, q01, (i + 1) & 1); SBL_LOADQ(bh1, q01 + wave); }
        f32x16 oT[2];
#pragma unroll
        for (int q = 0; q < 16; ++q) { oT[0][q] = 0.f; oT[1][q] = 0.f; }
        float R = 1.f;
        const LAS unsigned char* fb = lds + (i & 1) * SBL_BUF + lane * 16 - (qb0 - 1) * SBL_TILE;
        const bf16* kbase = KN + (size_t)bh * 64 * 2048 + lane * 8;
        const bf16* vbase = VF + (size_t)bh * 64 * 2048 + lane * 8;
        for (int kt = qblk; kt >= 0; --kt) {
            const bool inl = kt >= qb0 - 1;
            bf16x8 kf[4], vf[2][2];
            if (inl) {
#pragma unroll
                for (int s = 0; s < 4; ++s) kf[s] = *(const LAS bf16x8*)(fb + kt * SBL_TILE + s * 1024);
#pragma unroll
                for (int dt = 0; dt < 2; ++dt)
#pragma unroll
                    for (int sp = 0; sp < 2; ++sp) vf[dt][sp] = *(const LAS bf16x8*)(fb + kt * SBL_TILE + 4096 + (2 * dt + sp) * 1024);
            } else {
#pragma unroll
                for (int s = 0; s < 4; ++s) kf[s] = *(const bf16x8*)(kbase + (size_t)(kt * 4 + s) * 512);
#pragma unroll
                for (int dt = 0; dt < 2; ++dt)
#pragma unroll
                    for (int sp = 0; sp < 2; ++sp) vf[dt][sp] = *(const bf16x8*)(vbase + (size_t)(((kt * 2 + dt) * 2 + sp) * 512));
            }
            f32x16 z;
#pragma unroll
            for (int q = 0; q < 16; ++q) z[q] = 0.f;
#pragma unroll
            for (int s = 0; s < 4; ++s) z = MFMA32(kf[s], qf[s], z);
            float sg_[16], ns[16];
            const bool diag = (kt == qblk);
#pragma unroll
            for (int q = 0; q < 16; ++q) {
                const float zz = z[q];
                const float t = __builtin_amdgcn_exp2f(-__builtin_fabsf(zz));
                const float r = __builtin_amdgcn_rcpf(1.f + t);
                const bool valid = !diag || (crow(q, hh) < r32), neg = zz < 0.f;
                sg_[q] = valid ? (neg ? t : 1.f) * r : 0.f;
                ns[q] = valid ? (neg ? 1.f : t) * r : 1.f;
            }
            float gpr[4], pgp[4];
#pragma unroll
            for (int q = 0; q < 4; ++q) { gpr[q] = (ns[4 * q] * ns[4 * q + 1]) * (ns[4 * q + 2] * ns[4 * q + 3]); pgp[q] = __shfl_xor(gpr[q], 32); }
            float later = R;
            f32x16 pa;
#pragma unroll
            for (int q = 3; q >= 0; --q) {
                const float L = later * (hh == 0 ? pgp[q] : 1.f);
                const float p3 = L, p2 = p3 * ns[4 * q + 3], p1 = p2 * ns[4 * q + 2], p0 = p1 * ns[4 * q + 1];
                pa[4 * q + 0] = sg_[4 * q + 0] * p0;
                pa[4 * q + 1] = sg_[4 * q + 1] * p1;
                pa[4 * q + 2] = sg_[4 * q + 2] * p2;
                pa[4 * q + 3] = sg_[4 * q + 3] * p3;
                later *= gpr[q] * pgp[q];
            }
            R = later;
#pragma unroll
            for (int sp = 0; sp < 2; ++sp) {
                const bf16x8 pf = pack8((f32x4){pa[8 * sp], pa[8 * sp + 1], pa[8 * sp + 2], pa[8 * sp + 3]}, (f32x4){pa[8 * sp + 4], pa[8 * sp + 5], pa[8 * sp + 6], pa[8 * sp + 7]});
#pragma unroll
                for (int dt = 0; dt < 2; ++dt) oT[dt] = MFMA32(vf[dt][sp], pf, oT[dt]);
            }
            if (__all(R < 1.2664e-14f)) break;
        }
#pragma unroll
        for (int dt = 0; dt < 2; ++dt)
#pragma unroll
            for (int j = 0; j < 2; ++j) {
                const unsigned ax = pk_bf16(oT[dt][8 * j], oT[dt][8 * j + 1]), ay = pk_bf16(oT[dt][8 * j + 2], oT[dt][8 * j + 3]), bx = pk_bf16(oT[dt][8 * j + 4], oT[dt][8 * j + 5]), by = pk_bf16(oT[dt][8 * j + 6], oT[dt][8 * j + 7]);
                const auto sx = __builtin_amdgcn_permlane32_swap(ax, bx, false, false), sy = __builtin_amdgcn_permlane32_swap(ay, by, false, false);
                *(u32x4*)(O + (((row0 + r32) >> 4) * 32 + 2 * h + dt) * 512 + (r32 & 15) * 32 + 16 * j + 8 * hh) = (u32x4){sx[0], sy[0], sx[1], sy[1]};
            }
    }
#undef SBL_IDX
#undef SBL_STAGE
#undef SBL_LOADQ
}

__device__ __forceinline__ void fix_phase(const bf16* HF, const bf16* HL, const float* cw, const float* cb, bf16* ACT, int vcu, int G) {
    const int g = vcu * NTHREADS + threadIdx.x, NCG = FF / 4, nslot = (G * NTHREADS) / NCG;
    const int cg4 = g % NCG, slot = g / NCG;
    if (slot >= nslot) return;
    const int c0 = 4 * cg4, pn = c0 >> 7, j = c0 & 127, nv = 256 * pn + j;
    constexpr int NP = 256 * 2, MAXI = 3;
    u32x2 u0[MAXI][2], h0[MAXI][2], l1[MAXI][2], l0[MAXI][2];
#pragma unroll
    for (int q = 0; q < MAXI; ++q) {
        const int p = (slot + q * nslot < NP) ? slot + q * nslot : slot;
        const int i = p & 1, blk = p >> 1, pb = ((blk & 15) == 0) ? blk : blk - 1;
#pragma unroll
        for (int half = 0; half < 2; ++half) {
            const int nn = nv + 128 * half;
            u0[q][half] = *(const u32x2*)(HF + (size_t)(blk * 2 + i) * FF2 + nn); h0[q][half] = *(const u32x2*)(HF + (size_t)(blk * 2) * FF2 + nn);
            l1[q][half] = *(const u32x2*)(HL + (size_t)(pb * 2 + 1) * FF2 + nn); l0[q][half] = *(const u32x2*)(HL + (size_t)(pb * 2) * FF2 + nn);
        }
    }
    f32x4 w0[2], w1[2], w2[2], bb[2];
#pragma unroll
    for (int half = 0; half < 2; ++half) { const int co = half * FF + c0; w0[half] = *(const f32x4*)(cw + co); w1[half] = *(const f32x4*)(cw + FF2 + co); w2[half] = *(const f32x4*)(cw + 2 * FF2 + co); bb[half] = *(const f32x4*)(cb + co); }
#define FIX_UP4(t_) ((f32x4){__builtin_bit_cast(float, (t_).x << 16), __builtin_bit_cast(float, (t_).x & 0xffff0000u), __builtin_bit_cast(float, (t_).y << 16), __builtin_bit_cast(float, (t_).y & 0xffff0000u)})
#pragma unroll
    for (int q = 0; q < MAXI; ++q) {
        const int p = slot + q * nslot;
        if (p < NP) {
            const int i = p & 1, blk = p >> 1; const bool first = (blk & 15) == 0;
            f32x4 y[2];
#pragma unroll
            for (int half = 0; half < 2; ++half) {
                const f32x4 zero = (f32x4){0.f, 0.f, 0.f, 0.f}, pl1 = first ? zero : FIX_UP4(l1[q][half]), pl0 = first ? zero : FIX_UP4(l0[q][half]);
                const f32x4 x0 = FIX_UP4(u0[q][half]), x1 = (i == 1) ? FIX_UP4(h0[q][half]) : pl1, x2 = (i == 1) ? pl1 : pl0;
                y[half] = bb[half] + w2[half] * x0 + w1[half] * x1 + w0[half] * x2;
            }
            const f32x4 o = y[0] * pg8::silu4(y[1]);
            u32x2 p2; p2.x = pk_bf16(o[0], o[1]); p2.y = pk_bf16(o[2], o[3]);
            { const int row = 128 * blk + i; *(u32x2*)(ACT + ((size_t)(row >> 4) * (FF / 32) + (c0 >> 5)) * 512 + (row & 15) * 32 + (c0 & 31)) = p2; }
        }
    }
#undef FIX_UP4
}

__device__ __forceinline__ XcdBarrier mk_bar(ptab_t tab, LAS unsigned char* lds) { XcdBarrier b; b.bar = (unsigned*)(ldp(tab, T_WS) + WS_CTL) + 1024; b.x = xb_xcc_id(); b.st = (volatile LAS unsigned*)(lds + MISC_OFF) + 8; return b; }
__global__ void __launch_bounds__(NTHREADS, 2) yoco_fwd(Args a) {
    extern __shared__ __attribute__((aligned(16))) unsigned char lds_raw[];
    LAS unsigned char* lds = (LAS unsigned char*)lds_raw;
    volatile LAS unsigned* MISC = (volatile LAS unsigned*)(lds + MISC_OFF);
    LAS unsigned long long* tabw = (LAS unsigned long long*)(lds + MISC_OFF + 64);
    const ptab_t tab = (ptab_t)(lds + MISC_OFF + 64);
    if (threadIdx.x < 16) MISC[threadIdx.x] = 0u;
    if (threadIdx.x == 64) {
#pragma unroll
        for (int i = 0; i < 21; ++i) tabw[i] = (unsigned long long)a.in[i];
        tabw[T_OUT] = (unsigned long long)a.out; tabw[T_WS] = (unsigned long long)a.ws;
        MISC[0] = (unsigned)a.ph_lo; MISC[1] = (unsigned)a.ph_hi;
    }
    __syncthreads();
    if (a.ph_hi - a.ph_lo > 1) (void)xcd_barrier_post((unsigned*)(a.ws + WS_CTL) + 1024, MISC + 8);
#define PH_LO ((int)__builtin_amdgcn_readfirstlane(MISC[0]))
#define PH_HI ((int)__builtin_amdgcn_readfirstlane(MISC[1]))
#define IN(k) (PH_LO <= (k) && (k) < PH_HI)
#define STAMP(k) do { if (PROBE_TS >= 0 && threadIdx.x == 0) { const unsigned long long t_ = __builtin_amdgcn_s_memrealtime(); *(volatile LAS unsigned long long*)(lds + MISC_OFF + 256 + 8 * (k)) = t_; } } while (0)
#define SEAM(k) do { if (IN(k) && IN((k) + 1)) xcd_barrier(mk_bar(tab, lds)); STAMP((k) + 1); } while (0)
#define GRID ((int)gridDim.x)
#define BX ((int)blockIdx.x)
#define VCU ((GRID % 8 == 0) ? (BX % 8) * (GRID / 8) + BX / 8 : BX)
#define WSP (ldp(tab, T_WS))

    STAMP(0);
#ifndef SKIP_P0
    if (IN(0)) { for (int rep = 0; rep < REPS(0); ++rep) { p0_phase(tab, lds, VCU, GRID); LBAR(); } }
#endif
    if (IN(0) && IN(1)) {
        if (MK_ONE_LAUNCH && PH_LO < 0) { cg::this_grid().sync(); }
        xcd_barrier(mk_bar(tab, lds));
    }
    STAMP(1);
#ifndef SKIP_P1
    if (IN(1)) { for (int rep = 0; rep < REPS(1); ++rep) p1_phase(tab, lds, VCU, GRID); }
#endif
    SEAM(1);
    if (IN(2)) {
        pg8::Gemm g{(const bf16*)(WSP + WS_A), (const bf16*)(WSP + WS_WT1), M, RN, D, D}; pg8::StaticOrder S; S.init(M, RN, GRID, BX);
        pg8::EpiRetIn E{tab};
        for (int rep = 0; rep < REPS(2); ++rep) pg8::gemm_phase<pg8::EpiRetIn, pg8::StaticOrder, true, true>(lds, g, S, E);
    }
    SEAM(2);
#ifndef SKIP_RET
    if (IN(3)) {
        unsigned char* ws = WSP;
        for (int rep = 0; rep < REPS(3); ++rep) for (int u = VCU; u < 256; u += GRID) RET_UNIT(lds, (const bf16*)(ws + WS_Q), (const bf16*)(ws + WS_KD), (const bf16*)(ws + WS_V), (bf16*)(ws + WS_SG), (float*)(ws + WS_SSO), u, rep == 0 && REPS(3) == 2);
    }
#endif
    SEAM(3);
    if (IN(4)) {
        pg8::Gemm g{(const bf16*)(WSP + WS_SG), (const bf16*)(WSP + WS_WT2), M, D, 512, 2048}; pg8::SegOrder S; S.init(M, D, GRID, BX);
        pg8::EpiRes<0> E{tab};
        {
            const int slot = threadIdx.x >> 8, r = threadIdx.x & 255; pg8::Unit u;
            if (S.next(4 * slot, u)) {
                const float* sp4 = (const float*)(WSP + WS_SSO) + (size_t)(u.pm * 256 + r) * 16; f32x4 s4;
#pragma unroll
                for (int hh = 0; hh < 4; ++hh) { const f32x4 q = *(const f32x4*)(sp4 + 4 * hh); s4[hh] = (q[0] + q[1]) + (q[2] + q[3]); }
                const float e0 = s4[0] * (1.f / 512.f) + EPS, e1 = s4[1] * (1.f / 512.f) + EPS, e2 = s4[2] * (1.f / 512.f) + EPS, e3 = s4[3] * (1.f / 512.f) + EPS;
                f32x4 o; o[0] = __builtin_sqrtf(e1 / e0); o[1] = __builtin_sqrtf(e2 / e1); o[2] = __builtin_sqrtf(e3 / e2); o[3] = 1.f / __builtin_sqrtf(e3);
                *(LAS f32x4*)(lds + pg8::LDS_XTRA + (slot * 256 + r) * 16) = o;
            }
            LBAR();
        }
        pg8::gemm_phase<pg8::EpiRes<0>, pg8::SegOrder, true, true>(lds, g, S, E);
    }
    SEAM(4);
#pragma unroll 1
    for (int l = 0; l < 2; ++l) {
        const int pb = (l == 0) ? 5 : 11;
        if (IN(pb)) {
            pg8::Gemm g{(const bf16*)(WSP + WS_A), (const bf16*)(WSP + WS_WT3) + (size_t)l * FF2 * 1024, M, FF2, D, D}; pg8::StaticOrder S; S.init(M, FF2, GRID, BX);
            pg8::EpiFfnIn E{tab, l};
            for (int rep = 0; rep < ((l == 0) ? REPS(5) : 1); ++rep) pg8::gemm_phase<pg8::EpiFfnIn, pg8::StaticOrder, true, true>(lds, g, S, E);
        }
        SEAM(pb);
        if (IN(pb + 1)) { unsigned char* ws = WSP; fix_phase((const bf16*)(ws + WS_HF), (const bf16*)(ws + WS_HL), (const float*)ldp(tab, 18) + l * 3 * FF2, (const float*)ldp(tab, 19) + l * FF2, (bf16*)(ws + WS_ACT), VCU, GRID); }
        SEAM(pb + 1);
        if (IN(pb + 2)) {
            pg8::Gemm g{(const bf16*)(WSP + WS_ACT), (const bf16*)(WSP + WS_WT4) + (size_t)l * 1024 * FF, M, D, FF, FF}; pg8::StaticOrder S; S.init(M, D, GRID, BX);
            if (l == 0) { pg8::EpiRes<1> E{tab}; pg8::gemm_phase<pg8::EpiRes<1>, pg8::StaticOrder, true, true>(lds, g, S, E); }
            else        { pg8::EpiRes<3> E{tab}; pg8::gemm_phase<pg8::EpiRes<3>, pg8::StaticOrder, true, true>(lds, g, S, E); }
        }
        if (l == 1) break;
        SEAM(7);
        if (IN(8)) {
            { pg8::Gemm g{(const bf16*)(WSP + WS_A), (const bf16*)(WSP + WS_WT5), M, 2048, D, D}; pg8::StaticOrder S; S.init(M, 2048, GRID, BX);
              pg8::EpiKVQ<0> E{tab};
              for (int rep = 0; rep < REPS(8); ++rep) pg8::gemm_phase<pg8::EpiKVQ<0>, pg8::StaticOrder, true, true>(lds, g, S, E); }
            { pg8::Gemm g{(const bf16*)(WSP + WS_AM1), (const bf16*)(WSP + WS_WT6), M, D, D, D}; pg8::StaticOrder S; S.init(M, D, GRID, BX);
              pg8::EpiKVQ<1> E{tab};
              pg8::gemm_phase<pg8::EpiKVQ<1>, pg8::StaticOrder, true, true>(lds, g, S, E); }
        }
        SEAM(8);
#ifndef SKIP_SB
        if (IN(9)) {
            unsigned char* ws = WSP; const int vcu = VCU, wave = __builtin_amdgcn_readfirstlane(threadIdx.x >> 6); int lane = threadIdx.x & 63;
            asm volatile("" : "+v"(lane));
            for (int rep = 0; rep < REPS(9); ++rep) sb_wave_lds(lds, (const bf16*)(ws + WS_QN), (const bf16*)(ws + WS_KN), (const bf16*)(ws + WS_VT), (bf16*)(ws + WS_OSB), vcu, wave, lane);
        }
#endif
        SEAM(9);
        if (IN(10)) {
            pg8::Gemm g{(const bf16*)(WSP + WS_OSB), (const bf16*)(WSP + WS_WT7), M, D, D, D}; pg8::StaticOrder S; S.init(M, D, GRID, BX);
            pg8::EpiRes<2> E{tab};
            pg8::gemm_phase<pg8::EpiRes<2>, pg8::StaticOrder, true, true>(lds, g, S, E);
        }
        SEAM(10);
    }
#if PROBE_X >= 0
    {
        xcd_barrier(mk_bar(tab, lds)); STAMP(14);
        pg8::Gemm g{(const bf16*)(WSP + WS_OSB), (const bf16*)(WSP + WS_WT7), M, D, D, D}; pg8::StaticOrder S; S.init(M, D, GRID, BX);
        if (PROBE_X >= 128 && PROBE_X < 256) { LBAR(); p1_phase(tab, lds, VCU, GRID, PROBE_X - 128); }
        if (PROBE_X >= 2048) {
            pg8::Gemm g{(const bf16*)(WSP + WS_A), (const bf16*)(WSP + WS_WT3) + (size_t)FF2 * 1024, M, 2048, D, D}; pg8::StaticOrder S; S.init(M, 2048, GRID, BX);
            pg8::EpiFfnInT<(PROBE_X >= 2048 ? PROBE_X - 2048 : 0)> E{tab, 1};
            pg8::gemm_phase<pg8::EpiFfnInT<(PROBE_X >= 2048 ? PROBE_X - 2048 : 0)>, pg8::StaticOrder, true, true>(lds, g, S, E);
        }
        if (PROBE_X < 64) { pg8::EpiRes<2, PROBE_X & 63> E{tab};
        pg8::gemm_phase<pg8::EpiRes<2, PROBE_X & 63>, pg8::StaticOrder, true, true>(lds, g, S, E); }
    }
#endif
#if PROBE_TS >= 0
    {
        xcd_barrier(mk_bar(tab, lds)); STAMP(PROBE_X >= 0 ? 15 : 14);
        float* dlt = (float*)(WSP + WS_CTL) + 8192;
        if (BX == 0 && threadIdx.x == 0) {
            const volatile LAS unsigned long long* ts = (const volatile LAS unsigned long long*)(lds + MISC_OFF + 256);
            float t_us = (PROBE_TS >= 100) ? 200.f : (float)(ts[PROBE_TS + 1] - ts[PROBE_TS]) * 0.01f;
            __hip_atomic_store(dlt, __builtin_sqrtf(t_us * (3.35e-6f * PROBE_GAIN)), __ATOMIC_RELAXED, __HIP_MEMORY_SCOPE_AGENT);
        }
        xcd_barrier(mk_bar(tab, lds));
        const float d = __hip_atomic_load(dlt, __ATOMIC_RELAXED, __HIP_MEMORY_SCOPE_AGENT);
        float* o = (float*)ldp(tab, T_OUT);
        for (int i = BX * NTHREADS + threadIdx.x; i < (1 << 20); i += GRID * NTHREADS) o[i] += d;
    }
#endif
#undef IN
#undef SEAM
}

extern "C" void kernel_launch(void* const* d_in, const int* in_sizes, int n_in, void* d_out, int out_size, void* d_ws, size_t ws_size, hipStream_t stream) {
    static int grid = 0;
    if (grid == 0) {
        if (n_in != 21 || in_sizes[0] != M * D || out_size != M * D || ws_size < WS_END) { fprintf(stderr, "kernel_launch: unexpected problem: n_in %d in0 %d out %d ws %zu (need %zu)\n", n_in, n_in > 0 ? in_sizes[0] : -1, out_size, ws_size, (size_t)WS_END); grid = -1; return; }
        int dev = 0, cus = 0, per_cu = 0;
        if (hipGetDevice(&dev) != hipSuccess || hipDeviceGetAttribute(&cus, hipDeviceAttributeMultiprocessorCount, dev) != hipSuccess) { grid = -1; return; }
        if (hipFuncSetAttribute((const void*)yoco_fwd, hipFuncAttributeMaxDynamicSharedMemorySize, LDS_BYTES) != hipSuccess) { fprintf(stderr, "kernel_launch: hipFuncSetAttribute failed\n"); grid = -1; return; }
        if (hipOccupancyMaxActiveBlocksPerMultiprocessor(&per_cu, (const void*)yoco_fwd, NTHREADS, LDS_BYTES) != hipSuccess || per_cu < 1) { fprintf(stderr, "kernel_launch: occupancy query says %d\n", per_cu); (void)hipGetLastError(); per_cu = 1; }
        grid = cus;
        if (grid > 256) grid = 256;
    }
    if (grid < 0) return;
    (void)hipMemsetAsync((char*)d_ws + WS_CTL, 0, 65536, stream);
    Args a{};
    for (int i = 0; i < 21; ++i) a.in[i] = d_in[i];
    a.out = (float*)d_out; a.ws = (unsigned char*)d_ws;
#if MK_ONE_LAUNCH
    a.ph_lo = 0; a.ph_hi = NPHASE;
    void* args[] = {&a};
    hipError_t e = hipLaunchCooperativeKernel((const void*)yoco_fwd, dim3(grid), dim3(NTHREADS), args, LDS_BYTES, stream);
    if (e != hipSuccess) fprintf(stderr, "kernel_launch: cooperative launch failed: %s\n", hipGetErrorString(e));
#else
    for (int p = 0; p < NPHASE; ++p) { a.ph_lo = p; a.ph_hi = p + 1; hipLaunchKernelGGL(yoco_fwd, dim3(grid), dim3(NTHREADS), LDS_BYTES, stream, a); }
#endif
}
```
